# Optimizing an MI355X kernel written in HIP

```python
import jax, jax.numpy as jnp
from jax import lax
import numpy as np

D_MODEL = 1024
BATCH = 2
SEQ = 8192
DEPTH = 2

HEAD_DIM = 64
Q_BLOCK = 128
CONV_WIDTH = 3
CONV_CH = 256
DSA_HEADS = 4
IDX_HEADS = 4
IDX_DIM = 64
DSA_TOPK_MAX = 256
FOX_HEADS = 4
SWA_HEADS = 4
SWA_KV_HEADS = 2
WINDOW = 128
N_BRANCH = 4
BRANCH_WIDTH = 256
D_FF = -(-8 * D_MODEL // (3 * 256)) * 256
RMS_EPS = 1e-6
N_MOD = 6

IN_SIZES = (
    CONV_CH, CONV_CH, CONV_CH,
    DSA_HEADS * HEAD_DIM, HEAD_DIM, HEAD_DIM,
    IDX_HEADS * IDX_DIM, IDX_DIM, IDX_HEADS,
    FOX_HEADS * HEAD_DIM, FOX_HEADS * HEAD_DIM, FOX_HEADS * HEAD_DIM, FOX_HEADS,
    SWA_HEADS * HEAD_DIM, SWA_KV_HEADS * HEAD_DIM, SWA_KV_HEADS * HEAD_DIM,
    N_BRANCH * D_MODEL,
)
IN_WIDTH = sum(IN_SIZES)

kernel_name = "hybrid_gated_parallel_mixers"


def _split(z, sizes):
    offs = [int(o) for o in np.cumsum(sizes)[:-1]]
    return jnp.split(z, offs, axis=-1)


def _alibi_slopes(n):
    return jnp.asarray(2.0 ** (-8.0 * np.arange(1, n + 1) / n), dtype=jnp.float32)


def _rmsnorm(x, g):
    xf = x.astype(jnp.float32)
    y = xf * lax.rsqrt(jnp.mean(xf * xf, axis=-1, keepdims=True) + RMS_EPS)
    return (y * g.astype(jnp.float32)).astype(x.dtype)


def _to_blocks(a, bsz, nb):
    return jnp.moveaxis(a.reshape(bsz, nb, Q_BLOCK, *a.shape[2:]), 1, 0)


def _short_conv(u, b_gate, c_gate, w_conv):
    z = c_gate * u
    kern = w_conv[:, None, :].astype(z.dtype)
    y = lax.conv_general_dilated(z, kern, window_strides=(1,), padding=[(CONV_WIDTH - 1, 0)],
                                 dimension_numbers=('NWC', 'WIO', 'NWC'),
                                 feature_group_count=z.shape[-1])
    return b_gate * y


def _dsa(q, k, v, qi, ki, wi, slopes):
    bsz, L = q.shape[:2]
    nb = L // Q_BLOCK
    topk = min(DSA_TOPK_MAX, L // 4)
    scale = HEAD_DIM ** -0.5
    key_pos = jnp.arange(L)

    def blk(args):
        qb, qib, wib, t0 = args
        qpos = t0 + jnp.arange(Q_BLOCK)
        s = jnp.einsum('bqhd,bkd->bqhk', qib, ki).astype(jnp.float32)
        score = jnp.einsum('bqh,bqhk->bqk', wib.astype(jnp.float32), jax.nn.relu(s))
        causal = key_pos[None, :] <= qpos[:, None]
        score = jnp.where(causal[None], score, -jnp.inf)
        _, idx = lax.top_k(score, topk)
        kg = jax.vmap(lambda kb, ib: kb[ib])(k, idx)
        vg = jax.vmap(lambda vb, ib: vb[ib])(v, idx)
        dist = qpos[None, :, None] - idx
        logits = jnp.einsum('bqhd,bqkd->bhqk', qb, kg).astype(jnp.float32) * scale
        logits = logits - slopes[None, :, None, None] * dist[:, None].astype(jnp.float32)
        logits = jnp.where((dist >= 0)[:, None], logits, -jnp.inf)
        p = jax.nn.softmax(logits, axis=-1).astype(vg.dtype)
        return jnp.einsum('bhqk,bqkd->bqhd', p, vg)

    out = lax.map(blk, (_to_blocks(q, bsz, nb), _to_blocks(qi, bsz, nb), _to_blocks(wi, bsz, nb),
                        jnp.arange(nb) * Q_BLOCK))
    return jnp.moveaxis(out, 0, 1).reshape(bsz, L, DSA_HEADS * HEAD_DIM)


def _fox(q, k, v, f_logit):
    bsz, L = q.shape[:2]
    nb = L // Q_BLOCK
    scale = HEAD_DIM ** -0.5
    F = jnp.cumsum(jax.nn.log_sigmoid(f_logit.astype(jnp.float32)), axis=1)
    Ft = jnp.moveaxis(F, 1, 2)
    Fq_blocks = jnp.moveaxis(Ft.reshape(bsz, FOX_HEADS, nb, Q_BLOCK), 2, 0)
    key_pos = jnp.arange(L)

    def blk(args):
        qb, Fq, t0 = args
        qpos = t0 + jnp.arange(Q_BLOCK)
        logits = (jnp.einsum('bqhd,bkhd->bhqk', qb, k).astype(jnp.float32) * scale
                  + Fq[..., None] - Ft[:, :, None, :])
        causal = key_pos[None, :] <= qpos[:, None]
        logits = jnp.where(causal, logits, -jnp.inf)
        p = jax.nn.softmax(logits, axis=-1).astype(v.dtype)
        return jnp.einsum('bhqk,bkhd->bqhd', p, v)

    out = lax.map(blk, (_to_blocks(q, bsz, nb), Fq_blocks, jnp.arange(nb) * Q_BLOCK))
    return jnp.moveaxis(out, 0, 1).reshape(bsz, L, FOX_HEADS * HEAD_DIM)


def _swa(q, k, v, sinks, slopes):
    bsz, L = q.shape[:2]
    nb = L // Q_BLOCK
    G = SWA_HEADS // SWA_KV_HEADS
    scale = HEAD_DIM ** -0.5
    qb = q.reshape(bsz, nb, Q_BLOCK, SWA_KV_HEADS, G, HEAD_DIM)

    def band(a):
        a = a.reshape(bsz, nb, Q_BLOCK, SWA_KV_HEADS, HEAD_DIM)
        prev = jnp.pad(a[:, :-1], ((0, 0), (1, 0), (0, 0), (0, 0), (0, 0)))
        return jnp.concatenate([prev, a], axis=2)

    kb, vb = band(k), band(v)
    logits = jnp.einsum('bnqhgd,bnshd->bnhgqs', qb, kb).astype(jnp.float32) * scale
    i = jnp.arange(Q_BLOCK)[:, None]
    j = jnp.arange(2 * Q_BLOCK)[None, :]
    dist = i - j + Q_BLOCK
    key_ok = (jnp.arange(nb)[:, None, None] * Q_BLOCK + j[None] - Q_BLOCK) >= 0
    valid = (dist >= 0)[None] & (dist < WINDOW)[None] & key_ok
    sl = slopes.reshape(SWA_KV_HEADS, G)
    logits = logits - sl[None, None, :, :, None, None] * dist.astype(jnp.float32)
    logits = jnp.where(valid[None, :, None, None], logits, -jnp.inf)
    sink = jnp.broadcast_to(sinks.astype(jnp.float32).reshape(SWA_KV_HEADS, G)[None, None, :, :, None, None],
                            logits.shape[:-1] + (1,))
    p = jax.nn.softmax(jnp.concatenate([logits, sink], axis=-1), axis=-1)[..., :-1].astype(vb.dtype)
    out = jnp.einsum('bnhgqs,bnshd->bnqhgd', p, vb)
    return out.reshape(bsz, L, SWA_HEADS * HEAD_DIM)


def _mixer(h, w_in, conv_w, fox_bias, swa_sinks, w_branch, w_o, swa_slopes, dsa_slopes):
    bsz, L, _ = h.shape
    z = h @ w_in
    (a_u, a_b, a_c, d_q, d_k, d_v, d_qi, d_ki, d_wi,
     f_q, f_k, f_v, f_f, s_q, s_k, s_v, g) = _split(z, IN_SIZES)
    heads = lambda t, n, dh: t.reshape(bsz, L, n, dh)
    y_a = _short_conv(a_u, a_b, a_c, conv_w)
    y_d = _dsa(heads(d_q, DSA_HEADS, HEAD_DIM), d_k, d_v, heads(d_qi, IDX_HEADS, IDX_DIM),
               d_ki, d_wi, dsa_slopes)
    y_f = _fox(heads(f_q, FOX_HEADS, HEAD_DIM), heads(f_k, FOX_HEADS, HEAD_DIM),
               heads(f_v, FOX_HEADS, HEAD_DIM), f_f + fox_bias)
    y_s = _swa(heads(s_q, SWA_HEADS, HEAD_DIM), heads(s_k, SWA_KV_HEADS, HEAD_DIM),
               heads(s_v, SWA_KV_HEADS, HEAD_DIM), swa_sinks, swa_slopes)
    ys = jnp.stack([y_a, y_d, y_f, y_s], axis=2)
    proj = jnp.einsum('blnc,ncd->blnd', ys, w_branch)
    gates = jax.nn.sigmoid(g.reshape(bsz, L, N_BRANCH, D_MODEL))
    return jnp.sum(gates * proj, axis=2) @ w_o


def setup_inputs(seed: int = 0) -> dict:
    key = jax.random.key(seed)
    ks = jax.random.split(key, 16)
    nrm = lambda k, shape, s: jax.random.normal(k, shape, jnp.float32) * s
    return {
        "x": nrm(ks[0], (BATCH, SEQ, D_MODEL), 1.0),
        "c": nrm(ks[1], (BATCH, D_MODEL), 1.0),
        "w_ada": nrm(ks[2], (DEPTH, D_MODEL, N_MOD * D_MODEL), 0.5 * D_MODEL ** -0.5),
        "b_ada": nrm(ks[3], (DEPTH, N_MOD * D_MODEL), 0.02),
        "norm_g": 1.0 + nrm(ks[4], (DEPTH, 4, D_MODEL), 0.05),
        "w_in": nrm(ks[5], (DEPTH, D_MODEL, IN_WIDTH), D_MODEL ** -0.5),
        "conv_w": nrm(ks[6], (DEPTH, CONV_WIDTH, CONV_CH), CONV_WIDTH ** -0.5),
        "fox_bias": 2.0 + nrm(ks[7], (DEPTH, FOX_HEADS), 0.5),
        "swa_sinks": nrm(ks[8], (DEPTH, SWA_HEADS), 0.5),
        "w_branch": nrm(ks[9], (DEPTH, N_BRANCH, BRANCH_WIDTH, D_MODEL), BRANCH_WIDTH ** -0.5),
        "w_o": nrm(ks[10], (DEPTH, D_MODEL, D_MODEL), D_MODEL ** -0.5),
        "w_gate": nrm(ks[11], (DEPTH, D_MODEL, D_FF), D_MODEL ** -0.5),
        "w_up": nrm(ks[12], (DEPTH, D_MODEL, D_FF), D_MODEL ** -0.5),
        "w_down": nrm(ks[13], (DEPTH, D_FF, D_MODEL), D_FF ** -0.5),
    }


def reference(x, c, w_ada, b_ada, norm_g, w_in, conv_w, fox_bias, swa_sinks, w_branch, w_o,
              w_gate, w_up, w_down):
    slopes = _alibi_slopes(SWA_HEADS + DSA_HEADS)
    swa_slopes, dsa_slopes = slopes[:SWA_HEADS], slopes[SWA_HEADS:]
    for l in range(DEPTH):
        mod = jax.nn.silu(c) @ w_ada[l] + b_ada[l]
        sh1, sc1, g1, sh2, sc2, g2 = [m[:, None, :] for m in jnp.split(mod, N_MOD, axis=-1)]
        h = _rmsnorm(x, norm_g[l, 0]) * (1.0 + sc1) + sh1
        y = _mixer(h, w_in[l], conv_w[l], fox_bias[l], swa_sinks[l], w_branch[l], w_o[l],
                   swa_slopes, dsa_slopes)
        x = x + g1 * _rmsnorm(y, norm_g[l, 1])
        h = _rmsnorm(x, norm_g[l, 2]) * (1.0 + sc2) + sh2
        y = (jax.nn.silu(h @ w_gate[l]) * (h @ w_up[l])) @ w_down[l]
        x = x + g2 * _rmsnorm(y, norm_g[l, 3])
    return x
```

```cpp
#include <hip/hip_runtime.h>
#include <hip/hip_cooperative_groups.h>
#include <cstdio>
#include <cstdint>
namespace cg = cooperative_groups;
namespace pg8 {
#define PG8_LAS __attribute__((address_space(3)))
typedef unsigned short bf16_t;
typedef short bf16x8 __attribute__((ext_vector_type(8)));
typedef float f32x4 __attribute__((ext_vector_type(4)));
typedef unsigned u32x4 __attribute__((ext_vector_type(4)));
typedef int v4i_t __attribute__((ext_vector_type(4)));
typedef int v8i_t __attribute__((ext_vector_type(8)));
constexpr int BM = 256, BK = 64, HALF = 128, HTB = HALF * BK * 2  , STAGE_BYTES = 8 * HTB, NXCD = 8, WGM = 8;

__host__ __device__ __forceinline__ int lds_byte(int r, int c) { const int st = (r >> 4) * 2 + (c >> 5), rr = r & 15, cc = c & 31, ob = rr * 64 + cc * 2; return st * 1024 + (ob ^ (((ob >> 9) & 1) << 5)); }
__host__ __device__ __forceinline__ void stage_rc(int b, int& R, int& C) { const int st = b / 1024, sb = b % 1024, swz = sb ^ (((sb >> 9) & 1) << 5); R = (st >> 1) * 16 + swz / 64; C = (st & 1) * 32 + (swz % 64) / 2; }
__host__ __device__ __forceinline__ int perm32(int rho) { const int n = rho >> 4, i = rho & 15; return 8 * (i >> 2) + 4 * n + (i & 3); }

struct Unit { int pm, pn; };
struct Gemm { const bf16_t* A; const bf16_t* Bt; int M, N, K; };

struct StaticOrder {
    int nM, nN, nwg, G, c;
    __host__ __device__ void init(int M, int N, int G_, int c_) { nM = M / BM; nN = N / BM; nwg = nM * nN; G = G_; c = c_; }
    __host__ __device__ bool next(int i, Unit& u) const {
        const long L = (long)i * G + c; if (L >= nwg) return false;
        int wgid = (int)L; { const int q = nwg / NXCD, r = nwg % NXCD, xcd = wgid % NXCD, off = wgid / NXCD; wgid = (xcd < r ? xcd * (q + 1) : r * (q + 1) + (xcd - r) * q) + off; }
        const int nig = WGM * nN, gid = wgid / nig, fm = gid * WGM, gsz = (nM - fm) < WGM ? (nM - fm) : WGM;
        u.pm = fm + ((wgid % nig) % gsz); u.pn = (wgid % nig) / gsz; return true;
    }
    __device__ __forceinline__ void a_ready(const Unit&) const {}
    __device__ __forceinline__ void done(const Unit&) const {}
};

__device__ __forceinline__ unsigned cvt_pk_bf16(float lo, float hi) { unsigned r; asm volatile("v_cvt_pk_bf16_f32 %0, %1, %2" : "=v"(r) : "v"(lo), "v"(hi)); return r; }
typedef float f32x2 __attribute__((ext_vector_type(2)));
#ifndef MERGE_FENCE
#define MERGE_FENCE 1
#endif
typedef unsigned u32x2 __attribute__((ext_vector_type(2)));
__device__ __forceinline__ float bf_lo(unsigned w) { return __uint_as_float(w << 16); }
__device__ __forceinline__ float bf_hi(unsigned w) { return __uint_as_float(w & 0xffff0000u); }
#ifdef PROBE_CHEAPSIG
__device__ __forceinline__ float sigmoidf_fast(float x) { return 0.5f + 0.25f * fminf(fmaxf(x, -2.0f), 2.0f); }
#else
__device__ __forceinline__ float sigmoidf_fast(float x) { return __builtin_amdgcn_rcpf(1.0f + __builtin_amdgcn_exp2f(-1.4426950408889634f * x)); }
#endif

struct EpiPlain {
    static constexpr bool PERM = true, AFTER_DRAIN = false;
    bf16_t* O; int ldc;
    __device__ __forceinline__ void operator()(const f32x4 (&acc)[2][2][4][2], const Unit& u, int wr, int wc, int fr, int fq) const {
        const int row0 = u.pm * BM + wr * 64 + fr, col0 = u.pn * BM + wc * 32 + 8 * fq;
#pragma unroll
        for (int ai = 0; ai < 2; ++ai)
#pragma unroll
            for (int m = 0; m < 4; ++m) { bf16_t* rowp = O + (size_t)(row0 + ai * HALF + m * 16) * ldc + col0;
#pragma unroll
                for (int bj = 0; bj < 2; ++bj) { const f32x4 v0 = acc[ai][bj][m][0], v1 = acc[ai][bj][m][1];
                    u32x4 w; w.x = cvt_pk_bf16(v0[0], v0[1]); w.y = cvt_pk_bf16(v0[2], v0[3]); w.z = cvt_pk_bf16(v1[0], v1[1]); w.w = cvt_pk_bf16(v1[2], v1[3]);
                    *(u32x4*)(rowp + bj * HALF) = w; } }
    }
};
struct EpiZ {
    static constexpr bool PERM = true, AFTER_DRAIN = false;
    bf16_t* Z; float* SM; unsigned char* G;
    __device__ __forceinline__ void operator()(const f32x4 (&acc)[2][2][4][2], const Unit& u, int wr, int wc, int fr, int fq) const {
        const int row0 = u.pm * BM + wr * 64 + fr;
        if (u.pn < 11) {
            const int col0 = u.pn * BM + wc * 32 + 8 * fq;
#pragma unroll
            for (int ai = 0; ai < 2; ++ai)
#pragma unroll
                for (int m = 0; m < 4; ++m) { bf16_t* rowp = Z + (size_t)(row0 + ai * HALF + m * 16) * 2816 + col0;
#pragma unroll
                    for (int bj = 0; bj < 2; ++bj) { const f32x4 v0 = acc[ai][bj][m][0], v1 = acc[ai][bj][m][1];
                        u32x4 w; w.x = cvt_pk_bf16(v0[0], v0[1]); w.y = cvt_pk_bf16(v0[2], v0[3]); w.z = cvt_pk_bf16(v1[0], v1[1]); w.w = cvt_pk_bf16(v1[2], v1[3]);
                        *(u32x4*)(rowp + bj * HALF) = w; } }
            if (u.pn == 10 && wc == 2 && fq == 0) {
#pragma unroll
                for (int ai = 0; ai < 2; ++ai)
#pragma unroll
                    for (int m = 0; m < 4; ++m) { float* sp = SM + (size_t)(row0 + ai * HALF + m * 16) * 8;
                        *(f32x4*)sp = acc[ai][1][m][0]; *(f32x4*)(sp + 4) = acc[ai][1][m][1]; }
            }
        } else {
            const int col0 = (u.pn - 11) * BM + wc * 32 + 8 * fq;
#pragma unroll
            for (int ai = 0; ai < 2; ++ai)
#pragma unroll
                for (int m = 0; m < 4; ++m) { unsigned char* rowp = G + (size_t)(row0 + ai * HALF + m * 16) * 4096 + col0;
#pragma unroll
                    for (int bj = 0; bj < 2; ++bj) { const f32x4 v0 = acc[ai][bj][m][0], v1 = acc[ai][bj][m][1];
                        unsigned b[8];
#pragma unroll
                        for (int k = 0; k < 4; ++k) { b[k] = (unsigned)(sigmoidf_fast(v0[k]) * 255.0f + 0.5f); b[4 + k] = (unsigned)(sigmoidf_fast(v1[k]) * 255.0f + 0.5f); }
                        u32x2 w; w.x = b[0] | (b[1] << 8) | (b[2] << 16) | (b[3] << 24); w.y = b[4] | (b[5] << 8) | (b[6] << 16) | (b[7] << 24);
                        *(u32x2*)(rowp + bj * HALF) = w; } }
        }
    }
};
struct EpiG {
    static constexpr bool PERM = false, AFTER_DRAIN = false;
    unsigned char* G;
    __device__ __forceinline__ void operator()(const f32x4 (&acc)[2][2][4][2], const Unit& u, int wr, int wc, int fr, int fq) const {
        unsigned ones_ = ~0u; asm volatile("" : "+s"(ones_)); const int ln_ = (int)__builtin_amdgcn_mbcnt_hi(ones_, __builtin_amdgcn_mbcnt_lo(ones_, 0u)); const int fr_ = ln_ & 15, fq_ = ln_ >> 4; (void)fr; (void)fq;
        const unsigned row0 = u.pm * BM + wr * 64 + fr_, col0 = u.pn * BM + wc * 32 + 4 * fq_;
        unsigned char* gb = G + col0;
#pragma unroll
        for (int ai = 0; ai < 2; ++ai)
#pragma unroll
            for (int m = 0; m < 4; ++m) { const unsigned ro = (row0 + ai * HALF + m * 16) * 4096u;
#pragma unroll
                for (int bj = 0; bj < 2; ++bj)
#pragma unroll
                    for (int n = 0; n < 2; ++n) { const f32x4 v0 = acc[ai][bj][m][n];
                        unsigned b[4];
#pragma unroll
                        for (int k = 0; k < 4; ++k) b[k] = (unsigned)(sigmoidf_fast(v0[k]) * 255.0f + 0.5f);
                        *(unsigned*)(gb + ro + bj * HALF + n * 16) = b[0] | (b[1] << 8) | (b[2] << 16) | (b[3] << 24); }
                asm volatile("" ::: "memory"); }
    }
};
struct EpiMerge {
    static constexpr bool PERM = true, AFTER_DRAIN = false;
    bf16_t* MG; const unsigned char* G;
    __device__ __forceinline__ void operator()(const f32x4 (&acc)[2][2][4][2], const Unit& u, int wr, int wc, int fr, int fq) const {
        const int n = u.pm >> 6, pm = u.pm & 63, pn = u.pn & 3;
        const unsigned row0 = pm * BM + wr * 64 + fr, col0 = pn * BM + wc * 32 + 8 * fq;
        const unsigned char* gbase = G + n * 1024 + col0; bf16_t* mbase = MG + col0;
#pragma unroll
        for (int ai = 0; ai < 2; ++ai) {
            u32x2 gw[4][2]; u32x4 old[4][2];
#pragma unroll
            for (int m = 0; m < 4; ++m)
#pragma unroll
                for (int bj = 0; bj < 2; ++bj) { const unsigned row = row0 + ai * HALF + m * 16;
                    gw[m][bj] = *(const u32x2*)(gbase + row * 4096u + bj * HALF);
                    if (n > 0) old[m][bj] = *(const u32x4*)(mbase + row * 1024u + bj * HALF); }
#pragma unroll
            for (int m = 0; m < 4; ++m)
#pragma unroll
                for (int bj = 0; bj < 2; ++bj) { const unsigned row = row0 + ai * HALF + m * 16;
                    const f32x4 v0 = acc[ai][bj][m][0], v1 = acc[ai][bj][m][1];
                    float r[8];
#pragma unroll
                    for (int k = 0; k < 4; ++k) { r[k] = v0[k] * ((float)((gw[m][bj].x >> (8 * k)) & 255u) * (1.0f / 255.0f)); r[4 + k] = v1[k] * ((float)((gw[m][bj].y >> (8 * k)) & 255u) * (1.0f / 255.0f)); }
                    if (n > 0) { const u32x4 o = old[m][bj];
                        r[0] += bf_lo(o.x); r[1] += bf_hi(o.x); r[2] += bf_lo(o.y); r[3] += bf_hi(o.y); r[4] += bf_lo(o.z); r[5] += bf_hi(o.z); r[6] += bf_lo(o.w); r[7] += bf_hi(o.w); }
                    u32x4 w; w.x = cvt_pk_bf16(r[0], r[1]); w.y = cvt_pk_bf16(r[2], r[3]); w.z = cvt_pk_bf16(r[4], r[5]); w.w = cvt_pk_bf16(r[6], r[7]);
                    *(u32x4*)(mbase + row * 1024u + bj * HALF) = w; }
            asm volatile("" ::: "memory");
        }
    }
};
struct EpiSwiglu {
    static constexpr bool PERM = true, AFTER_DRAIN = false;
    bf16_t* Hd;
    __device__ __forceinline__ void operator()(const f32x4 (&acc)[2][2][4][2], const Unit& u, int wr, int wc, int fr, int fq) const {
        const int row0 = u.pm * BM + wr * 64 + fr, j0 = u.pn * 128 + wc * 16 + 4 * fq;
#pragma unroll
        for (int ai = 0; ai < 2; ++ai)
#pragma unroll
            for (int m = 0; m < 4; ++m) { bf16_t* rowp = Hd + (size_t)(row0 + ai * HALF + m * 16) * 2816 + j0;
#pragma unroll
                for (int bj = 0; bj < 2; ++bj) { const f32x4 v0 = acc[ai][bj][m][0], v1 = acc[ai][bj][m][1];
                    const float h0 = v0[0] * sigmoidf_fast(v0[0]) * v0[1], h1 = v0[2] * sigmoidf_fast(v0[2]) * v0[3];
                    const float h2 = v1[0] * sigmoidf_fast(v1[0]) * v1[1], h3 = v1[2] * sigmoidf_fast(v1[2]) * v1[3];
                    u32x2 w; w.x = cvt_pk_bf16(h0, h1); w.y = cvt_pk_bf16(h2, h3);
                    *(u32x2*)(rowp + bj * 64) = w; } }
    }
};
template <bool H8> struct EpiSwiglu8 {
    static constexpr bool PERM = false, AFTER_DRAIN = false;
    bf16_t* Hd;
    __device__ __forceinline__ void operator()(const f32x4 (&acc)[2][2][4][2], const Unit& u, int wr, int wc, int fr, int fq) const {
        unsigned ones_ = ~0u; asm volatile("" : "+s"(ones_)); const int ln_ = (int)__builtin_amdgcn_mbcnt_hi(ones_, __builtin_amdgcn_mbcnt_lo(ones_, 0u)); const int fr_ = ln_ & 15, fq_ = ln_ >> 4; (void)fr; (void)fq;
        const unsigned row0 = u.pm * BM + wr * 64 + fr_, j0 = u.pn * 128 + wc * 16 + 2 * fq_;
        bf16_t* hb = Hd + j0; unsigned char* h8b = (unsigned char*)Hd + j0;
#pragma unroll
        for (int ai = 0; ai < 2; ++ai)
#pragma unroll
            for (int m = 0; m < 4; ++m) { const unsigned ro = (row0 + ai * HALF + m * 16) * 2816u;
#pragma unroll
                for (int bj = 0; bj < 2; ++bj)
#pragma unroll
                    for (int n = 0; n < 2; ++n) { const f32x4 v = acc[ai][bj][m][n];
                        const float h0 = v[0] * sigmoidf_fast(v[0]) * v[1], h1 = v[2] * sigmoidf_fast(v[2]) * v[3];
                        if (H8) *(unsigned short*)(h8b + ro + bj * 64 + n * 8) = (unsigned short)__builtin_amdgcn_cvt_pk_fp8_f32(h0, h1, 0u, false);
                        else *(unsigned*)(hb + ro + bj * 64 + n * 8) = cvt_pk_bf16(h0, h1); }
                asm volatile("" ::: "memory"); }
    }
};
struct EpiPlain8 {
    static constexpr bool PERM = false, AFTER_DRAIN = false;
    bf16_t* O; int ldc;
    __device__ __forceinline__ void operator()(const f32x4 (&acc)[2][2][4][2], const Unit& u, int wr, int wc, int fr, int fq) const {
        unsigned ones_ = ~0u; asm volatile("" : "+s"(ones_)); const int ln_ = (int)__builtin_amdgcn_mbcnt_hi(ones_, __builtin_amdgcn_mbcnt_lo(ones_, 0u)); const int fr_ = ln_ & 15, fq_ = ln_ >> 4; (void)fr; (void)fq;
        const unsigned row0 = u.pm * BM + wr * 64 + fr_, col0 = u.pn * BM + wc * 32 + 4 * fq_;
        bf16_t* ob = O + col0;
#pragma unroll
        for (int ai = 0; ai < 2; ++ai)
#pragma unroll
            for (int m = 0; m < 4; ++m) { const unsigned ro = (row0 + ai * HALF + m * 16) * (unsigned)ldc;
#pragma unroll
                for (int bj = 0; bj < 2; ++bj)
#pragma unroll
                    for (int n = 0; n < 2; ++n) { const f32x4 v = acc[ai][bj][m][n]; u32x2 w; w.x = cvt_pk_bf16(v[0], v[1]); w.y = cvt_pk_bf16(v[2], v[3]);
                        *(u32x2*)(ob + ro + bj * HALF + n * 16) = w; }
                asm volatile("" ::: "memory"); }
    }
};
struct MergeOrder {
    int G, c;
    __device__ __forceinline__ bool next(int i, Unit& u) const {
        const int t = (i >> 2) * G + c; if (t >= 256) return false;
        const int n = i & 3, pm = t >> 2, pn = t & 3;
        u.pm = n * 64 + pm; u.pn = n * 4 + pn; return true;
    }
    __device__ __forceinline__ void a_ready(const Unit&) const {}
    __device__ __forceinline__ void done(const Unit&) const {}
};
struct EpiMerge2 {
    static constexpr bool PERM = true, AFTER_DRAIN = false;
    bf16_t* MG; const unsigned char* G;
    mutable f32x4 tot[2][4][2];
    __device__ __forceinline__ void zero() const {
#pragma unroll
        for (int bj = 0; bj < 2; ++bj)
#pragma unroll
            for (int m = 0; m < 4; ++m)
#pragma unroll
                for (int k = 0; k < 2; ++k) tot[bj][m][k] = (f32x4){0.f, 0.f, 0.f, 0.f};
    }
    __device__ __forceinline__ void operator()(const f32x4 (&acc)[2][2][4][2], const Unit& u, int wr, int wc, int fr, int fq) const {
        const int n = u.pn >> 2, pn = u.pn & 3, pm = u.pm - n * 128;
        const unsigned row0 = pm * HALF + wr * 64 + fr, col0 = pn * BM + wc * 32 + 8 * fq;
        const unsigned char* gbase = G + n * 1024 + col0;
        u32x2 gw[4][2];
#pragma unroll
        for (int m = 0; m < 4; ++m)
#pragma unroll
            for (int bj = 0; bj < 2; ++bj) gw[m][bj] = *(const u32x2*)(gbase + (row0 + m * 16) * 4096u + bj * HALF);
#pragma unroll
        for (int m = 0; m < 4; ++m)
#pragma unroll
            for (int bj = 0; bj < 2; ++bj) {
#pragma unroll
                for (int k = 0; k < 4; ++k) { tot[bj][m][0][k] += acc[0][bj][m][0][k] * ((float)((gw[m][bj].x >> (8 * k)) & 255u) * (1.0f / 255.0f));
                                              tot[bj][m][1][k] += acc[0][bj][m][1][k] * ((float)((gw[m][bj].y >> (8 * k)) & 255u) * (1.0f / 255.0f)); } }
        if (n == 3) {
            bf16_t* mbase = MG + col0;
#pragma unroll
            for (int m = 0; m < 4; ++m)
#pragma unroll
                for (int bj = 0; bj < 2; ++bj) { const f32x4 t0 = tot[bj][m][0], t1 = tot[bj][m][1];
                    u32x4 w; w.x = cvt_pk_bf16(t0[0], t0[1]); w.y = cvt_pk_bf16(t0[2], t0[3]); w.z = cvt_pk_bf16(t1[0], t1[1]); w.w = cvt_pk_bf16(t1[2], t1[3]);
                    *(u32x4*)(mbase + (row0 + m * 16) * 1024u + bj * HALF) = w; }
            zero();
        }
    }
};
struct MergeOrder2 {
    int G, c;
    __device__ __forceinline__ bool next(int i, Unit& u) const {
        const int t = (i >> 2) * G + c; if (t >= 512) return false;
        const int n = i & 3, pm = t >> 2, pn = t & 3;
        u.pm = n * 128 + pm; u.pn = n * 4 + pn; return true;
    }
    __device__ __forceinline__ void a_ready(const Unit&) const {}
    __device__ __forceinline__ void done(const Unit&) const {}
};
struct Frag16x2 { bf16x8 k[2]; };
template <bool FP8> struct FragSel;
template <> struct FragSel<false> {
    typedef Frag16x2 type;
    static __device__ __forceinline__ type load(PG8_LAS unsigned char* p) { type f; f.k[0] = *(const PG8_LAS bf16x8*)p; f.k[1] = *(const PG8_LAS bf16x8*)(p + 1024); return f; }
    static __device__ __forceinline__ f32x4 mma(const type& w, const type& a, f32x4 c) {
        c = __builtin_amdgcn_mfma_f32_16x16x32_bf16(w.k[0], a.k[0], c, 0, 0, 0); return __builtin_amdgcn_mfma_f32_16x16x32_bf16(w.k[1], a.k[1], c, 0, 0, 0); }
};
template <> struct FragSel<true> {
    struct type { v4i_t lo, hi; };
    static __device__ __forceinline__ type load(PG8_LAS unsigned char* p) { type f; f.lo = *(const PG8_LAS v4i_t*)p; f.hi = *(const PG8_LAS v4i_t*)(p + 1024); return f; }
    static __device__ __forceinline__ f32x4 mma(const type& w, const type& a, f32x4 c) {
        return __builtin_amdgcn_mfma_scale_f32_16x16x128_f8f6f4(__builtin_shufflevector(w.lo, w.hi, 0, 1, 2, 3, 4, 5, 6, 7), __builtin_shufflevector(a.lo, a.hi, 0, 1, 2, 3, 4, 5, 6, 7), c, 0, 0, 0, 0x7a7a7a7a, 0, 0x7f7f7f7f); }
};
template <class Epi, class Sched, bool ALIGN_EPI = false, bool SP2 = false, bool FP8 = false, bool HALFM = false>
__device__ __forceinline__ void gemm_phase(PG8_LAS unsigned char* lds, const Gemm g, const Sched& S, const Epi& E, int wid_s) {
    unsigned ones_ = ~0u; asm volatile("" : "+s"(ones_));
    int tid_ = wid_s * 64 + (int)__builtin_amdgcn_mbcnt_hi(ones_, __builtin_amdgcn_mbcnt_lo(ones_, 0u)); asm volatile("" : "+v"(tid_));
    const int tid = tid_, wid = __builtin_amdgcn_readfirstlane(tid >> 6), lane = tid & 63, wr = wid >> 2, wc = wid & 3, fr = lane & 15, fq = lane >> 4;
    const int K = FP8 ? g.K / 2 : g.K, nt = K / BK;
    unsigned voffA[2], voffB[2];
#pragma unroll
    for (int i = 0; i < 2; ++i) { int R, C; stage_rc(tid * 16 + i * 8192, R, C); const int Rb = Epi::PERM ? ((R & ~31) + perm32(R & 31)) : R;
        voffA[i] = (unsigned)(R * K + C) * 2u; voffB[i] = (unsigned)(Rb * K + C) * 2u; }
    const size_t kstep = (size_t)(BK * 2);
    const size_t hstep = (size_t)HALF * K * 2;
    const size_t tstep = 2 * hstep;
    const unsigned ldsw = (unsigned)wid * 1024u;
    const unsigned ldsbase = (unsigned)(__UINTPTR_TYPE__)lds;
    const __amdgpu_buffer_rsrc_t srdA = __builtin_amdgcn_make_buffer_rsrc((void*)g.A, (short)0, 0x7fffffff, 0x00020000);
    const __amdgpu_buffer_rsrc_t srdB = __builtin_amdgcn_make_buffer_rsrc((void*)g.Bt, (short)0, 0x7fffffff, 0x00020000);
    const int aoff = lds_byte(wr * 64 + fr, fq * 8), boff = lds_byte(wc * 32 + fr, fq * 8);
#define PG8_SA(b, h) (((b) * 2 + (h)) * HTB)
#define PG8_SB(b, h) ((4 + (b) * 2 + (h)) * HTB)
#define PG8_STAGE(bufoff, gbase, voff, srd, base) do { const unsigned so_ = (unsigned)((const char*)(gbase) - (const char*)(base)); _Pragma("unroll") for (int _i = 0; _i < 2; ++_i) \
        asm volatile("s_mov_b32 m0, %0\n\ts_nop 0\n\tbuffer_load_dwordx4 %1, %2, %3 offen lds" :: "s"(ldsbase + (unsigned)(bufoff) + ldsw + (unsigned)(_i * 8192)), "v"((voff)[_i]), "s"(srd), "s"(so_) : "m0", "memory"); } while (0)
#define PG8_LDA(dst, b, h) do { _Pragma("unroll") for (int m = 0; m < 4; ++m) dst[m] = FragSel<FP8>::load(lds + PG8_SA(b, h) + aoff + m * 2048); } while (0)
#define PG8_LDB(dst, b, h) do { _Pragma("unroll") for (int n = 0; n < 2; ++n) dst[n] = FragSel<FP8>::load(lds + PG8_SB(b, h) + boff + n * 2048); } while (0)
#define PG8_MMA(ai, bj, At, Bt) do { __builtin_amdgcn_s_setprio(1); _Pragma("unroll") for (int m = 0; m < 4; ++m) _Pragma("unroll") for (int n = 0; n < 2; ++n) \
        acc[ai][bj][m][n] = FragSel<FP8>::mma(Bt[n], At[m], acc[ai][bj][m][n]); __builtin_amdgcn_s_setprio(0); } while (0)
#define PG8_WAIT_V(n) asm volatile("s_waitcnt vmcnt(" #n ")" ::: "memory")
#define PG8_WAIT_L(n) asm volatile("s_waitcnt lgkmcnt(" #n ")" ::: "memory")
#define PG8_BAR __builtin_amdgcn_s_barrier()
#define PG8_SCHED __builtin_amdgcn_sched_barrier(0)
    Unit cur, nxt; int ui = 0;
    if (!S.next(0, cur)) return;
    f32x4 acc[2][2][4][2];
#pragma unroll
    for (int a = 0; a < 2; ++a)
#pragma unroll
        for (int b = 0; b < 2; ++b)
#pragma unroll
            for (int m = 0; m < 4; ++m)
#pragma unroll
                for (int n = 0; n < 2; ++n) acc[a][b][m][n] = (f32x4){0.f, 0.f, 0.f, 0.f};
    typedef typename FragSel<FP8>::type frag_t;
    frag_t At[4], B0[2], B1[2];
    const size_t tstepA = HALFM ? hstep : tstep;
    const char* cA = (const char*)g.A + (size_t)cur.pm * tstepA; const char* cB = (const char*)g.Bt + (size_t)cur.pn * tstep;
    S.a_ready(cur);
    if constexpr (SP2) {
        PG8_STAGE(PG8_SB(0, 0), cB, voffB, srdB, g.Bt); PG8_STAGE(PG8_SB(0, 1), cB + hstep, voffB, srdB, g.Bt); PG8_STAGE(PG8_SA(0, 0), cA, voffA, srdA, g.A); PG8_STAGE(PG8_SA(0, 1), cA + hstep, voffA, srdA, g.A);
        if (wr == 1) PG8_BAR;
        PG8_WAIT_V(2); PG8_BAR;
        PG8_STAGE(PG8_SB(1, 0), cB + kstep, voffB, srdB, g.Bt); PG8_STAGE(PG8_SA(1, 0), cA + kstep, voffA, srdA, g.A); PG8_STAGE(PG8_SB(1, 1), cB + hstep + kstep, voffB, srdB, g.Bt);
        PG8_WAIT_V(6); PG8_BAR;
    } else {
        PG8_STAGE(PG8_SB(0, 0), cB, voffB, srdB, g.Bt); PG8_STAGE(PG8_SA(0, 0), cA, voffA, srdA, g.A); PG8_STAGE(PG8_SB(0, 1), cB + hstep, voffB, srdB, g.Bt); PG8_STAGE(PG8_SA(0, 1), cA + hstep, voffA, srdA, g.A);
        if (wr == 1) PG8_BAR;
        PG8_WAIT_V(4); PG8_BAR;
        PG8_STAGE(PG8_SB(1, 0), cB + kstep, voffB, srdB, g.Bt); PG8_STAGE(PG8_SA(1, 0), cA + kstep, voffA, srdA, g.A); PG8_STAGE(PG8_SB(1, 1), cB + hstep + kstep, voffB, srdB, g.Bt);
        PG8_WAIT_V(6); PG8_BAR;
    }
    for (;;) {
        const bool has_next = S.next(ui + 1, nxt);
        const char* nA = has_next ? (const char*)g.A + (size_t)nxt.pm * tstepA : cA; const char* nB = has_next ? (const char*)g.Bt + (size_t)nxt.pn * tstep : cB;
#pragma unroll 1
        for (int t = 0; t < nt; t += 2) {
            const bool last = (t == nt - 2);
            const char* a1 = cA + (size_t)(t + 1) * kstep;
            const char* a2 = last ? nA : cA + (size_t)(t + 2) * kstep; const char* b2 = last ? nB : cB + (size_t)(t + 2) * kstep;
            const char* a3 = a2 + kstep; const char* b3 = b2 + kstep;
            if (last && has_next) S.a_ready(nxt);
            if constexpr (SP2) {
            PG8_LDB(B0, 0, 0); PG8_LDB(B1, 0, 1); PG8_SCHED; PG8_LDA(At, 0, 0); PG8_STAGE(PG8_SA(1, 1), a1 + hstep, voffA, srdA, g.A);
            PG8_WAIT_V(8); PG8_WAIT_L(0); PG8_BAR; PG8_MMA(0, 0, At, B0); PG8_MMA(0, 1, At, B1); PG8_BAR; PG8_SCHED;
            if constexpr (!HALFM) PG8_LDA(At, 0, 1); PG8_STAGE(PG8_SB(0, 0), b2, voffB, srdB, g.Bt); PG8_STAGE(PG8_SB(0, 1), b2 + hstep, voffB, srdB, g.Bt); PG8_STAGE(PG8_SA(0, 0), a2, voffA, srdA, g.A);
            PG8_WAIT_V(8); PG8_WAIT_L(0); PG8_BAR; if constexpr (!HALFM) { PG8_MMA(1, 0, At, B0); PG8_MMA(1, 1, At, B1); } PG8_BAR; PG8_SCHED;
            PG8_LDB(B0, 1, 0); PG8_LDB(B1, 1, 1); PG8_SCHED; PG8_LDA(At, 1, 0); PG8_STAGE(PG8_SA(0, 1), a2 + hstep, voffA, srdA, g.A);
            PG8_WAIT_V(8); PG8_WAIT_L(0); PG8_BAR; PG8_MMA(0, 0, At, B0); PG8_MMA(0, 1, At, B1); PG8_BAR; PG8_SCHED;
            if constexpr (!HALFM) PG8_LDA(At, 1, 1); PG8_STAGE(PG8_SB(1, 0), b3, voffB, srdB, g.Bt); PG8_STAGE(PG8_SB(1, 1), b3 + hstep, voffB, srdB, g.Bt); PG8_STAGE(PG8_SA(1, 0), a3, voffA, srdA, g.A);
            PG8_WAIT_V(8); PG8_WAIT_L(0); PG8_BAR; if constexpr (!HALFM) { PG8_MMA(1, 0, At, B0); PG8_MMA(1, 1, At, B1); } PG8_BAR; PG8_SCHED;
            } else {
            PG8_LDB(B0, 0, 0); PG8_SCHED; PG8_LDA(At, 0, 0); PG8_STAGE(PG8_SA(1, 1), a1 + hstep, voffA, srdA, g.A);
            PG8_WAIT_L(8); PG8_BAR; PG8_WAIT_L(0); PG8_MMA(0, 0, At, B0); PG8_BAR; PG8_SCHED;
            PG8_LDB(B1, 0, 1); PG8_STAGE(PG8_SB(0, 0), b2, voffB, srdB, g.Bt);
            PG8_BAR; PG8_WAIT_L(0); PG8_MMA(0, 1, At, B1); PG8_BAR;
            if constexpr (!HALFM) PG8_LDA(At, 0, 1); PG8_STAGE(PG8_SA(0, 0), a2, voffA, srdA, g.A);
            PG8_BAR; PG8_WAIT_L(0); if constexpr (!HALFM) PG8_MMA(1, 0, At, B0); PG8_BAR; PG8_SCHED;
            PG8_STAGE(PG8_SB(0, 1), b2 + hstep, voffB, srdB, g.Bt);
            PG8_WAIT_V(6); PG8_BAR; if constexpr (!HALFM) PG8_MMA(1, 1, At, B1); PG8_BAR;
            PG8_LDB(B0, 1, 0); PG8_SCHED; PG8_LDA(At, 1, 0); PG8_STAGE(PG8_SA(0, 1), a2 + hstep, voffA, srdA, g.A);
            PG8_WAIT_L(8); PG8_BAR; PG8_WAIT_L(0); PG8_MMA(0, 0, At, B0); PG8_BAR; PG8_SCHED;
            PG8_LDB(B1, 1, 1); PG8_STAGE(PG8_SB(1, 0), b3, voffB, srdB, g.Bt);
            PG8_BAR; PG8_WAIT_L(0); PG8_MMA(0, 1, At, B1); PG8_BAR;
            if constexpr (!HALFM) PG8_LDA(At, 1, 1); PG8_STAGE(PG8_SA(1, 0), a3, voffA, srdA, g.A);
            PG8_BAR; PG8_WAIT_L(0); if constexpr (!HALFM) PG8_MMA(1, 0, At, B0); PG8_BAR; PG8_SCHED;
            PG8_STAGE(PG8_SB(1, 1), b3 + hstep, voffB, srdB, g.Bt);
            PG8_WAIT_V(6); PG8_BAR; if constexpr (!HALFM) PG8_MMA(1, 1, At, B1); PG8_BAR;
            }
        }
        if constexpr (ALIGN_EPI) { if (wr == 0) PG8_BAR; }
        if constexpr (!Epi::AFTER_DRAIN) { E(acc, cur, wr, wc, fr, fq); S.done(cur); }
        if (!has_next) break;
#pragma unroll
        for (int a = 0; a < 2; ++a)
#pragma unroll
            for (int b = 0; b < 2; ++b)
#pragma unroll
                for (int m = 0; m < 4; ++m)
#pragma unroll
                    for (int n = 0; n < 2; ++n) acc[a][b][m][n] = (f32x4){0.f, 0.f, 0.f, 0.f};
        cur = nxt; cA = nA; cB = nB; ++ui;
        if constexpr (ALIGN_EPI) { if (wr == 1) PG8_BAR; }
    }
    PG8_WAIT_V(0);
    if constexpr (!ALIGN_EPI) { if (wr == 0) PG8_BAR; }
    PG8_BAR;
    if constexpr (Epi::AFTER_DRAIN) { E.fused(acc, cur, wr, wc, fr, fq, lds, wid, lane); S.done(cur); }
#undef PG8_SA
#undef PG8_SB
#undef PG8_STAGE
#undef PG8_LDA
#undef PG8_LDB
#undef PG8_MMA
#undef PG8_WAIT_V
#undef PG8_WAIT_L
#undef PG8_BAR
#undef PG8_SCHED
}
}

typedef unsigned short bf16_t;
typedef short bf16x8 __attribute__((ext_vector_type(8)));
typedef short s16x4 __attribute__((ext_vector_type(4)));
typedef float f32x4 __attribute__((ext_vector_type(4)));
typedef float f32x16 __attribute__((ext_vector_type(16)));
typedef unsigned u32x4 __attribute__((ext_vector_type(4)));
typedef unsigned u32x2 __attribute__((ext_vector_type(2)));
#define LAS __attribute__((address_space(3)))

constexpr int D = 1024, BATCH = 2, SEQ = 8192, MROWS = BATCH * SEQ, DEPTH = 2;
constexpr int ZW = 2816, NW1 = 6912, INW = 6856, DFF = 2816, NGU = 5632, NMOD = 6 * D;
constexpr float RMS_EPS = 1e-6f, LOG2E = 1.4426950408889634f, C2 = 0.125f * 1.4426950408889634f;
constexpr int ZC_AU = 0, ZC_AB = 256, ZC_AC = 512, ZC_DQ = 768, ZC_DK = 1024, ZC_DV = 1088, ZC_DQI = 1152, ZC_DKI = 1408, ZC_FQ = 1472, ZC_FK = 1728, ZC_FV = 1984, ZC_SQ = 2240, ZC_SK = 2496, ZC_SV = 2624;

constexpr size_t MiB = 1u << 20;
constexpr size_t WS_KMAX = 4096;
constexpr size_t WS_MOD = 65536;
constexpr size_t WS_FCUM = WS_MOD + 98304;
constexpr size_t WS_SMALL = WS_FCUM + 262144;
constexpr size_t WS_W1T = 1 * MiB;
constexpr size_t WS_WG8 = WS_W1T + (size_t)2816 * D * 2;
constexpr size_t WS_WGU = WS_W1T + (size_t)NW1 * D * 2;
constexpr size_t WS_WBT = WS_WGU + (size_t)NGU * D * 2;
constexpr size_t WS_WOT = WS_WBT + (size_t)4 * D * 256 * 2;
constexpr size_t WS_WDT = WS_WOT + (size_t)D * D * 2;
constexpr size_t WS_H = 35 * MiB;
constexpr size_t WS_Z = 67 * MiB;
constexpr size_t WS_G = 155 * MiB;
constexpr size_t WS_MG = 219 * MiB;
constexpr size_t WS_END = 251 * MiB;
static_assert(WS_WDT + (size_t)D * DFF * 2 <= WS_H && WS_SMALL + 524288 <= WS_W1T, "ws map");

#ifndef FFN8
#define FFN8 1
#endif
#ifndef DOWN8
#define DOWN8 1
#endif
constexpr int LDS_BYTES = 151552;

struct Args {
    const float *x, *c, *w_ada, *b_ada, *norm_g, *w_in, *conv_w, *fox_bias, *swa_sinks, *w_branch, *w_o, *w_gate, *w_up, *w_down;
    float* out; unsigned char* ws;
};

__device__ __forceinline__ unsigned f2bf(float f) { unsigned u = __builtin_bit_cast(unsigned, f); return (u + 0x7fffu + ((u >> 16) & 1u)) >> 16; }
__device__ __forceinline__ unsigned pk2(float lo, float hi) { return f2bf(lo) | (f2bf(hi) << 16); }
__device__ __forceinline__ float bflo(unsigned w) { return __uint_as_float(w << 16); }
__device__ __forceinline__ float bfhi(unsigned w) { return __uint_as_float(w & 0xffff0000u); }

__device__ __forceinline__ float shf(float v, int src) { return __int_as_float(__builtin_amdgcn_ds_bpermute(src << 2, __float_as_int(v))); }
__device__ __forceinline__ unsigned shu(unsigned v, int src) { return (unsigned)__builtin_amdgcn_ds_bpermute(src << 2, (int)v); }
__device__ __forceinline__ float wave_sum(float v, int lane) {
#pragma unroll
    for (int o = 1; o < 64; o <<= 1) v += shf(v, lane ^ o);
    return v;
}
__device__ __forceinline__ int crow(int r, int hi) { return (r & 3) + 8 * (r >> 2) + 4 * hi; }
__device__ __forceinline__ float swap32_max(float m) { auto rr = __builtin_amdgcn_permlane32_swap(__float_as_uint(m), __float_as_uint(m), false, false); return fmaxf(__uint_as_float(rr[0]), __uint_as_float(rr[1])); }
__device__ __forceinline__ float swap32_sum(float m) { auto rr = __builtin_amdgcn_permlane32_swap(__float_as_uint(m), __float_as_uint(m), false, false); return __uint_as_float(rr[0]) + __uint_as_float(rr[1]); }
#define LDSWAIT() asm volatile("s_waitcnt lgkmcnt(0)" ::: "memory")
__device__ __forceinline__ int ftid(int wid_s) { unsigned ones = ~0u; asm volatile("" : "+s"(ones)); int t = wid_s * 64 + (int)__builtin_amdgcn_mbcnt_hi(ones, __builtin_amdgcn_mbcnt_lo(ones, 0u)); asm volatile("" : "+v"(t)); return t; }

__device__ __forceinline__ void ada_gemv(const Args& a, unsigned char* lds, int wid_s) {
    float* sc = (float*)lds;
    float* part = (float*)(lds + 8192);
    const int tid = ftid(wid_s), lane = tid & 63, wid = tid >> 6;
    for (int i = tid; i < 2 * D; i += 512) { const float v = a.c[i]; sc[i] = v / (1.0f + __expf(-v)); }
    __syncthreads();
    float* mod = (float*)(a.ws + WS_MOD);
    for (int item = blockIdx.x; item < DEPTH * (NMOD / 64); item += gridDim.x) {
        const int l = item / (NMOD / 64), jc = item % (NMOD / 64);
        const float* w = a.w_ada + (size_t)l * D * NMOD + (size_t)(wid * 128) * NMOD + jc * 64 + lane;
        float a0 = 0.f, a1 = 0.f;
#pragma unroll 32
        for (int k = 0; k < 128; ++k) { const float wv = w[(size_t)k * NMOD]; a0 += sc[wid * 128 + k] * wv; a1 += sc[D + wid * 128 + k] * wv; }
        part[(wid * 2 + 0) * 64 + lane] = a0; part[(wid * 2 + 1) * 64 + lane] = a1;
        __syncthreads();
        if (tid < 128) { const int b = tid >> 6, j = tid & 63; float s = 0.f;
#pragma unroll
            for (int w8 = 0; w8 < 8; ++w8) s += part[(w8 * 2 + b) * 64 + j];
            mod[((size_t)l * 2 + b) * NMOD + jc * 64 + j] = s + a.b_ada[(size_t)l * NMOD + jc * 64 + j]; }
        __syncthreads();
    }
}
__device__ __forceinline__ void transpose_item(const float* colptr, int ld, bf16_t* dst  , int dstK, float* scr, int lane) {
    float tv[32];
#pragma unroll
    for (int i = 0; i < 32; ++i) tv[i] = colptr ? colptr[(size_t)(2 * i + (lane >> 5)) * ld] : 0.f;
#pragma unroll
    for (int i = 0; i < 32; ++i) scr[(2 * i + (lane >> 5)) * 33 + (lane & 31)] = tv[i];
    LDSWAIT();
    const int c = lane & 7;
#pragma unroll
    for (int j = 0; j < 4; ++j) { const int n = (lane >> 3) + 8 * j; const float* s = scr + (8 * c) * 33 + n;
        u32x4 o; o.x = pk2(s[0 * 33], s[1 * 33]); o.y = pk2(s[2 * 33], s[3 * 33]); o.z = pk2(s[4 * 33], s[5 * 33]); o.w = pk2(s[6 * 33], s[7 * 33]);
        *(u32x4*)(dst + (size_t)n * dstK + 8 * c) = o; }
    LDSWAIT();
}
__device__ __forceinline__ void transpose_item_fp8(const float* colptr, int ld, unsigned char* dst  , int dstK, float scale, float* scr, int lane) {
    float tv[32];
#pragma unroll
    for (int i = 0; i < 32; ++i) tv[i] = colptr ? colptr[(size_t)(2 * i + (lane >> 5)) * ld] : 0.f;
#pragma unroll
    for (int i = 0; i < 32; ++i) scr[(2 * i + (lane >> 5)) * 33 + (lane & 31)] = tv[i];
    LDSWAIT();
    const int n = lane >> 1, kh = 32 * (lane & 1); const float* s = scr + kh * 33 + n;
    unsigned w[8];
#pragma unroll
    for (int q = 0; q < 8; ++q) { unsigned t = 0u;
        t = __builtin_amdgcn_cvt_pk_fp8_f32(s[(4 * q + 0) * 33] * scale, s[(4 * q + 1) * 33] * scale, t, false);
        t = __builtin_amdgcn_cvt_pk_fp8_f32(s[(4 * q + 2) * 33] * scale, s[(4 * q + 3) * 33] * scale, t, true);
        w[q] = t; }
    unsigned char* dp = dst + (size_t)n * dstK + kh;
    *(u32x4*)dp = (u32x4){w[0], w[1], w[2], w[3]}; *(u32x4*)(dp + 16) = (u32x4){w[4], w[5], w[6], w[7]};
    LDSWAIT();
}
__device__ __forceinline__ int w1_src_col(int n) {
    if (n < 1472) return n;
    if (n < 2240) return n + 4;
    if (n < 2752) return n + 8;
    if (n < 2756) return 1472 + (n - 2752);
    if (n < 2760) return 2244 + (n - 2756);
    if (n < 2816) return -1;
    return 2760 + (n - 2816);
}
__device__ __forceinline__ void convert_weights(const Args& a, int l, unsigned char* lds, int wid_s) {
    const int tid = ftid(wid_s), lane = tid & 63, wid = tid >> 6;
    float* scr = (float*)(lds + 16384) + wid * (64 * 33);
    const int gw = blockIdx.x * 8 + wid, NGW = gridDim.x * 8;
    constexpr int I_IN = 16 * 216, I_GU = 16 * 176, I_B = 512, I_O = 512, I_D = 44 * 32;
    bf16_t* W1T = (bf16_t*)(a.ws + WS_W1T); bf16_t* WGU = (bf16_t*)(a.ws + WS_WGU); bf16_t* WBT = (bf16_t*)(a.ws + WS_WBT); bf16_t* WOT = (bf16_t*)(a.ws + WS_WOT); bf16_t* WDT = (bf16_t*)(a.ws + WS_WDT);
    const int cl = lane & 31;
    for (int it = gw; it < I_IN + I_GU + I_B + I_O + I_D; it += NGW) {
        int r = it;
        if (r < I_IN) { const int kb = r / 216, nb = r % 216;
            if (nb < 88) { const int n = 32 * nb + cl, sc_ = w1_src_col(n);
                const float* cp = sc_ >= 0 ? a.w_in + (size_t)l * D * INW + (size_t)(64 * kb) * INW + sc_ : nullptr;
                transpose_item(cp, INW, W1T + (size_t)(32 * nb) * D + 64 * kb, D, scr, lane); }
            else { const int n = 32 * nb + cl;
                const float* cp = a.w_in + (size_t)l * D * INW + (size_t)(64 * kb) * INW + w1_src_col(n);
                transpose_item_fp8(cp, INW, a.ws + WS_WG8 + (size_t)(32 * (nb - 88)) * D + 64 * kb, D, 32.0f, scr, lane); }
            continue; }
        r -= I_IN;
        if (r < I_GU) { const int kb = r / 176, nb = r % 176, n = 32 * nb + cl;
            const float* cp = ((n & 1) ? a.w_up : a.w_gate) + (size_t)l * D * DFF + (size_t)(64 * kb) * DFF + (n >> 1);
#if FFN8
            transpose_item_fp8(cp, DFF, a.ws + WS_WGU + (size_t)(32 * nb) * D + 64 * kb, D, 32.0f, scr, lane); continue; }
#else
            transpose_item(cp, DFF, WGU + (size_t)(32 * nb) * D + 64 * kb, D, scr, lane); continue; }
#endif
        r -= I_GU;
        if (r < I_B) { const int nbr = r / 128, rr = r % 128, kb = rr / 32, nb = rr % 32;
            const float* cp = a.w_branch + ((size_t)(l * 4 + nbr) * 256 + 64 * kb) * D + 32 * nb + cl;
            transpose_item(cp, D, WBT + ((size_t)nbr * D + 32 * nb) * 256 + 64 * kb, 256, scr, lane); continue; }
        r -= I_B;
        if (r < I_O) { const int kb = r / 32, nb = r % 32;
            const float* cp = a.w_o + (size_t)l * D * D + (size_t)(64 * kb) * D + 32 * nb + cl;
            transpose_item(cp, D, WOT + (size_t)(32 * nb) * D + 64 * kb, D, scr, lane); continue; }
        r -= I_O;
        { const int kb = r / 32, nb = r % 32;
            const float* cp = a.w_down + (size_t)l * DFF * D + (size_t)(64 * kb) * D + 32 * nb + cl;
#if DOWN8
            transpose_item_fp8(cp, D, a.ws + WS_WDT + (size_t)(32 * nb) * DFF + 64 * kb, DFF, 32.0f, scr, lane); }
#else
            transpose_item(cp, D, WDT + (size_t)(32 * nb) * DFF + 64 * kb, DFF, scr, lane); }
#endif
    }
}

template <bool HAS_RAW, bool HAS_H, bool XIN16 = false, bool XOUT16 = false, bool HAS_H8 = false>
__device__ __forceinline__ void row_pass8(const void* xres_, const bf16_t* raw, void* xdst_, bf16_t* hdst, unsigned char* h8dst, const float* gate, const float* gam_out, const float* gam_in, const float* sc, const float* sh, int lane) {
    f32x4 A[4], B[4], C[4];
#pragma unroll
    for (int j = 0; j < 4; ++j) {
        if (HAS_RAW) A[j] = ((const f32x4*)gate)[lane + 64 * j] * ((const f32x4*)gam_out)[lane + 64 * j];
        if (HAS_H) { B[j] = ((const f32x4*)gam_in)[lane + 64 * j] * (((const f32x4*)sc)[lane + 64 * j] + 1.0f); C[j] = ((const f32x4*)sh)[lane + 64 * j]; }
    }
    const float* xres = (const float*)xres_; const bf16_t* xres16 = (const bf16_t*)xres_; float* xdst = (float*)xdst_; bf16_t* xdst16 = (bf16_t*)xdst_;
    f32x4 nv[4]; u32x2 nx[4], nr[4];
#pragma unroll
    for (int j = 0; j < 4; ++j) { if (XIN16) nx[j] = ((const u32x2*)xres16)[lane + 64 * j]; else nv[j] = ((const f32x4*)xres)[lane + 64 * j]; if (HAS_RAW) nr[j] = ((const u32x2*)raw)[lane + 64 * j]; }
#pragma unroll 1
    for (int r = 0; r < 8; ++r) {
        f32x4 v[4]; u32x2 w[4];
#pragma unroll
        for (int j = 0; j < 4; ++j) { if (XIN16) v[j] = (f32x4){bflo(nx[j].x), bfhi(nx[j].x), bflo(nx[j].y), bfhi(nx[j].y)}; else v[j] = nv[j]; if (HAS_RAW) w[j] = nr[j]; }
        if (r + 1 < 8) {
#pragma unroll
            for (int j = 0; j < 4; ++j) { if (XIN16) nx[j] = ((const u32x2*)(xres16 + (size_t)(r + 1) * D))[lane + 64 * j]; else nv[j] = ((const f32x4*)(xres + (size_t)(r + 1) * D))[lane + 64 * j];
                if (HAS_RAW) nr[j] = ((const u32x2*)(raw + (size_t)(r + 1) * D))[lane + 64 * j]; }
        }
        if (HAS_RAW) {
            f32x4 o[4]; float ss = 0.f;
#pragma unroll
            for (int j = 0; j < 4; ++j) { o[j] = (f32x4){bflo(w[j].x), bfhi(w[j].x), bflo(w[j].y), bfhi(w[j].y)}; ss += (o[j][0] * o[j][0] + o[j][1] * o[j][1]) + (o[j][2] * o[j][2] + o[j][3] * o[j][3]); }
            const float rstd = 1.0f / sqrtf(wave_sum(ss, lane) * (1.0f / D) + RMS_EPS);
#pragma unroll
            for (int j = 0; j < 4; ++j) { v[j] = v[j] + A[j] * (o[j] * rstd);
                if (XOUT16) { u32x2 pw; pw.x = pk2(v[j][0], v[j][1]); pw.y = pk2(v[j][2], v[j][3]); ((u32x2*)(xdst16 + (size_t)r * D))[lane + 64 * j] = pw; }
                else ((f32x4*)(xdst + (size_t)r * D))[lane + 64 * j] = v[j]; }
        }
        if (HAS_H) {
            float ss = 0.f;
#pragma unroll
            for (int j = 0; j < 4; ++j) ss += (v[j][0] * v[j][0] + v[j][1] * v[j][1]) + (v[j][2] * v[j][2] + v[j][3] * v[j][3]);
            const float rstd = 1.0f / sqrtf(wave_sum(ss, lane) * (1.0f / D) + RMS_EPS);
#pragma unroll
            for (int j = 0; j < 4; ++j) { const f32x4 h = v[j] * rstd * B[j] + C[j]; if (hdst) { u32x2 pw; pw.x = pk2(h[0], h[1]); pw.y = pk2(h[2], h[3]); ((u32x2*)(hdst + (size_t)r * D))[lane + 64 * j] = pw; }
                if (HAS_H8) { unsigned t8 = 0u; t8 = __builtin_amdgcn_cvt_pk_fp8_f32(h[0], h[1], t8, false); t8 = __builtin_amdgcn_cvt_pk_fp8_f32(h[2], h[3], t8, true); ((unsigned*)(h8dst + (size_t)r * D))[lane + 64 * j] = t8; } }
        }
    }
}

__device__ __forceinline__ void conv_phase(const Args& a, int l, int wid_s) {
    const bf16_t* Z = (const bf16_t*)(a.ws + WS_Z); bf16_t* Y0 = (bf16_t*)(a.ws + WS_H);
    const float* cw = a.conv_w + (size_t)l * 3 * 256;
    const int gt = blockIdx.x * 512 + ftid(wid_s), GT = gridDim.x * 512;
    for (int it = gt; it < MROWS * 32; it += GT) {
        const int row = it >> 5, ch = (it & 31) * 8, t = row & (SEQ - 1);
        float acc[8];
#pragma unroll
        for (int k = 0; k < 8; ++k) acc[k] = 0.f;
#pragma unroll
        for (int j = 0; j < 3; ++j) { const int dt = 2 - j; if (t - dt < 0) continue;
            const bf16_t* zr = Z + (size_t)(row - dt) * ZW;
            const u32x4 u = *(const u32x4*)(zr + ZC_AU + ch), cgt = *(const u32x4*)(zr + ZC_AC + ch);
            const f32x4 w0 = *(const f32x4*)(cw + j * 256 + ch), w1 = *(const f32x4*)(cw + j * 256 + ch + 4);
            acc[0] += w0[0] * bflo(u.x) * bflo(cgt.x); acc[1] += w0[1] * bfhi(u.x) * bfhi(cgt.x); acc[2] += w0[2] * bflo(u.y) * bflo(cgt.y); acc[3] += w0[3] * bfhi(u.y) * bfhi(cgt.y);
            acc[4] += w1[0] * bflo(u.z) * bflo(cgt.z); acc[5] += w1[1] * bfhi(u.z) * bfhi(cgt.z); acc[6] += w1[2] * bflo(u.w) * bflo(cgt.w); acc[7] += w1[3] * bfhi(u.w) * bfhi(cgt.w); }
        const u32x4 bg = *(const u32x4*)(Z + (size_t)row * ZW + ZC_AB + ch);
        u32x4 o; o.x = pk2(acc[0] * bflo(bg.x), acc[1] * bfhi(bg.x)); o.y = pk2(acc[2] * bflo(bg.y), acc[3] * bfhi(bg.y)); o.z = pk2(acc[4] * bflo(bg.z), acc[5] * bfhi(bg.z)); o.w = pk2(acc[6] * bflo(bg.w), acc[7] * bfhi(bg.w));
        *(u32x4*)(Y0 + (size_t)row * 256 + ch) = o;
    }
}

__device__ __forceinline__ void fox_scan(const Args& a, int l, int bh, unsigned char* lds, int wid_s) {
    const int tid = ftid(wid_s), lane = tid & 63, wid = tid >> 6, b = bh >> 2, h = bh & 3;
    const float* SM = (const float*)(a.ws + WS_SMALL); float* F2 = (float*)(a.ws + WS_FCUM) + (size_t)bh * SEQ;
    const float bias = a.fox_bias[l * 4 + h];
    float* wtot = (float*)lds;
    float v[16]; float run = 0.f;
#pragma unroll
    for (int i = 0; i < 16; ++i) { const float x = SM[((size_t)b * SEQ + tid * 16 + i) * 8 + 4 + h] + bias;
        const float ls = fminf(x, 0.f) - log1pf(__expf(-fabsf(x))); run += ls; v[i] = run; }
    float inc = run;
#pragma unroll
    for (int o = 1; o < 64; o <<= 1) { const float t = shf(inc, lane - o); if (lane >= o) inc += t; }
    if (lane == 63) wtot[wid] = inc;
    __syncthreads();
    float base = inc - run;
    for (int w = 0; w < wid; ++w) base += wtot[w];
#pragma unroll
    for (int i = 0; i < 16; ++i) F2[tid * 16 + i] = (base + v[i]) * LOG2E;
    __syncthreads();
}


__device__ __forceinline__ void fox_kmax_item(const Args& a, int l, int item, int wid_s) {
    const int tid = ftid(wid_s), lane = tid & 63, bh = item >> 3, chunk = item & 7, b = bh >> 2, h = bh & 3;
    const bf16_t* Z = (const bf16_t*)(a.ws + WS_Z);
    float mx = 0.f;
#pragma unroll
    for (int rr = 0; rr < 2; ++rr) { const bf16_t* kp = Z + ((size_t)b * SEQ + chunk * 1024 + rr * 512 + tid) * ZW + ZC_FK + h * 64; float q2 = 0.f;
#pragma unroll
        for (int i = 0; i < 8; ++i) { const u32x4 w = *(const u32x4*)(kp + 8 * i);
            q2 += bflo(w.x) * bflo(w.x) + bfhi(w.x) * bfhi(w.x) + bflo(w.y) * bflo(w.y) + bfhi(w.y) * bfhi(w.y) + bflo(w.z) * bflo(w.z) + bfhi(w.z) * bfhi(w.z) + bflo(w.w) * bflo(w.w) + bfhi(w.w) * bfhi(w.w); }
        mx = fmaxf(mx, q2); }
#pragma unroll
    for (int o = 1; o < 64; o <<= 1) mx = fmaxf(mx, shf(mx, lane ^ o));
    if (lane == 0) atomicMax((unsigned*)(a.ws + WS_KMAX) + l * 8 + bh, __float_as_uint(mx));
}

template <int MODE>
__device__ __forceinline__ void attn_unit(unsigned char* lds, const bf16_t* __restrict__ Z, bf16_t* __restrict__ Yn, int b, int head, int qb, const float* __restrict__ F2, float slope2, float sink2, int tile_lo, float kmax, int wid_s) {
    const int tid = ftid(wid_s), lane = tid & 63, r32 = lane & 31, hi = lane >> 5; const int wid = __builtin_amdgcn_readfirstlane(tid >> 6);
    constexpr int QOFF = MODE == 0 ? ZC_FQ : ZC_SQ, KOFF = MODE == 0 ? ZC_FK : ZC_SK, VOFF = MODE == 0 ? ZC_FV : ZC_SV;
    const int hk = MODE == 0 ? head : (head >> 1);
    const size_t rowbase = (size_t)b * SEQ;
    const int q0 = qb * 256, qa = q0 + 32 * wid, myq = qa + r32;
    unsigned char* Ks = lds; unsigned char* Vs = lds + 9216; float* Fk = (float*)(lds + 9216 + 12288); float* wsc = (float*)(lds + 49152) + wid * 64;
    bf16x8 qr[4];
    { const bf16_t* qp = Z + (rowbase + myq) * ZW + QOFF + head * 64 + hi * 8;
#pragma unroll
      for (int ks = 0; ks < 4; ++ks) qr[ks] = *(const bf16x8*)(qp + 16 * ks); }
    const float* Fh = MODE == 0 ? F2 + ((size_t)b * 4 + head) * SEQ : nullptr;
    const float fq2 = MODE == 0 ? Fh[myq] : 0.f;
    float m = -1e30f, l = 0.f; f32x16 o0, o1;
#pragma unroll
    for (int r = 0; r < 16; ++r) { o0[r] = 0.f; o1[r] = 0.f; }
    const int t_hi = (q0 + 255) >> 6;
    if (MODE == 0) {
        int* smin = (int*)(lds + 49152 + 2048);
        __syncthreads();
        if (tid == 0) *smin = 0x7fffffff;
        __syncthreads();
        if (tid < 256) {
            const int t = q0 + tid; const bf16_t* qp2 = Z + (rowbase + t) * ZW + QOFF + head * 64; float q2 = 0.f;
#pragma unroll
            for (int i = 0; i < 8; ++i) { const u32x4 w = *(const u32x4*)(qp2 + 8 * i);
                q2 += bflo(w.x) * bflo(w.x) + bfhi(w.x) * bfhi(w.x) + bflo(w.y) * bflo(w.y) + bfhi(w.y) * bfhi(w.y) + bflo(w.z) * bflo(w.z) + bfhi(w.z) * bfhi(w.z) + bflo(w.w) * bflo(w.w) + bfhi(w.w) * bfhi(w.w); }
            const float target = Fh[t] + (40.0f + 0.25f * sqrtf(q2) * kmax) * LOG2E;
            int lo = 0, hi2 = t;
            while (lo < hi2) { const int mid = (lo + hi2) >> 1; if (Fh[mid] <= target) hi2 = mid; else lo = mid + 1; }
            atomicMin(smin, lo);
        }
        __syncthreads();
        tile_lo = *smin >> 6;
    }
    const int srow = tid >> 3, sch = tid & 7;
    const int i16 = lane & 15;
    const LAS unsigned char* vtr_base = (const LAS unsigned char*)(Vs) + (4 * hi + (i16 >> 2)) * 192 + (16 * ((lane >> 4) & 1) + 4 * (i16 & 3)) * 2;
    u32x4 nk, nv4; float nf = 0.f;
    { const bf16_t* src = Z + (rowbase + 64 * t_hi + srow) * ZW;
      nk = *(const u32x4*)(src + KOFF + hk * 64 + sch * 8); nv4 = *(const u32x4*)(src + VOFF + hk * 64 + sch * 8);
      if (MODE == 0 && tid < 64) nf = Fh[64 * t_hi + tid]; }
    constexpr int ABUF = 24576;
    __syncthreads();
    { unsigned char* kb_ = Ks + (t_hi & 1) * ABUF; unsigned char* vb_ = Vs + (t_hi & 1) * ABUF;
      *(u32x4*)(kb_ + srow * 144 + sch * 16) = nk; *(u32x4*)(vb_ + srow * 192 + sch * 16) = nv4;
      if (MODE == 0 && tid < 64) (Fk + (t_hi & 1) * (ABUF / 4))[tid] = nf; }
    if (t_hi > tile_lo) { const bf16_t* src = Z + (rowbase + 64 * (t_hi - 1) + srow) * ZW;
      nk = *(const u32x4*)(src + KOFF + hk * 64 + sch * 8); nv4 = *(const u32x4*)(src + VOFF + hk * 64 + sch * 8);
      if (MODE == 0 && tid < 64) nf = Fh[64 * (t_hi - 1) + tid]; }
    for (int T = t_hi; T >= tile_lo; --T) {
        __syncthreads();
        if (T > tile_lo) {
            unsigned char* kb_ = Ks + ((T - 1) & 1) * ABUF; unsigned char* vb_ = Vs + ((T - 1) & 1) * ABUF;
            *(u32x4*)(kb_ + srow * 144 + sch * 16) = nk; *(u32x4*)(vb_ + srow * 192 + sch * 16) = nv4;
            if (MODE == 0 && tid < 64) (Fk + ((T - 1) & 1) * (ABUF / 4))[tid] = nf;
            if (T - 1 > tile_lo) { const bf16_t* src = Z + (rowbase + 64 * (T - 2) + srow) * ZW;
              nk = *(const u32x4*)(src + KOFF + hk * 64 + sch * 8); nv4 = *(const u32x4*)(src + VOFF + hk * 64 + sch * 8);
              if (MODE == 0 && tid < 64) nf = Fh[64 * (T - 2) + tid]; }
        }
        const unsigned char* Kc = Ks + (T & 1) * ABUF; const float* Fc = Fk + (T & 1) * (ABUF / 4); const int vofs = (T & 1) * ABUF;
        const bool part = (64 * T <= qa + 31) && (MODE == 0 || (64 * T + 63 >= qa - 127));
        if (part) {
            f32x16 p0, p1;
#pragma unroll
            for (int r = 0; r < 16; ++r) { p0[r] = 0.f; p1[r] = 0.f; }
#pragma unroll
            for (int ks = 0; ks < 4; ++ks) {
                const bf16x8 k0 = *(const bf16x8*)(Kc + r32 * 144 + (16 * ks + 8 * hi) * 2);
                const bf16x8 k1 = *(const bf16x8*)(Kc + (32 + r32) * 144 + (16 * ks + 8 * hi) * 2);
                p0 = __builtin_amdgcn_mfma_f32_32x32x16_bf16(k0, qr[ks], p0, 0, 0, 0);
                p1 = __builtin_amdgcn_mfma_f32_32x32x16_bf16(k1, qr[ks], p1, 0, 0, 0);
            }
            const int kvb = 64 * T + 4 * hi;
            float mx = -INFINITY;
#pragma unroll
            for (int g = 0; g < 4; ++g) {
                f32x4 fk0 = {0.f, 0.f, 0.f, 0.f}, fk1 = {0.f, 0.f, 0.f, 0.f};
                if (MODE == 0) { fk0 = *(const f32x4*)(Fc + 8 * g + 4 * hi); fk1 = *(const f32x4*)(Fc + 32 + 8 * g + 4 * hi); }
#pragma unroll
                for (int i = 0; i < 4; ++i) { const int r = 4 * g + i, kv0 = kvb + 8 * g + i, kv1 = kv0 + 32;
                    float x0, x1;
                    if (MODE == 0) { x0 = p0[r] * C2 + (fq2 - fk0[i]); x1 = p1[r] * C2 + (fq2 - fk1[i]); if (kv0 > myq) x0 = -INFINITY; if (kv1 > myq) x1 = -INFINITY; }
                    else { const int d0 = myq - kv0, d1 = myq - kv1; x0 = p0[r] * C2 - slope2 * (float)d0; x1 = p1[r] * C2 - slope2 * (float)d1; if (d0 < 0 || d0 >= 128) x0 = -INFINITY; if (d1 < 0 || d1 >= 128) x1 = -INFINITY; }
                    p0[r] = x0; p1[r] = x1; mx = fmaxf(mx, fmaxf(x0, x1)); }
            }
            mx = swap32_max(mx);
            const float mn = fmaxf(m, mx), alpha = __builtin_amdgcn_exp2f(m - mn); m = mn;
            float ps = 0.f;
#pragma unroll
            for (int r = 0; r < 16; ++r) { p0[r] = __builtin_amdgcn_exp2f(p0[r] - mn); p1[r] = __builtin_amdgcn_exp2f(p1[r] - mn); ps += p0[r] + p1[r]; }
            l = l * alpha + ps;
            if (hi == 0) wsc[r32] = alpha;
            LDSWAIT();
#pragma unroll
            for (int g = 0; g < 4; ++g) { const f32x4 a4 = *(const f32x4*)(wsc + 8 * g + 4 * hi);
#pragma unroll
                for (int i = 0; i < 4; ++i) { o0[4 * g + i] *= a4[i]; o1[4 * g + i] *= a4[i]; } }
            LDSWAIT();
#pragma unroll
            for (int s = 0; s < 4; ++s) {
                u32x4 pw;
                if (s < 2) { const int e = 8 * s; pw.x = pk2(p0[e], p0[e + 1]); pw.y = pk2(p0[e + 2], p0[e + 3]); pw.z = pk2(p0[e + 4], p0[e + 5]); pw.w = pk2(p0[e + 6], p0[e + 7]); }
                else { const int e = 8 * (s - 2); pw.x = pk2(p1[e], p1[e + 1]); pw.y = pk2(p1[e + 2], p1[e + 3]); pw.z = pk2(p1[e + 4], p1[e + 5]); pw.w = pk2(p1[e + 6], p1[e + 7]); }
                const bf16x8 pa = __builtin_bit_cast(bf16x8, pw);
#pragma unroll
                for (int db = 0; db < 2; ++db) {
                    const LAS unsigned char* vp = vtr_base + vofs + (16 * s) * 192 + 64 * db;
                    const s16x4 lo = __builtin_bit_cast(s16x4, __builtin_amdgcn_ds_read_tr16_b64_v4i16((LAS s16x4*)vp));
                    const s16x4 hv = __builtin_bit_cast(s16x4, __builtin_amdgcn_ds_read_tr16_b64_v4i16((LAS s16x4*)(vp + 8 * 192)));
                    const bf16x8 vf = (bf16x8){lo[0], lo[1], lo[2], lo[3], hv[0], hv[1], hv[2], hv[3]};
                    if (db == 0) o0 = __builtin_amdgcn_mfma_f32_32x32x16_bf16(pa, vf, o0, 0, 0, 0); else o1 = __builtin_amdgcn_mfma_f32_32x32x16_bf16(pa, vf, o1, 0, 0, 0);
                }
            }
        }
    }
    float lt = swap32_sum(l);
    if (MODE == 1) lt += __builtin_amdgcn_exp2f(sink2 - m);
    const float inv = 1.0f / lt;
    LDSWAIT();
    if (hi == 0) wsc[32 + r32] = inv;
    LDSWAIT();
#pragma unroll
    for (int g = 0; g < 4; ++g) { const f32x4 iv = *(const f32x4*)(wsc + 32 + 8 * g + 4 * hi);
#pragma unroll
        for (int i = 0; i < 4; ++i) { const int r = 4 * g + i, q = qa + 8 * g + 4 * hi + i;
            bf16_t* yp = Yn + (rowbase + q) * 256 + head * 64 + r32;
            yp[0] = (bf16_t)f2bf(o0[r] * iv[i]); yp[32] = (bf16_t)f2bf(o1[r] * iv[i]); } }
    LDSWAIT();
}

__device__ __forceinline__ unsigned score_key(float s) { const unsigned u = __float_as_uint(s + 0.0f); return (u & 0x80000000u) ? ~u : (u | 0x80000000u); }
__device__ __forceinline__ void hist_find(const unsigned* hrow, int lane, unsigned need, unsigned& bin, unsigned& above) {
    unsigned w[16]; unsigned tot = 0;
#pragma unroll
    for (int i = 0; i < 16; i += 4) { const u32x4 t = *(const u32x4*)(hrow + 16 * lane + i); w[i] = t.x; w[i + 1] = t.y; w[i + 2] = t.z; w[i + 3] = t.w; }
#pragma unroll
    for (int i = 0; i < 16; ++i) tot += (w[i] & 0xffffu) + (w[i] >> 16);
    unsigned inc = tot;
#pragma unroll
    for (int o = 1; o < 64; o <<= 1) { const unsigned t = shu(inc, lane + o); if (lane + o < 64) inc += t; }
    const unsigned exc = inc - tot;
    const bool owner = (exc < need) && (inc >= need);
    unsigned run = exc, fb = 0, fa = 0; bool found = false;
#pragma unroll
    for (int i = 15; i >= 0; --i) {
        const unsigned hi = w[i] >> 16, lo = w[i] & 0xffffu;
        if (!found && run + hi >= need) { found = true; fb = 32 * lane + 2 * i + 1; fa = run; }
        run += hi;
        if (!found && run + lo >= need) { found = true; fb = 32 * lane + 2 * i; fa = run; }
        run += lo;
    }
    const unsigned long long bal = __ballot(owner);
    const int src = bal ? (int)__builtin_ctzll(bal) : 0;
    bin = shu(fb, src); above = shu(fa, src);
}
__device__ __forceinline__ void dsa_select_slow(const Args& a, unsigned char* lds, int b, int qb32, int wid_s) {
    const int tid = ftid(wid_s), lane = tid & 63; const int wid = __builtin_amdgcn_readfirstlane(tid >> 6);
    const int c16 = lane & 15, g = lane >> 4;
    const bf16_t* Z = (const bf16_t*)(a.ws + WS_Z); const float* SM = (const float*)(a.ws + WS_SMALL);
    unsigned short* IDX = (unsigned short*)(a.ws + WS_MG);
    unsigned* hist = (unsigned*)lds;
    unsigned char* kt = lds + 131072;
    const size_t rowbase = (size_t)b * SEQ;
    const int t0 = qb32 * 32, myt = t0 + 4 * wid + g;
    const int ntile = (t0 + 32 + 63) >> 6;
    bf16x8 af[2];
    { const int qq = c16 >> 2, h = c16 & 3; const bf16_t* qp = Z + (rowbase + t0 + 4 * wid + qq) * ZW + ZC_DQI + h * 64 + 8 * g;
      af[0] = *(const bf16x8*)qp; af[1] = *(const bf16x8*)(qp + 32); }
    const f32x4 wv = *(const f32x4*)(SM + (rowbase + myt) * 8);
    const unsigned need = (unsigned)((myt + 1) < 256 ? (myt + 1) : 256);
    unsigned b1 = 0, above1 = 0, thr22 = 0, quota = 0;
    unsigned tiecount = 0, outcount = 0;
    unsigned* myhist = hist + (size_t)(4 * wid + g) * 1024;
    unsigned short* myidx = IDX + (rowbase + myt) * 256;
    const int srow = tid >> 3, sch = tid & 7;
    for (int pass = 0; pass < 3; ++pass) {
        if (pass < 2) { unsigned z_ = 0u; asm volatile("" : "+v"(z_)); const u32x4 z4 = {z_, z_, z_, z_};
            for (int i = tid; i < 32 * 1024 / 4; i += 512) ((u32x4*)hist)[i] = z4; }
        for (int T = 0; T < ntile; ++T) {
            __syncthreads();
            *(u32x4*)(kt + srow * 144 + sch * 16) = *(const u32x4*)(Z + (rowbase + 64 * T + srow) * ZW + ZC_DKI + sch * 8);
            __syncthreads();
#pragma unroll
            for (int cg4 = 0; cg4 < 4; ++cg4) {
                const bf16x8 k0 = *(const bf16x8*)(kt + (16 * cg4 + c16) * 144 + (8 * g) * 2);
                const bf16x8 k1 = *(const bf16x8*)(kt + (16 * cg4 + c16) * 144 + (32 + 8 * g) * 2);
                f32x4 acc = {0.f, 0.f, 0.f, 0.f};
                acc = __builtin_amdgcn_mfma_f32_16x16x32_bf16(af[0], k0, acc, 0, 0, 0);
                acc = __builtin_amdgcn_mfma_f32_16x16x32_bf16(af[1], k1, acc, 0, 0, 0);
                const int key = 64 * T + 16 * cg4 + c16;
                const bool valid = key <= myt;
                const float sc = wv[0] * fmaxf(acc[0], 0.f) + wv[1] * fmaxf(acc[1], 0.f) + wv[2] * fmaxf(acc[2], 0.f) + wv[3] * fmaxf(acc[3], 0.f);
                const unsigned u = score_key(sc);
                if (pass == 0) { if (valid) { const unsigned bin = u >> 21; atomicAdd(myhist + (bin >> 1), (bin & 1u) ? 65536u : 1u); } }
                else if (pass == 1) { if (valid && (u >> 21) == b1) { const unsigned bin = (u >> 10) & 0x7ffu; atomicAdd(myhist + (bin >> 1), (bin & 1u) ? 65536u : 1u); } }
                else {
                    const unsigned p22 = u >> 10;
                    const bool tie = valid && (p22 == thr22);
                    const unsigned long long tb = __ballot(tie);
                    const unsigned tmask = (unsigned)(tb >> (16 * g)) & 0xffffu;
                    const bool acc_tie = tie && (tiecount + __popc(tmask & ((1u << c16) - 1u)) < quota);
                    tiecount += __popc(tmask);
                    const bool sel = (valid && p22 > thr22) || acc_tie;
                    const unsigned long long sb = __ballot(sel);
                    const unsigned smask = (unsigned)(sb >> (16 * g)) & 0xffffu;
                    if (sel) myidx[outcount + __popc(smask & ((1u << c16) - 1u))] = (unsigned short)key;
                    outcount += __popc(smask);
                }
            }
        }
        __syncthreads();
        if (pass == 0) {
#pragma unroll
            for (int qq = 0; qq < 4; ++qq) { const unsigned nd = shu(need, 16 * qq); unsigned bn, ab; hist_find(hist + (size_t)(4 * wid + qq) * 1024, lane, nd, bn, ab); if (g == qq) { b1 = bn; above1 = ab; } }
            __syncthreads();
        } else if (pass == 1) {
#pragma unroll
            for (int qq = 0; qq < 4; ++qq) { const unsigned nd = shu(need - above1, 16 * qq); unsigned bn, ab; hist_find(hist + (size_t)(4 * wid + qq) * 1024, lane, nd, bn, ab); if (g == qq) { thr22 = (b1 << 11) | bn; quota = need - above1 - ab; } }
            __syncthreads();
        }
    }
}


#ifndef SELREP
#define SELREP 0
#endif
constexpr int DS_CAP = 576, DS_RANK = 104;
constexpr unsigned ZCLASS = 0x80000000u >> 10;
__device__ __forceinline__ unsigned below_me(unsigned long long bal) { return __builtin_amdgcn_mbcnt_hi((unsigned)(bal >> 32), __builtin_amdgcn_mbcnt_lo((unsigned)bal, 0u)); }
__device__ __forceinline__ float relu1(float x) { return __builtin_amdgcn_fmed3f(x, 0.0f, 3.0e38f); }
__device__ __forceinline__ float idx_score_acc(const f32x4& acc, const f32x4& wv) {
    return fmaf(wv[3], relu1(acc[3]), fmaf(wv[2], relu1(acc[2]), fmaf(wv[1], relu1(acc[1]), wv[0] * relu1(acc[0])))) + 0.0f;
}
__device__ __forceinline__ unsigned fkey(float s) { const unsigned u = __float_as_uint(s); return (u & 0x80000000u) ? ~u : (u | 0x80000000u); }
__device__ __forceinline__ float key_to_float(unsigned k) { return k == 0u ? -INFINITY : __uint_as_float((k & 0x80000000u) ? (k & 0x7fffffffu) : ~k); }
__device__ __forceinline__ void idx_scores8(const unsigned char* kt, int c16, int g, const bf16x8 (&af)[2], const f32x4& wv, float (&u)[8]) {
    bf16x8 kf[8][2];
#pragma unroll
    for (int grp = 0; grp < 8; ++grp) { kf[grp][0] = *(const bf16x8*)(kt + (16 * grp + c16) * 144 + (8 * g) * 2); kf[grp][1] = *(const bf16x8*)(kt + (16 * grp + c16) * 144 + (32 + 8 * g) * 2); }
    __builtin_amdgcn_sched_barrier(0);
    f32x4 acc[8];
#pragma unroll
    for (int grp = 0; grp < 8; ++grp) acc[grp] = __builtin_amdgcn_mfma_f32_16x16x32_bf16(af[0], kf[grp][0], (f32x4){0.f, 0.f, 0.f, 0.f}, 0, 0, 0);
#pragma unroll
    for (int grp = 0; grp < 8; ++grp) acc[grp] = __builtin_amdgcn_mfma_f32_16x16x32_bf16(af[1], kf[grp][1], acc[grp], 0, 0, 0);
    __builtin_amdgcn_sched_barrier(0);
#pragma unroll
    for (int grp = 0; grp < 8; ++grp) u[grp] = idx_score_acc(acc[grp], wv);
}
__device__ __forceinline__ unsigned row_scan_incl(unsigned x) {
    x += (unsigned)__builtin_amdgcn_update_dpp(0, (int)x, 0x111, 0xF, 0xF, true);
    x += (unsigned)__builtin_amdgcn_update_dpp(0, (int)x, 0x112, 0xF, 0xF, true);
    x += (unsigned)__builtin_amdgcn_update_dpp(0, (int)x, 0x114, 0xF, 0xF, true);
    x += (unsigned)__builtin_amdgcn_update_dpp(0, (int)x, 0x118, 0xF, 0xF, true);
    return x;
}
__device__ __forceinline__ unsigned wave_total(unsigned x) {
    x = row_scan_incl(x);
    return (unsigned)__builtin_amdgcn_readlane((int)x, 15) + (unsigned)__builtin_amdgcn_readlane((int)x, 31) + (unsigned)__builtin_amdgcn_readlane((int)x, 47) + (unsigned)__builtin_amdgcn_readlane((int)x, 63);
}
__device__ __forceinline__ unsigned wave_max_u(unsigned x) {
    unsigned y;
    y = (unsigned)__builtin_amdgcn_update_dpp(0, (int)x, 0x111, 0xF, 0xF, true); x = x > y ? x : y;
    y = (unsigned)__builtin_amdgcn_update_dpp(0, (int)x, 0x112, 0xF, 0xF, true); x = x > y ? x : y;
    y = (unsigned)__builtin_amdgcn_update_dpp(0, (int)x, 0x114, 0xF, 0xF, true); x = x > y ? x : y;
    y = (unsigned)__builtin_amdgcn_update_dpp(0, (int)x, 0x118, 0xF, 0xF, true); x = x > y ? x : y;
    const unsigned a = (unsigned)__builtin_amdgcn_readlane((int)x, 15), b = (unsigned)__builtin_amdgcn_readlane((int)x, 31), c = (unsigned)__builtin_amdgcn_readlane((int)x, 47), d = (unsigned)__builtin_amdgcn_readlane((int)x, 63);
    const unsigned ab = a > b ? a : b, cd = c > d ? c : d; return ab > cd ? ab : cd;
}
template <bool EDGE, bool NEEDZ>
__device__ __forceinline__ void selB_groups(const float (&sc)[8], int keybase, int myt, float tauf, unsigned need, int lane, int c16, int g, unsigned& cnt, unsigned& zc, unsigned* curow, unsigned char* chrow, unsigned short* zlrow) {
    unsigned hm = 0u;
#pragma unroll
    for (int grp = 0; grp < 8; ++grp) {
        const float s = sc[grp];
        bool h = NEEDZ ? ((s >= tauf) && (s != 0.0f)) : (s >= tauf);
        if (EDGE) h = h && (keybase + 16 * grp + c16 <= myt);
        hm |= h ? (1u << grp) : 0u;
    }
    const unsigned nh = (unsigned)__popc(hm), inc = row_scan_incl(nh);
    unsigned pos = cnt + inc - nh;
    cnt += shu(inc, (lane & 48) | 15);
    unsigned rem = hm;
    while (__ballot(rem != 0u)) {
        if (rem) {
            const int grp = __builtin_ctz(rem); rem &= rem - 1u;
            const float a0 = (grp & 1) ? sc[1] : sc[0], a1 = (grp & 1) ? sc[3] : sc[2], a2 = (grp & 1) ? sc[5] : sc[4], a3 = (grp & 1) ? sc[7] : sc[6];
            const float b0 = (grp & 2) ? a1 : a0, b1 = (grp & 2) ? a3 : a2, s = (grp & 4) ? b1 : b0;
            const int key = keybase + 16 * grp + c16;
            if (pos < (unsigned)DS_CAP) { curow[pos] = (fkey(s) & 0xfffffc00u) | ((unsigned)key & 1023u); chrow[pos] = (unsigned char)(key >> 10); }
            ++pos;
        }
    }
    if (NEEDZ) {
        const unsigned lowm = (1u << c16) - 1u;
#pragma unroll
        for (int grp = 0; grp < 8; ++grp) {
            const int key = keybase + 16 * grp + c16;
            bool isz = sc[grp] == 0.0f;
            if (EDGE) isz = isz && (key <= myt);
            const unsigned zmask = (unsigned)(__ballot(isz) >> (16 * g)) & 0xffffu;
            const unsigned zpos = zc + __popc(zmask & lowm);
            if (isz && zpos < need) zlrow[zpos] = (unsigned short)key;
            zc += __popc(zmask);
        }
    }
}
__device__ __forceinline__ void dsa_select_item(const Args& a, unsigned char* lds, int b, int qb32, int wid_s) {
    const int tid = ftid(wid_s), lane = tid & 63; const int wid = __builtin_amdgcn_readfirstlane(tid >> 6);
    const int c16 = lane & 15, g = lane >> 4;
    const bf16_t* Z = (const bf16_t*)(a.ws + WS_Z); const float* SM = (const float*)(a.ws + WS_SMALL);
    unsigned short* IDX = (unsigned short*)(a.ws + WS_MG);
    unsigned short* samp = (unsigned short*)lds;
    unsigned char* ktA = lds + 131072;
    unsigned* cu = (unsigned*)lds;
    unsigned char* ch = lds + 73728;
    unsigned short* zl = (unsigned short*)(lds + 92160);
    unsigned char* ktB = lds + 108544;
    unsigned* flag = (unsigned*)(lds + 149760);
    const size_t rowbase = (size_t)b * SEQ;
    const int t0 = qb32 * 32, myt = t0 + 4 * wid + g, myrow = 4 * wid + g;
    bf16x8 af[2];
    { const int qq = c16 >> 2, h = c16 & 3; const bf16_t* qp = Z + (rowbase + t0 + 4 * wid + qq) * ZW + ZC_DQI + h * 64 + 8 * g;
      af[0] = *(const bf16x8*)qp; af[1] = *(const bf16x8*)(qp + 32); }
#ifdef PROBE_QTRUNC
    { u32x4 t0_ = __builtin_bit_cast(u32x4, af[0]), t1_ = __builtin_bit_cast(u32x4, af[1]); const unsigned mk = 0xfffcfffcu;
      t0_.x &= mk; t0_.y &= mk; t0_.z &= mk; t0_.w &= mk; t1_.x &= mk; t1_.y &= mk; t1_.z &= mk; t1_.w &= mk; af[0] = __builtin_bit_cast(bf16x8, t0_); af[1] = __builtin_bit_cast(bf16x8, t1_); }
#endif
    const f32x4 wv = *(const f32x4*)(SM + (rowbase + myt) * 8);
    const unsigned need = (unsigned)((myt + 1) < 256 ? (myt + 1) : 256);
    const int srow = tid >> 3, sch = tid & 7;
    __syncthreads();
    if (tid == 0) *flag = 0u;
    unsigned tau = 0u;
    for (int repA_ = 0; repA_ < ((SELREP & 1) ? 2 : 1); ++repA_)
    if (t0 + 32 > DS_CAP) {
        __syncthreads();
        const int ms = (t0 + 32) >> 2, ntA = (ms + 127) >> 7;
        const bf16_t* sbase = Z + (rowbase + 3) * ZW + ZC_DKI + sch * 8;
        u32x4 n0, n1;
        { const int i0 = srow < ms ? srow : ms - 1, i1 = 64 + srow < ms ? 64 + srow : ms - 1;
          n0 = *(const u32x4*)(sbase + (size_t)(4 * i0) * ZW); n1 = *(const u32x4*)(sbase + (size_t)(4 * i1) * ZW); }
        for (int T = 0; T < ntA; ++T) {
            __syncthreads();
            *(u32x4*)(ktA + srow * 144 + sch * 16) = n0; *(u32x4*)(ktA + (64 + srow) * 144 + sch * 16) = n1;
            __syncthreads();
            if (T + 1 < ntA) { const int j0 = 128 * (T + 1) + srow, j1 = j0 + 64; const int i0 = j0 < ms ? j0 : ms - 1, i1 = j1 < ms ? j1 : ms - 1;
                n0 = *(const u32x4*)(sbase + (size_t)(4 * i0) * ZW); n1 = *(const u32x4*)(sbase + (size_t)(4 * i1) * ZW); }
            float ua[8]; idx_scores8(ktA, c16, g, af, wv, ua);
#pragma unroll
            for (int grp = 0; grp < 8; ++grp) {
                const int i = 128 * T + 16 * grp + c16;
                samp[myrow * 2048 + i] = ((i < ms) && (4 * i + 3 <= myt)) ? (unsigned short)(fkey(ua[grp]) >> 16) : (unsigned short)0;
            }
        }
        LDSWAIT();
        const int nvalid = 128 * ntA;
        for (int repS_ = 0; repS_ < ((SELREP & 16) ? 2 : 1); ++repS_) {
            unsigned w[4][16];
#pragma unroll
            for (int qq = 0; qq < 4; ++qq) {
                const unsigned* sp = (const unsigned*)(samp + (4 * wid + qq) * 2048) + 16 * lane;
#pragma unroll
                for (int j = 0; j < 16; j += 4) { const u32x4 t4 = *(const u32x4*)(sp + j); w[qq][j] = t4.x; w[qq][j + 1] = t4.y; w[qq][j + 2] = t4.z; w[qq][j + 3] = t4.w; }
#pragma unroll
                for (int j = 0; j < 16; ++j) if (32 * lane + 2 * j >= nvalid) w[qq][j] = 0u;
            }
            unsigned T4[4] = {0u, 0u, 0u, 0u};
#pragma unroll 1
            for (int bit = 15; bit >= 0; --bit) {
                unsigned c[4];
#pragma unroll
                for (int qq = 0; qq < 4; ++qq) { const unsigned cand = T4[qq] | (1u << bit); unsigned cc = 0;
#pragma unroll
                    for (int j = 0; j < 16; ++j) cc += ((w[qq][j] & 0xffffu) >= cand ? 1u : 0u) + ((w[qq][j] >> 16) >= cand ? 1u : 0u);
                    c[qq] = cc; }
                const unsigned t01 = wave_total(c[0] | (c[1] << 16)), t23 = wave_total(c[2] | (c[3] << 16));
                if ((t01 & 0xffffu) >= (unsigned)DS_RANK) T4[0] |= 1u << bit;
                if ((t01 >> 16) >= (unsigned)DS_RANK) T4[1] |= 1u << bit;
                if ((t23 & 0xffffu) >= (unsigned)DS_RANK) T4[2] |= 1u << bit;
                if ((t23 >> 16) >= (unsigned)DS_RANK) T4[3] |= 1u << bit;
            }
#pragma unroll
            for (int qq = 0; qq < 4; ++qq) { const int n = t0 + 4 * wid + qq + 1; if (g == qq) tau = n > DS_CAP ? (T4[qq] << 16) : 0u; }
        }
    }
    unsigned cnt = 0u, zc = 0u;
    const float tauf = key_to_float(tau);
    const bool needz = __ballot(tauf <= 0.0f) != 0ull;
    const int ntile = (t0 + 32 + 127) >> 7;
    for (int repB_ = 0; repB_ < ((SELREP & 2) ? 2 : 1); ++repB_) { cnt = 0u; zc = 0u;
        const bf16_t* kbase = Z + (rowbase + srow) * ZW + ZC_DKI + sch * 8;
        u32x4 n0 = *(const u32x4*)kbase, n1 = *(const u32x4*)(kbase + (size_t)64 * ZW);
        __syncthreads();
        *(u32x4*)(ktB + srow * 144 + sch * 16) = n0; *(u32x4*)(ktB + (64 + srow) * 144 + sch * 16) = n1;
        __syncthreads();
        for (int T = 0; T < ntile; ++T) {
            const unsigned char* kt = ktB + (T & 1) * 18432;
            if (T + 1 < ntile) { const bf16_t* src = kbase + (size_t)(128 * (T + 1)) * ZW; n0 = *(const u32x4*)src; n1 = *(const u32x4*)(src + (size_t)64 * ZW); }
            float ub[8]; idx_scores8(kt, c16, g, af, wv, ub);
            if (128 * T + 127 <= t0) { if (needz) selB_groups<false, true>(ub, 128 * T, myt, tauf, need, lane, c16, g, cnt, zc, cu + myrow * DS_CAP, ch + myrow * DS_CAP, zl + myrow * 256);
                                       else selB_groups<false, false>(ub, 128 * T, myt, tauf, need, lane, c16, g, cnt, zc, cu + myrow * DS_CAP, ch + myrow * DS_CAP, zl + myrow * 256); }
            else { if (needz) selB_groups<true, true>(ub, 128 * T, myt, tauf, need, lane, c16, g, cnt, zc, cu + myrow * DS_CAP, ch + myrow * DS_CAP, zl + myrow * 256);
                   else selB_groups<true, false>(ub, 128 * T, myt, tauf, need, lane, c16, g, cnt, zc, cu + myrow * DS_CAP, ch + myrow * DS_CAP, zl + myrow * 256); }
            if (T + 1 < ntile) { unsigned char* kn = ktB + ((T + 1) & 1) * 18432; *(u32x4*)(kn + srow * 144 + sch * 16) = n0; *(u32x4*)(kn + (64 + srow) * 144 + sch * 16) = n1; }
            __syncthreads();
        }
    }
#if SELREP & 8
    {
        float dummy = 0.f;
        const bf16_t* kbase = Z + (rowbase + srow) * ZW + ZC_DKI + sch * 8;
        u32x4 n0 = *(const u32x4*)kbase, n1 = *(const u32x4*)(kbase + (size_t)64 * ZW);
        __syncthreads();
        *(u32x4*)(ktB + srow * 144 + sch * 16) = n0; *(u32x4*)(ktB + (64 + srow) * 144 + sch * 16) = n1;
        __syncthreads();
        for (int T = 0; T < ntile; ++T) {
            const unsigned char* kt = ktB + (T & 1) * 18432;
            if (T + 1 < ntile) { const bf16_t* src = kbase + (size_t)(128 * (T + 1)) * ZW; n0 = *(const u32x4*)src; n1 = *(const u32x4*)(src + (size_t)64 * ZW); }
            float ub[8]; idx_scores8(kt, c16, g, af, wv, ub);
#pragma unroll
            for (int grp = 0; grp < 8; ++grp) dummy += ub[grp];
            if (T + 1 < ntile) { unsigned char* kn = ktB + ((T + 1) & 1) * 18432; *(u32x4*)(kn + srow * 144 + sch * 16) = n0; *(u32x4*)(kn + (64 + srow) * 144 + sch * 16) = n1; }
            __syncthreads();
        }
        if (dummy == 123456.789f) *flag = 2u;
    }
#endif
    LDSWAIT();
    bool bad = false;
    for (int repC_ = 0; repC_ < ((SELREP & 4) ? 2 : 1); ++repC_) {
        unsigned ncq[4], ndq[4], nzq[4], uj[4][9], T4[4]; int topb[4];
#pragma unroll
        for (int qq = 0; qq < 4; ++qq) {
            ncq[qq] = (unsigned)__builtin_amdgcn_readlane((int)cnt, 16 * qq); ndq[qq] = (unsigned)__builtin_amdgcn_readlane((int)need, 16 * qq); nzq[qq] = (unsigned)__builtin_amdgcn_readlane((int)zc, 16 * qq);
            const unsigned ncl = ncq[qq] < (unsigned)DS_CAP ? ncq[qq] : (unsigned)DS_CAP;
            unsigned hi = 0u, lo = 0u;
#pragma unroll
            for (int j = 0; j < 9; ++j) { const unsigned pos = lane + 64 * j; const bool in = pos < ncl; uj[qq][j] = in ? (cu[(4 * wid + qq) * DS_CAP + pos] >> 10) : 0u;
                hi = hi > uj[qq][j] ? hi : uj[qq][j]; const unsigned x = in ? ~uj[qq][j] : 0u; lo = lo > x ? lo : x; }
            hi = wave_max_u(hi); lo = ~wave_max_u(lo);
            if (ncl == 0u) lo = hi;
            if (nzq[qq]) { hi = hi > ZCLASS ? hi : ZCLASS; lo = lo < ZCLASS ? lo : ZCLASS; }
            topb[qq] = (hi ^ lo) ? 31 - __builtin_clz(hi ^ lo) : -1;
            T4[qq] = topb[qq] >= 0 ? (hi & ~((2u << topb[qq]) - 1u)) : hi;
        }
#pragma unroll 1
        for (int bit = 21; bit >= 0; --bit) {
            unsigned c[4];
#pragma unroll
            for (int qq = 0; qq < 4; ++qq) { const unsigned cand = T4[qq] | (1u << bit); unsigned cc = 0;
#pragma unroll
                for (int j = 0; j < 9; ++j) cc += uj[qq][j] >= cand ? 1u : 0u;
                c[qq] = cc; }
            const unsigned t01 = wave_total(c[0] | (c[1] << 16)), t23 = wave_total(c[2] | (c[3] << 16));
            const unsigned tq[4] = {t01 & 0xffffu, t01 >> 16, t23 & 0xffffu, t23 >> 16};
#pragma unroll
            for (int qq = 0; qq < 4; ++qq) { const unsigned cand = T4[qq] | (1u << bit);
                if (bit <= topb[qq] && tq[qq] + (cand <= ZCLASS ? nzq[qq] : 0u) >= ndq[qq]) T4[qq] = cand; }
        }
#pragma unroll 1
        for (int qq = 0; qq < 4; ++qq) {
            const unsigned nc = ncq[qq], nd = ndq[qq], nz = nzq[qq], T = T4[qq];
            if (nc + nz < nd || nc > (unsigned)DS_CAP) { bad = true;
#ifdef NOFALLBACK
                { unsigned short* orow = IDX + (rowbase + t0 + 4 * wid + qq) * 256;
                  for (int j = 0; j < 4; ++j) if ((unsigned)(lane + 64 * j) < nd) orow[lane + 64 * j] = (unsigned short)(lane + 64 * j); }
#endif
                continue; }
            const int row = 4 * wid + qq;
            unsigned ujr[9], kj[9]; int ca = T < ZCLASS ? (int)nz : 0, nt = 0;
#pragma unroll
            for (int j = 0; j < 9; ++j) { const unsigned pos = lane + 64 * j; const unsigned cwj = pos < nc ? cu[row * DS_CAP + pos] : 0u; ujr[j] = cwj >> 10;
                kj[j] = pos < nc ? ((cwj & 1023u) | ((unsigned)ch[row * DS_CAP + pos] << 10)) : 0u;
                ca += __popcll(__ballot(ujr[j] > T)); nt += __popcll(__ballot(ujr[j] == T)); }
            const unsigned quota = nd - (unsigned)ca;
            unsigned Kstar = 0xffffu;
            if (T != ZCLASS && (unsigned)nt > quota) {
                unsigned K = 0u;
#pragma unroll 1
                for (int bit = 12; bit >= 0; --bit) { const unsigned test = K | (1u << bit); int c = 0;
#pragma unroll
                    for (int j = 0; j < 9; ++j) c += __popcll(__ballot(ujr[j] == T && kj[j] < test));
                    if ((unsigned)c < quota) K = test; }
                Kstar = K;
            }
            unsigned outbase = 0u;
            unsigned short* orow = IDX + (rowbase + t0 + row) * 256;
#pragma unroll
            for (int j = 0; j < 9; ++j) {
                const bool s = (ujr[j] > T) || (ujr[j] == T && kj[j] <= Kstar);
                const unsigned long long sb = __ballot(s);
                if (s) orow[outbase + below_me(sb)] = (unsigned short)kj[j];
                outbase += (unsigned)__popcll(sb);
            }
            const unsigned zsel = T < ZCLASS ? nz : (T == ZCLASS ? quota : 0u);
            for (unsigned i = lane; i < zsel; i += 64) orow[outbase + i] = zl[row * 256 + i];
        }
    }
    if (bad && lane == 0) atomicOr(flag, 1u);
    __syncthreads();
    const bool redo = *flag != 0u;
    __syncthreads();
#ifndef NOFALLBACK
    if (redo) dsa_select_slow(a, lds, b, qb32, wid_s);
#endif
}

constexpr int DA_WAVE_LDS = 512 + 64 * 160;
__device__ __forceinline__ void dsa_attend_wave(const Args& a, int gw, int NGW, int lane, unsigned char* wl) {
    const bf16_t* Z = (const bf16_t*)(a.ws + WS_Z); const unsigned short* IDXB = (const unsigned short*)(a.ws + WS_MG);
    bf16_t* Y1 = (bf16_t*)(a.ws + WS_H) + (size_t)MROWS * 256;
    const int c16 = lane & 15, g = lane >> 4, vr = lane >> 3, vc = lane & 7;
    unsigned short* il = (unsigned short*)wl; unsigned char* vl = wl + 512;
    const float slope2 = LOG2E * __builtin_amdgcn_exp2f(-(float)(5 + (c16 & 3)));
    const LAS unsigned char* vtr = (const LAS unsigned char*)vl + (4 * g + (c16 >> 2)) * 160 + (4 * (c16 & 3)) * 2;
    u32x2 iw = {0u, 0u};
    if (gw < MROWS) iw = *(const u32x2*)(IDXB + (size_t)gw * 256 + 4 * lane);
#pragma unroll 1
    for (int row = gw; row < MROWS; row += NGW) {
        const int t = row & (SEQ - 1); const size_t rowbase = (size_t)(row - t);
        const int nsel = (t + 1) < 256 ? (t + 1) : 256;
        { u32x2 w = iw; const int p0 = 4 * lane;
          if (p0 >= nsel) w.x &= 0xffff0000u; if (p0 + 1 >= nsel) w.x &= 0x0000ffffu; if (p0 + 2 >= nsel) w.y &= 0xffff0000u; if (p0 + 3 >= nsel) w.y &= 0x0000ffffu;
          *(u32x2*)(il + 4 * lane) = w; }
        if (row + NGW < MROWS) iw = *(const u32x2*)(IDXB + (size_t)(row + NGW) * 256 + 4 * lane);
        LDSWAIT();
        u32x4 v[8];
        const bf16_t* vb = Z + rowbase * ZW + ZC_DV + 8 * vc;
#pragma unroll
        for (int i = 0; i < 8; ++i) v[i] = *(const u32x4*)(vb + (size_t)il[8 * i + vr] * ZW);
        bf16x8 qf[2];
        { const bf16_t* qp = Z + (size_t)row * ZW + ZC_DQ + (c16 & 3) * 64 + 8 * g; const bf16x8 z8 = {0, 0, 0, 0, 0, 0, 0, 0};
          qf[0] = c16 < 4 ? *(const bf16x8*)qp : z8; qf[1] = c16 < 4 ? *(const bf16x8*)(qp + 32) : z8; }
        f32x4 s[16];
        const bf16_t* kb0 = Z + rowbase * ZW + ZC_DK + 8 * g;
        {
            bf16x8 kf[16][2];
#pragma unroll
            for (int kk = 0; kk < 16; ++kk) { const bf16_t* kp = kb0 + (size_t)il[16 * kk + c16] * ZW; kf[kk][0] = *(const bf16x8*)kp; kf[kk][1] = *(const bf16x8*)(kp + 32); }
            __builtin_amdgcn_sched_barrier(0);
#pragma unroll
            for (int kk = 0; kk < 16; ++kk) { f32x4 acc = {0.f, 0.f, 0.f, 0.f};
                acc = __builtin_amdgcn_mfma_f32_16x16x32_bf16(kf[kk][0], qf[0], acc, 0, 0, 0);
                acc = __builtin_amdgcn_mfma_f32_16x16x32_bf16(kf[kk][1], qf[1], acc, 0, 0, 0);
                s[kk] = acc; }
        }
        float mx = -INFINITY;
#pragma unroll
        for (int kb = 0; kb < 16; ++kb) {
            const u32x2 kw = *(const u32x2*)(il + 16 * kb + 4 * g); const int p0 = 16 * kb + 4 * g;
            const int k0 = kw.x & 0xffff, k1 = kw.x >> 16, k2 = kw.y & 0xffff, k3 = kw.y >> 16;
            s[kb][0] = p0 < nsel ? s[kb][0] * C2 - slope2 * (float)(t - k0) : -INFINITY;
            s[kb][1] = p0 + 1 < nsel ? s[kb][1] * C2 - slope2 * (float)(t - k1) : -INFINITY;
            s[kb][2] = p0 + 2 < nsel ? s[kb][2] * C2 - slope2 * (float)(t - k2) : -INFINITY;
            s[kb][3] = p0 + 3 < nsel ? s[kb][3] * C2 - slope2 * (float)(t - k3) : -INFINITY;
            mx = fmaxf(fmaxf(mx, fmaxf(s[kb][0], s[kb][1])), fmaxf(s[kb][2], s[kb][3]));
        }
        mx = fmaxf(mx, shf(mx, lane ^ 16)); mx = fmaxf(mx, shf(mx, lane ^ 32));
        float ls = 0.f;
#pragma unroll
        for (int kb = 0; kb < 16; ++kb) {
#pragma unroll
            for (int r = 0; r < 4; ++r) { s[kb][r] = __builtin_amdgcn_exp2f(s[kb][r] - mx); ls += s[kb][r]; } }
        ls += shf(ls, lane ^ 16); ls += shf(ls, lane ^ 32);
        f32x4 o[4];
#pragma unroll
        for (int db = 0; db < 4; ++db) o[db] = (f32x4){0.f, 0.f, 0.f, 0.f};
#pragma unroll
        for (int ch = 0; ch < 4; ++ch) {
            if (64 * ch < nsel) {
#pragma unroll
                for (int i = 0; i < 8; ++i) *(u32x4*)(vl + (8 * i + vr) * 160 + 16 * vc) = v[i];
                if (ch < 3 && 64 * (ch + 1) < nsel) {
#pragma unroll
                    for (int i = 0; i < 8; ++i) v[i] = *(const u32x4*)(vb + (size_t)il[64 * (ch + 1) + 8 * i + vr] * ZW);
                }
                LDSWAIT();
#pragma unroll
                for (int s2 = 0; s2 < 2; ++s2) {
                    const f32x4 pa4 = s[4 * ch + 2 * s2], pb4 = s[4 * ch + 2 * s2 + 1];
                    u32x4 pw; pw.x = pk2(pa4[0], pa4[1]); pw.y = pk2(pa4[2], pa4[3]); pw.z = pk2(pb4[0], pb4[1]); pw.w = pk2(pb4[2], pb4[3]);
                    const bf16x8 pa = __builtin_bit_cast(bf16x8, pw);
#pragma unroll
                    for (int db = 0; db < 4; ++db) {
                        const LAS unsigned char* vp = vtr + (32 * s2) * 160 + 32 * db;
                        const s16x4 lo = __builtin_bit_cast(s16x4, __builtin_amdgcn_ds_read_tr16_b64_v4i16((LAS s16x4*)vp));
                        const s16x4 hv = __builtin_bit_cast(s16x4, __builtin_amdgcn_ds_read_tr16_b64_v4i16((LAS s16x4*)(vp + 16 * 160)));
                        const bf16x8 vf = (bf16x8){lo[0], lo[1], lo[2], lo[3], hv[0], hv[1], hv[2], hv[3]};
                        o[db] = __builtin_amdgcn_mfma_f32_16x16x32_bf16(pa, vf, o[db], 0, 0, 0);
                    }
                }
                asm volatile("" ::: "memory");
            }
        }
        const int lsi = __float_as_int(ls);
        const float i0 = 1.0f / __int_as_float(__builtin_amdgcn_readlane(lsi, 0)), i1 = 1.0f / __int_as_float(__builtin_amdgcn_readlane(lsi, 1)), i2 = 1.0f / __int_as_float(__builtin_amdgcn_readlane(lsi, 2)), i3 = 1.0f / __int_as_float(__builtin_amdgcn_readlane(lsi, 3));
        if (g == 0) { bf16_t* yp = Y1 + (size_t)row * 256 + c16;
#pragma unroll
            for (int db = 0; db < 4; ++db) { yp[0 * 64 + 16 * db] = (bf16_t)f2bf(o[db][0] * i0); yp[1 * 64 + 16 * db] = (bf16_t)f2bf(o[db][1] * i1); yp[2 * 64 + 16 * db] = (bf16_t)f2bf(o[db][2] * i2); yp[3 * 64 + 16 * db] = (bf16_t)f2bf(o[db][3] * i3); } }
        LDSWAIT();
    }
}


#ifndef PHMASK
#define PHMASK 0xffff
#endif
#ifndef DUPMASK
#define DUPMASK 0
#endif
#ifndef DUPN
#define DUPN 2
#endif
#ifndef MERGE_SP2
#define MERGE_SP2 true
#endif
#ifndef G8_SP2
#define G8_SP2 false
#endif
#ifndef EXTRASYNC
#define EXTRASYNC 0
#endif
typedef __attribute__((address_space(1))) unsigned gu32;
#define XB_TMO      128
#define XB_XCNT(j)  (256  + 64 * (j))
#define XB_XSUB(j)  (1280 + 64 * (j))
#define XB_XGEN(j)  (2304 + 64 * (j))
#define XB_TOP      3328
#define XB_TOPGEN   3392
#define XCD_BAR_WORDS 3456
#define XB_SPIN_CAP (1u << 18)

__device__ __forceinline__ unsigned xb_ld(unsigned* p)              { return __hip_atomic_load(p, __ATOMIC_RELAXED, __HIP_MEMORY_SCOPE_AGENT); }
__device__ __forceinline__ unsigned xb_add(unsigned* p, unsigned v) { return __hip_atomic_fetch_add(p, v, __ATOMIC_RELAXED, __HIP_MEMORY_SCOPE_AGENT); }
__device__ __forceinline__ unsigned xb_xcc_id() { return (unsigned)__builtin_amdgcn_s_getreg((3 << 11) | 20) & 0xFu; }
#define XB_SPIN(cond, bar) do { unsigned _sp = 0; while (cond) { __builtin_amdgcn_s_sleep(1); \
    if ((++_sp & 255u) == 0u) { if (xb_ld(&(bar)[XB_TMO])) break; if (_sp > XB_SPIN_CAP) { atomicAdd(&(bar)[XB_TMO], 1u); break; } } } } while (0)

struct XcdBarrier {
    unsigned* bar; unsigned x; int w;
    volatile LAS unsigned* st;
};

__device__ __forceinline__ bool xb_first_lane(int w) { unsigned ones = ~0u; asm volatile("" : "+s"(ones)); return w == 0 && __builtin_amdgcn_mbcnt_hi(ones, __builtin_amdgcn_mbcnt_lo(ones, 0u)) == 0u; }
__device__ __forceinline__ XcdBarrier xcd_barrier_post(unsigned* bar, volatile LAS unsigned* st, int w) {
    XcdBarrier b; b.bar = bar; b.x = xb_xcc_id(); b.st = st; b.w = w;
    if (xb_first_lane(w)) (void)xb_add(&bar[XB_XCNT(b.x)], 1u);
    return b;
}
__device__ __forceinline__ void xcd_barrier_complete(unsigned* bar, unsigned x, unsigned& nloc, unsigned& nx) {
    const unsigned G = gridDim.x * gridDim.y * gridDim.z;
    unsigned sum, cnt, mine, sp = 0u;
    for (;;) {
        sum = 0u; cnt = 0u; mine = 0u;
#pragma unroll
        for (unsigned j = 0; j < 16; ++j) { const unsigned c = xb_ld(&bar[XB_XCNT(j)]); sum += c; cnt += (c > 0u) ? 1u : 0u; mine = (j == x) ? c : mine; }
        if (sum == G) break;
        __builtin_amdgcn_s_sleep(1);
        if ((++sp & 255u) == 0u) { if (xb_ld(&bar[XB_TMO])) break; if (sp > XB_SPIN_CAP) { atomicAdd(&bar[XB_TMO], 1u); break; } }
    }
    nloc = mine > 0u ? mine : 1u; nx = cnt > 0u ? cnt : 1u;
}

__device__ __forceinline__ void xcd_barrier(const XcdBarrier& b) {
    asm volatile("s_waitcnt vmcnt(0)" ::: "memory");
    __syncthreads();
    if (xb_first_lane(b.w)) {
        unsigned* bar = b.bar;
        __builtin_amdgcn_s_waitcnt(0);
        unsigned nloc = b.st[0], nx = b.st[1];
        if (nloc == 0u) { xcd_barrier_complete(bar, b.x, nloc, nx); b.st[0] = nloc; b.st[1] = nx; }
        const unsigned old = xb_add(&bar[XB_XSUB(b.x)], 1u);
        const unsigned gen = old / nloc;
        if (old + 1u == (gen + 1u) * nloc) {
            __builtin_amdgcn_fence(__ATOMIC_RELEASE, "agent");
            asm volatile("s_waitcnt vmcnt(0)" ::: "memory");
            const unsigned og = xb_add(&bar[XB_TOP], 1u);
            const unsigned tg = og / nx;
            if (og + 1u == (tg + 1u) * nx) xb_add(&bar[XB_TOPGEN], 1u);
            else XB_SPIN(xb_ld(&bar[XB_TOPGEN]) == tg, bar);
            __builtin_amdgcn_fence(__ATOMIC_ACQUIRE, "agent");
            xb_add(&bar[XB_XGEN(b.x)], 1u);
            asm volatile("s_waitcnt vmcnt(0)" ::: "memory");
        } else {
            XB_SPIN(xb_ld(&bar[XB_XGEN(b.x)]) == gen, bar);
            __builtin_amdgcn_fence(__ATOMIC_ACQUIRE, "agent");
            asm volatile("s_waitcnt vmcnt(0)" ::: "memory");
        }
    }
    __syncthreads();
}

constexpr size_t WS_BAR = 16384;
constexpr int LDS_BARST = LDS_BYTES - 16;
#define GRID_SYNC() xcd_barrier(bar)
typedef const __attribute__((address_space(4))) Args* kargs_ptr;
__device__ __forceinline__ Args fresh_args() {
#if defined(__HIP_DEVICE_COMPILE__)
    kargs_ptr p = (kargs_ptr)__builtin_amdgcn_kernarg_segment_ptr(); asm volatile("" : "+s"(p)); return *p;
#else
    return Args{};
#endif
}
#define FRESH() const int tid = ftid(wid_s), lane = tid & 63, wid = __builtin_amdgcn_readfirstlane(tid >> 6), gw = blockIdx.x * 8 + wid, NGW = gridDim.x * 8; (void)lane; (void)gw; (void)NGW
#define WSP(T, off) ((T*)(a.ws + (off)))
__global__ void __launch_bounds__(512, 2) mega(Args a_unused) {
    extern __shared__ __attribute__((aligned(16))) unsigned char lds[];
    PG8_LAS unsigned char* lds3 = (PG8_LAS unsigned char*)lds;
    const int wid_s = __builtin_amdgcn_readfirstlane(threadIdx.x >> 6);
    if (threadIdx.x < 4) ((volatile LAS unsigned*)(lds3 + LDS_BARST))[threadIdx.x] = 0u;
    __syncthreads();
    XcdBarrier bar; { const Args a0 = fresh_args(); bar = xcd_barrier_post((unsigned*)(a0.ws + WS_BAR), (volatile LAS unsigned*)(lds3 + LDS_BARST), wid_s); }

#if PHMASK & 1
    for (int rep_ = 0; rep_ < ((DUPMASK & 1) ? DUPN : 1); ++rep_) { if (rep_) GRID_SYNC();
    { const Args a = fresh_args(); if (blockIdx.x == 0 && threadIdx.x < 16) WSP(unsigned, WS_KMAX)[threadIdx.x] = 0u; ada_gemv(a, lds, wid_s); convert_weights(a, 0, lds, wid_s); }
    }
#endif
    GRID_SYNC();
#if PHMASK & 2
    for (int rep_ = 0; rep_ < ((DUPMASK & 2) ? DUPN : 1); ++rep_) { if (rep_) GRID_SYNC();
    { const Args a = fresh_args(); FRESH();
      for (int row = gw * 8; row < MROWS; row += NGW * 8) { const int b = row >> 13; const float* md = WSP(float, WS_MOD) + (size_t)(0 * 2 + b) * NMOD;
        row_pass8<false, true, false, false, true>(a.x + (size_t)row * D, nullptr, nullptr, WSP(bf16_t, WS_H) + (size_t)row * D, WSP(unsigned char, WS_MG) + (size_t)row * D, nullptr, nullptr, a.norm_g + 0 * D, md + 1 * D, md + 0 * D, lane); } }
    }
#endif
    GRID_SYNC();

#pragma unroll 1
    for (int l = 0; l < DEPTH; ++l) {
        for (int es_ = 0; es_ < EXTRASYNC; ++es_) GRID_SYNC();
#if PHMASK & 4
    for (int rep_ = 0; rep_ < ((DUPMASK & 4) ? DUPN : 1); ++rep_) { if (rep_) GRID_SYNC();
        { const Args a = fresh_args(); const int G = gridDim.x, bid = blockIdx.x;
          { pg8::Gemm g{WSP(bf16_t, WS_MG), WSP(bf16_t, WS_WG8), MROWS, 4 * D, D}; pg8::StaticOrder S; S.init(MROWS, 4 * D, G, bid);
            pg8::EpiG E{WSP(unsigned char, WS_G)};
            pg8::gemm_phase<pg8::EpiG, pg8::StaticOrder, true, G8_SP2, true>(lds3, g, S, E, wid_s); }
          { pg8::Gemm g{WSP(bf16_t, WS_H), WSP(bf16_t, WS_W1T), MROWS, 2816, D}; pg8::StaticOrder S; S.init(MROWS, 2816, G, (bid + 64) % G);
            pg8::EpiZ E{WSP(bf16_t, WS_Z), WSP(float, WS_SMALL), WSP(unsigned char, WS_G)};
            pg8::gemm_phase<pg8::EpiZ, pg8::StaticOrder, true, true>(lds3, g, S, E, wid_s); } }
    }
#endif
        GRID_SYNC();
#if PHMASK & 8
    for (int rep_ = 0; rep_ < ((DUPMASK & 8) ? DUPN : 1); ++rep_) { if (rep_) GRID_SYNC();
        { const Args a = fresh_args(); const int G = gridDim.x, bid = blockIdx.x;
          if (bid < 8) fox_scan(a, l, bid, lds, wid_s);
          for (int it = bid - 8; it >= 0 && it < 64; it += G) fox_kmax_item(a, l, it, wid_s);
          conv_phase(a, l, wid_s);
          for (int u = bid; u < 256; u += G) { const int b = u >> 7, head = (u >> 5) & 3, qb = u & 31;
            const float slope2 = LOG2E * __builtin_amdgcn_exp2f(-(float)(1 + head)), sink2 = LOG2E * a.swa_sinks[l * 4 + head];
            const int q0 = qb * 256, tlo = q0 >= 128 ? ((q0 - 127) >> 6) : 0;
            attn_unit<1>(lds, WSP(bf16_t, WS_Z), WSP(bf16_t, WS_H) + (size_t)3 * MROWS * 256, b, head, qb, nullptr, slope2, sink2, tlo, 0.f, wid_s); } }
    }
#endif
        __syncthreads();
#if PHMASK & 16
    for (int rep_ = 0; rep_ < ((DUPMASK & 16) ? DUPN : 1); ++rep_) { if (rep_) GRID_SYNC();
        { const Args a = fresh_args(); const int G = gridDim.x, bid = blockIdx.x;
          for (int u = bid; u < 256; u += G) { const int b = u & 1, j = u >> 1;
            dsa_select_item(a, lds, b, j, wid_s); dsa_select_item(a, lds, b, 255 - j, wid_s); } }
    }
#endif
        GRID_SYNC();
#if PHMASK & 32
    for (int rep_ = 0; rep_ < ((DUPMASK & 32) ? DUPN : 1); ++rep_) { if (rep_) GRID_SYNC();
        { const Args a = fresh_args(); const int G = gridDim.x, bid = blockIdx.x;
          for (int u = bid; u < 256; u += G) { const int b = u >> 7, head = (u >> 5) & 3, qb = u & 31;
            attn_unit<0>(lds, WSP(bf16_t, WS_Z), WSP(bf16_t, WS_H) + (size_t)2 * MROWS * 256, b, head, qb, WSP(const float, WS_FCUM), 0.f, 0.f, 0, sqrtf(__uint_as_float(WSP(const unsigned, WS_KMAX)[l * 8 + b * 4 + head])), wid_s); } }
    }
#endif
#if PHMASK & 64
    for (int rep_ = 0; rep_ < ((DUPMASK & 64) ? DUPN : 1); ++rep_) { if (rep_) GRID_SYNC();
        { const Args a = fresh_args(); FRESH(); __syncthreads(); dsa_attend_wave(a, gw, NGW, lane, lds + wid * DA_WAVE_LDS); __syncthreads(); }
    }
#endif
        GRID_SYNC();
#if PHMASK & 128
    for (int rep_ = 0; rep_ < ((DUPMASK & 128) ? DUPN : 1); ++rep_) { if (rep_) GRID_SYNC();
        { const Args a = fresh_args(); const int G = gridDim.x, bid = blockIdx.x;
          int kmerge = 256; asm volatile("" : "+s"(kmerge));
          pg8::Gemm g{WSP(bf16_t, WS_H), WSP(bf16_t, WS_WBT), 4 * MROWS, 4 * D, kmerge}; pg8::MergeOrder2 S{G, bid};
          pg8::EpiMerge2 E{WSP(bf16_t, WS_MG), WSP(unsigned char, WS_G)}; E.zero();
          pg8::gemm_phase<pg8::EpiMerge2, pg8::MergeOrder2, true, MERGE_SP2, false, true>(lds3, g, S, E, wid_s); }
    }
#endif
        GRID_SYNC();
#if PHMASK & 256
    for (int rep_ = 0; rep_ < ((DUPMASK & 256) ? DUPN : 1); ++rep_) { if (rep_) GRID_SYNC();
        { const Args a = fresh_args(); const int G = gridDim.x, bid = blockIdx.x;
          pg8::Gemm g{WSP(bf16_t, WS_MG), WSP(bf16_t, WS_WOT), MROWS, D, D}; pg8::StaticOrder S; S.init(MROWS, D, G, bid);
          pg8::EpiPlain E{WSP(bf16_t, WS_H), D};
          pg8::gemm_phase<pg8::EpiPlain, pg8::StaticOrder, true, true>(lds3, g, S, E, wid_s); }
    }
#endif
        GRID_SYNC();
#if PHMASK & 512
    for (int rep_ = 0; rep_ < ((DUPMASK & 512) ? DUPN : 1); ++rep_) { if (rep_) GRID_SYNC();
        { const Args a = fresh_args(); FRESH(); const float* ng = a.norm_g + (size_t)l * 4 * D;
          for (int row = gw * 8; row < MROWS; row += NGW * 8) { const int b = row >> 13; const float* md = WSP(float, WS_MOD) + (size_t)(l * 2 + b) * NMOD;
            bf16_t* x1g = WSP(bf16_t, WS_G) + (size_t)row * D; bf16_t* h2 = FFN8 ? nullptr : WSP(bf16_t, WS_MG) + (size_t)row * D; const bf16_t* rawp = WSP(bf16_t, WS_H) + (size_t)row * D;
            unsigned char* h28 = WSP(unsigned char, WS_G) + 32 * MiB + (size_t)row * D;
            if (l == 0) row_pass8<true, true, false, true, FFN8 != 0>(a.x + (size_t)row * D, rawp, x1g, h2, h28, md + 2 * D, ng + 1 * D, ng + 2 * D, md + 4 * D, md + 3 * D, lane);
            else row_pass8<true, true, true, true, FFN8 != 0>((const bf16_t*)a.out + (size_t)row * D, rawp, x1g, h2, h28, md + 2 * D, ng + 1 * D, ng + 2 * D, md + 4 * D, md + 3 * D, lane); } }
    }
#endif
        GRID_SYNC();
#if PHMASK & 1024
    for (int rep_ = 0; rep_ < ((DUPMASK & 1024) ? DUPN : 1); ++rep_) { if (rep_) GRID_SYNC();
        { const Args a = fresh_args(); const int G = gridDim.x, bid = blockIdx.x;
#if FFN8
          pg8::Gemm g{(const bf16_t*)(a.ws + WS_G + 32 * MiB), WSP(bf16_t, WS_WGU), MROWS, NGU, D}; pg8::StaticOrder S; S.init(MROWS, NGU, G, bid);
          pg8::EpiSwiglu8<DOWN8 != 0> E{WSP(bf16_t, WS_Z)};
          pg8::gemm_phase<pg8::EpiSwiglu8<DOWN8 != 0>, pg8::StaticOrder, true, G8_SP2, true>(lds3, g, S, E, wid_s); }
#else
          pg8::Gemm g{WSP(bf16_t, WS_MG), WSP(bf16_t, WS_WGU), MROWS, NGU, D}; pg8::StaticOrder S; S.init(MROWS, NGU, G, bid);
          pg8::EpiSwiglu E{WSP(bf16_t, WS_Z)};
          pg8::gemm_phase<pg8::EpiSwiglu, pg8::StaticOrder, true, true>(lds3, g, S, E, wid_s); }
#endif
    }
#endif
        GRID_SYNC();
#if PHMASK & 2048
    for (int rep_ = 0; rep_ < ((DUPMASK & 2048) ? DUPN : 1); ++rep_) { if (rep_) GRID_SYNC();
        { const Args a = fresh_args(); const int G = gridDim.x, bid = blockIdx.x;
#if DOWN8
          pg8::Gemm g{WSP(bf16_t, WS_Z), WSP(bf16_t, WS_WDT), MROWS, D, DFF}; pg8::StaticOrder S; S.init(MROWS, D, G, bid);
          pg8::EpiPlain8 E{WSP(bf16_t, WS_H), D};
          pg8::gemm_phase<pg8::EpiPlain8, pg8::StaticOrder, true, G8_SP2, true>(lds3, g, S, E, wid_s); }
#else
          pg8::Gemm g{WSP(bf16_t, WS_Z), WSP(bf16_t, WS_WDT), MROWS, D, DFF}; pg8::StaticOrder S; S.init(MROWS, D, G, bid);
          pg8::EpiPlain E{WSP(bf16_t, WS_H), D};
          pg8::gemm_phase<pg8::EpiPlain, pg8::StaticOrder, true, true>(lds3, g, S, E, wid_s); }
#endif
    }
#endif
        GRID_SYNC();
#if PHMASK & 4096
    for (int rep_ = 0; rep_ < ((DUPMASK & 4096) ? DUPN : 1); ++rep_) { if (rep_) GRID_SYNC();
        { const Args a = fresh_args(); FRESH(); const float* ng = a.norm_g + (size_t)l * 4 * D;
          for (int row = gw * 8; row < MROWS; row += NGW * 8) { const int b = row >> 13; const float* md = WSP(float, WS_MOD) + (size_t)(l * 2 + b) * NMOD;
            const float* mdn = WSP(float, WS_MOD) + (size_t)((l + 1) * 2 + b) * NMOD; const float* ngn = a.norm_g + (size_t)(l + 1) * 4 * D;
            const bf16_t* x1g = WSP(bf16_t, WS_G) + (size_t)row * D; bf16_t* hr = WSP(bf16_t, WS_H) + (size_t)row * D;
            if (l + 1 < DEPTH) row_pass8<true, true, true, true, true>(x1g, hr, (bf16_t*)a.out + (size_t)row * D, hr, WSP(unsigned char, WS_MG) + (size_t)row * D, md + 5 * D, ng + 3 * D, ngn, mdn + 1 * D, mdn + 0 * D, lane);
            else row_pass8<true, false, true, false>(x1g, hr, a.out + (size_t)row * D, nullptr, nullptr, md + 5 * D, ng + 3 * D, nullptr, nullptr, nullptr, lane); }
          if (l + 1 < DEPTH) convert_weights(a, l + 1, lds, wid_s); }
    }
#endif
        if (l + 1 < DEPTH) GRID_SYNC();
    }
}

extern "C" void kernel_launch(void* const* d_in, const int* in_sizes, int n_in, void* d_out, int out_size, void* d_ws, size_t ws_size, hipStream_t stream) {
    static int grid = 0;
    if (grid == 0) {
        if (n_in != 14 || out_size != MROWS * D || ws_size < WS_END) { fprintf(stderr, "kernel_launch: unexpected shapes (n_in %d out %d ws %zu)\n", n_in, out_size, ws_size); grid = -1; return; }
        int dev = 0, cus = 0, per_cu = 0;
        (void)hipGetDevice(&dev);
        (void)hipDeviceGetAttribute(&cus, hipDeviceAttributeMultiprocessorCount, dev);
        (void)hipFuncSetAttribute((const void*)mega, hipFuncAttributeMaxDynamicSharedMemorySize, LDS_BYTES);
        (void)hipOccupancyMaxActiveBlocksPerMultiprocessor(&per_cu, (const void*)mega, 512, LDS_BYTES);
        if (per_cu < 1) { fprintf(stderr, "kernel_launch: occupancy query says 0 blocks per CU\n"); per_cu = 1; }
        grid = cus;
        (void)hipGetLastError();
    }
    if (grid < 0) return;
    if (hipMemsetAsync(d_ws, 0, 65536, stream) != hipSuccess) { fprintf(stderr, "kernel_launch: memset failed\n"); return; }
    Args a{};
    const float** pp = (const float**)&a;
    for (int i = 0; i < 14; ++i) pp[i] = (const float*)d_in[i];
    a.out = (float*)d_out; a.ws = (unsigned char*)d_ws;
    void* args[] = {&a};
    hipError_t e = hipLaunchCooperativeKernel((const void*)mega, dim3(grid), dim3(512), args, LDS_BYTES, stream);
    if (e != hipSuccess) fprintf(stderr, "cooperative launch failed: %s (grid %d)\n", hipGetErrorString(e), grid);
}
```

```cpp
#include <hip/hip_runtime.h>
#include <hip/hip_cooperative_groups.h>
#include <cstdio>
#include <cstdint>
namespace cg = cooperative_groups;
namespace pg8 {
#define PG8_LAS __attribute__((address_space(3)))
typedef unsigned short bf16_t;
typedef short bf16x8 __attribute__((ext_vector_type(8)));
typedef float f32x4 __attribute__((ext_vector_type(4)));
typedef unsigned u32x4 __attribute__((ext_vector_type(4)));
typedef int v4i_t __attribute__((ext_vector_type(4)));
typedef int v8i_t __attribute__((ext_vector_type(8)));
constexpr int BM = 256, BK = 64, HALF = 128, HTB = HALF * BK * 2  , STAGE_BYTES = 8 * HTB, NXCD = 8, WGM = 8;

__host__ __device__ __forceinline__ int lds_byte(int r, int c) { const int st = (r >> 4) * 2 + (c >> 5), rr = r & 15, cc = c & 31, ob = rr * 64 + cc * 2; return st * 1024 + (ob ^ (((ob >> 9) & 1) << 5)); }
__host__ __device__ __forceinline__ void stage_rc(int b, int& R, int& C) { const int st = b / 1024, sb = b % 1024, swz = sb ^ (((sb >> 9) & 1) << 5); R = (st >> 1) * 16 + swz / 64; C = (st & 1) * 32 + (swz % 64) / 2; }
__host__ __device__ __forceinline__ int perm32(int rho) { const int n = rho >> 4, i = rho & 15; return 8 * (i >> 2) + 4 * n + (i & 3); }

struct Unit { int pm, pn; };
struct Gemm { const bf16_t* A; const bf16_t* Bt; int M, N, K; };

struct StaticOrder {
    int nM, nN, nwg, G, c;
    __host__ __device__ void init(int M, int N, int G_, int c_) { nM = M / BM; nN = N / BM; nwg = nM * nN; G = G_; c = c_; }
    __host__ __device__ bool next(int i, Unit& u) const {
        const long L = (long)i * G + c; if (L >= nwg) return false;
        int wgid = (int)L; { const int q = nwg / NXCD, r = nwg % NXCD, xcd = wgid % NXCD, off = wgid / NXCD; wgid = (xcd < r ? xcd * (q + 1) : r * (q + 1) + (xcd - r) * q) + off; }
        const int nig = WGM * nN, gid = wgid / nig, fm = gid * WGM, gsz = (nM - fm) < WGM ? (nM - fm) : WGM;
        u.pm = fm + ((wgid % nig) % gsz); u.pn = (wgid % nig) / gsz; return true;
    }
    __device__ __forceinline__ void a_ready(const Unit&) const {}
    __device__ __forceinline__ void done(const Unit&) const {}
};

__device__ __forceinline__ unsigned cvt_pk_bf16(float lo, float hi) { unsigned r; asm volatile("v_cvt_pk_bf16_f32 %0, %1, %2" : "=v"(r) : "v"(lo), "v"(hi)); return r; }
typedef float f32x2 __attribute__((ext_vector_type(2)));
#ifndef WO8
#define WO8 1
#endif
#ifndef MERGE_FENCE
#define MERGE_FENCE 1
#endif
typedef unsigned u32x2 __attribute__((ext_vector_type(2)));
__device__ __forceinline__ float bf_lo(unsigned w) { return __uint_as_float(w << 16); }
__device__ __forceinline__ float bf_hi(unsigned w) { return __uint_as_float(w & 0xffff0000u); }
#ifdef PROBE_CHEAPSIG
__device__ __forceinline__ float sigmoidf_fast(float x) { return 0.5f + 0.25f * fminf(fmaxf(x, -2.0f), 2.0f); }
#else
__device__ __forceinline__ float sigmoidf_fast(float x) { return __builtin_amdgcn_rcpf(1.0f + __builtin_amdgcn_exp2f(-1.4426950408889634f * x)); }
#endif

struct EpiPlain {
    static constexpr bool PERM = true, AFTER_DRAIN = false;
    bf16_t* O; int ldc;
    __device__ __forceinline__ void operator()(const f32x4 (&acc)[2][2][4][2], const Unit& u, int wr, int wc, int fr, int fq) const {
        const int row0 = u.pm * BM + wr * 64 + fr, col0 = u.pn * BM + wc * 32 + 8 * fq;
#pragma unroll
        for (int ai = 0; ai < 2; ++ai)
#pragma unroll
            for (int m = 0; m < 4; ++m) { bf16_t* rowp = O + (size_t)(row0 + ai * HALF + m * 16) * ldc + col0;
#pragma unroll
                for (int bj = 0; bj < 2; ++bj) { const f32x4 v0 = acc[ai][bj][m][0], v1 = acc[ai][bj][m][1];
                    u32x4 w; w.x = cvt_pk_bf16(v0[0], v0[1]); w.y = cvt_pk_bf16(v0[2], v0[3]); w.z = cvt_pk_bf16(v1[0], v1[1]); w.w = cvt_pk_bf16(v1[2], v1[3]);
                    *(u32x4*)(rowp + bj * HALF) = w; } }
    }
};
struct EpiZ {
    static constexpr bool PERM = true, AFTER_DRAIN = false;
    bf16_t* Z; float* SM; unsigned char* G;
    __device__ __forceinline__ void operator()(const f32x4 (&acc)[2][2][4][2], const Unit& u, int wr, int wc, int fr, int fq) const {
        const int row0 = u.pm * BM + wr * 64 + fr;
        if (u.pn < 11) {
            const int col0 = u.pn * BM + wc * 32 + 8 * fq;
#pragma unroll
            for (int ai = 0; ai < 2; ++ai)
#pragma unroll
                for (int m = 0; m < 4; ++m) { bf16_t* rowp = Z + (size_t)(row0 + ai * HALF + m * 16) * 2816 + col0;
#pragma unroll
                    for (int bj = 0; bj < 2; ++bj) { const f32x4 v0 = acc[ai][bj][m][0], v1 = acc[ai][bj][m][1];
                        u32x4 w; w.x = cvt_pk_bf16(v0[0], v0[1]); w.y = cvt_pk_bf16(v0[2], v0[3]); w.z = cvt_pk_bf16(v1[0], v1[1]); w.w = cvt_pk_bf16(v1[2], v1[3]);
                        *(u32x4*)(rowp + bj * HALF) = w; } }
            if (u.pn == 10 && wc == 2 && fq == 0) {
#pragma unroll
                for (int ai = 0; ai < 2; ++ai)
#pragma unroll
                    for (int m = 0; m < 4; ++m) { float* sp = SM + (size_t)(row0 + ai * HALF + m * 16) * 8;
                        *(f32x4*)sp = acc[ai][1][m][0]; *(f32x4*)(sp + 4) = acc[ai][1][m][1]; }
            }
        } else {
            const int col0 = (u.pn - 11) * BM + wc * 32 + 8 * fq;
#pragma unroll
            for (int ai = 0; ai < 2; ++ai)
#pragma unroll
                for (int m = 0; m < 4; ++m) { unsigned char* rowp = G + (size_t)(row0 + ai * HALF + m * 16) * 4096 + col0;
#pragma unroll
                    for (int bj = 0; bj < 2; ++bj) { const f32x4 v0 = acc[ai][bj][m][0], v1 = acc[ai][bj][m][1];
                        unsigned b[8];
#pragma unroll
                        for (int k = 0; k < 4; ++k) { b[k] = (unsigned)(sigmoidf_fast(v0[k]) * 255.0f + 0.5f); b[4 + k] = (unsigned)(sigmoidf_fast(v1[k]) * 255.0f + 0.5f); }
                        u32x2 w; w.x = b[0] | (b[1] << 8) | (b[2] << 16) | (b[3] << 24); w.y = b[4] | (b[5] << 8) | (b[6] << 16) | (b[7] << 24);
                        *(u32x2*)(rowp + bj * HALF) = w; } }
        }
    }
};
struct EpiG {
    static constexpr bool PERM = false, AFTER_DRAIN = false;
    unsigned char* G;
    __device__ __forceinline__ void operator()(const f32x4 (&acc)[2][2][4][2], const Unit& u, int wr, int wc, int fr, int fq) const {
        unsigned ones_ = ~0u; asm volatile("" : "+s"(ones_)); const int ln_ = (int)__builtin_amdgcn_mbcnt_hi(ones_, __builtin_amdgcn_mbcnt_lo(ones_, 0u)); const int fr_ = ln_ & 15, fq_ = ln_ >> 4; (void)fr; (void)fq;
        const unsigned row0 = u.pm * BM + wr * 64 + fr_, col0 = u.pn * BM + wc * 32 + 4 * fq_;
        unsigned char* gb = G + col0;
#pragma unroll
        for (int ai = 0; ai < 2; ++ai)
#pragma unroll
            for (int m = 0; m < 4; ++m) { const unsigned ro = (row0 + ai * HALF + m * 16) * 4096u;
#pragma unroll
                for (int bj = 0; bj < 2; ++bj)
#pragma unroll
                    for (int n = 0; n < 2; ++n) { const f32x4 v0 = acc[ai][bj][m][n];
                        unsigned b[4];
#pragma unroll
                        for (int k = 0; k < 4; ++k) b[k] = (unsigned)(sigmoidf_fast(v0[k]) * 255.0f + 0.5f);
                        *(unsigned*)(gb + ro + bj * HALF + n * 16) = b[0] | (b[1] << 8) | (b[2] << 16) | (b[3] << 24); }
                asm volatile("" ::: "memory"); }
    }
};
struct EpiMerge {
    static constexpr bool PERM = true, AFTER_DRAIN = false;
    bf16_t* MG; const unsigned char* G;
    __device__ __forceinline__ void operator()(const f32x4 (&acc)[2][2][4][2], const Unit& u, int wr, int wc, int fr, int fq) const {
        const int n = u.pm >> 6, pm = u.pm & 63, pn = u.pn & 3;
        const unsigned row0 = pm * BM + wr * 64 + fr, col0 = pn * BM + wc * 32 + 8 * fq;
        const unsigned char* gbase = G + n * 1024 + col0; bf16_t* mbase = MG + col0;
#pragma unroll
        for (int ai = 0; ai < 2; ++ai) {
            u32x2 gw[4][2]; u32x4 old[4][2];
#pragma unroll
            for (int m = 0; m < 4; ++m)
#pragma unroll
                for (int bj = 0; bj < 2; ++bj) { const unsigned row = row0 + ai * HALF + m * 16;
                    gw[m][bj] = *(const u32x2*)(gbase + row * 4096u + bj * HALF);
                    if (n > 0) old[m][bj] = *(const u32x4*)(mbase + row * 1024u + bj * HALF); }
#pragma unroll
            for (int m = 0; m < 4; ++m)
#pragma unroll
                for (int bj = 0; bj < 2; ++bj) { const unsigned row = row0 + ai * HALF + m * 16;
                    const f32x4 v0 = acc[ai][bj][m][0], v1 = acc[ai][bj][m][1];
                    float r[8];
#pragma unroll
                    for (int k = 0; k < 4; ++k) { r[k] = v0[k] * ((float)((gw[m][bj].x >> (8 * k)) & 255u) * (1.0f / 255.0f)); r[4 + k] = v1[k] * ((float)((gw[m][bj].y >> (8 * k)) & 255u) * (1.0f / 255.0f)); }
                    if (n > 0) { const u32x4 o = old[m][bj];
                        r[0] += bf_lo(o.x); r[1] += bf_hi(o.x); r[2] += bf_lo(o.y); r[3] += bf_hi(o.y); r[4] += bf_lo(o.z); r[5] += bf_hi(o.z); r[6] += bf_lo(o.w); r[7] += bf_hi(o.w); }
                    u32x4 w; w.x = cvt_pk_bf16(r[0], r[1]); w.y = cvt_pk_bf16(r[2], r[3]); w.z = cvt_pk_bf16(r[4], r[5]); w.w = cvt_pk_bf16(r[6], r[7]);
                    *(u32x4*)(mbase + row * 1024u + bj * HALF) = w; }
            asm volatile("" ::: "memory");
        }
    }
};
struct EpiSwiglu {
    static constexpr bool PERM = true, AFTER_DRAIN = false;
    bf16_t* Hd;
    __device__ __forceinline__ void operator()(const f32x4 (&acc)[2][2][4][2], const Unit& u, int wr, int wc, int fr, int fq) const {
        const int row0 = u.pm * BM + wr * 64 + fr, j0 = u.pn * 128 + wc * 16 + 4 * fq;
#pragma unroll
        for (int ai = 0; ai < 2; ++ai)
#pragma unroll
            for (int m = 0; m < 4; ++m) { bf16_t* rowp = Hd + (size_t)(row0 + ai * HALF + m * 16) * 2816 + j0;
#pragma unroll
                for (int bj = 0; bj < 2; ++bj) { const f32x4 v0 = acc[ai][bj][m][0], v1 = acc[ai][bj][m][1];
                    const float h0 = v0[0] * sigmoidf_fast(v0[0]) * v0[1], h1 = v0[2] * sigmoidf_fast(v0[2]) * v0[3];
                    const float h2 = v1[0] * sigmoidf_fast(v1[0]) * v1[1], h3 = v1[2] * sigmoidf_fast(v1[2]) * v1[3];
                    u32x2 w; w.x = cvt_pk_bf16(h0, h1); w.y = cvt_pk_bf16(h2, h3);
                    *(u32x2*)(rowp + bj * 64) = w; } }
    }
};
template <bool H8> struct EpiSwiglu8 {
    static constexpr bool PERM = false, AFTER_DRAIN = false;
    bf16_t* Hd;
    __device__ __forceinline__ void operator()(const f32x4 (&acc)[2][2][4][2], const Unit& u, int wr, int wc, int fr, int fq) const {
        unsigned ones_ = ~0u; asm volatile("" : "+s"(ones_)); const int ln_ = (int)__builtin_amdgcn_mbcnt_hi(ones_, __builtin_amdgcn_mbcnt_lo(ones_, 0u)); const int fr_ = ln_ & 15, fq_ = ln_ >> 4; (void)fr; (void)fq;
        const unsigned row0 = u.pm * BM + wr * 64 + fr_, j0 = u.pn * 128 + wc * 16 + 2 * fq_;
        bf16_t* hb = Hd + j0; unsigned char* h8b = (unsigned char*)Hd + j0;
#pragma unroll
        for (int ai = 0; ai < 2; ++ai)
#pragma unroll
            for (int m = 0; m < 4; ++m) { const unsigned ro = (row0 + ai * HALF + m * 16) * 2816u;
#pragma unroll
                for (int bj = 0; bj < 2; ++bj)
#pragma unroll
                    for (int n = 0; n < 2; ++n) { const f32x4 v = acc[ai][bj][m][n];
                        const float h0 = v[0] * sigmoidf_fast(v[0]) * v[1], h1 = v[2] * sigmoidf_fast(v[2]) * v[3];
                        if (H8) *(unsigned short*)(h8b + ro + bj * 64 + n * 8) = (unsigned short)__builtin_amdgcn_cvt_pk_fp8_f32(h0, h1, 0u, false);
                        else *(unsigned*)(hb + ro + bj * 64 + n * 8) = cvt_pk_bf16(h0, h1); }
                asm volatile("" ::: "memory"); }
    }
};
struct EpiPlain8 {
    static constexpr bool PERM = false, AFTER_DRAIN = false;
    bf16_t* O; int ldc;
    __device__ __forceinline__ void operator()(const f32x4 (&acc)[2][2][4][2], const Unit& u, int wr, int wc, int fr, int fq) const {
        unsigned ones_ = ~0u; asm volatile("" : "+s"(ones_)); const int ln_ = (int)__builtin_amdgcn_mbcnt_hi(ones_, __builtin_amdgcn_mbcnt_lo(ones_, 0u)); const int fr_ = ln_ & 15, fq_ = ln_ >> 4; (void)fr; (void)fq;
        const unsigned row0 = u.pm * BM + wr * 64 + fr_, col0 = u.pn * BM + wc * 32 + 4 * fq_;
        bf16_t* ob = O + col0;
#pragma unroll
        for (int ai = 0; ai < 2; ++ai)
#pragma unroll
            for (int m = 0; m < 4; ++m) { const unsigned ro = (row0 + ai * HALF + m * 16) * (unsigned)ldc;
#pragma unroll
                for (int bj = 0; bj < 2; ++bj)
#pragma unroll
                    for (int n = 0; n < 2; ++n) { const f32x4 v = acc[ai][bj][m][n]; u32x2 w; w.x = cvt_pk_bf16(v[0], v[1]); w.y = cvt_pk_bf16(v[2], v[3]);
                        *(u32x2*)(ob + ro + bj * HALF + n * 16) = w; }
                asm volatile("" ::: "memory"); }
    }
};
struct MergeOrder {
    int G, c;
    __device__ __forceinline__ bool next(int i, Unit& u) const {
        const int t = (i >> 2) * G + c; if (t >= 256) return false;
        const int n = i & 3, pm = t >> 2, pn = t & 3;
        u.pm = n * 64 + pm; u.pn = n * 4 + pn; return true;
    }
    __device__ __forceinline__ void a_ready(const Unit&) const {}
    __device__ __forceinline__ void done(const Unit&) const {}
};
struct EpiMerge2 {
    static constexpr bool PERM = true, AFTER_DRAIN = false;
    bf16_t* MG; const unsigned char* G;
    mutable f32x4 tot[2][4][2];
    __device__ __forceinline__ void zero() const {
#pragma unroll
        for (int bj = 0; bj < 2; ++bj)
#pragma unroll
            for (int m = 0; m < 4; ++m)
#pragma unroll
                for (int k = 0; k < 2; ++k) tot[bj][m][k] = (f32x4){0.f, 0.f, 0.f, 0.f};
    }
    __device__ __forceinline__ void operator()(const f32x4 (&acc)[2][2][4][2], const Unit& u, int wr, int wc, int fr, int fq) const {
        const int n = u.pn >> 2, pn = u.pn & 3, pm = u.pm - n * 128;
        const unsigned row0 = pm * HALF + wr * 64 + fr, col0 = pn * BM + wc * 32 + 8 * fq;
        const unsigned char* gbase = G + n * 1024 + col0;
        u32x2 gw[4][2];
#pragma unroll
        for (int m = 0; m < 4; ++m)
#pragma unroll
            for (int bj = 0; bj < 2; ++bj) gw[m][bj] = *(const u32x2*)(gbase + (row0 + m * 16) * 4096u + bj * HALF);
#pragma unroll
        for (int m = 0; m < 4; ++m)
#pragma unroll
            for (int bj = 0; bj < 2; ++bj) {
#pragma unroll
                for (int k = 0; k < 4; ++k) { tot[bj][m][0][k] += acc[0][bj][m][0][k] * ((float)((gw[m][bj].x >> (8 * k)) & 255u) * (1.0f / 255.0f));
                                              tot[bj][m][1][k] += acc[0][bj][m][1][k] * ((float)((gw[m][bj].y >> (8 * k)) & 255u) * (1.0f / 255.0f)); } }
        if (n == 3) {
            bf16_t* mbase = MG + col0;
#pragma unroll
            for (int m = 0; m < 4; ++m)
#pragma unroll
                for (int bj = 0; bj < 2; ++bj) { const f32x4 t0 = tot[bj][m][0], t1 = tot[bj][m][1];
#if WO8
                    u32x2 w8; w8.x = __builtin_amdgcn_cvt_pk_fp8_f32(t0[2], t0[3], __builtin_amdgcn_cvt_pk_fp8_f32(t0[0], t0[1], 0u, false), true);
                    w8.y = __builtin_amdgcn_cvt_pk_fp8_f32(t1[2], t1[3], __builtin_amdgcn_cvt_pk_fp8_f32(t1[0], t1[1], 0u, false), true);
                    *(u32x2*)((unsigned char*)MG + col0 + (row0 + m * 16) * 1024u + bj * HALF) = w8; }
#else
                    u32x4 w; w.x = cvt_pk_bf16(t0[0], t0[1]); w.y = cvt_pk_bf16(t0[2], t0[3]); w.z = cvt_pk_bf16(t1[0], t1[1]); w.w = cvt_pk_bf16(t1[2], t1[3]);
                    *(u32x4*)(mbase + (row0 + m * 16) * 1024u + bj * HALF) = w; }
#endif
            zero();
        }
    }
};
struct MergeOrder2 {
    int G, c;
    __device__ __forceinline__ bool next(int i, Unit& u) const {
        const int t = (i >> 2) * G + c; if (t >= 512) return false;
        const int n = i & 3, pm = t >> 2, pn = t & 3;
        u.pm = n * 128 + pm; u.pn = n * 4 + pn; return true;
    }
    __device__ __forceinline__ void a_ready(const Unit&) const {}
    __device__ __forceinline__ void done(const Unit&) const {}
};
struct Frag16x2 { bf16x8 k[2]; };
template <bool FP8> struct FragSel;
template <> struct FragSel<false> {
    typedef Frag16x2 type;
    static __device__ __forceinline__ type load(PG8_LAS unsigned char* p) { type f; f.k[0] = *(const PG8_LAS bf16x8*)p; f.k[1] = *(const PG8_LAS bf16x8*)(p + 1024); return f; }
    static __device__ __forceinline__ f32x4 mma(const type& w, const type& a, f32x4 c) {
        c = __builtin_amdgcn_mfma_f32_16x16x32_bf16(w.k[0], a.k[0], c, 0, 0, 0); return __builtin_amdgcn_mfma_f32_16x16x32_bf16(w.k[1], a.k[1], c, 0, 0, 0); }
};
template <> struct FragSel<true> {
    struct type { v4i_t lo, hi; };
    static __device__ __forceinline__ type load(PG8_LAS unsigned char* p) { type f; f.lo = *(const PG8_LAS v4i_t*)p; f.hi = *(const PG8_LAS v4i_t*)(p + 1024); return f; }
    static __device__ __forceinline__ f32x4 mma(const type& w, const type& a, f32x4 c) {
        return __builtin_amdgcn_mfma_scale_f32_16x16x128_f8f6f4(__builtin_shufflevector(w.lo, w.hi, 0, 1, 2, 3, 4, 5, 6, 7), __builtin_shufflevector(a.lo, a.hi, 0, 1, 2, 3, 4, 5, 6, 7), c, 0, 0, 0, 0x7a7a7a7a, 0, 0x7f7f7f7f); }
};
template <class Epi, class Sched, bool ALIGN_EPI = false, bool SP2 = false, bool FP8 = false, bool HALFM = false>
__device__ __forceinline__ void gemm_phase(PG8_LAS unsigned char* lds, const Gemm g, const Sched& S, const Epi& E, int wid_s) {
    unsigned ones_ = ~0u; asm volatile("" : "+s"(ones_));
    int tid_ = wid_s * 64 + (int)__builtin_amdgcn_mbcnt_hi(ones_, __builtin_amdgcn_mbcnt_lo(ones_, 0u)); asm volatile("" : "+v"(tid_));
    const int tid = tid_, wid = __builtin_amdgcn_readfirstlane(tid >> 6), lane = tid & 63, wr = wid >> 2, wc = wid & 3, fr = lane & 15, fq = lane >> 4;
    const int K = FP8 ? g.K / 2 : g.K, nt = K / BK;
    unsigned voffA[2], voffB[2];
#pragma unroll
    for (int i = 0; i < 2; ++i) { int R, C; stage_rc(tid * 16 + i * 8192, R, C); const int Rb = Epi::PERM ? ((R & ~31) + perm32(R & 31)) : R;
        voffA[i] = (unsigned)(R * K + C) * 2u; voffB[i] = (unsigned)(Rb * K + C) * 2u; }
    const size_t kstep = (size_t)(BK * 2);
    const size_t hstep = (size_t)HALF * K * 2;
    const size_t tstep = 2 * hstep;
    const unsigned ldsw = (unsigned)wid * 1024u;
    const unsigned ldsbase = (unsigned)(__UINTPTR_TYPE__)lds;
    const __amdgpu_buffer_rsrc_t srdA = __builtin_amdgcn_make_buffer_rsrc((void*)g.A, (short)0, 0x7fffffff, 0x00020000);
    const __amdgpu_buffer_rsrc_t srdB = __builtin_amdgcn_make_buffer_rsrc((void*)g.Bt, (short)0, 0x7fffffff, 0x00020000);
    const int aoff = lds_byte(wr * 64 + fr, fq * 8), boff = lds_byte(wc * 32 + fr, fq * 8);
#define PG8_SA(b, h) (((b) * 2 + (h)) * HTB)
#define PG8_SB(b, h) ((4 + (b) * 2 + (h)) * HTB)
#define PG8_STAGE(bufoff, gbase, voff, srd, base) do { const unsigned so_ = (unsigned)((const char*)(gbase) - (const char*)(base)); _Pragma("unroll") for (int _i = 0; _i < 2; ++_i) \
        asm volatile("s_mov_b32 m0, %0\n\ts_nop 0\n\tbuffer_load_dwordx4 %1, %2, %3 offen lds" :: "s"(ldsbase + (unsigned)(bufoff) + ldsw + (unsigned)(_i * 8192)), "v"((voff)[_i]), "s"(srd), "s"(so_) : "m0", "memory"); } while (0)
#define PG8_LDA(dst, b, h) do { _Pragma("unroll") for (int m = 0; m < 4; ++m) dst[m] = FragSel<FP8>::load(lds + PG8_SA(b, h) + aoff + m * 2048); } while (0)
#define PG8_LDB(dst, b, h) do { _Pragma("unroll") for (int n = 0; n < 2; ++n) dst[n] = FragSel<FP8>::load(lds + PG8_SB(b, h) + boff + n * 2048); } while (0)
#define PG8_MMA(ai, bj, At, Bt) do { __builtin_amdgcn_s_setprio(1); _Pragma("unroll") for (int m = 0; m < 4; ++m) _Pragma("unroll") for (int n = 0; n < 2; ++n) \
        acc[ai][bj][m][n] = FragSel<FP8>::mma(Bt[n], At[m], acc[ai][bj][m][n]); __builtin_amdgcn_s_setprio(0); } while (0)
#define PG8_WAIT_V(n) asm volatile("s_waitcnt vmcnt(" #n ")" ::: "memory")
#define PG8_WAIT_L(n) asm volatile("s_waitcnt lgkmcnt(" #n ")" ::: "memory")
#define PG8_BAR __builtin_amdgcn_s_barrier()
#define PG8_SCHED __builtin_amdgcn_sched_barrier(0)
    Unit cur, nxt; int ui = 0;
    if (!S.next(0, cur)) return;
    f32x4 acc[2][2][4][2];
#pragma unroll
    for (int a = 0; a < 2; ++a)
#pragma unroll
        for (int b = 0; b < 2; ++b)
#pragma unroll
            for (int m = 0; m < 4; ++m)
#pragma unroll
                for (int n = 0; n < 2; ++n) acc[a][b][m][n] = (f32x4){0.f, 0.f, 0.f, 0.f};
    typedef typename FragSel<FP8>::type frag_t;
    frag_t At[4], B0[2], B1[2];
    const size_t tstepA = HALFM ? hstep : tstep;
    const char* cA = (const char*)g.A + (size_t)cur.pm * tstepA; const char* cB = (const char*)g.Bt + (size_t)cur.pn * tstep;
    S.a_ready(cur);
    if constexpr (SP2) {
        PG8_STAGE(PG8_SB(0, 0), cB, voffB, srdB, g.Bt); PG8_STAGE(PG8_SB(0, 1), cB + hstep, voffB, srdB, g.Bt); PG8_STAGE(PG8_SA(0, 0), cA, voffA, srdA, g.A); PG8_STAGE(PG8_SA(0, 1), cA + hstep, voffA, srdA, g.A);
        if (wr == 1) PG8_BAR;
        PG8_WAIT_V(2); PG8_BAR;
        PG8_STAGE(PG8_SB(1, 0), cB + kstep, voffB, srdB, g.Bt); PG8_STAGE(PG8_SA(1, 0), cA + kstep, voffA, srdA, g.A); PG8_STAGE(PG8_SB(1, 1), cB + hstep + kstep, voffB, srdB, g.Bt);
        PG8_WAIT_V(6); PG8_BAR;
    } else {
        PG8_STAGE(PG8_SB(0, 0), cB, voffB, srdB, g.Bt); PG8_STAGE(PG8_SA(0, 0), cA, voffA, srdA, g.A); PG8_STAGE(PG8_SB(0, 1), cB + hstep, voffB, srdB, g.Bt); PG8_STAGE(PG8_SA(0, 1), cA + hstep, voffA, srdA, g.A);
        if (wr == 1) PG8_BAR;
        PG8_WAIT_V(4); PG8_BAR;
        PG8_STAGE(PG8_SB(1, 0), cB + kstep, voffB, srdB, g.Bt); PG8_STAGE(PG8_SA(1, 0), cA + kstep, voffA, srdA, g.A); PG8_STAGE(PG8_SB(1, 1), cB + hstep + kstep, voffB, srdB, g.Bt);
        PG8_WAIT_V(6); PG8_BAR;
    }
    for (;;) {
        const bool has_next = S.next(ui + 1, nxt);
        const char* nA = has_next ? (const char*)g.A + (size_t)nxt.pm * tstepA : cA; const char* nB = has_next ? (const char*)g.Bt + (size_t)nxt.pn * tstep : cB;
#pragma unroll 1
        for (int t = 0; t < nt; t += 2) {
            const bool last = (t == nt - 2);
            const char* a1 = cA + (size_t)(t + 1) * kstep;
            const char* a2 = last ? nA : cA + (size_t)(t + 2) * kstep; const char* b2 = last ? nB : cB + (size_t)(t + 2) * kstep;
            const char* a3 = a2 + kstep; const char* b3 = b2 + kstep;
            if (last && has_next) S.a_ready(nxt);
            if constexpr (SP2) {
            PG8_LDB(B0, 0, 0); PG8_LDB(B1, 0, 1); PG8_SCHED; PG8_LDA(At, 0, 0); PG8_STAGE(PG8_SA(1, 1), a1 + hstep, voffA, srdA, g.A);
            PG8_WAIT_V(8); PG8_WAIT_L(0); PG8_BAR; PG8_MMA(0, 0, At, B0); PG8_MMA(0, 1, At, B1); PG8_BAR; PG8_SCHED;
            if constexpr (!HALFM) PG8_LDA(At, 0, 1); PG8_STAGE(PG8_SB(0, 0), b2, voffB, srdB, g.Bt); PG8_STAGE(PG8_SB(0, 1), b2 + hstep, voffB, srdB, g.Bt); PG8_STAGE(PG8_SA(0, 0), a2, voffA, srdA, g.A);
            PG8_WAIT_V(8); PG8_WAIT_L(0); PG8_BAR; if constexpr (!HALFM) { PG8_MMA(1, 0, At, B0); PG8_MMA(1, 1, At, B1); } PG8_BAR; PG8_SCHED;
            PG8_LDB(B0, 1, 0); PG8_LDB(B1, 1, 1); PG8_SCHED; PG8_LDA(At, 1, 0); PG8_STAGE(PG8_SA(0, 1), a2 + hstep, voffA, srdA, g.A);
            PG8_WAIT_V(8); PG8_WAIT_L(0); PG8_BAR; PG8_MMA(0, 0, At, B0); PG8_MMA(0, 1, At, B1); PG8_BAR; PG8_SCHED;
            if constexpr (!HALFM) PG8_LDA(At, 1, 1); PG8_STAGE(PG8_SB(1, 0), b3, voffB, srdB, g.Bt); PG8_STAGE(PG8_SB(1, 1), b3 + hstep, voffB, srdB, g.Bt); PG8_STAGE(PG8_SA(1, 0), a3, voffA, srdA, g.A);
            PG8_WAIT_V(8); PG8_WAIT_L(0); PG8_BAR; if constexpr (!HALFM) { PG8_MMA(1, 0, At, B0); PG8_MMA(1, 1, At, B1); } PG8_BAR; PG8_SCHED;
            } else {
            PG8_LDB(B0, 0, 0); PG8_SCHED; PG8_LDA(At, 0, 0); PG8_STAGE(PG8_SA(1, 1), a1 + hstep, voffA, srdA, g.A);
            PG8_WAIT_L(8); PG8_BAR; PG8_WAIT_L(0); PG8_MMA(0, 0, At, B0); PG8_BAR; PG8_SCHED;
            PG8_LDB(B1, 0, 1); PG8_STAGE(PG8_SB(0, 0), b2, voffB, srdB, g.Bt);
            PG8_BAR; PG8_WAIT_L(0); PG8_MMA(0, 1, At, B1); PG8_BAR;
            if constexpr (!HALFM) PG8_LDA(At, 0, 1); PG8_STAGE(PG8_SA(0, 0), a2, voffA, srdA, g.A);
            PG8_BAR; PG8_WAIT_L(0); if constexpr (!HALFM) PG8_MMA(1, 0, At, B0); PG8_BAR; PG8_SCHED;
            PG8_STAGE(PG8_SB(0, 1), b2 + hstep, voffB, srdB, g.Bt);
            PG8_WAIT_V(6); PG8_BAR; if constexpr (!HALFM) PG8_MMA(1, 1, At, B1); PG8_BAR;
            PG8_LDB(B0, 1, 0); PG8_SCHED; PG8_LDA(At, 1, 0); PG8_STAGE(PG8_SA(0, 1), a2 + hstep, voffA, srdA, g.A);
            PG8_WAIT_L(8); PG8_BAR; PG8_WAIT_L(0); PG8_MMA(0, 0, At, B0); PG8_BAR; PG8_SCHED;
            PG8_LDB(B1, 1, 1); PG8_STAGE(PG8_SB(1, 0), b3, voffB, srdB, g.Bt);
            PG8_BAR; PG8_WAIT_L(0); PG8_MMA(0, 1, At, B1); PG8_BAR;
            if constexpr (!HALFM) PG8_LDA(At, 1, 1); PG8_STAGE(PG8_SA(1, 0), a3, voffA, srdA, g.A);
            PG8_BAR; PG8_WAIT_L(0); if constexpr (!HALFM) PG8_MMA(1, 0, At, B0); PG8_BAR; PG8_SCHED;
            PG8_STAGE(PG8_SB(1, 1), b3 + hstep, voffB, srdB, g.Bt);
            PG8_WAIT_V(6); PG8_BAR; if constexpr (!HALFM) PG8_MMA(1, 1, At, B1); PG8_BAR;
            }
        }
        if constexpr (ALIGN_EPI) { if (wr == 0) PG8_BAR; }
        if constexpr (!Epi::AFTER_DRAIN) { E(acc, cur, wr, wc, fr, fq); S.done(cur); }
        if (!has_next) break;
#pragma unroll
        for (int a = 0; a < 2; ++a)
#pragma unroll
            for (int b = 0; b < 2; ++b)
#pragma unroll
                for (int m = 0; m < 4; ++m)
#pragma unroll
                    for (int n = 0; n < 2; ++n) acc[a][b][m][n] = (f32x4){0.f, 0.f, 0.f, 0.f};
        cur = nxt; cA = nA; cB = nB; ++ui;
        if constexpr (ALIGN_EPI) { if (wr == 1) PG8_BAR; }
    }
    PG8_WAIT_V(0);
    if constexpr (!ALIGN_EPI) { if (wr == 0) PG8_BAR; }
    PG8_BAR;
    if constexpr (Epi::AFTER_DRAIN) { E.fused(acc, cur, wr, wc, fr, fq, lds, wid, lane); S.done(cur); }
#undef PG8_SA
#undef PG8_SB
#undef PG8_STAGE
#undef PG8_LDA
#undef PG8_LDB
#undef PG8_MMA
#undef PG8_WAIT_V
#undef PG8_WAIT_L
#undef PG8_BAR
#undef PG8_SCHED
}
}

typedef unsigned short bf16_t;
typedef short bf16x8 __attribute__((ext_vector_type(8)));
typedef short s16x4 __attribute__((ext_vector_type(4)));
typedef float f32x4 __attribute__((ext_vector_type(4)));
typedef float f32x16 __attribute__((ext_vector_type(16)));
typedef unsigned u32x4 __attribute__((ext_vector_type(4)));
typedef unsigned u32x2 __attribute__((ext_vector_type(2)));
#define LAS __attribute__((address_space(3)))

constexpr int D = 1024, BATCH = 2, SEQ = 8192, MROWS = BATCH * SEQ, DEPTH = 2;
constexpr int ZW = 2816, NW1 = 6912, INW = 6856, DFF = 2816, NGU = 5632, NMOD = 6 * D;
constexpr float RMS_EPS = 1e-6f, LOG2E = 1.4426950408889634f, C2 = 0.125f * 1.4426950408889634f;
constexpr int ZC_AU = 0, ZC_AB = 256, ZC_AC = 512, ZC_DQ = 768, ZC_DK = 1024, ZC_DV = 1088, ZC_DQI = 1152, ZC_DKI = 1408, ZC_FQ = 1472, ZC_FK = 1728, ZC_FV = 1984, ZC_SQ = 2240, ZC_SK = 2496, ZC_SV = 2624;

constexpr size_t MiB = 1u << 20;
constexpr size_t WS_KMAX = 4096;
constexpr size_t WS_MOD = 65536;
constexpr size_t WS_FCUM = WS_MOD + 98304;
constexpr size_t WS_SMALL = WS_FCUM + 262144;
constexpr size_t WS_W1T = 1 * MiB;
constexpr size_t WS_WG8 = WS_W1T + (size_t)2816 * D * 2;
constexpr size_t WS_WGU = WS_W1T + (size_t)NW1 * D * 2;
constexpr size_t WS_WBT = WS_WGU + (size_t)NGU * D * 2;
constexpr size_t WS_WOT = WS_WBT + (size_t)4 * D * 256 * 2;
constexpr size_t WS_WDT = WS_WOT + (size_t)D * D * 2;
constexpr size_t WS_H = 35 * MiB;
constexpr size_t WS_Z = 67 * MiB;
constexpr size_t WS_G = 155 * MiB;
constexpr size_t WS_MG = 219 * MiB;
constexpr size_t WS_END = 251 * MiB;
static_assert(WS_WDT + (size_t)D * DFF * 2 <= WS_H && WS_SMALL + 524288 <= WS_W1T, "ws map");

#ifndef FFN8
#define FFN8 1
#endif
#ifndef DOWN8
#define DOWN8 1
#endif
constexpr int LDS_BYTES = 151552;

struct Args {
    const float *x, *c, *w_ada, *b_ada, *norm_g, *w_in, *conv_w, *fox_bias, *swa_sinks, *w_branch, *w_o, *w_gate, *w_up, *w_down;
    float* out; unsigned char* ws;
};

__device__ __forceinline__ unsigned f2bf(float f) { unsigned u = __builtin_bit_cast(unsigned, f); return (u + 0x7fffu + ((u >> 16) & 1u)) >> 16; }
__device__ __forceinline__ unsigned pk2(float lo, float hi) { return f2bf(lo) | (f2bf(hi) << 16); }
__device__ __forceinline__ float bflo(unsigned w) { return __uint_as_float(w << 16); }
__device__ __forceinline__ float bfhi(unsigned w) { return __uint_as_float(w & 0xffff0000u); }

__device__ __forceinline__ float shf(float v, int src) { return __int_as_float(__builtin_amdgcn_ds_bpermute(src << 2, __float_as_int(v))); }
__device__ __forceinline__ unsigned shu(unsigned v, int src) { return (unsigned)__builtin_amdgcn_ds_bpermute(src << 2, (int)v); }
__device__ __forceinline__ float wave_sum(float v, int lane) {
#pragma unroll
    for (int o = 1; o < 64; o <<= 1) v += shf(v, lane ^ o);
    return v;
}
__device__ __forceinline__ int crow(int r, int hi) { return (r & 3) + 8 * (r >> 2) + 4 * hi; }
__device__ __forceinline__ float swap32_max(float m) { auto rr = __builtin_amdgcn_permlane32_swap(__float_as_uint(m), __float_as_uint(m), false, false); return fmaxf(__uint_as_float(rr[0]), __uint_as_float(rr[1])); }
__device__ __forceinline__ float swap32_sum(float m) { auto rr = __builtin_amdgcn_permlane32_swap(__float_as_uint(m), __float_as_uint(m), false, false); return __uint_as_float(rr[0]) + __uint_as_float(rr[1]); }
#define LDSWAIT() asm volatile("s_waitcnt lgkmcnt(0)" ::: "memory")
__device__ __forceinline__ int ftid(int wid_s) { unsigned ones = ~0u; asm volatile("" : "+s"(ones)); int t = wid_s * 64 + (int)__builtin_amdgcn_mbcnt_hi(ones, __builtin_amdgcn_mbcnt_lo(ones, 0u)); asm volatile("" : "+v"(t)); return t; }

__device__ __forceinline__ void ada_gemv(const Args& a, unsigned char* lds, int wid_s) {
    float* sc = (float*)lds;
    float* part = (float*)(lds + 8192);
    const int tid = ftid(wid_s), lane = tid & 63, wid = tid >> 6;
    for (int i = tid; i < 2 * D; i += 512) { const float v = a.c[i]; sc[i] = v / (1.0f + __expf(-v)); }
    __syncthreads();
    float* mod = (float*)(a.ws + WS_MOD);
    for (int item = blockIdx.x; item < DEPTH * (NMOD / 64); item += gridDim.x) {
        const int l = item / (NMOD / 64), jc = item % (NMOD / 64);
        const float* w = a.w_ada + (size_t)l * D * NMOD + (size_t)(wid * 128) * NMOD + jc * 64 + lane;
        float a0 = 0.f, a1 = 0.f;
#pragma unroll 32
        for (int k = 0; k < 128; ++k) { const float wv = w[(size_t)k * NMOD]; a0 += sc[wid * 128 + k] * wv; a1 += sc[D + wid * 128 + k] * wv; }
        part[(wid * 2 + 0) * 64 + lane] = a0; part[(wid * 2 + 1) * 64 + lane] = a1;
        __syncthreads();
        if (tid < 128) { const int b = tid >> 6, j = tid & 63; float s = 0.f;
#pragma unroll
            for (int w8 = 0; w8 < 8; ++w8) s += part[(w8 * 2 + b) * 64 + j];
            mod[((size_t)l * 2 + b) * NMOD + jc * 64 + j] = s + a.b_ada[(size_t)l * NMOD + jc * 64 + j]; }
        __syncthreads();
    }
}
__device__ __forceinline__ void transpose_item(const float* colptr, int ld, bf16_t* dst  , int dstK, float* scr, int lane) {
    float tv[32];
#pragma unroll
    for (int i = 0; i < 32; ++i) tv[i] = colptr ? colptr[(size_t)(2 * i + (lane >> 5)) * ld] : 0.f;
#pragma unroll
    for (int i = 0; i < 32; ++i) scr[(2 * i + (lane >> 5)) * 33 + (lane & 31)] = tv[i];
    LDSWAIT();
    const int c = lane & 7;
#pragma unroll
    for (int j = 0; j < 4; ++j) { const int n = (lane >> 3) + 8 * j; const float* s = scr + (8 * c) * 33 + n;
        u32x4 o; o.x = pk2(s[0 * 33], s[1 * 33]); o.y = pk2(s[2 * 33], s[3 * 33]); o.z = pk2(s[4 * 33], s[5 * 33]); o.w = pk2(s[6 * 33], s[7 * 33]);
        *(u32x4*)(dst + (size_t)n * dstK + 8 * c) = o; }
    LDSWAIT();
}
__device__ __forceinline__ void transpose_item_fp8(const float* colptr, int ld, unsigned char* dst  , int dstK, float scale, float* scr, int lane) {
    float tv[32];
#pragma unroll
    for (int i = 0; i < 32; ++i) tv[i] = colptr ? colptr[(size_t)(2 * i + (lane >> 5)) * ld] : 0.f;
#pragma unroll
    for (int i = 0; i < 32; ++i) scr[(2 * i + (lane >> 5)) * 33 + (lane & 31)] = tv[i];
    LDSWAIT();
    const int n = lane >> 1, kh = 32 * (lane & 1); const float* s = scr + kh * 33 + n;
    unsigned w[8];
#pragma unroll
    for (int q = 0; q < 8; ++q) { unsigned t = 0u;
        t = __builtin_amdgcn_cvt_pk_fp8_f32(s[(4 * q + 0) * 33] * scale, s[(4 * q + 1) * 33] * scale, t, false);
        t = __builtin_amdgcn_cvt_pk_fp8_f32(s[(4 * q + 2) * 33] * scale, s[(4 * q + 3) * 33] * scale, t, true);
        w[q] = t; }
    unsigned char* dp = dst + (size_t)n * dstK + kh;
    *(u32x4*)dp = (u32x4){w[0], w[1], w[2], w[3]}; *(u32x4*)(dp + 16) = (u32x4){w[4], w[5], w[6], w[7]};
    LDSWAIT();
}
__device__ __forceinline__ int w1_src_col(int n) {
    if (n < 1472) return n;
    if (n < 2240) return n + 4;
    if (n < 2752) return n + 8;
    if (n < 2756) return 1472 + (n - 2752);
    if (n < 2760) return 2244 + (n - 2756);
    if (n < 2816) return -1;
    return 2760 + (n - 2816);
}
__device__ __forceinline__ void convert_weights(const Args& a, int l, unsigned char* lds, int wid_s) {
    const int tid = ftid(wid_s), lane = tid & 63, wid = tid >> 6;
    float* scr = (float*)(lds + 16384) + wid * (64 * 33);
    const int gw = blockIdx.x * 8 + wid, NGW = gridDim.x * 8;
    constexpr int I_IN = 16 * 216, I_GU = 16 * 176, I_B = 512, I_O = 512, I_D = 44 * 32;
    bf16_t* W1T = (bf16_t*)(a.ws + WS_W1T); bf16_t* WGU = (bf16_t*)(a.ws + WS_WGU); bf16_t* WBT = (bf16_t*)(a.ws + WS_WBT); bf16_t* WOT = (bf16_t*)(a.ws + WS_WOT); bf16_t* WDT = (bf16_t*)(a.ws + WS_WDT);
    const int cl = lane & 31;
    for (int it = gw; it < I_IN + I_GU + I_B + I_O + I_D; it += NGW) {
        int r = it;
        if (r < I_IN) { const int kb = r / 216, nb = r % 216;
            if (nb < 88) { const int n = 32 * nb + cl, sc_ = w1_src_col(n);
                const float* cp = sc_ >= 0 ? a.w_in + (size_t)l * D * INW + (size_t)(64 * kb) * INW + sc_ : nullptr;
                transpose_item(cp, INW, W1T + (size_t)(32 * nb) * D + 64 * kb, D, scr, lane); }
            else { const int n = 32 * nb + cl;
                const float* cp = a.w_in + (size_t)l * D * INW + (size_t)(64 * kb) * INW + w1_src_col(n);
                transpose_item_fp8(cp, INW, a.ws + WS_WG8 + (size_t)(32 * (nb - 88)) * D + 64 * kb, D, 32.0f, scr, lane); }
            continue; }
        r -= I_IN;
        if (r < I_GU) { const int kb = r / 176, nb = r % 176, n = 32 * nb + cl;
            const float* cp = ((n & 1) ? a.w_up : a.w_gate) + (size_t)l * D * DFF + (size_t)(64 * kb) * DFF + (n >> 1);
#if FFN8
            transpose_item_fp8(cp, DFF, a.ws + WS_WGU + (size_t)(32 * nb) * D + 64 * kb, D, 32.0f, scr, lane); continue; }
#else
            transpose_item(cp, DFF, WGU + (size_t)(32 * nb) * D + 64 * kb, D, scr, lane); continue; }
#endif
        r -= I_GU;
        if (r < I_B) { const int nbr = r / 128, rr = r % 128, kb = rr / 32, nb = rr % 32;
            const float* cp = a.w_branch + ((size_t)(l * 4 + nbr) * 256 + 64 * kb) * D + 32 * nb + cl;
            transpose_item(cp, D, WBT + ((size_t)nbr * D + 32 * nb) * 256 + 64 * kb, 256, scr, lane); continue; }
        r -= I_B;
        if (r < I_O) { const int kb = r / 32, nb = r % 32;
            const float* cp = a.w_o + (size_t)l * D * D + (size_t)(64 * kb) * D + 32 * nb + cl;
#if WO8
            transpose_item_fp8(cp, D, a.ws + WS_WOT + (size_t)(32 * nb) * D + 64 * kb, D, 32.0f, scr, lane); continue; }
#else
            transpose_item(cp, D, WOT + (size_t)(32 * nb) * D + 64 * kb, D, scr, lane); continue; }
#endif
        r -= I_O;
        { const int kb = r / 32, nb = r % 32;
            const float* cp = a.w_down + (size_t)l * DFF * D + (size_t)(64 * kb) * D + 32 * nb + cl;
#if DOWN8
            transpose_item_fp8(cp, D, a.ws + WS_WDT + (size_t)(32 * nb) * DFF + 64 * kb, DFF, 32.0f, scr, lane); }
#else
            transpose_item(cp, D, WDT + (size_t)(32 * nb) * DFF + 64 * kb, DFF, scr, lane); }
#endif
    }
}

template <bool HAS_RAW, bool HAS_H, bool XIN16 = false, bool XOUT16 = false, bool HAS_H8 = false>
__device__ __forceinline__ void row_pass8(const void* xres_, const bf16_t* raw, void* xdst_, bf16_t* hdst, unsigned char* h8dst, const float* gate, const float* gam_out, const float* gam_in, const float* sc, const float* sh, int lane) {
    f32x4 A[4], B[4], C[4];
#pragma unroll
    for (int j = 0; j < 4; ++j) {
        if (HAS_RAW) A[j] = ((const f32x4*)gate)[lane + 64 * j] * ((const f32x4*)gam_out)[lane + 64 * j];
        if (HAS_H) { B[j] = ((const f32x4*)gam_in)[lane + 64 * j] * (((const f32x4*)sc)[lane + 64 * j] + 1.0f); C[j] = ((const f32x4*)sh)[lane + 64 * j]; }
    }
    const float* xres = (const float*)xres_; const bf16_t* xres16 = (const bf16_t*)xres_; float* xdst = (float*)xdst_; bf16_t* xdst16 = (bf16_t*)xdst_;
    f32x4 nv[4]; u32x2 nx[4], nr[4];
#pragma unroll
    for (int j = 0; j < 4; ++j) { if (XIN16) nx[j] = ((const u32x2*)xres16)[lane + 64 * j]; else nv[j] = ((const f32x4*)xres)[lane + 64 * j]; if (HAS_RAW) nr[j] = ((const u32x2*)raw)[lane + 64 * j]; }
#pragma unroll 1
    for (int r = 0; r < 8; ++r) {
        f32x4 v[4]; u32x2 w[4];
#pragma unroll
        for (int j = 0; j < 4; ++j) { if (XIN16) v[j] = (f32x4){bflo(nx[j].x), bfhi(nx[j].x), bflo(nx[j].y), bfhi(nx[j].y)}; else v[j] = nv[j]; if (HAS_RAW) w[j] = nr[j]; }
        if (r + 1 < 8) {
#pragma unroll
            for (int j = 0; j < 4; ++j) { if (XIN16) nx[j] = ((const u32x2*)(xres16 + (size_t)(r + 1) * D))[lane + 64 * j]; else nv[j] = ((const f32x4*)(xres + (size_t)(r + 1) * D))[lane + 64 * j];
                if (HAS_RAW) nr[j] = ((const u32x2*)(raw + (size_t)(r + 1) * D))[lane + 64 * j]; }
        }
        if (HAS_RAW) {
            f32x4 o[4]; float ss = 0.f;
#pragma unroll
            for (int j = 0; j < 4; ++j) { o[j] = (f32x4){bflo(w[j].x), bfhi(w[j].x), bflo(w[j].y), bfhi(w[j].y)}; ss += (o[j][0] * o[j][0] + o[j][1] * o[j][1]) + (o[j][2] * o[j][2] + o[j][3] * o[j][3]); }
            const float rstd = 1.0f / sqrtf(wave_sum(ss, lane) * (1.0f / D) + RMS_EPS);
#pragma unroll
            for (int j = 0; j < 4; ++j) { v[j] = v[j] + A[j] * (o[j] * rstd);
                if (XOUT16) { u32x2 pw; pw.x = pk2(v[j][0], v[j][1]); pw.y = pk2(v[j][2], v[j][3]); ((u32x2*)(xdst16 + (size_t)r * D))[lane + 64 * j] = pw; }
                else ((f32x4*)(xdst + (size_t)r * D))[lane + 64 * j] = v[j]; }
        }
        if (HAS_H) {
            float ss = 0.f;
#pragma unroll
            for (int j = 0; j < 4; ++j) ss += (v[j][0] * v[j][0] + v[j][1] * v[j][1]) + (v[j][2] * v[j][2] + v[j][3] * v[j][3]);
            const float rstd = 1.0f / sqrtf(wave_sum(ss, lane) * (1.0f / D) + RMS_EPS);
#pragma unroll
            for (int j = 0; j < 4; ++j) { const f32x4 h = v[j] * rstd * B[j] + C[j]; if (hdst) { u32x2 pw; pw.x = pk2(h[0], h[1]); pw.y = pk2(h[2], h[3]); ((u32x2*)(hdst + (size_t)r * D))[lane + 64 * j] = pw; }
                if (HAS_H8) { unsigned t8 = 0u; t8 = __builtin_amdgcn_cvt_pk_fp8_f32(h[0], h[1], t8, false); t8 = __builtin_amdgcn_cvt_pk_fp8_f32(h[2], h[3], t8, true); ((unsigned*)(h8dst + (size_t)r * D))[lane + 64 * j] = t8; } }
        }
    }
}

__device__ __forceinline__ void conv_phase(const Args& a, int l, int wid_s) {
    const bf16_t* Z = (const bf16_t*)(a.ws + WS_Z); bf16_t* Y0 = (bf16_t*)(a.ws + WS_H);
    const float* cw = a.conv_w + (size_t)l * 3 * 256;
    const int gt = blockIdx.x * 512 + ftid(wid_s), GT = gridDim.x * 512;
    for (int it = gt; it < MROWS * 32; it += GT) {
        const int row = it >> 5, ch = (it & 31) * 8, t = row & (SEQ - 1);
        float acc[8];
#pragma unroll
        for (int k = 0; k < 8; ++k) acc[k] = 0.f;
#pragma unroll
        for (int j = 0; j < 3; ++j) { const int dt = 2 - j; if (t - dt < 0) continue;
            const bf16_t* zr = Z + (size_t)(row - dt) * ZW;
            const u32x4 u = *(const u32x4*)(zr + ZC_AU + ch), cgt = *(const u32x4*)(zr + ZC_AC + ch);
            const f32x4 w0 = *(const f32x4*)(cw + j * 256 + ch), w1 = *(const f32x4*)(cw + j * 256 + ch + 4);
            acc[0] += w0[0] * bflo(u.x) * bflo(cgt.x); acc[1] += w0[1] * bfhi(u.x) * bfhi(cgt.x); acc[2] += w0[2] * bflo(u.y) * bflo(cgt.y); acc[3] += w0[3] * bfhi(u.y) * bfhi(cgt.y);
            acc[4] += w1[0] * bflo(u.z) * bflo(cgt.z); acc[5] += w1[1] * bfhi(u.z) * bfhi(cgt.z); acc[6] += w1[2] * bflo(u.w) * bflo(cgt.w); acc[7] += w1[3] * bfhi(u.w) * bfhi(cgt.w); }
        const u32x4 bg = *(const u32x4*)(Z + (size_t)row * ZW + ZC_AB + ch);
        u32x4 o; o.x = pk2(acc[0] * bflo(bg.x), acc[1] * bfhi(bg.x)); o.y = pk2(acc[2] * bflo(bg.y), acc[3] * bfhi(bg.y)); o.z = pk2(acc[4] * bflo(bg.z), acc[5] * bfhi(bg.z)); o.w = pk2(acc[6] * bflo(bg.w), acc[7] * bfhi(bg.w));
        *(u32x4*)(Y0 + (size_t)row * 256 + ch) = o;
    }
}

__device__ __forceinline__ void fox_scan(const Args& a, int l, int bh, unsigned char* lds, int wid_s) {
    const int tid = ftid(wid_s), lane = tid & 63, wid = tid >> 6, b = bh >> 2, h = bh & 3;
    const float* SM = (const float*)(a.ws + WS_SMALL); float* F2 = (float*)(a.ws + WS_FCUM) + (size_t)bh * SEQ;
    const float bias = a.fox_bias[l * 4 + h];
    float* wtot = (float*)lds;
    float v[16]; float run = 0.f;
#pragma unroll
    for (int i = 0; i < 16; ++i) { const float x = SM[((size_t)b * SEQ + tid * 16 + i) * 8 + 4 + h] + bias;
        const float ls = fminf(x, 0.f) - log1pf(__expf(-fabsf(x))); run += ls; v[i] = run; }
    float inc = run;
#pragma unroll
    for (int o = 1; o < 64; o <<= 1) { const float t = shf(inc, lane - o); if (lane >= o) inc += t; }
    if (lane == 63) wtot[wid] = inc;
    __syncthreads();
    float base = inc - run;
    for (int w = 0; w < wid; ++w) base += wtot[w];
#pragma unroll
    for (int i = 0; i < 16; ++i) F2[tid * 16 + i] = (base + v[i]) * LOG2E;
    __syncthreads();
}


__device__ __forceinline__ void fox_kmax_item(const Args& a, int l, int item, int wid_s) {
    const int tid = ftid(wid_s), lane = tid & 63, bh = item >> 3, chunk = item & 7, b = bh >> 2, h = bh & 3;
    const bf16_t* Z = (const bf16_t*)(a.ws + WS_Z);
    float mx = 0.f;
#pragma unroll
    for (int rr = 0; rr < 2; ++rr) { const bf16_t* kp = Z + ((size_t)b * SEQ + chunk * 1024 + rr * 512 + tid) * ZW + ZC_FK + h * 64; float q2 = 0.f;
#pragma unroll
        for (int i = 0; i < 8; ++i) { const u32x4 w = *(const u32x4*)(kp + 8 * i);
            q2 += bflo(w.x) * bflo(w.x) + bfhi(w.x) * bfhi(w.x) + bflo(w.y) * bflo(w.y) + bfhi(w.y) * bfhi(w.y) + bflo(w.z) * bflo(w.z) + bfhi(w.z) * bfhi(w.z) + bflo(w.w) * bflo(w.w) + bfhi(w.w) * bfhi(w.w); }
        mx = fmaxf(mx, q2); }
#pragma unroll
    for (int o = 1; o < 64; o <<= 1) mx = fmaxf(mx, shf(mx, lane ^ o));
    if (lane == 0) atomicMax((unsigned*)(a.ws + WS_KMAX) + l * 8 + bh, __float_as_uint(mx));
}

template <int MODE>
__device__ __forceinline__ void attn_unit(unsigned char* lds, const bf16_t* __restrict__ Z, bf16_t* __restrict__ Yn, int b, int head, int qb, const float* __restrict__ F2, float slope2, float sink2, int tile_lo, float kmax, int wid_s) {
    const int tid = ftid(wid_s), lane = tid & 63, r32 = lane & 31, hi = lane >> 5; const int wid = __builtin_amdgcn_readfirstlane(tid >> 6);
    constexpr int QOFF = MODE == 0 ? ZC_FQ : ZC_SQ, KOFF = MODE == 0 ? ZC_FK : ZC_SK, VOFF = MODE == 0 ? ZC_FV : ZC_SV;
    const int hk = MODE == 0 ? head : (head >> 1);
    const size_t rowbase = (size_t)b * SEQ;
    const int q0 = qb * 256, qa = q0 + 32 * wid, myq = qa + r32;
    unsigned char* Ks = lds; unsigned char* Vs = lds + 9216; float* Fk = (float*)(lds + 9216 + 12288); float* wsc = (float*)(lds + 49152) + wid * 64;
    bf16x8 qr[4];
    { const bf16_t* qp = Z + (rowbase + myq) * ZW + QOFF + head * 64 + hi * 8;
#pragma unroll
      for (int ks = 0; ks < 4; ++ks) qr[ks] = *(const bf16x8*)(qp + 16 * ks); }
    const float* Fh = MODE == 0 ? F2 + ((size_t)b * 4 + head) * SEQ : nullptr;
    const float fq2 = MODE == 0 ? Fh[myq] : 0.f;
    float m = -1e30f, l = 0.f; f32x16 o0, o1;
#pragma unroll
    for (int r = 0; r < 16; ++r) { o0[r] = 0.f; o1[r] = 0.f; }
    const int t_hi = (q0 + 255) >> 6;
    if (MODE == 0) {
        int* smin = (int*)(lds + 49152 + 2048);
        __syncthreads();
        if (tid == 0) *smin = 0x7fffffff;
        __syncthreads();
        if (tid < 256) {
            const int t = q0 + tid; const bf16_t* qp2 = Z + (rowbase + t) * ZW + QOFF + head * 64; float q2 = 0.f;
#pragma unroll
            for (int i = 0; i < 8; ++i) { const u32x4 w = *(const u32x4*)(qp2 + 8 * i);
                q2 += bflo(w.x) * bflo(w.x) + bfhi(w.x) * bfhi(w.x) + bflo(w.y) * bflo(w.y) + bfhi(w.y) * bfhi(w.y) + bflo(w.z) * bflo(w.z) + bfhi(w.z) * bfhi(w.z) + bflo(w.w) * bflo(w.w) + bfhi(w.w) * bfhi(w.w); }
            const float target = Fh[t] + (40.0f + 0.25f * sqrtf(q2) * kmax) * LOG2E;
            int lo = 0, hi2 = t;
            while (lo < hi2) { const int mid = (lo + hi2) >> 1; if (Fh[mid] <= target) hi2 = mid; else lo = mid + 1; }
            atomicMin(smin, lo);
        }
        __syncthreads();
#ifdef PROBE_FOXFULL
        tile_lo = 0;
#else
        tile_lo = *smin >> 6;
#endif
    }
    const int srow = tid >> 3, sch = tid & 7;
    const int i16 = lane & 15;
    const LAS unsigned char* vtr_base = (const LAS unsigned char*)(Vs) + (4 * hi + (i16 >> 2)) * 192 + (16 * ((lane >> 4) & 1) + 4 * (i16 & 3)) * 2;
    u32x4 nk, nv4; float nf = 0.f;
    { const bf16_t* src = Z + (rowbase + 64 * t_hi + srow) * ZW;
      nk = *(const u32x4*)(src + KOFF + hk * 64 + sch * 8); nv4 = *(const u32x4*)(src + VOFF + hk * 64 + sch * 8);
      if (MODE == 0 && tid < 64) nf = Fh[64 * t_hi + tid]; }
    constexpr int ABUF = 24576;
    __syncthreads();
    { unsigned char* kb_ = Ks + (t_hi & 1) * ABUF; unsigned char* vb_ = Vs + (t_hi & 1) * ABUF;
      *(u32x4*)(kb_ + srow * 144 + sch * 16) = nk; *(u32x4*)(vb_ + srow * 192 + sch * 16) = nv4;
      if (MODE == 0 && tid < 64) (Fk + (t_hi & 1) * (ABUF / 4))[tid] = nf; }
    if (t_hi > tile_lo) { const bf16_t* src = Z + (rowbase + 64 * (t_hi - 1) + srow) * ZW;
      nk = *(const u32x4*)(src + KOFF + hk * 64 + sch * 8); nv4 = *(const u32x4*)(src + VOFF + hk * 64 + sch * 8);
      if (MODE == 0 && tid < 64) nf = Fh[64 * (t_hi - 1) + tid]; }
    for (int T = t_hi; T >= tile_lo; --T) {
        __syncthreads();
        if (T > tile_lo) {
            unsigned char* kb_ = Ks + ((T - 1) & 1) * ABUF; unsigned char* vb_ = Vs + ((T - 1) & 1) * ABUF;
            *(u32x4*)(kb_ + srow * 144 + sch * 16) = nk; *(u32x4*)(vb_ + srow * 192 + sch * 16) = nv4;
            if (MODE == 0 && tid < 64) (Fk + ((T - 1) & 1) * (ABUF / 4))[tid] = nf;
            if (T - 1 > tile_lo) { const bf16_t* src = Z + (rowbase + 64 * (T - 2) + srow) * ZW;
              nk = *(const u32x4*)(src + KOFF + hk * 64 + sch * 8); nv4 = *(const u32x4*)(src + VOFF + hk * 64 + sch * 8);
              if (MODE == 0 && tid < 64) nf = Fh[64 * (T - 2) + tid]; }
        }
        const unsigned char* Kc = Ks + (T & 1) * ABUF; const float* Fc = Fk + (T & 1) * (ABUF / 4); const int vofs = (T & 1) * ABUF;
        const bool part = (64 * T <= qa + 31) && (MODE == 0 || (64 * T + 63 >= qa - 127));
        if (part) {
            f32x16 p0, p1;
#pragma unroll
            for (int r = 0; r < 16; ++r) { p0[r] = 0.f; p1[r] = 0.f; }
#pragma unroll
            for (int ks = 0; ks < 4; ++ks) {
                const bf16x8 k0 = *(const bf16x8*)(Kc + r32 * 144 + (16 * ks + 8 * hi) * 2);
                const bf16x8 k1 = *(const bf16x8*)(Kc + (32 + r32) * 144 + (16 * ks + 8 * hi) * 2);
                p0 = __builtin_amdgcn_mfma_f32_32x32x16_bf16(k0, qr[ks], p0, 0, 0, 0);
                p1 = __builtin_amdgcn_mfma_f32_32x32x16_bf16(k1, qr[ks], p1, 0, 0, 0);
            }
            const int kvb = 64 * T + 4 * hi;
            float mx = -INFINITY;
#pragma unroll
            for (int g = 0; g < 4; ++g) {
                f32x4 fk0 = {0.f, 0.f, 0.f, 0.f}, fk1 = {0.f, 0.f, 0.f, 0.f};
                if (MODE == 0) { fk0 = *(const f32x4*)(Fc + 8 * g + 4 * hi); fk1 = *(const f32x4*)(Fc + 32 + 8 * g + 4 * hi); }
#pragma unroll
                for (int i = 0; i < 4; ++i) { const int r = 4 * g + i, kv0 = kvb + 8 * g + i, kv1 = kv0 + 32;
                    float x0, x1;
                    if (MODE == 0) { x0 = p0[r] * C2 + (fq2 - fk0[i]); x1 = p1[r] * C2 + (fq2 - fk1[i]); if (kv0 > myq) x0 = -INFINITY; if (kv1 > myq) x1 = -INFINITY; }
                    else { const int d0 = myq - kv0, d1 = myq - kv1; x0 = p0[r] * C2 - slope2 * (float)d0; x1 = p1[r] * C2 - slope2 * (float)d1; if (d0 < 0 || d0 >= 128) x0 = -INFINITY; if (d1 < 0 || d1 >= 128) x1 = -INFINITY; }
                    p0[r] = x0; p1[r] = x1; mx = fmaxf(mx, fmaxf(x0, x1)); }
            }
            mx = swap32_max(mx);
            const float mn = fmaxf(m, mx), alpha = __builtin_amdgcn_exp2f(m - mn); m = mn;
            float ps = 0.f;
#pragma unroll
            for (int r = 0; r < 16; ++r) { p0[r] = __builtin_amdgcn_exp2f(p0[r] - mn); p1[r] = __builtin_amdgcn_exp2f(p1[r] - mn); ps += p0[r] + p1[r]; }
            l = l * alpha + ps;
            if (hi == 0) wsc[r32] = alpha;
            LDSWAIT();
#pragma unroll
            for (int g = 0; g < 4; ++g) { const f32x4 a4 = *(const f32x4*)(wsc + 8 * g + 4 * hi);
#pragma unroll
                for (int i = 0; i < 4; ++i) { o0[4 * g + i] *= a4[i]; o1[4 * g + i] *= a4[i]; } }
            LDSWAIT();
#pragma unroll
            for (int s = 0; s < 4; ++s) {
                u32x4 pw;
                if (s < 2) { const int e = 8 * s; pw.x = pk2(p0[e], p0[e + 1]); pw.y = pk2(p0[e + 2], p0[e + 3]); pw.z = pk2(p0[e + 4], p0[e + 5]); pw.w = pk2(p0[e + 6], p0[e + 7]); }
                else { const int e = 8 * (s - 2); pw.x = pk2(p1[e], p1[e + 1]); pw.y = pk2(p1[e + 2], p1[e + 3]); pw.z = pk2(p1[e + 4], p1[e + 5]); pw.w = pk2(p1[e + 6], p1[e + 7]); }
                const bf16x8 pa = __builtin_bit_cast(bf16x8, pw);
#pragma unroll
                for (int db = 0; db < 2; ++db) {
                    const LAS unsigned char* vp = vtr_base + vofs + (16 * s) * 192 + 64 * db;
                    const s16x4 lo = __builtin_bit_cast(s16x4, __builtin_amdgcn_ds_read_tr16_b64_v4i16((LAS s16x4*)vp));
                    const s16x4 hv = __builtin_bit_cast(s16x4, __builtin_amdgcn_ds_read_tr16_b64_v4i16((LAS s16x4*)(vp + 8 * 192)));
                    const bf16x8 vf = (bf16x8){lo[0], lo[1], lo[2], lo[3], hv[0], hv[1], hv[2], hv[3]};
                    if (db == 0) o0 = __builtin_amdgcn_mfma_f32_32x32x16_bf16(pa, vf, o0, 0, 0, 0); else o1 = __builtin_amdgcn_mfma_f32_32x32x16_bf16(pa, vf, o1, 0, 0, 0);
                }
            }
        }
    }
    float lt = swap32_sum(l);
    if (MODE == 1) lt += __builtin_amdgcn_exp2f(sink2 - m);
    const float inv = 1.0f / lt;
    LDSWAIT();
    if (hi == 0) wsc[32 + r32] = inv;
    LDSWAIT();
#pragma unroll
    for (int g = 0; g < 4; ++g) { const f32x4 iv = *(const f32x4*)(wsc + 32 + 8 * g + 4 * hi);
#pragma unroll
        for (int i = 0; i < 4; ++i) { const int r = 4 * g + i, q = qa + 8 * g + 4 * hi + i;
            bf16_t* yp = Yn + (rowbase + q) * 256 + head * 64 + r32;
            yp[0] = (bf16_t)f2bf(o0[r] * iv[i]); yp[32] = (bf16_t)f2bf(o1[r] * iv[i]); } }
    LDSWAIT();
}

__device__ __forceinline__ unsigned score_key(float s) { const unsigned u = __float_as_uint(s + 0.0f); return (u & 0x80000000u) ? ~u : (u | 0x80000000u); }
__device__ __forceinline__ void hist_find(const unsigned* hrow, int lane, unsigned need, unsigned& bin, unsigned& above) {
    unsigned w[16]; unsigned tot = 0;
#pragma unroll
    for (int i = 0; i < 16; i += 4) { const u32x4 t = *(const u32x4*)(hrow + 16 * lane + i); w[i] = t.x; w[i + 1] = t.y; w[i + 2] = t.z; w[i + 3] = t.w; }
#pragma unroll
    for (int i = 0; i < 16; ++i) tot += (w[i] & 0xffffu) + (w[i] >> 16);
    unsigned inc = tot;
#pragma unroll
    for (int o = 1; o < 64; o <<= 1) { const unsigned t = shu(inc, lane + o); if (lane + o < 64) inc += t; }
    const unsigned exc = inc - tot;
    const bool owner = (exc < need) && (inc >= need);
    unsigned run = exc, fb = 0, fa = 0; bool found = false;
#pragma unroll
    for (int i = 15; i >= 0; --i) {
        const unsigned hi = w[i] >> 16, lo = w[i] & 0xffffu;
        if (!found && run + hi >= need) { found = true; fb = 32 * lane + 2 * i + 1; fa = run; }
        run += hi;
        if (!found && run + lo >= need) { found = true; fb = 32 * lane + 2 * i; fa = run; }
        run += lo;
    }
    const unsigned long long bal = __ballot(owner);
    const int src = bal ? (int)__builtin_ctzll(bal) : 0;
    bin = shu(fb, src); above = shu(fa, src);
}
__device__ __forceinline__ void dsa_select_slow(const Args& a, unsigned char* lds, int b, int qb32, int wid_s) {
    const int tid = ftid(wid_s), lane = tid & 63; const int wid = __builtin_amdgcn_readfirstlane(tid >> 6);
    const int c16 = lane & 15, g = lane >> 4;
    const bf16_t* Z = (const bf16_t*)(a.ws + WS_Z); const float* SM = (const float*)(a.ws + WS_SMALL);
    unsigned short* IDX = (unsigned short*)(a.ws + WS_MG);
    unsigned* hist = (unsigned*)lds;
    unsigned char* kt = lds + 131072;
    const size_t rowbase = (size_t)b * SEQ;
    const int t0 = qb32 * 32, myt = t0 + 4 * wid + g;
    const int ntile = (t0 + 32 + 63) >> 6;
    bf16x8 af[2];
    { const int qq = c16 >> 2, h = c16 & 3; const bf16_t* qp = Z + (rowbase + t0 + 4 * wid + qq) * ZW + ZC_DQI + h * 64 + 8 * g;
      af[0] = *(const bf16x8*)qp; af[1] = *(const bf16x8*)(qp + 32); }
    const f32x4 wv = *(const f32x4*)(SM + (rowbase + myt) * 8);
    const unsigned need = (unsigned)((myt + 1) < 256 ? (myt + 1) : 256);
    unsigned b1 = 0, above1 = 0, thr22 = 0, quota = 0;
    unsigned tiecount = 0, outcount = 0;
    unsigned* myhist = hist + (size_t)(4 * wid + g) * 1024;
    unsigned short* myidx = IDX + (rowbase + myt) * 256;
    const int srow = tid >> 3, sch = tid & 7;
    for (int pass = 0; pass < 3; ++pass) {
        if (pass < 2) { unsigned z_ = 0u; asm volatile("" : "+v"(z_)); const u32x4 z4 = {z_, z_, z_, z_};
            for (int i = tid; i < 32 * 1024 / 4; i += 512) ((u32x4*)hist)[i] = z4; }
        for (int T = 0; T < ntile; ++T) {
            __syncthreads();
            *(u32x4*)(kt + srow * 144 + sch * 16) = *(const u32x4*)(Z + (rowbase + 64 * T + srow) * ZW + ZC_DKI + sch * 8);
            __syncthreads();
#pragma unroll
            for (int cg4 = 0; cg4 < 4; ++cg4) {
                const bf16x8 k0 = *(const bf16x8*)(kt + (16 * cg4 + c16) * 144 + (8 * g) * 2);
                const bf16x8 k1 = *(const bf16x8*)(kt + (16 * cg4 + c16) * 144 + (32 + 8 * g) * 2);
                f32x4 acc = {0.f, 0.f, 0.f, 0.f};
                acc = __builtin_amdgcn_mfma_f32_16x16x32_bf16(af[0], k0, acc, 0, 0, 0);
                acc = __builtin_amdgcn_mfma_f32_16x16x32_bf16(af[1], k1, acc, 0, 0, 0);
                const int key = 64 * T + 16 * cg4 + c16;
                const bool valid = key <= myt;
                const float sc = wv[0] * fmaxf(acc[0], 0.f) + wv[1] * fmaxf(acc[1], 0.f) + wv[2] * fmaxf(acc[2], 0.f) + wv[3] * fmaxf(acc[3], 0.f);
                const unsigned u = score_key(sc);
                if (pass == 0) { if (valid) { const unsigned bin = u >> 21; atomicAdd(myhist + (bin >> 1), (bin & 1u) ? 65536u : 1u); } }
                else if (pass == 1) { if (valid && (u >> 21) == b1) { const unsigned bin = (u >> 10) & 0x7ffu; atomicAdd(myhist + (bin >> 1), (bin & 1u) ? 65536u : 1u); } }
                else {
                    const unsigned p22 = u >> 10;
                    const bool tie = valid && (p22 == thr22);
                    const unsigned long long tb = __ballot(tie);
                    const unsigned tmask = (unsigned)(tb >> (16 * g)) & 0xffffu;
                    const bool acc_tie = tie && (tiecount + __popc(tmask & ((1u << c16) - 1u)) < quota);
                    tiecount += __popc(tmask);
                    const bool sel = (valid && p22 > thr22) || acc_tie;
                    const unsigned long long sb = __ballot(sel);
                    const unsigned smask = (unsigned)(sb >> (16 * g)) & 0xffffu;
                    if (sel) myidx[outcount + __popc(smask & ((1u << c16) - 1u))] = (unsigned short)key;
                    outcount += __popc(smask);
                }
            }
        }
        __syncthreads();
        if (pass == 0) {
#pragma unroll
            for (int qq = 0; qq < 4; ++qq) { const unsigned nd = shu(need, 16 * qq); unsigned bn, ab; hist_find(hist + (size_t)(4 * wid + qq) * 1024, lane, nd, bn, ab); if (g == qq) { b1 = bn; above1 = ab; } }
            __syncthreads();
        } else if (pass == 1) {
#pragma unroll
            for (int qq = 0; qq < 4; ++qq) { const unsigned nd = shu(need - above1, 16 * qq); unsigned bn, ab; hist_find(hist + (size_t)(4 * wid + qq) * 1024, lane, nd, bn, ab); if (g == qq) { thr22 = (b1 << 11) | bn; quota = need - above1 - ab; } }
            __syncthreads();
        }
    }
}


#ifndef SELREP
#define SELREP 0
#endif
constexpr int DS_CAP = 576, DS_RANK = 104;
constexpr unsigned ZCLASS = 0x80000000u >> 10;
__device__ __forceinline__ unsigned below_me(unsigned long long bal) { return __builtin_amdgcn_mbcnt_hi((unsigned)(bal >> 32), __builtin_amdgcn_mbcnt_lo((unsigned)bal, 0u)); }
__device__ __forceinline__ float relu1(float x) { return __builtin_amdgcn_fmed3f(x, 0.0f, 3.0e38f); }
__device__ __forceinline__ float idx_score_acc(const f32x4& acc, const f32x4& wv) {
    return fmaf(wv[3], relu1(acc[3]), fmaf(wv[2], relu1(acc[2]), fmaf(wv[1], relu1(acc[1]), wv[0] * relu1(acc[0])))) + 0.0f;
}
__device__ __forceinline__ unsigned fkey(float s) { const unsigned u = __float_as_uint(s); return (u & 0x80000000u) ? ~u : (u | 0x80000000u); }
__device__ __forceinline__ float key_to_float(unsigned k) { return k == 0u ? -INFINITY : __uint_as_float((k & 0x80000000u) ? (k & 0x7fffffffu) : ~k); }
__device__ __forceinline__ void idx_scores8(const unsigned char* kt, int c16, int g, const bf16x8 (&af)[2], const f32x4& wv, float (&u)[8]) {
    bf16x8 kf[8][2];
#pragma unroll
    for (int grp = 0; grp < 8; ++grp) { kf[grp][0] = *(const bf16x8*)(kt + (16 * grp + c16) * 144 + (8 * g) * 2); kf[grp][1] = *(const bf16x8*)(kt + (16 * grp + c16) * 144 + (32 + 8 * g) * 2); }
    __builtin_amdgcn_sched_barrier(0);
    f32x4 acc[8];
#pragma unroll
    for (int grp = 0; grp < 8; ++grp) acc[grp] = __builtin_amdgcn_mfma_f32_16x16x32_bf16(af[0], kf[grp][0], (f32x4){0.f, 0.f, 0.f, 0.f}, 0, 0, 0);
#pragma unroll
    for (int grp = 0; grp < 8; ++grp) acc[grp] = __builtin_amdgcn_mfma_f32_16x16x32_bf16(af[1], kf[grp][1], acc[grp], 0, 0, 0);
    __builtin_amdgcn_sched_barrier(0);
#pragma unroll
    for (int grp = 0; grp < 8; ++grp) u[grp] = idx_score_acc(acc[grp], wv);
}
__device__ __forceinline__ unsigned row_scan_incl(unsigned x) {
    x += (unsigned)__builtin_amdgcn_update_dpp(0, (int)x, 0x111, 0xF, 0xF, true);
    x += (unsigned)__builtin_amdgcn_update_dpp(0, (int)x, 0x112, 0xF, 0xF, true);
    x += (unsigned)__builtin_amdgcn_update_dpp(0, (int)x, 0x114, 0xF, 0xF, true);
    x += (unsigned)__builtin_amdgcn_update_dpp(0, (int)x, 0x118, 0xF, 0xF, true);
    return x;
}
__device__ __forceinline__ unsigned wave_total(unsigned x) {
    x = row_scan_incl(x);
    return (unsigned)__builtin_amdgcn_readlane((int)x, 15) + (unsigned)__builtin_amdgcn_readlane((int)x, 31) + (unsigned)__builtin_amdgcn_readlane((int)x, 47) + (unsigned)__builtin_amdgcn_readlane((int)x, 63);
}
__device__ __forceinline__ unsigned wave_max_u(unsigned x) {
    unsigned y;
    y = (unsigned)__builtin_amdgcn_update_dpp(0, (int)x, 0x111, 0xF, 0xF, true); x = x > y ? x : y;
    y = (unsigned)__builtin_amdgcn_update_dpp(0, (int)x, 0x112, 0xF, 0xF, true); x = x > y ? x : y;
    y = (unsigned)__builtin_amdgcn_update_dpp(0, (int)x, 0x114, 0xF, 0xF, true); x = x > y ? x : y;
    y = (unsigned)__builtin_amdgcn_update_dpp(0, (int)x, 0x118, 0xF, 0xF, true); x = x > y ? x : y;
    const unsigned a = (unsigned)__builtin_amdgcn_readlane((int)x, 15), b = (unsigned)__builtin_amdgcn_readlane((int)x, 31), c = (unsigned)__builtin_amdgcn_readlane((int)x, 47), d = (unsigned)__builtin_amdgcn_readlane((int)x, 63);
    const unsigned ab = a > b ? a : b, cd = c > d ? c : d; return ab > cd ? ab : cd;
}
template <bool EDGE, bool NEEDZ>
__device__ __forceinline__ void selB_groups(const float (&sc)[8], int keybase, int myt, float tauf, unsigned need, int lane, int c16, int g, unsigned& cnt, unsigned& zc, unsigned* curow, unsigned char* chrow, unsigned short* zlrow) {
    unsigned hm = 0u;
#pragma unroll
    for (int grp = 0; grp < 8; ++grp) {
        const float s = sc[grp];
        bool h = NEEDZ ? ((s >= tauf) && (s != 0.0f)) : (s >= tauf);
        if (EDGE) h = h && (keybase + 16 * grp + c16 <= myt);
        hm |= h ? (1u << grp) : 0u;
    }
    const unsigned nh = (unsigned)__popc(hm), inc = row_scan_incl(nh);
    unsigned pos = cnt + inc - nh;
    cnt += shu(inc, (lane & 48) | 15);
    unsigned rem = hm;
    while (__ballot(rem != 0u)) {
        if (rem) {
            const int grp = __builtin_ctz(rem); rem &= rem - 1u;
            const float a0 = (grp & 1) ? sc[1] : sc[0], a1 = (grp & 1) ? sc[3] : sc[2], a2 = (grp & 1) ? sc[5] : sc[4], a3 = (grp & 1) ? sc[7] : sc[6];
            const float b0 = (grp & 2) ? a1 : a0, b1 = (grp & 2) ? a3 : a2, s = (grp & 4) ? b1 : b0;
            const int key = keybase + 16 * grp + c16;
            if (pos < (unsigned)DS_CAP) { curow[pos] = (fkey(s) & 0xfffffc00u) | ((unsigned)key & 1023u); chrow[pos] = (unsigned char)(key >> 10); }
            ++pos;
        }
    }
    if (NEEDZ) {
        const unsigned lowm = (1u << c16) - 1u;
#pragma unroll
        for (int grp = 0; grp < 8; ++grp) {
            const int key = keybase + 16 * grp + c16;
            bool isz = sc[grp] == 0.0f;
            if (EDGE) isz = isz && (key <= myt);
            const unsigned zmask = (unsigned)(__ballot(isz) >> (16 * g)) & 0xffffu;
            const unsigned zpos = zc + __popc(zmask & lowm);
            if (isz && zpos < need) zlrow[zpos] = (unsigned short)key;
            zc += __popc(zmask);
        }
    }
}
__device__ __forceinline__ void dsa_select_item(const Args& a, unsigned char* lds, int b, int qb32, int wid_s) {
    const int tid = ftid(wid_s), lane = tid & 63; const int wid = __builtin_amdgcn_readfirstlane(tid >> 6);
    const int c16 = lane & 15, g = lane >> 4;
    const bf16_t* Z = (const bf16_t*)(a.ws + WS_Z); const float* SM = (const float*)(a.ws + WS_SMALL);
    unsigned short* IDX = (unsigned short*)(a.ws + WS_MG);
    unsigned short* samp = (unsigned short*)lds;
    unsigned char* ktA = lds + 131072;
    unsigned* cu = (unsigned*)lds;
    unsigned char* ch = lds + 73728;
    unsigned short* zl = (unsigned short*)(lds + 92160);
    unsigned char* ktB = lds + 108544;
    unsigned* flag = (unsigned*)(lds + 149760);
    const size_t rowbase = (size_t)b * SEQ;
    const int t0 = qb32 * 32, myt = t0 + 4 * wid + g, myrow = 4 * wid + g;
    bf16x8 af[2];
    { const int qq = c16 >> 2, h = c16 & 3; const bf16_t* qp = Z + (rowbase + t0 + 4 * wid + qq) * ZW + ZC_DQI + h * 64 + 8 * g;
      af[0] = *(const bf16x8*)qp; af[1] = *(const bf16x8*)(qp + 32); }
#ifdef PROBE_QTRUNC
    { u32x4 t0_ = __builtin_bit_cast(u32x4, af[0]), t1_ = __builtin_bit_cast(u32x4, af[1]); const unsigned mk = 0xfffcfffcu;
      t0_.x &= mk; t0_.y &= mk; t0_.z &= mk; t0_.w &= mk; t1_.x &= mk; t1_.y &= mk; t1_.z &= mk; t1_.w &= mk; af[0] = __builtin_bit_cast(bf16x8, t0_); af[1] = __builtin_bit_cast(bf16x8, t1_); }
#endif
    const f32x4 wv = *(const f32x4*)(SM + (rowbase + myt) * 8);
    const unsigned need = (unsigned)((myt + 1) < 256 ? (myt + 1) : 256);
    const int srow = tid >> 3, sch = tid & 7;
    __syncthreads();
    if (tid == 0) *flag = 0u;
    unsigned tau = 0u;
    for (int repA_ = 0; repA_ < ((SELREP & 1) ? 2 : 1); ++repA_)
    if (t0 + 32 > DS_CAP) {
        __syncthreads();
        const int ms = (t0 + 32) >> 2, ntA = (ms + 127) >> 7;
        const bf16_t* sbase = Z + (rowbase + 3) * ZW + ZC_DKI + sch * 8;
        u32x4 n0, n1;
        { const int i0 = srow < ms ? srow : ms - 1, i1 = 64 + srow < ms ? 64 + srow : ms - 1;
          n0 = *(const u32x4*)(sbase + (size_t)(4 * i0) * ZW); n1 = *(const u32x4*)(sbase + (size_t)(4 * i1) * ZW); }
        for (int T = 0; T < ntA; ++T) {
            __syncthreads();
            *(u32x4*)(ktA + srow * 144 + sch * 16) = n0; *(u32x4*)(ktA + (64 + srow) * 144 + sch * 16) = n1;
            __syncthreads();
            if (T + 1 < ntA) { const int j0 = 128 * (T + 1) + srow, j1 = j0 + 64; const int i0 = j0 < ms ? j0 : ms - 1, i1 = j1 < ms ? j1 : ms - 1;
                n0 = *(const u32x4*)(sbase + (size_t)(4 * i0) * ZW); n1 = *(const u32x4*)(sbase + (size_t)(4 * i1) * ZW); }
            float ua[8]; idx_scores8(ktA, c16, g, af, wv, ua);
#pragma unroll
            for (int grp = 0; grp < 8; ++grp) {
                const int i = 128 * T + 16 * grp + c16;
                samp[myrow * 2048 + i] = ((i < ms) && (4 * i + 3 <= myt)) ? (unsigned short)(fkey(ua[grp]) >> 16) : (unsigned short)0;
            }
        }
        LDSWAIT();
        const int nvalid = 128 * ntA;
        for (int repS_ = 0; repS_ < ((SELREP & 16) ? 2 : 1); ++repS_) {
            unsigned w[4][16];
#pragma unroll
            for (int qq = 0; qq < 4; ++qq) {
                const unsigned* sp = (const unsigned*)(samp + (4 * wid + qq) * 2048) + 16 * lane;
#pragma unroll
                for (int j = 0; j < 16; j += 4) { const u32x4 t4 = *(const u32x4*)(sp + j); w[qq][j] = t4.x; w[qq][j + 1] = t4.y; w[qq][j + 2] = t4.z; w[qq][j + 3] = t4.w; }
#pragma unroll
                for (int j = 0; j < 16; ++j) if (32 * lane + 2 * j >= nvalid) w[qq][j] = 0u;
            }
            unsigned T4[4] = {0u, 0u, 0u, 0u};
#pragma unroll 1
            for (int bit = 15; bit >= 0; --bit) {
                unsigned c[4];
#pragma unroll
                for (int qq = 0; qq < 4; ++qq) { const unsigned cand = T4[qq] | (1u << bit); unsigned cc = 0;
#pragma unroll
                    for (int j = 0; j < 16; ++j) cc += ((w[qq][j] & 0xffffu) >= cand ? 1u : 0u) + ((w[qq][j] >> 16) >= cand ? 1u : 0u);
                    c[qq] = cc; }
                const unsigned t01 = wave_total(c[0] | (c[1] << 16)), t23 = wave_total(c[2] | (c[3] << 16));
                if ((t01 & 0xffffu) >= (unsigned)DS_RANK) T4[0] |= 1u << bit;
                if ((t01 >> 16) >= (unsigned)DS_RANK) T4[1] |= 1u << bit;
                if ((t23 & 0xffffu) >= (unsigned)DS_RANK) T4[2] |= 1u << bit;
                if ((t23 >> 16) >= (unsigned)DS_RANK) T4[3] |= 1u << bit;
            }
#pragma unroll
            for (int qq = 0; qq < 4; ++qq) { const int n = t0 + 4 * wid + qq + 1; if (g == qq) tau = n > DS_CAP ? (T4[qq] << 16) : 0u; }
        }
    }
    unsigned cnt = 0u, zc = 0u;
    const float tauf = key_to_float(tau);
    const bool needz = __ballot(tauf <= 0.0f) != 0ull;
    const int ntile = (t0 + 32 + 127) >> 7;
    for (int repB_ = 0; repB_ < ((SELREP & 2) ? 2 : 1); ++repB_) { cnt = 0u; zc = 0u;
        const bf16_t* kbase = Z + (rowbase + srow) * ZW + ZC_DKI + sch * 8;
        u32x4 n0 = *(const u32x4*)kbase, n1 = *(const u32x4*)(kbase + (size_t)64 * ZW);
        __syncthreads();
        *(u32x4*)(ktB + srow * 144 + sch * 16) = n0; *(u32x4*)(ktB + (64 + srow) * 144 + sch * 16) = n1;
        __syncthreads();
        for (int T = 0; T < ntile; ++T) {
            const unsigned char* kt = ktB + (T & 1) * 18432;
            if (T + 1 < ntile) { const bf16_t* src = kbase + (size_t)(128 * (T + 1)) * ZW; n0 = *(const u32x4*)src; n1 = *(const u32x4*)(src + (size_t)64 * ZW); }
            float ub[8]; idx_scores8(kt, c16, g, af, wv, ub);
            if (128 * T + 127 <= t0) { if (needz) selB_groups<false, true>(ub, 128 * T, myt, tauf, need, lane, c16, g, cnt, zc, cu + myrow * DS_CAP, ch + myrow * DS_CAP, zl + myrow * 256);
                                       else selB_groups<false, false>(ub, 128 * T, myt, tauf, need, lane, c16, g, cnt, zc, cu + myrow * DS_CAP, ch + myrow * DS_CAP, zl + myrow * 256); }
            else { if (needz) selB_groups<true, true>(ub, 128 * T, myt, tauf, need, lane, c16, g, cnt, zc, cu + myrow * DS_CAP, ch + myrow * DS_CAP, zl + myrow * 256);
                   else selB_groups<true, false>(ub, 128 * T, myt, tauf, need, lane, c16, g, cnt, zc, cu + myrow * DS_CAP, ch + myrow * DS_CAP, zl + myrow * 256); }
            if (T + 1 < ntile) { unsigned char* kn = ktB + ((T + 1) & 1) * 18432; *(u32x4*)(kn + srow * 144 + sch * 16) = n0; *(u32x4*)(kn + (64 + srow) * 144 + sch * 16) = n1; }
            __syncthreads();
        }
    }
#if SELREP & 8
    {
        float dummy = 0.f;
        const bf16_t* kbase = Z + (rowbase + srow) * ZW + ZC_DKI + sch * 8;
        u32x4 n0 = *(const u32x4*)kbase, n1 = *(const u32x4*)(kbase + (size_t)64 * ZW);
        __syncthreads();
        *(u32x4*)(ktB + srow * 144 + sch * 16) = n0; *(u32x4*)(ktB + (64 + srow) * 144 + sch * 16) = n1;
        __syncthreads();
        for (int T = 0; T < ntile; ++T) {
            const unsigned char* kt = ktB + (T & 1) * 18432;
            if (T + 1 < ntile) { const bf16_t* src = kbase + (size_t)(128 * (T + 1)) * ZW; n0 = *(const u32x4*)src; n1 = *(const u32x4*)(src + (size_t)64 * ZW); }
            float ub[8]; idx_scores8(kt, c16, g, af, wv, ub);
#pragma unroll
            for (int grp = 0; grp < 8; ++grp) dummy += ub[grp];
            if (T + 1 < ntile) { unsigned char* kn = ktB + ((T + 1) & 1) * 18432; *(u32x4*)(kn + srow * 144 + sch * 16) = n0; *(u32x4*)(kn + (64 + srow) * 144 + sch * 16) = n1; }
            __syncthreads();
        }
        if (dummy == 123456.789f) *flag = 2u;
    }
#endif
    LDSWAIT();
    bool bad = false;
    for (int repC_ = 0; repC_ < ((SELREP & 4) ? 2 : 1); ++repC_) {
        unsigned ncq[4], ndq[4], nzq[4], uj[4][9], T4[4]; int topb[4];
#pragma unroll
        for (int qq = 0; qq < 4; ++qq) {
            ncq[qq] = (unsigned)__builtin_amdgcn_readlane((int)cnt, 16 * qq); ndq[qq] = (unsigned)__builtin_amdgcn_readlane((int)need, 16 * qq); nzq[qq] = (unsigned)__builtin_amdgcn_readlane((int)zc, 16 * qq);
            const unsigned ncl = ncq[qq] < (unsigned)DS_CAP ? ncq[qq] : (unsigned)DS_CAP;
            unsigned hi = 0u, lo = 0u;
#pragma unroll
            for (int j = 0; j < 9; ++j) { const unsigned pos = lane + 64 * j; const bool in = pos < ncl; uj[qq][j] = in ? (cu[(4 * wid + qq) * DS_CAP + pos] >> 10) : 0u;
                hi = hi > uj[qq][j] ? hi : uj[qq][j]; const unsigned x = in ? ~uj[qq][j] : 0u; lo = lo > x ? lo : x; }
            hi = wave_max_u(hi); lo = ~wave_max_u(lo);
            if (ncl == 0u) lo = hi;
            if (nzq[qq]) { hi = hi > ZCLASS ? hi : ZCLASS; lo = lo < ZCLASS ? lo : ZCLASS; }
            topb[qq] = (hi ^ lo) ? 31 - __builtin_clz(hi ^ lo) : -1;
            T4[qq] = topb[qq] >= 0 ? (hi & ~((2u << topb[qq]) - 1u)) : hi;
        }
#pragma unroll 1
        for (int bit = 21; bit >= 0; --bit) {
            unsigned c[4];
#pragma unroll
            for (int qq = 0; qq < 4; ++qq) { const unsigned cand = T4[qq] | (1u << bit); unsigned cc = 0;
#pragma unroll
                for (int j = 0; j < 9; ++j) cc += uj[qq][j] >= cand ? 1u : 0u;
                c[qq] = cc; }
            const unsigned t01 = wave_total(c[0] | (c[1] << 16)), t23 = wave_total(c[2] | (c[3] << 16));
            const unsigned tq[4] = {t01 & 0xffffu, t01 >> 16, t23 & 0xffffu, t23 >> 16};
#pragma unroll
            for (int qq = 0; qq < 4; ++qq) { const unsigned cand = T4[qq] | (1u << bit);
                if (bit <= topb[qq] && tq[qq] + (cand <= ZCLASS ? nzq[qq] : 0u) >= ndq[qq]) T4[qq] = cand; }
        }
#pragma unroll 1
        for (int qq = 0; qq < 4; ++qq) {
            const unsigned nc = ncq[qq], nd = ndq[qq], nz = nzq[qq], T = T4[qq];
            if (nc + nz < nd || nc > (unsigned)DS_CAP) { bad = true;
#ifdef NOFALLBACK
                { unsigned short* orow = IDX + (rowbase + t0 + 4 * wid + qq) * 256;
                  for (int j = 0; j < 4; ++j) if ((unsigned)(lane + 64 * j) < nd) orow[lane + 64 * j] = (unsigned short)(lane + 64 * j); }
#endif
                continue; }
            const int row = 4 * wid + qq;
            unsigned ujr[9], kj[9]; int ca = T < ZCLASS ? (int)nz : 0, nt = 0;
#pragma unroll
            for (int j = 0; j < 9; ++j) { const unsigned pos = lane + 64 * j; const unsigned cwj = pos < nc ? cu[row * DS_CAP + pos] : 0u; ujr[j] = cwj >> 10;
                kj[j] = pos < nc ? ((cwj & 1023u) | ((unsigned)ch[row * DS_CAP + pos] << 10)) : 0u;
                ca += __popcll(__ballot(ujr[j] > T)); nt += __popcll(__ballot(ujr[j] == T)); }
            const unsigned quota = nd - (unsigned)ca;
            unsigned Kstar = 0xffffu;
            if (T != ZCLASS && (unsigned)nt > quota) {
                unsigned K = 0u;
#pragma unroll 1
                for (int bit = 12; bit >= 0; --bit) { const unsigned test = K | (1u << bit); int c = 0;
#pragma unroll
                    for (int j = 0; j < 9; ++j) c += __popcll(__ballot(ujr[j] == T && kj[j] < test));
                    if ((unsigned)c < quota) K = test; }
                Kstar = K;
            }
            unsigned outbase = 0u;
            unsigned short* orow = IDX + (rowbase + t0 + row) * 256;
#pragma unroll
            for (int j = 0; j < 9; ++j) {
                const bool s = (ujr[j] > T) || (ujr[j] == T && kj[j] <= Kstar);
                const unsigned long long sb = __ballot(s);
                if (s) orow[outbase + below_me(sb)] = (unsigned short)kj[j];
                outbase += (unsigned)__popcll(sb);
            }
            const unsigned zsel = T < ZCLASS ? nz : (T == ZCLASS ? quota : 0u);
            for (unsigned i = lane; i < zsel; i += 64) orow[outbase + i] = zl[row * 256 + i];
        }
    }
    if (bad && lane == 0) atomicOr(flag, 1u);
    __syncthreads();
    const bool redo = *flag != 0u;
    __syncthreads();
#ifndef NOFALLBACK
    if (redo) dsa_select_slow(a, lds, b, qb32, wid_s);
#endif
}

constexpr int DA_WAVE_LDS = 512 + 64 * 160;
__device__ __forceinline__ void dsa_attend_wave(const Args& a, int gw, int NGW, int lane, unsigned char* wl) {
    const bf16_t* Z = (const bf16_t*)(a.ws + WS_Z); const unsigned short* IDXB = (const unsigned short*)(a.ws + WS_MG);
    bf16_t* Y1 = (bf16_t*)(a.ws + WS_H) + (size_t)MROWS * 256;
    const int c16 = lane & 15, g = lane >> 4, vr = lane >> 3, vc = lane & 7;
    unsigned short* il = (unsigned short*)wl; unsigned char* vl = wl + 512;
    const float slope2 = LOG2E * __builtin_amdgcn_exp2f(-(float)(5 + (c16 & 3)));
    const LAS unsigned char* vtr = (const LAS unsigned char*)vl + (4 * g + (c16 >> 2)) * 160 + (4 * (c16 & 3)) * 2;
    u32x2 iw = {0u, 0u};
    if (gw < MROWS) iw = *(const u32x2*)(IDXB + (size_t)gw * 256 + 4 * lane);
#pragma unroll 1
    for (int row = gw; row < MROWS; row += NGW) {
        const int t = row & (SEQ - 1); const size_t rowbase = (size_t)(row - t);
        const int nsel = (t + 1) < 256 ? (t + 1) : 256;
        { u32x2 w = iw; const int p0 = 4 * lane;
          if (p0 >= nsel) w.x &= 0xffff0000u; if (p0 + 1 >= nsel) w.x &= 0x0000ffffu; if (p0 + 2 >= nsel) w.y &= 0xffff0000u; if (p0 + 3 >= nsel) w.y &= 0x0000ffffu;
          *(u32x2*)(il + 4 * lane) = w; }
        if (row + NGW < MROWS) iw = *(const u32x2*)(IDXB + (size_t)(row + NGW) * 256 + 4 * lane);
        LDSWAIT();
        u32x4 v[8];
        const bf16_t* vb = Z + rowbase * ZW + ZC_DV + 8 * vc;
#pragma unroll
        for (int i = 0; i < 8; ++i) v[i] = *(const u32x4*)(vb + (size_t)il[8 * i + vr] * ZW);
        bf16x8 qf[2];
        { const bf16_t* qp = Z + (size_t)row * ZW + ZC_DQ + (c16 & 3) * 64 + 8 * g; const bf16x8 z8 = {0, 0, 0, 0, 0, 0, 0, 0};
          qf[0] = c16 < 4 ? *(const bf16x8*)qp : z8; qf[1] = c16 < 4 ? *(const bf16x8*)(qp + 32) : z8; }
        f32x4 s[16];
        const bf16_t* kb0 = Z + rowbase * ZW + ZC_DK + 8 * g;
        {
            bf16x8 kf[16][2];
#pragma unroll
            for (int kk = 0; kk < 16; ++kk) { const bf16_t* kp = kb0 + (size_t)il[16 * kk + c16] * ZW; kf[kk][0] = *(const bf16x8*)kp; kf[kk][1] = *(const bf16x8*)(kp + 32); }
            __builtin_amdgcn_sched_barrier(0);
#pragma unroll
            for (int kk = 0; kk < 16; ++kk) { f32x4 acc = {0.f, 0.f, 0.f, 0.f};
                acc = __builtin_amdgcn_mfma_f32_16x16x32_bf16(kf[kk][0], qf[0], acc, 0, 0, 0);
                acc = __builtin_amdgcn_mfma_f32_16x16x32_bf16(kf[kk][1], qf[1], acc, 0, 0, 0);
                s[kk] = acc; }
        }
        float mx = -INFINITY;
#pragma unroll
        for (int kb = 0; kb < 16; ++kb) {
            const u32x2 kw = *(const u32x2*)(il + 16 * kb + 4 * g); const int p0 = 16 * kb + 4 * g;
            const int k0 = kw.x & 0xffff, k1 = kw.x >> 16, k2 = kw.y & 0xffff, k3 = kw.y >> 16;
            s[kb][0] = p0 < nsel ? s[kb][0] * C2 - slope2 * (float)(t - k0) : -INFINITY;
            s[kb][1] = p0 + 1 < nsel ? s[kb][1] * C2 - slope2 * (float)(t - k1) : -INFINITY;
            s[kb][2] = p0 + 2 < nsel ? s[kb][2] * C2 - slope2 * (float)(t - k2) : -INFINITY;
            s[kb][3] = p0 + 3 < nsel ? s[kb][3] * C2 - slope2 * (float)(t - k3) : -INFINITY;
            mx = fmaxf(fmaxf(mx, fmaxf(s[kb][0], s[kb][1])), fmaxf(s[kb][2], s[kb][3]));
        }
        mx = fmaxf(mx, shf(mx, lane ^ 16)); mx = fmaxf(mx, shf(mx, lane ^ 32));
        float ls = 0.f;
#pragma unroll
        for (int kb = 0; kb < 16; ++kb) {
#pragma unroll
            for (int r = 0; r < 4; ++r) { s[kb][r] = __builtin_amdgcn_exp2f(s[kb][r] - mx); ls += s[kb][r]; } }
        ls += shf(ls, lane ^ 16); ls += shf(ls, lane ^ 32);
        f32x4 o[4];
#pragma unroll
        for (int db = 0; db < 4; ++db) o[db] = (f32x4){0.f, 0.f, 0.f, 0.f};
#pragma unroll
        for (int ch = 0; ch < 4; ++ch) {
            if (64 * ch < nsel) {
#pragma unroll
                for (int i = 0; i < 8; ++i) *(u32x4*)(vl + (8 * i + vr) * 160 + 16 * vc) = v[i];
                if (ch < 3 && 64 * (ch + 1) < nsel) {
#pragma unroll
                    for (int i = 0; i < 8; ++i) v[i] = *(const u32x4*)(vb + (size_t)il[64 * (ch + 1) + 8 * i + vr] * ZW);
                }
                LDSWAIT();
#pragma unroll
                for (int s2 = 0; s2 < 2; ++s2) {
                    const f32x4 pa4 = s[4 * ch + 2 * s2], pb4 = s[4 * ch + 2 * s2 + 1];
                    u32x4 pw; pw.x = pk2(pa4[0], pa4[1]); pw.y = pk2(pa4[2], pa4[3]); pw.z = pk2(pb4[0], pb4[1]); pw.w = pk2(pb4[2], pb4[3]);
                    const bf16x8 pa = __builtin_bit_cast(bf16x8, pw);
#pragma unroll
                    for (int db = 0; db < 4; ++db) {
                        const LAS unsigned char* vp = vtr + (32 * s2) * 160 + 32 * db;
                        const s16x4 lo = __builtin_bit_cast(s16x4, __builtin_amdgcn_ds_read_tr16_b64_v4i16((LAS s16x4*)vp));
                        const s16x4 hv = __builtin_bit_cast(s16x4, __builtin_amdgcn_ds_read_tr16_b64_v4i16((LAS s16x4*)(vp + 16 * 160)));
                        const bf16x8 vf = (bf16x8){lo[0], lo[1], lo[2], lo[3], hv[0], hv[1], hv[2], hv[3]};
                        o[db] = __builtin_amdgcn_mfma_f32_16x16x32_bf16(pa, vf, o[db], 0, 0, 0);
                    }
                }
                asm volatile("" ::: "memory");
            }
        }
        const int lsi = __float_as_int(ls);
        const float i0 = 1.0f / __int_as_float(__builtin_amdgcn_readlane(lsi, 0)), i1 = 1.0f / __int_as_float(__builtin_amdgcn_readlane(lsi, 1)), i2 = 1.0f / __int_as_float(__builtin_amdgcn_readlane(lsi, 2)), i3 = 1.0f / __int_as_float(__builtin_amdgcn_readlane(lsi, 3));
        if (g == 0) { bf16_t* yp = Y1 + (size_t)row * 256 + c16;
#pragma unroll
            for (int db = 0; db < 4; ++db) { yp[0 * 64 + 16 * db] = (bf16_t)f2bf(o[db][0] * i0); yp[1 * 64 + 16 * db] = (bf16_t)f2bf(o[db][1] * i1); yp[2 * 64 + 16 * db] = (bf16_t)f2bf(o[db][2] * i2); yp[3 * 64 + 16 * db] = (bf16_t)f2bf(o[db][3] * i3); } }
        LDSWAIT();
    }
}


#ifndef PHMASK
#define PHMASK 0xffff
#endif
#ifndef DUPMASK
#define DUPMASK 0
#endif
#ifndef DUPN
#define DUPN 2
#endif
#ifndef MERGE_SP2
#define MERGE_SP2 true
#endif
#ifndef G8_SP2
#define G8_SP2 false
#endif
#ifndef EXTRASYNC
#define EXTRASYNC 0
#endif
typedef __attribute__((address_space(1))) unsigned gu32;
#define XB_TMO      128
#define XB_XCNT(j)  (256  + 64 * (j))
#define XB_XSUB(j)  (1280 + 64 * (j))
#define XB_XGEN(j)  (2304 + 64 * (j))
#define XB_TOP      3328
#define XB_TOPGEN   3392
#define XCD_BAR_WORDS 3456
#define XB_SPIN_CAP (1u << 18)

__device__ __forceinline__ unsigned xb_ld(unsigned* p)              { return __hip_atomic_load(p, __ATOMIC_RELAXED, __HIP_MEMORY_SCOPE_AGENT); }
__device__ __forceinline__ unsigned xb_add(unsigned* p, unsigned v) { return __hip_atomic_fetch_add(p, v, __ATOMIC_RELAXED, __HIP_MEMORY_SCOPE_AGENT); }
__device__ __forceinline__ unsigned xb_xcc_id() { return (unsigned)__builtin_amdgcn_s_getreg((3 << 11) | 20) & 0xFu; }
#define XB_SPIN(cond, bar) do { unsigned _sp = 0; while (cond) { __builtin_amdgcn_s_sleep(1); \
    if ((++_sp & 255u) == 0u) { if (xb_ld(&(bar)[XB_TMO])) break; if (_sp > XB_SPIN_CAP) { atomicAdd(&(bar)[XB_TMO], 1u); break; } } } } while (0)

struct XcdBarrier {
    unsigned* bar; unsigned x; int w;
    volatile LAS unsigned* st;
};

__device__ __forceinline__ bool xb_first_lane(int w) { unsigned ones = ~0u; asm volatile("" : "+s"(ones)); return w == 0 && __builtin_amdgcn_mbcnt_hi(ones, __builtin_amdgcn_mbcnt_lo(ones, 0u)) == 0u; }
__device__ __forceinline__ XcdBarrier xcd_barrier_post(unsigned* bar, volatile LAS unsigned* st, int w) {
    XcdBarrier b; b.bar = bar; b.x = xb_xcc_id(); b.st = st; b.w = w;
    if (xb_first_lane(w)) (void)xb_add(&bar[XB_XCNT(b.x)], 1u);
    return b;
}
__device__ __forceinline__ void xcd_barrier_complete(unsigned* bar, unsigned x, unsigned& nloc, unsigned& nx) {
    const unsigned G = gridDim.x * gridDim.y * gridDim.z;
    unsigned sum, cnt, mine, sp = 0u;
    for (;;) {
        sum = 0u; cnt = 0u; mine = 0u;
#pragma unroll
        for (unsigned j = 0; j < 16; ++j) { const unsigned c = xb_ld(&bar[XB_XCNT(j)]); sum += c; cnt += (c > 0u) ? 1u : 0u; mine = (j == x) ? c : mine; }
        if (sum == G) break;
        __builtin_amdgcn_s_sleep(1);
        if ((++sp & 255u) == 0u) { if (xb_ld(&bar[XB_TMO])) break; if (sp > XB_SPIN_CAP) { atomicAdd(&bar[XB_TMO], 1u); break; } }
    }
    nloc = mine > 0u ? mine : 1u; nx = cnt > 0u ? cnt : 1u;
}

__device__ __forceinline__ void xcd_barrier(const XcdBarrier& b) {
    asm volatile("s_waitcnt vmcnt(0)" ::: "memory");
    __syncthreads();
    if (xb_first_lane(b.w)) {
        unsigned* bar = b.bar;
        __builtin_amdgcn_s_waitcnt(0);
        unsigned nloc = b.st[0], nx = b.st[1];
        if (nloc == 0u) { xcd_barrier_complete(bar, b.x, nloc, nx); b.st[0] = nloc; b.st[1] = nx; }
        const unsigned old = xb_add(&bar[XB_XSUB(b.x)], 1u);
        const unsigned gen = old / nloc;
        if (old + 1u == (gen + 1u) * nloc) {
            __builtin_amdgcn_fence(__ATOMIC_RELEASE, "agent");
            asm volatile("s_waitcnt vmcnt(0)" ::: "memory");
            const unsigned og = xb_add(&bar[XB_TOP], 1u);
            const unsigned tg = og / nx;
            if (og + 1u == (tg + 1u) * nx) xb_add(&bar[XB_TOPGEN], 1u);
            else XB_SPIN(xb_ld(&bar[XB_TOPGEN]) == tg, bar);
            __builtin_amdgcn_fence(__ATOMIC_ACQUIRE, "agent");
            xb_add(&bar[XB_XGEN(b.x)], 1u);
            asm volatile("s_waitcnt vmcnt(0)" ::: "memory");
        } else {
            XB_SPIN(xb_ld(&bar[XB_XGEN(b.x)]) == gen, bar);
            __builtin_amdgcn_fence(__ATOMIC_ACQUIRE, "agent");
            asm volatile("s_waitcnt vmcnt(0)" ::: "memory");
        }
    }
    __syncthreads();
}

constexpr size_t WS_BAR = 16384;
constexpr int LDS_BARST = LDS_BYTES - 16;
#define GRID_SYNC() xcd_barrier(bar)
typedef const __attribute__((address_space(4))) Args* kargs_ptr;
__device__ __forceinline__ Args fresh_args() {
#if defined(__HIP_DEVICE_COMPILE__)
    kargs_ptr p = (kargs_ptr)__builtin_amdgcn_kernarg_segment_ptr(); asm volatile("" : "+s"(p)); return *p;
#else
    return Args{};
#endif
}
#define FRESH() const int tid = ftid(wid_s), lane = tid & 63, wid = __builtin_amdgcn_readfirstlane(tid >> 6), gw = blockIdx.x * 8 + wid, NGW = gridDim.x * 8; (void)lane; (void)gw; (void)NGW
#define WSP(T, off) ((T*)(a.ws + (off)))
__global__ void __launch_bounds__(512, 2) mega(Args a_unused) {
    extern __shared__ __attribute__((aligned(16))) unsigned char lds[];
    PG8_LAS unsigned char* lds3 = (PG8_LAS unsigned char*)lds;
    const int wid_s = __builtin_amdgcn_readfirstlane(threadIdx.x >> 6);
    if (threadIdx.x < 4) ((volatile LAS unsigned*)(lds3 + LDS_BARST))[threadIdx.x] = 0u;
    __syncthreads();
    XcdBarrier bar; { const Args a0 = fresh_args(); bar = xcd_barrier_post((unsigned*)(a0.ws + WS_BAR), (volatile LAS unsigned*)(lds3 + LDS_BARST), wid_s); }

#if PHMASK & 1
    for (int rep_ = 0; rep_ < ((DUPMASK & 1) ? DUPN : 1); ++rep_) { if (rep_) GRID_SYNC();
    { const Args a = fresh_args(); if (blockIdx.x == 0 && threadIdx.x < 16) WSP(unsigned, WS_KMAX)[threadIdx.x] = 0u; ada_gemv(a, lds, wid_s); convert_weights(a, 0, lds, wid_s); }
    }
#endif
    GRID_SYNC();
#if PHMASK & 2
    for (int rep_ = 0; rep_ < ((DUPMASK & 2) ? DUPN : 1); ++rep_) { if (rep_) GRID_SYNC();
    { const Args a = fresh_args(); FRESH();
      for (int row = gw * 8; row < MROWS; row += NGW * 8) { const int b = row >> 13; const float* md = WSP(float, WS_MOD) + (size_t)(0 * 2 + b) * NMOD;
        row_pass8<false, true, false, false, true>(a.x + (size_t)row * D, nullptr, nullptr, WSP(bf16_t, WS_H) + (size_t)row * D, WSP(unsigned char, WS_MG) + (size_t)row * D, nullptr, nullptr, a.norm_g + 0 * D, md + 1 * D, md + 0 * D, lane); } }
    }
#endif
    GRID_SYNC();

#pragma unroll 1
    for (int l = 0; l < DEPTH; ++l) {
        for (int es_ = 0; es_ < EXTRASYNC; ++es_) GRID_SYNC();
#if PHMASK & 4
    for (int rep_ = 0; rep_ < ((DUPMASK & 4) ? DUPN : 1); ++rep_) { if (rep_) GRID_SYNC();
        { const Args a = fresh_args(); const int G = gridDim.x, bid = blockIdx.x;
          { pg8::Gemm g{WSP(bf16_t, WS_MG), WSP(bf16_t, WS_WG8), MROWS, 4 * D, D}; pg8::StaticOrder S; S.init(MROWS, 4 * D, G, bid);
            pg8::EpiG E{WSP(unsigned char, WS_G)};
            pg8::gemm_phase<pg8::EpiG, pg8::StaticOrder, true, G8_SP2, true>(lds3, g, S, E, wid_s); }
          { pg8::Gemm g{WSP(bf16_t, WS_H), WSP(bf16_t, WS_W1T), MROWS, 2816, D}; pg8::StaticOrder S; S.init(MROWS, 2816, G, (bid + 64) % G);
            pg8::EpiZ E{WSP(bf16_t, WS_Z), WSP(float, WS_SMALL), WSP(unsigned char, WS_G)};
            pg8::gemm_phase<pg8::EpiZ, pg8::StaticOrder, true, true>(lds3, g, S, E, wid_s); } }
    }
#endif
        GRID_SYNC();
#if PHMASK & 8
    for (int rep_ = 0; rep_ < ((DUPMASK & 8) ? DUPN : 1); ++rep_) { if (rep_) GRID_SYNC();
        { const Args a = fresh_args(); const int G = gridDim.x, bid = blockIdx.x;
          if (bid < 8) fox_scan(a, l, bid, lds, wid_s);
          for (int it = bid - 8; it >= 0 && it < 64; it += G) fox_kmax_item(a, l, it, wid_s);
          conv_phase(a, l, wid_s);
          for (int u = bid; u < 256; u += G) { const int b = u >> 7, head = (u >> 5) & 3, qb = u & 31;
            const float slope2 = LOG2E * __builtin_amdgcn_exp2f(-(float)(1 + head)), sink2 = LOG2E * a.swa_sinks[l * 4 + head];
            const int q0 = qb * 256, tlo = q0 >= 128 ? ((q0 - 127) >> 6) : 0;
            attn_unit<1>(lds, WSP(bf16_t, WS_Z), WSP(bf16_t, WS_H) + (size_t)3 * MROWS * 256, b, head, qb, nullptr, slope2, sink2, tlo, 0.f, wid_s); } }
    }
#endif
        __syncthreads();
#if PHMASK & 16
    for (int rep_ = 0; rep_ < ((DUPMASK & 16) ? DUPN : 1); ++rep_) { if (rep_) GRID_SYNC();
        { const Args a = fresh_args(); const int G = gridDim.x, bid = blockIdx.x;
          for (int u = bid; u < 256; u += G) { const int b = u & 1, j = u >> 1;
            dsa_select_item(a, lds, b, j, wid_s); dsa_select_item(a, lds, b, 255 - j, wid_s); } }
    }
#endif
        GRID_SYNC();
#if PHMASK & 32
    for (int rep_ = 0; rep_ < ((DUPMASK & 32) ? DUPN : 1); ++rep_) { if (rep_) GRID_SYNC();
        { const Args a = fresh_args(); const int G = gridDim.x, bid = blockIdx.x;
          for (int u = bid; u < 256; u += G) { const int b = u >> 7, head = (u >> 5) & 3, qb = u & 31;
            attn_unit<0>(lds, WSP(bf16_t, WS_Z), WSP(bf16_t, WS_H) + (size_t)2 * MROWS * 256, b, head, qb, WSP(const float, WS_FCUM), 0.f, 0.f, 0, sqrtf(__uint_as_float(WSP(const unsigned, WS_KMAX)[l * 8 + b * 4 + head])), wid_s); } }
    }
#endif
#if PHMASK & 64
    for (int rep_ = 0; rep_ < ((DUPMASK & 64) ? DUPN : 1); ++rep_) { if (rep_) GRID_SYNC();
        { const Args a = fresh_args(); FRESH(); __syncthreads(); dsa_attend_wave(a, gw, NGW, lane, lds + wid * DA_WAVE_LDS); __syncthreads(); }
    }
#endif
        GRID_SYNC();
#if PHMASK & 128
    for (int rep_ = 0; rep_ < ((DUPMASK & 128) ? DUPN : 1); ++rep_) { if (rep_) GRID_SYNC();
        { const Args a = fresh_args(); const int G = gridDim.x, bid = blockIdx.x;
          int kmerge = 256; asm volatile("" : "+s"(kmerge));
          pg8::Gemm g{WSP(bf16_t, WS_H), WSP(bf16_t, WS_WBT), 4 * MROWS, 4 * D, kmerge}; pg8::MergeOrder2 S{G, bid};
          pg8::EpiMerge2 E{WSP(bf16_t, WS_MG), WSP(unsigned char, WS_G)}; E.zero();
          pg8::gemm_phase<pg8::EpiMerge2, pg8::MergeOrder2, true, MERGE_SP2, false, true>(lds3, g, S, E, wid_s); }
    }
#endif
        GRID_SYNC();
#if PHMASK & 256
    for (int rep_ = 0; rep_ < ((DUPMASK & 256) ? DUPN : 1); ++rep_) { if (rep_) GRID_SYNC();
        { const Args a = fresh_args(); const int G = gridDim.x, bid = blockIdx.x;
#if WO8
          pg8::Gemm g{WSP(bf16_t, WS_MG), WSP(bf16_t, WS_WOT), MROWS, D, D}; pg8::StaticOrder S; S.init(MROWS, D, G, bid);
          pg8::EpiPlain8 E{WSP(bf16_t, WS_H), D};
          pg8::gemm_phase<pg8::EpiPlain8, pg8::StaticOrder, true, G8_SP2, true>(lds3, g, S, E, wid_s); }
#else
          pg8::Gemm g{WSP(bf16_t, WS_MG), WSP(bf16_t, WS_WOT), MROWS, D, D}; pg8::StaticOrder S; S.init(MROWS, D, G, bid);
          pg8::EpiPlain E{WSP(bf16_t, WS_H), D};
          pg8::gemm_phase<pg8::EpiPlain, pg8::StaticOrder, true, true>(lds3, g, S, E, wid_s); }
#endif
    }
#endif
        GRID_SYNC();
#if PHMASK & 512
    for (int rep_ = 0; rep_ < ((DUPMASK & 512) ? DUPN : 1); ++rep_) { if (rep_) GRID_SYNC();
        { const Args a = fresh_args(); FRESH(); const float* ng = a.norm_g + (size_t)l * 4 * D;
          for (int row = gw * 8; row < MROWS; row += NGW * 8) { const int b = row >> 13; const float* md = WSP(float, WS_MOD) + (size_t)(l * 2 + b) * NMOD;
            bf16_t* x1g = WSP(bf16_t, WS_G) + (size_t)row * D; bf16_t* h2 = FFN8 ? nullptr : WSP(bf16_t, WS_MG) + (size_t)row * D; const bf16_t* rawp = WSP(bf16_t, WS_H) + (size_t)row * D;
            unsigned char* h28 = WSP(unsigned char, WS_G) + 32 * MiB + (size_t)row * D;
            if (l == 0) row_pass8<true, true, false, true, FFN8 != 0>(a.x + (size_t)row * D, rawp, x1g, h2, h28, md + 2 * D, ng + 1 * D, ng + 2 * D, md + 4 * D, md + 3 * D, lane);
            else row_pass8<true, true, true, true, FFN8 != 0>((const bf16_t*)a.out + (size_t)row * D, rawp, x1g, h2, h28, md + 2 * D, ng + 1 * D, ng + 2 * D, md + 4 * D, md + 3 * D, lane); } }
    }
#endif
        GRID_SYNC();
#if PHMASK & 1024
    for (int rep_ = 0; rep_ < ((DUPMASK & 1024) ? DUPN : 1); ++rep_) { if (rep_) GRID_SYNC();
        { const Args a = fresh_args(); const int G = gridDim.x, bid = blockIdx.x;
#if FFN8
          pg8::Gemm g{(const bf16_t*)(a.ws + WS_G + 32 * MiB), WSP(bf16_t, WS_WGU), MROWS, NGU, D}; pg8::StaticOrder S; S.init(MROWS, NGU, G, bid);
          pg8::EpiSwiglu8<DOWN8 != 0> E{WSP(bf16_t, WS_Z)};
          pg8::gemm_phase<pg8::EpiSwiglu8<DOWN8 != 0>, pg8::StaticOrder, true, G8_SP2, true>(lds3, g, S, E, wid_s); }
#else
          pg8::Gemm g{WSP(bf16_t, WS_MG), WSP(bf16_t, WS_WGU), MROWS, NGU, D}; pg8::StaticOrder S; S.init(MROWS, NGU, G, bid);
          pg8::EpiSwiglu E{WSP(bf16_t, WS_Z)};
          pg8::gemm_phase<pg8::EpiSwiglu, pg8::StaticOrder, true, true>(lds3, g, S, E, wid_s); }
#endif
    }
#endif
        GRID_SYNC();
#if PHMASK & 2048
    for (int rep_ = 0; rep_ < ((DUPMASK & 2048) ? DUPN : 1); ++rep_) { if (rep_) GRID_SYNC();
        { const Args a = fresh_args(); const int G = gridDim.x, bid = blockIdx.x;
#if DOWN8
          pg8::Gemm g{WSP(bf16_t, WS_Z), WSP(bf16_t, WS_WDT), MROWS, D, DFF}; pg8::StaticOrder S; S.init(MROWS, D, G, bid);
          pg8::EpiPlain8 E{WSP(bf16_t, WS_H), D};
          pg8::gemm_phase<pg8::EpiPlain8, pg8::StaticOrder, true, G8_SP2, true>(lds3, g, S, E, wid_s); }
#else
          pg8::Gemm g{WSP(bf16_t, WS_Z), WSP(bf16_t, WS_WDT), MROWS, D, DFF}; pg8::StaticOrder S; S.init(MROWS, D, G, bid);
          pg8::EpiPlain E{WSP(bf16_t, WS_H), D};
          pg8::gemm_phase<pg8::EpiPlain, pg8::StaticOrder, true, true>(lds3, g, S, E, wid_s); }
#endif
    }
#endif
        GRID_SYNC();
#if PHMASK & 4096
    for (int rep_ = 0; rep_ < ((DUPMASK & 4096) ? DUPN : 1); ++rep_) { if (rep_) GRID_SYNC();
        { const Args a = fresh_args(); FRESH(); const float* ng = a.norm_g + (size_t)l * 4 * D;
          for (int row = gw * 8; row < MROWS; row += NGW * 8) { const int b = row >> 13; const float* md = WSP(float, WS_MOD) + (size_t)(l * 2 + b) * NMOD;
            const float* mdn = WSP(float, WS_MOD) + (size_t)((l + 1) * 2 + b) * NMOD; const float* ngn = a.norm_g + (size_t)(l + 1) * 4 * D;
            const bf16_t* x1g = WSP(bf16_t, WS_G) + (size_t)row * D; bf16_t* hr = WSP(bf16_t, WS_H) + (size_t)row * D;
            if (l + 1 < DEPTH) row_pass8<true, true, true, true, true>(x1g, hr, (bf16_t*)a.out + (size_t)row * D, hr, WSP(unsigned char, WS_MG) + (size_t)row * D, md + 5 * D, ng + 3 * D, ngn, mdn + 1 * D, mdn + 0 * D, lane);
            else row_pass8<true, false, true, false>(x1g, hr, a.out + (size_t)row * D, nullptr, nullptr, md + 5 * D, ng + 3 * D, nullptr, nullptr, nullptr, lane); }
          if (l + 1 < DEPTH) convert_weights(a, l + 1, lds, wid_s); }
    }
#endif
        if (l + 1 < DEPTH) GRID_SYNC();
    }
}

extern "C" void kernel_launch(void* const* d_in, const int* in_sizes, int n_in, void* d_out, int out_size, void* d_ws, size_t ws_size, hipStream_t stream) {
    static int grid = 0;
    if (grid == 0) {
        if (n_in != 14 || out_size != MROWS * D || ws_size < WS_END) { fprintf(stderr, "kernel_launch: unexpected shapes (n_in %d out %d ws %zu)\n", n_in, out_size, ws_size); grid = -1; return; }
        int dev = 0, cus = 0, per_cu = 0;
        (void)hipGetDevice(&dev);
        (void)hipDeviceGetAttribute(&cus, hipDeviceAttributeMultiprocessorCount, dev);
        (void)hipFuncSetAttribute((const void*)mega, hipFuncAttributeMaxDynamicSharedMemorySize, LDS_BYTES);
        (void)hipOccupancyMaxActiveBlocksPerMultiprocessor(&per_cu, (const void*)mega, 512, LDS_BYTES);
        if (per_cu < 1) { fprintf(stderr, "kernel_launch: occupancy query says 0 blocks per CU\n"); per_cu = 1; }
        grid = cus;
        (void)hipGetLastError();
    }
    if (grid < 0) return;
    if (hipMemsetAsync(d_ws, 0, 65536, stream) != hipSuccess) { fprintf(stderr, "kernel_launch: memset failed\n"); return; }
    Args a{};
    const float** pp = (const float**)&a;
    for (int i = 0; i < 14; ++i) pp[i] = (const float*)d_in[i];
    a.out = (float*)d_out; a.ws = (unsigned char*)d_ws;
    void* args[] = {&a};
    hipError_t e = hipLaunchCooperativeKernel((const void*)mega, dim3(grid), dim3(512), args, LDS_BYTES, stream);
    if (e != hipSuccess) fprintf(stderr, "cooperative launch failed: %s (grid %d)\n", hipGetErrorString(e), grid);
}
```

```cpp
#include <hip/hip_runtime.h>
#include <hip/hip_cooperative_groups.h>
#include <cstdio>
#include <cstdint>
namespace cg = cooperative_groups;
namespace pg8 {
#define PG8_LAS __attribute__((address_space(3)))
typedef unsigned short bf16_t;
typedef short bf16x8 __attribute__((ext_vector_type(8)));
typedef float f32x4 __attribute__((ext_vector_type(4)));
typedef unsigned u32x4 __attribute__((ext_vector_type(4)));
typedef int v4i_t __attribute__((ext_vector_type(4)));
typedef int v8i_t __attribute__((ext_vector_type(8)));
constexpr int BM = 256, BK = 64, HALF = 128, HTB = HALF * BK * 2  , STAGE_BYTES = 8 * HTB, NXCD = 8, WGM = 8;

__host__ __device__ __forceinline__ int lds_byte(int r, int c) { const int st = (r >> 4) * 2 + (c >> 5), rr = r & 15, cc = c & 31, ob = rr * 64 + cc * 2; return st * 1024 + (ob ^ (((ob >> 9) & 1) << 5)); }
__host__ __device__ __forceinline__ void stage_rc(int b, int& R, int& C) { const int st = b / 1024, sb = b % 1024, swz = sb ^ (((sb >> 9) & 1) << 5); R = (st >> 1) * 16 + swz / 64; C = (st & 1) * 32 + (swz % 64) / 2; }
__host__ __device__ __forceinline__ int perm32(int rho) { const int n = rho >> 4, i = rho & 15; return 8 * (i >> 2) + 4 * n + (i & 3); }

struct Unit { int pm, pn; };
struct Gemm { const bf16_t* A; const bf16_t* Bt; int M, N, K; };

struct StaticOrder {
    int nM, nN, nwg, G, c;
    __host__ __device__ void init(int M, int N, int G_, int c_) { nM = M / BM; nN = N / BM; nwg = nM * nN; G = G_; c = c_; }
    __host__ __device__ bool next(int i, Unit& u) const {
        const long L = (long)i * G + c; if (L >= nwg) return false;
        int wgid = (int)L; { const int q = nwg / NXCD, r = nwg % NXCD, xcd = wgid % NXCD, off = wgid / NXCD; wgid = (xcd < r ? xcd * (q + 1) : r * (q + 1) + (xcd - r) * q) + off; }
        const int nig = WGM * nN, gid = wgid / nig, fm = gid * WGM, gsz = (nM - fm) < WGM ? (nM - fm) : WGM;
        u.pm = fm + ((wgid % nig) % gsz); u.pn = (wgid % nig) / gsz; return true;
    }
    __device__ __forceinline__ void a_ready(const Unit&) const {}
    __device__ __forceinline__ void done(const Unit&) const {}
};

__device__ __forceinline__ unsigned cvt_pk_bf16(float lo, float hi) { unsigned r; asm volatile("v_cvt_pk_bf16_f32 %0, %1, %2" : "=v"(r) : "v"(lo), "v"(hi)); return r; }
typedef float f32x2 __attribute__((ext_vector_type(2)));
#ifndef WO8
#define WO8 1
#endif
#ifndef MERGE_FENCE
#define MERGE_FENCE 1
#endif
typedef unsigned u32x2 __attribute__((ext_vector_type(2)));
__device__ __forceinline__ float bf_lo(unsigned w) { return __uint_as_float(w << 16); }
__device__ __forceinline__ float bf_hi(unsigned w) { return __uint_as_float(w & 0xffff0000u); }
#ifdef PROBE_CHEAPSIG
__device__ __forceinline__ float sigmoidf_fast(float x) { return 0.5f + 0.25f * fminf(fmaxf(x, -2.0f), 2.0f); }
#else
__device__ __forceinline__ float sigmoidf_fast(float x) { return __builtin_amdgcn_rcpf(1.0f + __builtin_amdgcn_exp2f(-1.4426950408889634f * x)); }
#endif

struct EpiPlain {
    static constexpr bool PERM = true, AFTER_DRAIN = false;
    bf16_t* O; int ldc;
    __device__ __forceinline__ void operator()(const f32x4 (&acc)[2][2][4][2], const Unit& u, int wr, int wc, int fr, int fq) const {
        const int row0 = u.pm * BM + wr * 64 + fr, col0 = u.pn * BM + wc * 32 + 8 * fq;
#pragma unroll
        for (int ai = 0; ai < 2; ++ai)
#pragma unroll
            for (int m = 0; m < 4; ++m) { bf16_t* rowp = O + (size_t)(row0 + ai * HALF + m * 16) * ldc + col0;
#pragma unroll
                for (int bj = 0; bj < 2; ++bj) { const f32x4 v0 = acc[ai][bj][m][0], v1 = acc[ai][bj][m][1];
                    u32x4 w; w.x = cvt_pk_bf16(v0[0], v0[1]); w.y = cvt_pk_bf16(v0[2], v0[3]); w.z = cvt_pk_bf16(v1[0], v1[1]); w.w = cvt_pk_bf16(v1[2], v1[3]);
                    *(u32x4*)(rowp + bj * HALF) = w; } }
    }
};
struct EpiZ {
    static constexpr bool PERM = true, AFTER_DRAIN = false;
    bf16_t* Z; float* SM; unsigned char* G;
    __device__ __forceinline__ void operator()(const f32x4 (&acc)[2][2][4][2], const Unit& u, int wr, int wc, int fr, int fq) const {
        const int row0 = u.pm * BM + wr * 64 + fr;
        if (u.pn < 11) {
            const int col0 = u.pn * BM + wc * 32 + 8 * fq;
#pragma unroll
            for (int ai = 0; ai < 2; ++ai)
#pragma unroll
                for (int m = 0; m < 4; ++m) { bf16_t* rowp = Z + (size_t)(row0 + ai * HALF + m * 16) * 2816 + col0;
#pragma unroll
                    for (int bj = 0; bj < 2; ++bj) { const f32x4 v0 = acc[ai][bj][m][0], v1 = acc[ai][bj][m][1];
                        u32x4 w; w.x = cvt_pk_bf16(v0[0], v0[1]); w.y = cvt_pk_bf16(v0[2], v0[3]); w.z = cvt_pk_bf16(v1[0], v1[1]); w.w = cvt_pk_bf16(v1[2], v1[3]);
                        *(u32x4*)(rowp + bj * HALF) = w; } }
            if (u.pn == 10 && wc == 2 && fq == 0) {
#pragma unroll
                for (int ai = 0; ai < 2; ++ai)
#pragma unroll
                    for (int m = 0; m < 4; ++m) { float* sp = SM + (size_t)(row0 + ai * HALF + m * 16) * 8;
                        *(f32x4*)sp = acc[ai][1][m][0]; *(f32x4*)(sp + 4) = acc[ai][1][m][1]; }
            }
        } else {
            const int col0 = (u.pn - 11) * BM + wc * 32 + 8 * fq;
#pragma unroll
            for (int ai = 0; ai < 2; ++ai)
#pragma unroll
                for (int m = 0; m < 4; ++m) { unsigned char* rowp = G + (size_t)(row0 + ai * HALF + m * 16) * 4096 + col0;
#pragma unroll
                    for (int bj = 0; bj < 2; ++bj) { const f32x4 v0 = acc[ai][bj][m][0], v1 = acc[ai][bj][m][1];
                        unsigned b[8];
#pragma unroll
                        for (int k = 0; k < 4; ++k) { b[k] = (unsigned)(sigmoidf_fast(v0[k]) * 255.0f + 0.5f); b[4 + k] = (unsigned)(sigmoidf_fast(v1[k]) * 255.0f + 0.5f); }
                        u32x2 w; w.x = b[0] | (b[1] << 8) | (b[2] << 16) | (b[3] << 24); w.y = b[4] | (b[5] << 8) | (b[6] << 16) | (b[7] << 24);
                        *(u32x2*)(rowp + bj * HALF) = w; } }
        }
    }
};
struct EpiG {
    static constexpr bool PERM = false, AFTER_DRAIN = false;
    unsigned char* G;
    __device__ __forceinline__ void operator()(const f32x4 (&acc)[2][2][4][2], const Unit& u, int wr, int wc, int fr, int fq) const {
        unsigned ones_ = ~0u; asm volatile("" : "+s"(ones_)); const int ln_ = (int)__builtin_amdgcn_mbcnt_hi(ones_, __builtin_amdgcn_mbcnt_lo(ones_, 0u)); const int fr_ = ln_ & 15, fq_ = ln_ >> 4; (void)fr; (void)fq;
        const unsigned row0 = u.pm * BM + wr * 64 + fr_, col0 = u.pn * BM + wc * 32 + 4 * fq_;
        unsigned char* gb = G + col0;
#pragma unroll
        for (int ai = 0; ai < 2; ++ai)
#pragma unroll
            for (int m = 0; m < 4; ++m) { const unsigned ro = (row0 + ai * HALF + m * 16) * 4096u;
#pragma unroll
                for (int bj = 0; bj < 2; ++bj)
#pragma unroll
                    for (int n = 0; n < 2; ++n) { const f32x4 v0 = acc[ai][bj][m][n];
                        unsigned b[4];
#pragma unroll
                        for (int k = 0; k < 4; ++k) b[k] = (unsigned)(sigmoidf_fast(v0[k]) * 255.0f + 0.5f);
                        *(unsigned*)(gb + ro + bj * HALF + n * 16) = b[0] | (b[1] << 8) | (b[2] << 16) | (b[3] << 24); }
                asm volatile("" ::: "memory"); }
    }
};
struct EpiMerge {
    static constexpr bool PERM = true, AFTER_DRAIN = false;
    bf16_t* MG; const unsigned char* G;
    __device__ __forceinline__ void operator()(const f32x4 (&acc)[2][2][4][2], const Unit& u, int wr, int wc, int fr, int fq) const {
        const int n = u.pm >> 6, pm = u.pm & 63, pn = u.pn & 3;
        const unsigned row0 = pm * BM + wr * 64 + fr, col0 = pn * BM + wc * 32 + 8 * fq;
        const unsigned char* gbase = G + n * 1024 + col0; bf16_t* mbase = MG + col0;
#pragma unroll
        for (int ai = 0; ai < 2; ++ai) {
            u32x2 gw[4][2]; u32x4 old[4][2];
#pragma unroll
            for (int m = 0; m < 4; ++m)
#pragma unroll
                for (int bj = 0; bj < 2; ++bj) { const unsigned row = row0 + ai * HALF + m * 16;
                    gw[m][bj] = *(const u32x2*)(gbase + row * 4096u + bj * HALF);
                    if (n > 0) old[m][bj] = *(const u32x4*)(mbase + row * 1024u + bj * HALF); }
#pragma unroll
            for (int m = 0; m < 4; ++m)
#pragma unroll
                for (int bj = 0; bj < 2; ++bj) { const unsigned row = row0 + ai * HALF + m * 16;
                    const f32x4 v0 = acc[ai][bj][m][0], v1 = acc[ai][bj][m][1];
                    float r[8];
#pragma unroll
                    for (int k = 0; k < 4; ++k) { r[k] = v0[k] * ((float)((gw[m][bj].x >> (8 * k)) & 255u) * (1.0f / 255.0f)); r[4 + k] = v1[k] * ((float)((gw[m][bj].y >> (8 * k)) & 255u) * (1.0f / 255.0f)); }
                    if (n > 0) { const u32x4 o = old[m][bj];
                        r[0] += bf_lo(o.x); r[1] += bf_hi(o.x); r[2] += bf_lo(o.y); r[3] += bf_hi(o.y); r[4] += bf_lo(o.z); r[5] += bf_hi(o.z); r[6] += bf_lo(o.w); r[7] += bf_hi(o.w); }
                    u32x4 w; w.x = cvt_pk_bf16(r[0], r[1]); w.y = cvt_pk_bf16(r[2], r[3]); w.z = cvt_pk_bf16(r[4], r[5]); w.w = cvt_pk_bf16(r[6], r[7]);
                    *(u32x4*)(mbase + row * 1024u + bj * HALF) = w; }
            asm volatile("" ::: "memory");
        }
    }
};
struct EpiSwiglu {
    static constexpr bool PERM = true, AFTER_DRAIN = false;
    bf16_t* Hd;
    __device__ __forceinline__ void operator()(const f32x4 (&acc)[2][2][4][2], const Unit& u, int wr, int wc, int fr, int fq) const {
        const int row0 = u.pm * BM + wr * 64 + fr, j0 = u.pn * 128 + wc * 16 + 4 * fq;
#pragma unroll
        for (int ai = 0; ai < 2; ++ai)
#pragma unroll
            for (int m = 0; m < 4; ++m) { bf16_t* rowp = Hd + (size_t)(row0 + ai * HALF + m * 16) * 2816 + j0;
#pragma unroll
                for (int bj = 0; bj < 2; ++bj) { const f32x4 v0 = acc[ai][bj][m][0], v1 = acc[ai][bj][m][1];
                    const float h0 = v0[0] * sigmoidf_fast(v0[0]) * v0[1], h1 = v0[2] * sigmoidf_fast(v0[2]) * v0[3];
                    const float h2 = v1[0] * sigmoidf_fast(v1[0]) * v1[1], h3 = v1[2] * sigmoidf_fast(v1[2]) * v1[3];
                    u32x2 w; w.x = cvt_pk_bf16(h0, h1); w.y = cvt_pk_bf16(h2, h3);
                    *(u32x2*)(rowp + bj * 64) = w; } }
    }
};
template <bool H8> struct EpiSwiglu8 {
    static constexpr bool PERM = false, AFTER_DRAIN = false;
    bf16_t* Hd;
    __device__ __forceinline__ void operator()(const f32x4 (&acc)[2][2][4][2], const Unit& u, int wr, int wc, int fr, int fq) const {
        unsigned ones_ = ~0u; asm volatile("" : "+s"(ones_)); const int ln_ = (int)__builtin_amdgcn_mbcnt_hi(ones_, __builtin_amdgcn_mbcnt_lo(ones_, 0u)); const int fr_ = ln_ & 15, fq_ = ln_ >> 4; (void)fr; (void)fq;
        const unsigned row0 = u.pm * BM + wr * 64 + fr_, j0 = u.pn * 128 + wc * 16 + 2 * fq_;
        bf16_t* hb = Hd + j0; unsigned char* h8b = (unsigned char*)Hd + j0;
#pragma unroll
        for (int ai = 0; ai < 2; ++ai)
#pragma unroll
            for (int m = 0; m < 4; ++m) { const unsigned ro = (row0 + ai * HALF + m * 16) * 2816u;
#pragma unroll
                for (int bj = 0; bj < 2; ++bj)
#pragma unroll
                    for (int n = 0; n < 2; ++n) { const f32x4 v = acc[ai][bj][m][n];
                        const float h0 = v[0] * sigmoidf_fast(v[0]) * v[1], h1 = v[2] * sigmoidf_fast(v[2]) * v[3];
                        if (H8) *(unsigned short*)(h8b + ro + bj * 64 + n * 8) = (unsigned short)__builtin_amdgcn_cvt_pk_fp8_f32(h0, h1, 0u, false);
                        else *(unsigned*)(hb + ro + bj * 64 + n * 8) = cvt_pk_bf16(h0, h1); }
                asm volatile("" ::: "memory"); }
    }
};
struct EpiPlain8 {
    static constexpr bool PERM = false, AFTER_DRAIN = false;
    bf16_t* O; int ldc;
    __device__ __forceinline__ void operator()(const f32x4 (&acc)[2][2][4][2], const Unit& u, int wr, int wc, int fr, int fq) const {
        unsigned ones_ = ~0u; asm volatile("" : "+s"(ones_)); const int ln_ = (int)__builtin_amdgcn_mbcnt_hi(ones_, __builtin_amdgcn_mbcnt_lo(ones_, 0u)); const int fr_ = ln_ & 15, fq_ = ln_ >> 4; (void)fr; (void)fq;
        const unsigned row0 = u.pm * BM + wr * 64 + fr_, col0 = u.pn * BM + wc * 32 + 4 * fq_;
        bf16_t* ob = O + col0;
#pragma unroll
        for (int ai = 0; ai < 2; ++ai)
#pragma unroll
            for (int m = 0; m < 4; ++m) { const unsigned ro = (row0 + ai * HALF + m * 16) * (unsigned)ldc;
#pragma unroll
                for (int bj = 0; bj < 2; ++bj)
#pragma unroll
                    for (int n = 0; n < 2; ++n) { const f32x4 v = acc[ai][bj][m][n]; u32x2 w; w.x = cvt_pk_bf16(v[0], v[1]); w.y = cvt_pk_bf16(v[2], v[3]);
                        *(u32x2*)(ob + ro + bj * HALF + n * 16) = w; }
                asm volatile("" ::: "memory"); }
    }
};
struct MergeOrder {
    int G, c;
    __device__ __forceinline__ bool next(int i, Unit& u) const {
        const int t = (i >> 2) * G + c; if (t >= 256) return false;
        const int n = i & 3, pm = t >> 2, pn = t & 3;
        u.pm = n * 64 + pm; u.pn = n * 4 + pn; return true;
    }
    __device__ __forceinline__ void a_ready(const Unit&) const {}
    __device__ __forceinline__ void done(const Unit&) const {}
};
struct EpiMerge2 {
    static constexpr bool PERM = true, AFTER_DRAIN = false;
    bf16_t* MG; const unsigned char* G;
    mutable f32x4 tot[2][4][2];
    __device__ __forceinline__ void zero() const {
#pragma unroll
        for (int bj = 0; bj < 2; ++bj)
#pragma unroll
            for (int m = 0; m < 4; ++m)
#pragma unroll
                for (int k = 0; k < 2; ++k) tot[bj][m][k] = (f32x4){0.f, 0.f, 0.f, 0.f};
    }
    __device__ __forceinline__ void operator()(const f32x4 (&acc)[2][2][4][2], const Unit& u, int wr, int wc, int fr, int fq) const {
        const int n = u.pn >> 2, pn = u.pn & 3, pm = u.pm - n * 128;
        const unsigned row0 = pm * HALF + wr * 64 + fr, col0 = pn * BM + wc * 32 + 8 * fq;
        const unsigned char* gbase = G + n * 1024 + col0;
        u32x2 gw[4][2];
#pragma unroll
        for (int m = 0; m < 4; ++m)
#pragma unroll
            for (int bj = 0; bj < 2; ++bj) gw[m][bj] = *(const u32x2*)(gbase + (row0 + m * 16) * 4096u + bj * HALF);
#pragma unroll
        for (int m = 0; m < 4; ++m)
#pragma unroll
            for (int bj = 0; bj < 2; ++bj) {
#pragma unroll
                for (int k = 0; k < 4; ++k) { tot[bj][m][0][k] += acc[0][bj][m][0][k] * ((float)((gw[m][bj].x >> (8 * k)) & 255u) * (1.0f / 255.0f));
                                              tot[bj][m][1][k] += acc[0][bj][m][1][k] * ((float)((gw[m][bj].y >> (8 * k)) & 255u) * (1.0f / 255.0f)); } }
        if (n == 3) {
            bf16_t* mbase = MG + col0;
#pragma unroll
            for (int m = 0; m < 4; ++m)
#pragma unroll
                for (int bj = 0; bj < 2; ++bj) { const f32x4 t0 = tot[bj][m][0], t1 = tot[bj][m][1];
#if WO8
                    u32x2 w8; w8.x = __builtin_amdgcn_cvt_pk_fp8_f32(t0[2], t0[3], __builtin_amdgcn_cvt_pk_fp8_f32(t0[0], t0[1], 0u, false), true);
                    w8.y = __builtin_amdgcn_cvt_pk_fp8_f32(t1[2], t1[3], __builtin_amdgcn_cvt_pk_fp8_f32(t1[0], t1[1], 0u, false), true);
                    *(u32x2*)((unsigned char*)MG + col0 + (row0 + m * 16) * 1024u + bj * HALF) = w8; }
#else
                    u32x4 w; w.x = cvt_pk_bf16(t0[0], t0[1]); w.y = cvt_pk_bf16(t0[2], t0[3]); w.z = cvt_pk_bf16(t1[0], t1[1]); w.w = cvt_pk_bf16(t1[2], t1[3]);
                    *(u32x4*)(mbase + (row0 + m * 16) * 1024u + bj * HALF) = w; }
#endif
            zero();
        }
    }
};
struct MergeOrder2 {
    int G, c;
    __device__ __forceinline__ bool next(int i, Unit& u) const {
        const int t = (i >> 2) * G + c; if (t >= 512) return false;
        const int n = i & 3, pm = t >> 2, pn = t & 3;
        u.pm = n * 128 + pm; u.pn = n * 4 + pn; return true;
    }
    __device__ __forceinline__ void a_ready(const Unit&) const {}
    __device__ __forceinline__ void done(const Unit&) const {}
};
struct Frag16x2 { bf16x8 k[2]; };
template <bool FP8> struct FragSel;
template <> struct FragSel<false> {
    typedef Frag16x2 type;
    static __device__ __forceinline__ type load(PG8_LAS unsigned char* p) { type f; f.k[0] = *(const PG8_LAS bf16x8*)p; f.k[1] = *(const PG8_LAS bf16x8*)(p + 1024); return f; }
    static __device__ __forceinline__ f32x4 mma(const type& w, const type& a, f32x4 c) {
        c = __builtin_amdgcn_mfma_f32_16x16x32_bf16(w.k[0], a.k[0], c, 0, 0, 0); return __builtin_amdgcn_mfma_f32_16x16x32_bf16(w.k[1], a.k[1], c, 0, 0, 0); }
};
template <> struct FragSel<true> {
    struct type { v4i_t lo, hi; };
    static __device__ __forceinline__ type load(PG8_LAS unsigned char* p) { type f; f.lo = *(const PG8_LAS v4i_t*)p; f.hi = *(const PG8_LAS v4i_t*)(p + 1024); return f; }
    static __device__ __forceinline__ f32x4 mma(const type& w, const type& a, f32x4 c) {
        return __builtin_amdgcn_mfma_scale_f32_16x16x128_f8f6f4(__builtin_shufflevector(w.lo, w.hi, 0, 1, 2, 3, 4, 5, 6, 7), __builtin_shufflevector(a.lo, a.hi, 0, 1, 2, 3, 4, 5, 6, 7), c, 0, 0, 0, 0x7a7a7a7a, 0, 0x7f7f7f7f); }
};
template <class Epi, class Sched, bool ALIGN_EPI = false, bool SP2 = false, bool FP8 = false, bool HALFM = false>
__device__ __forceinline__ void gemm_phase(PG8_LAS unsigned char* lds, const Gemm g, const Sched& S, const Epi& E, int wid_s) {
    unsigned ones_ = ~0u; asm volatile("" : "+s"(ones_));
    int tid_ = wid_s * 64 + (int)__builtin_amdgcn_mbcnt_hi(ones_, __builtin_amdgcn_mbcnt_lo(ones_, 0u)); asm volatile("" : "+v"(tid_));
    const int tid = tid_, wid = __builtin_amdgcn_readfirstlane(tid >> 6), lane = tid & 63, wr = wid >> 2, wc = wid & 3, fr = lane & 15, fq = lane >> 4;
    const int K = FP8 ? g.K / 2 : g.K, nt = K / BK;
    unsigned voffA[2], voffB[2];
#pragma unroll
    for (int i = 0; i < 2; ++i) { int R, C; stage_rc(tid * 16 + i * 8192, R, C); const int Rb = Epi::PERM ? ((R & ~31) + perm32(R & 31)) : R;
        voffA[i] = (unsigned)(R * K + C) * 2u; voffB[i] = (unsigned)(Rb * K + C) * 2u; }
    const size_t kstep = (size_t)(BK * 2);
    const size_t hstep = (size_t)HALF * K * 2;
    const size_t tstep = 2 * hstep;
    const unsigned ldsw = (unsigned)wid * 1024u;
    const unsigned ldsbase = (unsigned)(__UINTPTR_TYPE__)lds;
    const __amdgpu_buffer_rsrc_t srdA = __builtin_amdgcn_make_buffer_rsrc((void*)g.A, (short)0, 0x7fffffff, 0x00020000);
    const __amdgpu_buffer_rsrc_t srdB = __builtin_amdgcn_make_buffer_rsrc((void*)g.Bt, (short)0, 0x7fffffff, 0x00020000);
    const int aoff = lds_byte(wr * 64 + fr, fq * 8), boff = lds_byte(wc * 32 + fr, fq * 8);
#define PG8_SA(b, h) (((b) * 2 + (h)) * HTB)
#define PG8_SB(b, h) ((4 + (b) * 2 + (h)) * HTB)
#define PG8_STAGE(bufoff, gbase, voff, srd, base) do { const unsigned so_ = (unsigned)((const char*)(gbase) - (const char*)(base)); _Pragma("unroll") for (int _i = 0; _i < 2; ++_i) \
        asm volatile("s_mov_b32 m0, %0\n\ts_nop 0\n\tbuffer_load_dwordx4 %1, %2, %3 offen lds" :: "s"(ldsbase + (unsigned)(bufoff) + ldsw + (unsigned)(_i * 8192)), "v"((voff)[_i]), "s"(srd), "s"(so_) : "m0", "memory"); } while (0)
#define PG8_LDA(dst, b, h) do { _Pragma("unroll") for (int m = 0; m < 4; ++m) dst[m] = FragSel<FP8>::load(lds + PG8_SA(b, h) + aoff + m * 2048); } while (0)
#define PG8_LDB(dst, b, h) do { _Pragma("unroll") for (int n = 0; n < 2; ++n) dst[n] = FragSel<FP8>::load(lds + PG8_SB(b, h) + boff + n * 2048); } while (0)
#define PG8_MMA(ai, bj, At, Bt) do { __builtin_amdgcn_s_setprio(1); _Pragma("unroll") for (int m = 0; m < 4; ++m) _Pragma("unroll") for (int n = 0; n < 2; ++n) \
        acc[ai][bj][m][n] = FragSel<FP8>::mma(Bt[n], At[m], acc[ai][bj][m][n]); __builtin_amdgcn_s_setprio(0); } while (0)
#define PG8_WAIT_V(n) asm volatile("s_waitcnt vmcnt(" #n ")" ::: "memory")
#define PG8_WAIT_L(n) asm volatile("s_waitcnt lgkmcnt(" #n ")" ::: "memory")
#define PG8_BAR __builtin_amdgcn_s_barrier()
#define PG8_SCHED __builtin_amdgcn_sched_barrier(0)
    Unit cur, nxt; int ui = 0;
    if (!S.next(0, cur)) return;
    f32x4 acc[2][2][4][2];
#pragma unroll
    for (int a = 0; a < 2; ++a)
#pragma unroll
        for (int b = 0; b < 2; ++b)
#pragma unroll
            for (int m = 0; m < 4; ++m)
#pragma unroll
                for (int n = 0; n < 2; ++n) acc[a][b][m][n] = (f32x4){0.f, 0.f, 0.f, 0.f};
    typedef typename FragSel<FP8>::type frag_t;
    frag_t At[4], B0[2], B1[2];
    const size_t tstepA = HALFM ? hstep : tstep;
    const char* cA = (const char*)g.A + (size_t)cur.pm * tstepA; const char* cB = (const char*)g.Bt + (size_t)cur.pn * tstep;
    S.a_ready(cur);
    if constexpr (SP2) {
        PG8_STAGE(PG8_SB(0, 0), cB, voffB, srdB, g.Bt); PG8_STAGE(PG8_SB(0, 1), cB + hstep, voffB, srdB, g.Bt); PG8_STAGE(PG8_SA(0, 0), cA, voffA, srdA, g.A); PG8_STAGE(PG8_SA(0, 1), cA + hstep, voffA, srdA, g.A);
        if (wr == 1) PG8_BAR;
        PG8_WAIT_V(2); PG8_BAR;
        PG8_STAGE(PG8_SB(1, 0), cB + kstep, voffB, srdB, g.Bt); PG8_STAGE(PG8_SA(1, 0), cA + kstep, voffA, srdA, g.A); PG8_STAGE(PG8_SB(1, 1), cB + hstep + kstep, voffB, srdB, g.Bt);
        PG8_WAIT_V(6); PG8_BAR;
    } else {
        PG8_STAGE(PG8_SB(0, 0), cB, voffB, srdB, g.Bt); PG8_STAGE(PG8_SA(0, 0), cA, voffA, srdA, g.A); PG8_STAGE(PG8_SB(0, 1), cB + hstep, voffB, srdB, g.Bt); PG8_STAGE(PG8_SA(0, 1), cA + hstep, voffA, srdA, g.A);
        if (wr == 1) PG8_BAR;
        PG8_WAIT_V(4); PG8_BAR;
        PG8_STAGE(PG8_SB(1, 0), cB + kstep, voffB, srdB, g.Bt); PG8_STAGE(PG8_SA(1, 0), cA + kstep, voffA, srdA, g.A); PG8_STAGE(PG8_SB(1, 1), cB + hstep + kstep, voffB, srdB, g.Bt);
        PG8_WAIT_V(6); PG8_BAR;
    }
    for (;;) {
        const bool has_next = S.next(ui + 1, nxt);
        const char* nA = has_next ? (const char*)g.A + (size_t)nxt.pm * tstepA : cA; const char* nB = has_next ? (const char*)g.Bt + (size_t)nxt.pn * tstep : cB;
#pragma unroll 1
        for (int t = 0; t < nt; t += 2) {
            const bool last = (t == nt - 2);
            const char* a1 = cA + (size_t)(t + 1) * kstep;
            const char* a2 = last ? nA : cA + (size_t)(t + 2) * kstep; const char* b2 = last ? nB : cB + (size_t)(t + 2) * kstep;
            const char* a3 = a2 + kstep; const char* b3 = b2 + kstep;
            if (last && has_next) S.a_ready(nxt);
            if constexpr (SP2) {
            PG8_LDB(B0, 0, 0); PG8_LDB(B1, 0, 1); PG8_SCHED; PG8_LDA(At, 0, 0); PG8_STAGE(PG8_SA(1, 1), a1 + hstep, voffA, srdA, g.A);
            PG8_WAIT_V(8); PG8_WAIT_L(0); PG8_BAR; PG8_MMA(0, 0, At, B0); PG8_MMA(0, 1, At, B1); PG8_BAR; PG8_SCHED;
            if constexpr (!HALFM) PG8_LDA(At, 0, 1); PG8_STAGE(PG8_SB(0, 0), b2, voffB, srdB, g.Bt); PG8_STAGE(PG8_SB(0, 1), b2 + hstep, voffB, srdB, g.Bt); PG8_STAGE(PG8_SA(0, 0), a2, voffA, srdA, g.A);
            PG8_WAIT_V(8); PG8_WAIT_L(0); PG8_BAR; if constexpr (!HALFM) { PG8_MMA(1, 0, At, B0); PG8_MMA(1, 1, At, B1); } PG8_BAR; PG8_SCHED;
            PG8_LDB(B0, 1, 0); PG8_LDB(B1, 1, 1); PG8_SCHED; PG8_LDA(At, 1, 0); PG8_STAGE(PG8_SA(0, 1), a2 + hstep, voffA, srdA, g.A);
            PG8_WAIT_V(8); PG8_WAIT_L(0); PG8_BAR; PG8_MMA(0, 0, At, B0); PG8_MMA(0, 1, At, B1); PG8_BAR; PG8_SCHED;
            if constexpr (!HALFM) PG8_LDA(At, 1, 1); PG8_STAGE(PG8_SB(1, 0), b3, voffB, srdB, g.Bt); PG8_STAGE(PG8_SB(1, 1), b3 + hstep, voffB, srdB, g.Bt); PG8_STAGE(PG8_SA(1, 0), a3, voffA, srdA, g.A);
            PG8_WAIT_V(8); PG8_WAIT_L(0); PG8_BAR; if constexpr (!HALFM) { PG8_MMA(1, 0, At, B0); PG8_MMA(1, 1, At, B1); } PG8_BAR; PG8_SCHED;
            } else {
            PG8_LDB(B0, 0, 0); PG8_SCHED; PG8_LDA(At, 0, 0); PG8_STAGE(PG8_SA(1, 1), a1 + hstep, voffA, srdA, g.A);
            PG8_WAIT_L(8); PG8_BAR; PG8_WAIT_L(0); PG8_MMA(0, 0, At, B0); PG8_BAR; PG8_SCHED;
            PG8_LDB(B1, 0, 1); PG8_STAGE(PG8_SB(0, 0), b2, voffB, srdB, g.Bt);
            PG8_BAR; PG8_WAIT_L(0); PG8_MMA(0, 1, At, B1); PG8_BAR;
            if constexpr (!HALFM) PG8_LDA(At, 0, 1); PG8_STAGE(PG8_SA(0, 0), a2, voffA, srdA, g.A);
            PG8_BAR; PG8_WAIT_L(0); if constexpr (!HALFM) PG8_MMA(1, 0, At, B0); PG8_BAR; PG8_SCHED;
            PG8_STAGE(PG8_SB(0, 1), b2 + hstep, voffB, srdB, g.Bt);
            PG8_WAIT_V(6); PG8_BAR; if constexpr (!HALFM) PG8_MMA(1, 1, At, B1); PG8_BAR;
            PG8_LDB(B0, 1, 0); PG8_SCHED; PG8_LDA(At, 1, 0); PG8_STAGE(PG8_SA(0, 1), a2 + hstep, voffA, srdA, g.A);
            PG8_WAIT_L(8); PG8_BAR; PG8_WAIT_L(0); PG8_MMA(0, 0, At, B0); PG8_BAR; PG8_SCHED;
            PG8_LDB(B1, 1, 1); PG8_STAGE(PG8_SB(1, 0), b3, voffB, srdB, g.Bt);
            PG8_BAR; PG8_WAIT_L(0); PG8_MMA(0, 1, At, B1); PG8_BAR;
            if constexpr (!HALFM) PG8_LDA(At, 1, 1); PG8_STAGE(PG8_SA(1, 0), a3, voffA, srdA, g.A);
            PG8_BAR; PG8_WAIT_L(0); if constexpr (!HALFM) PG8_MMA(1, 0, At, B0); PG8_BAR; PG8_SCHED;
            PG8_STAGE(PG8_SB(1, 1), b3 + hstep, voffB, srdB, g.Bt);
            PG8_WAIT_V(6); PG8_BAR; if constexpr (!HALFM) PG8_MMA(1, 1, At, B1); PG8_BAR;
            }
        }
        if constexpr (ALIGN_EPI) { if (wr == 0) PG8_BAR; }
        if constexpr (!Epi::AFTER_DRAIN) { E(acc, cur, wr, wc, fr, fq); S.done(cur); }
        if (!has_next) break;
#pragma unroll
        for (int a = 0; a < 2; ++a)
#pragma unroll
            for (int b = 0; b < 2; ++b)
#pragma unroll
                for (int m = 0; m < 4; ++m)
#pragma unroll
                    for (int n = 0; n < 2; ++n) acc[a][b][m][n] = (f32x4){0.f, 0.f, 0.f, 0.f};
        cur = nxt; cA = nA; cB = nB; ++ui;
        if constexpr (ALIGN_EPI) { if (wr == 1) PG8_BAR; }
    }
    PG8_WAIT_V(0);
    if constexpr (!ALIGN_EPI) { if (wr == 0) PG8_BAR; }
    PG8_BAR;
    if constexpr (Epi::AFTER_DRAIN) { E.fused(acc, cur, wr, wc, fr, fq, lds, wid, lane); S.done(cur); }
#undef PG8_SA
#undef PG8_SB
#undef PG8_STAGE
#undef PG8_LDA
#undef PG8_LDB
#undef PG8_MMA
#undef PG8_WAIT_V
#undef PG8_WAIT_L
#undef PG8_BAR
#undef PG8_SCHED
}
}

typedef unsigned short bf16_t;
typedef short bf16x8 __attribute__((ext_vector_type(8)));
typedef short s16x4 __attribute__((ext_vector_type(4)));
typedef float f32x4 __attribute__((ext_vector_type(4)));
typedef float f32x16 __attribute__((ext_vector_type(16)));
typedef unsigned u32x4 __attribute__((ext_vector_type(4)));
typedef unsigned u32x2 __attribute__((ext_vector_type(2)));
#define LAS __attribute__((address_space(3)))

constexpr int D = 1024, BATCH = 2, SEQ = 8192, MROWS = BATCH * SEQ, DEPTH = 2;
constexpr int ZW = 2816, NW1 = 6912, INW = 6856, DFF = 2816, NGU = 5632, NMOD = 6 * D;
constexpr float RMS_EPS = 1e-6f, LOG2E = 1.4426950408889634f, C2 = 0.125f * 1.4426950408889634f;
constexpr int ZC_AU = 0, ZC_AB = 256, ZC_AC = 512, ZC_DQ = 768, ZC_DK = 1024, ZC_DV = 1088, ZC_DQI = 1152, ZC_DKI = 1408, ZC_FQ = 1472, ZC_FK = 1728, ZC_FV = 1984, ZC_SQ = 2240, ZC_SK = 2496, ZC_SV = 2624;

constexpr size_t MiB = 1u << 20;
constexpr size_t WS_KMAX = 4096;
constexpr size_t WS_MOD = 65536;
constexpr size_t WS_FCUM = WS_MOD + 98304;
constexpr size_t WS_SMALL = WS_FCUM + 262144;
constexpr size_t WS_W1T = 1 * MiB;
constexpr size_t WS_WG8 = WS_W1T + (size_t)2816 * D * 2;
constexpr size_t WS_WGU = WS_W1T + (size_t)NW1 * D * 2;
constexpr size_t WS_WBT = WS_WGU + (size_t)NGU * D * 2;
constexpr size_t WS_WOT = WS_WBT + (size_t)4 * D * 256 * 2;
constexpr size_t WS_WDT = WS_WOT + (size_t)D * D * 2;
constexpr size_t WS_H = 35 * MiB;
constexpr size_t WS_Z = 67 * MiB;
constexpr size_t WS_G = 155 * MiB;
constexpr size_t WS_MG = 219 * MiB;
constexpr size_t WS_END = 251 * MiB;
static_assert(WS_WDT + (size_t)D * DFF * 2 <= WS_H && WS_SMALL + 524288 <= WS_W1T, "ws map");

#ifndef FFN8
#define FFN8 1
#endif
#ifndef DOWN8
#define DOWN8 1
#endif
constexpr int LDS_BYTES = 151552;

struct Args {
    const float *x, *c, *w_ada, *b_ada, *norm_g, *w_in, *conv_w, *fox_bias, *swa_sinks, *w_branch, *w_o, *w_gate, *w_up, *w_down;
    float* out; unsigned char* ws;
};

__device__ __forceinline__ unsigned f2bf(float f) { unsigned u = __builtin_bit_cast(unsigned, f); return (u + 0x7fffu + ((u >> 16) & 1u)) >> 16; }
__device__ __forceinline__ unsigned pk2(float lo, float hi) { return f2bf(lo) | (f2bf(hi) << 16); }
__device__ __forceinline__ float bflo(unsigned w) { return __uint_as_float(w << 16); }
__device__ __forceinline__ float bfhi(unsigned w) { return __uint_as_float(w & 0xffff0000u); }

__device__ __forceinline__ float shf(float v, int src) { return __int_as_float(__builtin_amdgcn_ds_bpermute(src << 2, __float_as_int(v))); }
__device__ __forceinline__ unsigned shu(unsigned v, int src) { return (unsigned)__builtin_amdgcn_ds_bpermute(src << 2, (int)v); }
__device__ __forceinline__ float wave_sum(float v, int lane) {
#pragma unroll
    for (int o = 1; o < 64; o <<= 1) v += shf(v, lane ^ o);
    return v;
}
__device__ __forceinline__ int crow(int r, int hi) { return (r & 3) + 8 * (r >> 2) + 4 * hi; }
__device__ __forceinline__ float swap32_max(float m) { auto rr = __builtin_amdgcn_permlane32_swap(__float_as_uint(m), __float_as_uint(m), false, false); return fmaxf(__uint_as_float(rr[0]), __uint_as_float(rr[1])); }
__device__ __forceinline__ float swap32_sum(float m) { auto rr = __builtin_amdgcn_permlane32_swap(__float_as_uint(m), __float_as_uint(m), false, false); return __uint_as_float(rr[0]) + __uint_as_float(rr[1]); }
#define LDSWAIT() asm volatile("s_waitcnt lgkmcnt(0)" ::: "memory")
__device__ __forceinline__ int ftid(int wid_s) { unsigned ones = ~0u; asm volatile("" : "+s"(ones)); int t = wid_s * 64 + (int)__builtin_amdgcn_mbcnt_hi(ones, __builtin_amdgcn_mbcnt_lo(ones, 0u)); asm volatile("" : "+v"(t)); return t; }

__device__ __forceinline__ void ada_gemv(const Args& a, unsigned char* lds, int wid_s) {
    float* sc = (float*)lds;
    float* part = (float*)(lds + 8192);
    const int tid = ftid(wid_s), lane = tid & 63, wid = tid >> 6;
    for (int i = tid; i < 2 * D; i += 512) { const float v = a.c[i]; sc[i] = v / (1.0f + __expf(-v)); }
    __syncthreads();
    float* mod = (float*)(a.ws + WS_MOD);
    for (int item = blockIdx.x; item < DEPTH * (NMOD / 64); item += gridDim.x) {
        const int l = item / (NMOD / 64), jc = item % (NMOD / 64);
        const float* w = a.w_ada + (size_t)l * D * NMOD + (size_t)(wid * 128) * NMOD + jc * 64 + lane;
        float a0 = 0.f, a1 = 0.f;
#pragma unroll 32
        for (int k = 0; k < 128; ++k) { const float wv = w[(size_t)k * NMOD]; a0 += sc[wid * 128 + k] * wv; a1 += sc[D + wid * 128 + k] * wv; }
        part[(wid * 2 + 0) * 64 + lane] = a0; part[(wid * 2 + 1) * 64 + lane] = a1;
        __syncthreads();
        if (tid < 128) { const int b = tid >> 6, j = tid & 63; float s = 0.f;
#pragma unroll
            for (int w8 = 0; w8 < 8; ++w8) s += part[(w8 * 2 + b) * 64 + j];
            mod[((size_t)l * 2 + b) * NMOD + jc * 64 + j] = s + a.b_ada[(size_t)l * NMOD + jc * 64 + j]; }
        __syncthreads();
    }
}
__device__ __forceinline__ void transpose_item(const float* colptr, int ld, bf16_t* dst  , int dstK, float* scr, int lane) {
    float tv[32];
#pragma unroll
    for (int i = 0; i < 32; ++i) tv[i] = colptr ? colptr[(size_t)(2 * i + (lane >> 5)) * ld] : 0.f;
#pragma unroll
    for (int i = 0; i < 32; ++i) scr[(2 * i + (lane >> 5)) * 33 + (lane & 31)] = tv[i];
    LDSWAIT();
    const int c = lane & 7;
#pragma unroll
    for (int j = 0; j < 4; ++j) { const int n = (lane >> 3) + 8 * j; const float* s = scr + (8 * c) * 33 + n;
        u32x4 o; o.x = pk2(s[0 * 33], s[1 * 33]); o.y = pk2(s[2 * 33], s[3 * 33]); o.z = pk2(s[4 * 33], s[5 * 33]); o.w = pk2(s[6 * 33], s[7 * 33]);
        *(u32x4*)(dst + (size_t)n * dstK + 8 * c) = o; }
    LDSWAIT();
}
__device__ __forceinline__ void transpose_item_fp8(const float* colptr, int ld, unsigned char* dst  , int dstK, float scale, float* scr, int lane) {
    float tv[32];
#pragma unroll
    for (int i = 0; i < 32; ++i) tv[i] = colptr ? colptr[(size_t)(2 * i + (lane >> 5)) * ld] : 0.f;
#pragma unroll
    for (int i = 0; i < 32; ++i) scr[(2 * i + (lane >> 5)) * 33 + (lane & 31)] = tv[i];
    LDSWAIT();
    const int n = lane >> 1, kh = 32 * (lane & 1); const float* s = scr + kh * 33 + n;
    unsigned w[8];
#pragma unroll
    for (int q = 0; q < 8; ++q) { unsigned t = 0u;
        t = __builtin_amdgcn_cvt_pk_fp8_f32(s[(4 * q + 0) * 33] * scale, s[(4 * q + 1) * 33] * scale, t, false);
        t = __builtin_amdgcn_cvt_pk_fp8_f32(s[(4 * q + 2) * 33] * scale, s[(4 * q + 3) * 33] * scale, t, true);
        w[q] = t; }
    unsigned char* dp = dst + (size_t)n * dstK + kh;
    *(u32x4*)dp = (u32x4){w[0], w[1], w[2], w[3]}; *(u32x4*)(dp + 16) = (u32x4){w[4], w[5], w[6], w[7]};
    LDSWAIT();
}
__device__ __forceinline__ int w1_src_col(int n) {
    if (n < 1472) return n;
    if (n < 2240) return n + 4;
    if (n < 2752) return n + 8;
    if (n < 2756) return 1472 + (n - 2752);
    if (n < 2760) return 2244 + (n - 2756);
    if (n < 2816) return -1;
    return 2760 + (n - 2816);
}
__device__ __forceinline__ void convert_weights(const Args& a, int l, unsigned char* lds, int wid_s) {
    const int tid = ftid(wid_s), lane = tid & 63, wid = tid >> 6;
    float* scr = (float*)(lds + 16384) + wid * (64 * 33);
    const int gw = blockIdx.x * 8 + wid, NGW = gridDim.x * 8;
    constexpr int I_IN = 16 * 216, I_GU = 16 * 176, I_B = 512, I_O = 512, I_D = 44 * 32;
    bf16_t* W1T = (bf16_t*)(a.ws + WS_W1T); bf16_t* WGU = (bf16_t*)(a.ws + WS_WGU); bf16_t* WBT = (bf16_t*)(a.ws + WS_WBT); bf16_t* WOT = (bf16_t*)(a.ws + WS_WOT); bf16_t* WDT = (bf16_t*)(a.ws + WS_WDT);
    const int cl = lane & 31;
    for (int it = gw; it < I_IN + I_GU + I_B + I_O + I_D; it += NGW) {
        int r = it;
        if (r < I_IN) { const int kb = r / 216, nb = r % 216;
            if (nb < 88) { const int n = 32 * nb + cl, sc_ = w1_src_col(n);
                const float* cp = sc_ >= 0 ? a.w_in + (size_t)l * D * INW + (size_t)(64 * kb) * INW + sc_ : nullptr;
                transpose_item(cp, INW, W1T + (size_t)(32 * nb) * D + 64 * kb, D, scr, lane); }
            else { const int n = 32 * nb + cl;
                const float* cp = a.w_in + (size_t)l * D * INW + (size_t)(64 * kb) * INW + w1_src_col(n);
                transpose_item_fp8(cp, INW, a.ws + WS_WG8 + (size_t)(32 * (nb - 88)) * D + 64 * kb, D, 32.0f, scr, lane); }
            continue; }
        r -= I_IN;
        if (r < I_GU) { const int kb = r / 176, nb = r % 176, n = 32 * nb + cl;
            const float* cp = ((n & 1) ? a.w_up : a.w_gate) + (size_t)l * D * DFF + (size_t)(64 * kb) * DFF + (n >> 1);
#if FFN8
            transpose_item_fp8(cp, DFF, a.ws + WS_WGU + (size_t)(32 * nb) * D + 64 * kb, D, 32.0f, scr, lane); continue; }
#else
            transpose_item(cp, DFF, WGU + (size_t)(32 * nb) * D + 64 * kb, D, scr, lane); continue; }
#endif
        r -= I_GU;
        if (r < I_B) { const int nbr = r / 128, rr = r % 128, kb = rr / 32, nb = rr % 32;
            const float* cp = a.w_branch + ((size_t)(l * 4 + nbr) * 256 + 64 * kb) * D + 32 * nb + cl;
            transpose_item(cp, D, WBT + ((size_t)nbr * D + 32 * nb) * 256 + 64 * kb, 256, scr, lane); continue; }
        r -= I_B;
        if (r < I_O) { const int kb = r / 32, nb = r % 32;
            const float* cp = a.w_o + (size_t)l * D * D + (size_t)(64 * kb) * D + 32 * nb + cl;
#if WO8
            transpose_item_fp8(cp, D, a.ws + WS_WOT + (size_t)(32 * nb) * D + 64 * kb, D, 32.0f, scr, lane); continue; }
#else
            transpose_item(cp, D, WOT + (size_t)(32 * nb) * D + 64 * kb, D, scr, lane); continue; }
#endif
        r -= I_O;
        { const int kb = r / 32, nb = r % 32;
            const float* cp = a.w_down + (size_t)l * DFF * D + (size_t)(64 * kb) * D + 32 * nb + cl;
#if DOWN8
            transpose_item_fp8(cp, D, a.ws + WS_WDT + (size_t)(32 * nb) * DFF + 64 * kb, DFF, 32.0f, scr, lane); }
#else
            transpose_item(cp, D, WDT + (size_t)(32 * nb) * DFF + 64 * kb, DFF, scr, lane); }
#endif
    }
}

template <bool HAS_RAW, bool HAS_H, bool XIN16 = false, bool XOUT16 = false, bool HAS_H8 = false>
__device__ __forceinline__ void row_pass8(const void* xres_, const bf16_t* raw, void* xdst_, bf16_t* hdst, unsigned char* h8dst, const float* gate, const float* gam_out, const float* gam_in, const float* sc, const float* sh, int lane) {
    f32x4 A[4], B[4], C[4];
#pragma unroll
    for (int j = 0; j < 4; ++j) {
        if (HAS_RAW) A[j] = ((const f32x4*)gate)[lane + 64 * j] * ((const f32x4*)gam_out)[lane + 64 * j];
        if (HAS_H) { B[j] = ((const f32x4*)gam_in)[lane + 64 * j] * (((const f32x4*)sc)[lane + 64 * j] + 1.0f); C[j] = ((const f32x4*)sh)[lane + 64 * j]; }
    }
    const float* xres = (const float*)xres_; const bf16_t* xres16 = (const bf16_t*)xres_; float* xdst = (float*)xdst_; bf16_t* xdst16 = (bf16_t*)xdst_;
    f32x4 nv[4]; u32x2 nx[4], nr[4];
#pragma unroll
    for (int j = 0; j < 4; ++j) { if (XIN16) nx[j] = ((const u32x2*)xres16)[lane + 64 * j]; else nv[j] = ((const f32x4*)xres)[lane + 64 * j]; if (HAS_RAW) nr[j] = ((const u32x2*)raw)[lane + 64 * j]; }
#pragma unroll 1
    for (int r = 0; r < 8; ++r) {
        f32x4 v[4]; u32x2 w[4];
#pragma unroll
        for (int j = 0; j < 4; ++j) { if (XIN16) v[j] = (f32x4){bflo(nx[j].x), bfhi(nx[j].x), bflo(nx[j].y), bfhi(nx[j].y)}; else v[j] = nv[j]; if (HAS_RAW) w[j] = nr[j]; }
        if (r + 1 < 8) {
#pragma unroll
            for (int j = 0; j < 4; ++j) { if (XIN16) nx[j] = ((const u32x2*)(xres16 + (size_t)(r + 1) * D))[lane + 64 * j]; else nv[j] = ((const f32x4*)(xres + (size_t)(r + 1) * D))[lane + 64 * j];
                if (HAS_RAW) nr[j] = ((const u32x2*)(raw + (size_t)(r + 1) * D))[lane + 64 * j]; }
        }
        if (HAS_RAW) {
            f32x4 o[4]; float ss = 0.f;
#pragma unroll
            for (int j = 0; j < 4; ++j) { o[j] = (f32x4){bflo(w[j].x), bfhi(w[j].x), bflo(w[j].y), bfhi(w[j].y)}; ss += (o[j][0] * o[j][0] + o[j][1] * o[j][1]) + (o[j][2] * o[j][2] + o[j][3] * o[j][3]); }
            const float rstd = 1.0f / sqrtf(wave_sum(ss, lane) * (1.0f / D) + RMS_EPS);
#pragma unroll
            for (int j = 0; j < 4; ++j) { v[j] = v[j] + A[j] * (o[j] * rstd);
                if (XOUT16) { u32x2 pw; pw.x = pk2(v[j][0], v[j][1]); pw.y = pk2(v[j][2], v[j][3]); ((u32x2*)(xdst16 + (size_t)r * D))[lane + 64 * j] = pw; }
                else ((f32x4*)(xdst + (size_t)r * D))[lane + 64 * j] = v[j]; }
        }
        if (HAS_H) {
            float ss = 0.f;
#pragma unroll
            for (int j = 0; j < 4; ++j) ss += (v[j][0] * v[j][0] + v[j][1] * v[j][1]) + (v[j][2] * v[j][2] + v[j][3] * v[j][3]);
            const float rstd = 1.0f / sqrtf(wave_sum(ss, lane) * (1.0f / D) + RMS_EPS);
#pragma unroll
            for (int j = 0; j < 4; ++j) { const f32x4 h = v[j] * rstd * B[j] + C[j]; if (hdst) { u32x2 pw; pw.x = pk2(h[0], h[1]); pw.y = pk2(h[2], h[3]); ((u32x2*)(hdst + (size_t)r * D))[lane + 64 * j] = pw; }
                if (HAS_H8) { unsigned t8 = 0u; t8 = __builtin_amdgcn_cvt_pk_fp8_f32(h[0], h[1], t8, false); t8 = __builtin_amdgcn_cvt_pk_fp8_f32(h[2], h[3], t8, true); ((unsigned*)(h8dst + (size_t)r * D))[lane + 64 * j] = t8; } }
        }
    }
}

__device__ __forceinline__ void conv_phase(const Args& a, int l, int wid_s) {
    const bf16_t* Z = (const bf16_t*)(a.ws + WS_Z); bf16_t* Y0 = (bf16_t*)(a.ws + WS_H);
    const float* cw = a.conv_w + (size_t)l * 3 * 256;
    const int gt = blockIdx.x * 512 + ftid(wid_s), GT = gridDim.x * 512;
    for (int it = gt; it < MROWS * 32; it += GT) {
        const int row = it >> 5, ch = (it & 31) * 8, t = row & (SEQ - 1);
        float acc[8];
#pragma unroll
        for (int k = 0; k < 8; ++k) acc[k] = 0.f;
#pragma unroll
        for (int j = 0; j < 3; ++j) { const int dt = 2 - j; if (t - dt < 0) continue;
            const bf16_t* zr = Z + (size_t)(row - dt) * ZW;
            const u32x4 u = *(const u32x4*)(zr + ZC_AU + ch), cgt = *(const u32x4*)(zr + ZC_AC + ch);
            const f32x4 w0 = *(const f32x4*)(cw + j * 256 + ch), w1 = *(const f32x4*)(cw + j * 256 + ch + 4);
            acc[0] += w0[0] * bflo(u.x) * bflo(cgt.x); acc[1] += w0[1] * bfhi(u.x) * bfhi(cgt.x); acc[2] += w0[2] * bflo(u.y) * bflo(cgt.y); acc[3] += w0[3] * bfhi(u.y) * bfhi(cgt.y);
            acc[4] += w1[0] * bflo(u.z) * bflo(cgt.z); acc[5] += w1[1] * bfhi(u.z) * bfhi(cgt.z); acc[6] += w1[2] * bflo(u.w) * bflo(cgt.w); acc[7] += w1[3] * bfhi(u.w) * bfhi(cgt.w); }
        const u32x4 bg = *(const u32x4*)(Z + (size_t)row * ZW + ZC_AB + ch);
        u32x4 o; o.x = pk2(acc[0] * bflo(bg.x), acc[1] * bfhi(bg.x)); o.y = pk2(acc[2] * bflo(bg.y), acc[3] * bfhi(bg.y)); o.z = pk2(acc[4] * bflo(bg.z), acc[5] * bfhi(bg.z)); o.w = pk2(acc[6] * bflo(bg.w), acc[7] * bfhi(bg.w));
        *(u32x4*)(Y0 + (size_t)row * 256 + ch) = o;
    }
}

__device__ __forceinline__ void fox_scan(const Args& a, int l, int bh, unsigned char* lds, int wid_s) {
    const int tid = ftid(wid_s), lane = tid & 63, wid = tid >> 6, b = bh >> 2, h = bh & 3;
    const float* SM = (const float*)(a.ws + WS_SMALL); float* F2 = (float*)(a.ws + WS_FCUM) + (size_t)bh * SEQ;
    const float bias = a.fox_bias[l * 4 + h];
    float* wtot = (float*)lds;
    float v[16]; float run = 0.f;
#pragma unroll
    for (int i = 0; i < 16; ++i) { const float x = SM[((size_t)b * SEQ + tid * 16 + i) * 8 + 4 + h] + bias;
        const float ls = fminf(x, 0.f) - log1pf(__expf(-fabsf(x))); run += ls; v[i] = run; }
    float inc = run;
#pragma unroll
    for (int o = 1; o < 64; o <<= 1) { const float t = shf(inc, lane - o); if (lane >= o) inc += t; }
    if (lane == 63) wtot[wid] = inc;
    __syncthreads();
    float base = inc - run;
    for (int w = 0; w < wid; ++w) base += wtot[w];
#pragma unroll
    for (int i = 0; i < 16; ++i) F2[tid * 16 + i] = (base + v[i]) * LOG2E;
    __syncthreads();
}


__device__ __forceinline__ void fox_kmax_item(const Args& a, int l, int item, int wid_s) {
    const int tid = ftid(wid_s), lane = tid & 63, bh = item >> 3, chunk = item & 7, b = bh >> 2, h = bh & 3;
    const bf16_t* Z = (const bf16_t*)(a.ws + WS_Z);
    float mx = 0.f;
#pragma unroll
    for (int rr = 0; rr < 2; ++rr) { const bf16_t* kp = Z + ((size_t)b * SEQ + chunk * 1024 + rr * 512 + tid) * ZW + ZC_FK + h * 64; float q2 = 0.f;
#pragma unroll
        for (int i = 0; i < 8; ++i) { const u32x4 w = *(const u32x4*)(kp + 8 * i);
            q2 += bflo(w.x) * bflo(w.x) + bfhi(w.x) * bfhi(w.x) + bflo(w.y) * bflo(w.y) + bfhi(w.y) * bfhi(w.y) + bflo(w.z) * bflo(w.z) + bfhi(w.z) * bfhi(w.z) + bflo(w.w) * bflo(w.w) + bfhi(w.w) * bfhi(w.w); }
        mx = fmaxf(mx, q2); }
#pragma unroll
    for (int o = 1; o < 64; o <<= 1) mx = fmaxf(mx, shf(mx, lane ^ o));
    if (lane == 0) atomicMax((unsigned*)(a.ws + WS_KMAX) + l * 8 + bh, __float_as_uint(mx));
}

template <int MODE>
__device__ __forceinline__ void attn_unit(unsigned char* lds, const bf16_t* __restrict__ Z, bf16_t* __restrict__ Yn, int b, int head, int qb, const float* __restrict__ F2, float slope2, float sink2, int tile_lo, float kmax, int wid_s) {
    const int tid = ftid(wid_s), lane = tid & 63, r32 = lane & 31, hi = lane >> 5; const int wid = __builtin_amdgcn_readfirstlane(tid >> 6);
    constexpr int QOFF = MODE == 0 ? ZC_FQ : ZC_SQ, KOFF = MODE == 0 ? ZC_FK : ZC_SK, VOFF = MODE == 0 ? ZC_FV : ZC_SV;
    const int hk = MODE == 0 ? head : (head >> 1);
    const size_t rowbase = (size_t)b * SEQ;
    const int q0 = qb * 256, qa = q0 + 32 * wid, myq = qa + r32;
    unsigned char* Ks = lds; unsigned char* Vs = lds + 9216; float* Fk = (float*)(lds + 9216 + 12288); float* wsc = (float*)(lds + 49152) + wid * 64;
    bf16x8 qr[4];
    { const bf16_t* qp = Z + (rowbase + myq) * ZW + QOFF + head * 64 + hi * 8;
#pragma unroll
      for (int ks = 0; ks < 4; ++ks) qr[ks] = *(const bf16x8*)(qp + 16 * ks); }
    const float* Fh = MODE == 0 ? F2 + ((size_t)b * 4 + head) * SEQ : nullptr;
    const float fq2 = MODE == 0 ? Fh[myq] : 0.f;
    float m = -1e30f, l = 0.f; f32x16 o0, o1;
#pragma unroll
    for (int r = 0; r < 16; ++r) { o0[r] = 0.f; o1[r] = 0.f; }
    const int t_hi = (q0 + 255) >> 6;
    if (MODE == 0) {
        int* smin = (int*)(lds + 49152 + 2048);
        __syncthreads();
        if (tid == 0) *smin = 0x7fffffff;
        __syncthreads();
        if (tid < 256) {
            const int t = q0 + tid; const bf16_t* qp2 = Z + (rowbase + t) * ZW + QOFF + head * 64; float q2 = 0.f;
#pragma unroll
            for (int i = 0; i < 8; ++i) { const u32x4 w = *(const u32x4*)(qp2 + 8 * i);
                q2 += bflo(w.x) * bflo(w.x) + bfhi(w.x) * bfhi(w.x) + bflo(w.y) * bflo(w.y) + bfhi(w.y) * bfhi(w.y) + bflo(w.z) * bflo(w.z) + bfhi(w.z) * bfhi(w.z) + bflo(w.w) * bflo(w.w) + bfhi(w.w) * bfhi(w.w); }
            const float target = Fh[t] + (40.0f + 0.25f * sqrtf(q2) * kmax) * LOG2E;
            int lo = 0, hi2 = t;
            while (lo < hi2) { const int mid = (lo + hi2) >> 1; if (Fh[mid] <= target) hi2 = mid; else lo = mid + 1; }
            atomicMin(smin, lo);
        }
        __syncthreads();
#ifdef PROBE_FOXFULL
        tile_lo = 0;
#else
        tile_lo = *smin >> 6;
#endif
    }
    const int srow = tid >> 3, sch = tid & 7;
    const int i16 = lane & 15;
    const LAS unsigned char* vtr_base = (const LAS unsigned char*)(Vs) + (4 * hi + (i16 >> 2)) * 192 + (16 * ((lane >> 4) & 1) + 4 * (i16 & 3)) * 2;
    u32x4 nk, nv4; float nf = 0.f;
    { const bf16_t* src = Z + (rowbase + 64 * t_hi + srow) * ZW;
      nk = *(const u32x4*)(src + KOFF + hk * 64 + sch * 8); nv4 = *(const u32x4*)(src + VOFF + hk * 64 + sch * 8);
      if (MODE == 0 && tid < 64) nf = Fh[64 * t_hi + tid]; }
    constexpr int ABUF = 24576;
    __syncthreads();
    { unsigned char* kb_ = Ks + (t_hi & 1) * ABUF; unsigned char* vb_ = Vs + (t_hi & 1) * ABUF;
      *(u32x4*)(kb_ + srow * 144 + sch * 16) = nk; *(u32x4*)(vb_ + srow * 192 + sch * 16) = nv4;
      if (MODE == 0 && tid < 64) (Fk + (t_hi & 1) * (ABUF / 4))[tid] = nf; }
    if (t_hi > tile_lo) { const bf16_t* src = Z + (rowbase + 64 * (t_hi - 1) + srow) * ZW;
      nk = *(const u32x4*)(src + KOFF + hk * 64 + sch * 8); nv4 = *(const u32x4*)(src + VOFF + hk * 64 + sch * 8);
      if (MODE == 0 && tid < 64) nf = Fh[64 * (t_hi - 1) + tid]; }
    for (int T = t_hi; T >= tile_lo; --T) {
        __syncthreads();
        if (T > tile_lo) {
            unsigned char* kb_ = Ks + ((T - 1) & 1) * ABUF; unsigned char* vb_ = Vs + ((T - 1) & 1) * ABUF;
            *(u32x4*)(kb_ + srow * 144 + sch * 16) = nk; *(u32x4*)(vb_ + srow * 192 + sch * 16) = nv4;
            if (MODE == 0 && tid < 64) (Fk + ((T - 1) & 1) * (ABUF / 4))[tid] = nf;
            if (T - 1 > tile_lo) { const bf16_t* src = Z + (rowbase + 64 * (T - 2) + srow) * ZW;
              nk = *(const u32x4*)(src + KOFF + hk * 64 + sch * 8); nv4 = *(const u32x4*)(src + VOFF + hk * 64 + sch * 8);
              if (MODE == 0 && tid < 64) nf = Fh[64 * (T - 2) + tid]; }
        }
        const unsigned char* Kc = Ks + (T & 1) * ABUF; const float* Fc = Fk + (T & 1) * (ABUF / 4); const int vofs = (T & 1) * ABUF;
        const bool part = (64 * T <= qa + 31) && (MODE == 0 || (64 * T + 63 >= qa - 127));
        if (part) {
            f32x16 p0, p1;
#pragma unroll
            for (int r = 0; r < 16; ++r) { p0[r] = 0.f; p1[r] = 0.f; }
#pragma unroll
            for (int ks = 0; ks < 4; ++ks) {
                const bf16x8 k0 = *(const bf16x8*)(Kc + r32 * 144 + (16 * ks + 8 * hi) * 2);
                const bf16x8 k1 = *(const bf16x8*)(Kc + (32 + r32) * 144 + (16 * ks + 8 * hi) * 2);
                p0 = __builtin_amdgcn_mfma_f32_32x32x16_bf16(k0, qr[ks], p0, 0, 0, 0);
                p1 = __builtin_amdgcn_mfma_f32_32x32x16_bf16(k1, qr[ks], p1, 0, 0, 0);
            }
            const int kvb = 64 * T + 4 * hi;
            float mx = -INFINITY;
#pragma unroll
            for (int g = 0; g < 4; ++g) {
                f32x4 fk0 = {0.f, 0.f, 0.f, 0.f}, fk1 = {0.f, 0.f, 0.f, 0.f};
                if (MODE == 0) { fk0 = *(const f32x4*)(Fc + 8 * g + 4 * hi); fk1 = *(const f32x4*)(Fc + 32 + 8 * g + 4 * hi); }
#pragma unroll
                for (int i = 0; i < 4; ++i) { const int r = 4 * g + i, kv0 = kvb + 8 * g + i, kv1 = kv0 + 32;
                    float x0, x1;
                    if (MODE == 0) { x0 = p0[r] * C2 + (fq2 - fk0[i]); x1 = p1[r] * C2 + (fq2 - fk1[i]); if (kv0 > myq) x0 = -INFINITY; if (kv1 > myq) x1 = -INFINITY; }
                    else { const int d0 = myq - kv0, d1 = myq - kv1; x0 = p0[r] * C2 - slope2 * (float)d0; x1 = p1[r] * C2 - slope2 * (float)d1; if (d0 < 0 || d0 >= 128) x0 = -INFINITY; if (d1 < 0 || d1 >= 128) x1 = -INFINITY; }
                    p0[r] = x0; p1[r] = x1; mx = fmaxf(mx, fmaxf(x0, x1)); }
            }
            mx = swap32_max(mx);
            const float mn = fmaxf(m, mx), alpha = __builtin_amdgcn_exp2f(m - mn); m = mn;
            float ps = 0.f;
#pragma unroll
            for (int r = 0; r < 16; ++r) { p0[r] = __builtin_amdgcn_exp2f(p0[r] - mn); p1[r] = __builtin_amdgcn_exp2f(p1[r] - mn); ps += p0[r] + p1[r]; }
            l = l * alpha + ps;
            if (hi == 0) wsc[r32] = alpha;
            LDSWAIT();
#pragma unroll
            for (int g = 0; g < 4; ++g) { const f32x4 a4 = *(const f32x4*)(wsc + 8 * g + 4 * hi);
#pragma unroll
                for (int i = 0; i < 4; ++i) { o0[4 * g + i] *= a4[i]; o1[4 * g + i] *= a4[i]; } }
            LDSWAIT();
#pragma unroll
            for (int s = 0; s < 4; ++s) {
                u32x4 pw;
                if (s < 2) { const int e = 8 * s; pw.x = pk2(p0[e], p0[e + 1]); pw.y = pk2(p0[e + 2], p0[e + 3]); pw.z = pk2(p0[e + 4], p0[e + 5]); pw.w = pk2(p0[e + 6], p0[e + 7]); }
                else { const int e = 8 * (s - 2); pw.x = pk2(p1[e], p1[e + 1]); pw.y = pk2(p1[e + 2], p1[e + 3]); pw.z = pk2(p1[e + 4], p1[e + 5]); pw.w = pk2(p1[e + 6], p1[e + 7]); }
                const bf16x8 pa = __builtin_bit_cast(bf16x8, pw);
#pragma unroll
                for (int db = 0; db < 2; ++db) {
                    const LAS unsigned char* vp = vtr_base + vofs + (16 * s) * 192 + 64 * db;
                    const s16x4 lo = __builtin_bit_cast(s16x4, __builtin_amdgcn_ds_read_tr16_b64_v4i16((LAS s16x4*)vp));
                    const s16x4 hv = __builtin_bit_cast(s16x4, __builtin_amdgcn_ds_read_tr16_b64_v4i16((LAS s16x4*)(vp + 8 * 192)));
                    const bf16x8 vf = (bf16x8){lo[0], lo[1], lo[2], lo[3], hv[0], hv[1], hv[2], hv[3]};
                    if (db == 0) o0 = __builtin_amdgcn_mfma_f32_32x32x16_bf16(pa, vf, o0, 0, 0, 0); else o1 = __builtin_amdgcn_mfma_f32_32x32x16_bf16(pa, vf, o1, 0, 0, 0);
                }
            }
        }
    }
    float lt = swap32_sum(l);
    if (MODE == 1) lt += __builtin_amdgcn_exp2f(sink2 - m);
    const float inv = 1.0f / lt;
    LDSWAIT();
    if (hi == 0) wsc[32 + r32] = inv;
    LDSWAIT();
#pragma unroll
    for (int g = 0; g < 4; ++g) { const f32x4 iv = *(const f32x4*)(wsc + 32 + 8 * g + 4 * hi);
#pragma unroll
        for (int i = 0; i < 4; ++i) { const int r = 4 * g + i, q = qa + 8 * g + 4 * hi + i;
            bf16_t* yp = Yn + (rowbase + q) * 256 + head * 64 + r32;
            yp[0] = (bf16_t)f2bf(o0[r] * iv[i]); yp[32] = (bf16_t)f2bf(o1[r] * iv[i]); } }
    LDSWAIT();
}

__device__ __forceinline__ unsigned score_key(float s) { const unsigned u = __float_as_uint(s + 0.0f); return (u & 0x80000000u) ? ~u : (u | 0x80000000u); }
__device__ __forceinline__ void hist_find(const unsigned* hrow, int lane, unsigned need, unsigned& bin, unsigned& above) {
    unsigned w[16]; unsigned tot = 0;
#pragma unroll
    for (int i = 0; i < 16; i += 4) { const u32x4 t = *(const u32x4*)(hrow + 16 * lane + i); w[i] = t.x; w[i + 1] = t.y; w[i + 2] = t.z; w[i + 3] = t.w; }
#pragma unroll
    for (int i = 0; i < 16; ++i) tot += (w[i] & 0xffffu) + (w[i] >> 16);
    unsigned inc = tot;
#pragma unroll
    for (int o = 1; o < 64; o <<= 1) { const unsigned t = shu(inc, lane + o); if (lane + o < 64) inc += t; }
    const unsigned exc = inc - tot;
    const bool owner = (exc < need) && (inc >= need);
    unsigned run = exc, fb = 0, fa = 0; bool found = false;
#pragma unroll
    for (int i = 15; i >= 0; --i) {
        const unsigned hi = w[i] >> 16, lo = w[i] & 0xffffu;
        if (!found && run + hi >= need) { found = true; fb = 32 * lane + 2 * i + 1; fa = run; }
        run += hi;
        if (!found && run + lo >= need) { found = true; fb = 32 * lane + 2 * i; fa = run; }
        run += lo;
    }
    const unsigned long long bal = __ballot(owner);
    const int src = bal ? (int)__builtin_ctzll(bal) : 0;
    bin = shu(fb, src); above = shu(fa, src);
}
__device__ __forceinline__ void dsa_select_slow(const Args& a, unsigned char* lds, int b, int qb32, int wid_s) {
    const int tid = ftid(wid_s), lane = tid & 63; const int wid = __builtin_amdgcn_readfirstlane(tid >> 6);
    const int c16 = lane & 15, g = lane >> 4;
    const bf16_t* Z = (const bf16_t*)(a.ws + WS_Z); const float* SM = (const float*)(a.ws + WS_SMALL);
    unsigned short* IDX = (unsigned short*)(a.ws + WS_MG);
    unsigned* hist = (unsigned*)lds;
    unsigned char* kt = lds + 131072;
    const size_t rowbase = (size_t)b * SEQ;
    const int t0 = qb32 * 32, myt = t0 + 4 * wid + g;
    const int ntile = (t0 + 32 + 63) >> 6;
    bf16x8 af[2];
    { const int qq = c16 >> 2, h = c16 & 3; const bf16_t* qp = Z + (rowbase + t0 + 4 * wid + qq) * ZW + ZC_DQI + h * 64 + 8 * g;
      af[0] = *(const bf16x8*)qp; af[1] = *(const bf16x8*)(qp + 32); }
    const f32x4 wv = *(const f32x4*)(SM + (rowbase + myt) * 8);
    const unsigned need = (unsigned)((myt + 1) < 256 ? (myt + 1) : 256);
    unsigned b1 = 0, above1 = 0, thr22 = 0, quota = 0;
    unsigned tiecount = 0, outcount = 0;
    unsigned* myhist = hist + (size_t)(4 * wid + g) * 1024;
    unsigned short* myidx = IDX + (rowbase + myt) * 256;
    const int srow = tid >> 3, sch = tid & 7;
    for (int pass = 0; pass < 3; ++pass) {
        if (pass < 2) { unsigned z_ = 0u; asm volatile("" : "+v"(z_)); const u32x4 z4 = {z_, z_, z_, z_};
            for (int i = tid; i < 32 * 1024 / 4; i += 512) ((u32x4*)hist)[i] = z4; }
        for (int T = 0; T < ntile; ++T) {
            __syncthreads();
            *(u32x4*)(kt + srow * 144 + sch * 16) = *(const u32x4*)(Z + (rowbase + 64 * T + srow) * ZW + ZC_DKI + sch * 8);
            __syncthreads();
#pragma unroll
            for (int cg4 = 0; cg4 < 4; ++cg4) {
                const bf16x8 k0 = *(const bf16x8*)(kt + (16 * cg4 + c16) * 144 + (8 * g) * 2);
                const bf16x8 k1 = *(const bf16x8*)(kt + (16 * cg4 + c16) * 144 + (32 + 8 * g) * 2);
                f32x4 acc = {0.f, 0.f, 0.f, 0.f};
                acc = __builtin_amdgcn_mfma_f32_16x16x32_bf16(af[0], k0, acc, 0, 0, 0);
                acc = __builtin_amdgcn_mfma_f32_16x16x32_bf16(af[1], k1, acc, 0, 0, 0);
                const int key = 64 * T + 16 * cg4 + c16;
                const bool valid = key <= myt;
                const float sc = wv[0] * fmaxf(acc[0], 0.f) + wv[1] * fmaxf(acc[1], 0.f) + wv[2] * fmaxf(acc[2], 0.f) + wv[3] * fmaxf(acc[3], 0.f);
                const unsigned u = score_key(sc);
                if (pass == 0) { if (valid) { const unsigned bin = u >> 21; atomicAdd(myhist + (bin >> 1), (bin & 1u) ? 65536u : 1u); } }
                else if (pass == 1) { if (valid && (u >> 21) == b1) { const unsigned bin = (u >> 10) & 0x7ffu; atomicAdd(myhist + (bin >> 1), (bin & 1u) ? 65536u : 1u); } }
                else {
                    const unsigned p22 = u >> 10;
                    const bool tie = valid && (p22 == thr22);
                    const unsigned long long tb = __ballot(tie);
                    const unsigned tmask = (unsigned)(tb >> (16 * g)) & 0xffffu;
                    const bool acc_tie = tie && (tiecount + __popc(tmask & ((1u << c16) - 1u)) < quota);
                    tiecount += __popc(tmask);
                    const bool sel = (valid && p22 > thr22) || acc_tie;
                    const unsigned long long sb = __ballot(sel);
                    const unsigned smask = (unsigned)(sb >> (16 * g)) & 0xffffu;
                    if (sel) myidx[outcount + __popc(smask & ((1u << c16) - 1u))] = (unsigned short)key;
                    outcount += __popc(smask);
                }
            }
        }
        __syncthreads();
        if (pass == 0) {
#pragma unroll
            for (int qq = 0; qq < 4; ++qq) { const unsigned nd = shu(need, 16 * qq); unsigned bn, ab; hist_find(hist + (size_t)(4 * wid + qq) * 1024, lane, nd, bn, ab); if (g == qq) { b1 = bn; above1 = ab; } }
            __syncthreads();
        } else if (pass == 1) {
#pragma unroll
            for (int qq = 0; qq < 4; ++qq) { const unsigned nd = shu(need - above1, 16 * qq); unsigned bn, ab; hist_find(hist + (size_t)(4 * wid + qq) * 1024, lane, nd, bn, ab); if (g == qq) { thr22 = (b1 << 11) | bn; quota = need - above1 - ab; } }
            __syncthreads();
        }
    }
}


#ifndef SELREP
#define SELREP 0
#endif
constexpr int DS_CAP = 576, DS_RANK = 104;
constexpr unsigned ZCLASS = 0x80000000u >> 10;
__device__ __forceinline__ unsigned below_me(unsigned long long bal) { return __builtin_amdgcn_mbcnt_hi((unsigned)(bal >> 32), __builtin_amdgcn_mbcnt_lo((unsigned)bal, 0u)); }
__device__ __forceinline__ float relu1(float x) { return __builtin_amdgcn_fmed3f(x, 0.0f, 3.0e38f); }
__device__ __forceinline__ float idx_score_acc(const f32x4& acc, const f32x4& wv) {
    return fmaf(wv[3], relu1(acc[3]), fmaf(wv[2], relu1(acc[2]), fmaf(wv[1], relu1(acc[1]), wv[0] * relu1(acc[0])))) + 0.0f;
}
__device__ __forceinline__ unsigned fkey(float s) { const unsigned u = __float_as_uint(s); return (u & 0x80000000u) ? ~u : (u | 0x80000000u); }
__device__ __forceinline__ float key_to_float(unsigned k) { return k == 0u ? -INFINITY : __uint_as_float((k & 0x80000000u) ? (k & 0x7fffffffu) : ~k); }
__device__ __forceinline__ void idx_scores8(const unsigned char* kt, int c16, int g, const bf16x8 (&af)[2], const f32x4& wv, float (&u)[8]) {
    bf16x8 kf[8][2];
#pragma unroll
    for (int grp = 0; grp < 8; ++grp) { kf[grp][0] = *(const bf16x8*)(kt + (16 * grp + c16) * 144 + (8 * g) * 2); kf[grp][1] = *(const bf16x8*)(kt + (16 * grp + c16) * 144 + (32 + 8 * g) * 2); }
    __builtin_amdgcn_sched_barrier(0);
    f32x4 acc[8];
#pragma unroll
    for (int grp = 0; grp < 8; ++grp) acc[grp] = __builtin_amdgcn_mfma_f32_16x16x32_bf16(af[0], kf[grp][0], (f32x4){0.f, 0.f, 0.f, 0.f}, 0, 0, 0);
#pragma unroll
    for (int grp = 0; grp < 8; ++grp) acc[grp] = __builtin_amdgcn_mfma_f32_16x16x32_bf16(af[1], kf[grp][1], acc[grp], 0, 0, 0);
    __builtin_amdgcn_sched_barrier(0);
#pragma unroll
    for (int grp = 0; grp < 8; ++grp) u[grp] = idx_score_acc(acc[grp], wv);
}
__device__ __forceinline__ unsigned row_scan_incl(unsigned x) {
    x += (unsigned)__builtin_amdgcn_update_dpp(0, (int)x, 0x111, 0xF, 0xF, true);
    x += (unsigned)__builtin_amdgcn_update_dpp(0, (int)x, 0x112, 0xF, 0xF, true);
    x += (unsigned)__builtin_amdgcn_update_dpp(0, (int)x, 0x114, 0xF, 0xF, true);
    x += (unsigned)__builtin_amdgcn_update_dpp(0, (int)x, 0x118, 0xF, 0xF, true);
    return x;
}
__device__ __forceinline__ unsigned wave_total(unsigned x) {
    x = row_scan_incl(x);
    return (unsigned)__builtin_amdgcn_readlane((int)x, 15) + (unsigned)__builtin_amdgcn_readlane((int)x, 31) + (unsigned)__builtin_amdgcn_readlane((int)x, 47) + (unsigned)__builtin_amdgcn_readlane((int)x, 63);
}
__device__ __forceinline__ unsigned wave_max_u(unsigned x) {
    unsigned y;
    y = (unsigned)__builtin_amdgcn_update_dpp(0, (int)x, 0x111, 0xF, 0xF, true); x = x > y ? x : y;
    y = (unsigned)__builtin_amdgcn_update_dpp(0, (int)x, 0x112, 0xF, 0xF, true); x = x > y ? x : y;
    y = (unsigned)__builtin_amdgcn_update_dpp(0, (int)x, 0x114, 0xF, 0xF, true); x = x > y ? x : y;
    y = (unsigned)__builtin_amdgcn_update_dpp(0, (int)x, 0x118, 0xF, 0xF, true); x = x > y ? x : y;
    const unsigned a = (unsigned)__builtin_amdgcn_readlane((int)x, 15), b = (unsigned)__builtin_amdgcn_readlane((int)x, 31), c = (unsigned)__builtin_amdgcn_readlane((int)x, 47), d = (unsigned)__builtin_amdgcn_readlane((int)x, 63);
    const unsigned ab = a > b ? a : b, cd = c > d ? c : d; return ab > cd ? ab : cd;
}
template <bool EDGE, bool NEEDZ>
__device__ __forceinline__ void selB_groups(const float (&sc)[8], int keybase, int myt, float tauf, unsigned need, int lane, int c16, int g, unsigned& cnt, unsigned& zc, unsigned* curow, unsigned char* chrow, unsigned short* zlrow) {
    unsigned hm = 0u;
#pragma unroll
    for (int grp = 0; grp < 8; ++grp) {
        const float s = sc[grp];
        bool h = NEEDZ ? ((s >= tauf) && (s != 0.0f)) : (s >= tauf);
        if (EDGE) h = h && (keybase + 16 * grp + c16 <= myt);
        hm |= h ? (1u << grp) : 0u;
    }
    const unsigned nh = (unsigned)__popc(hm), inc = row_scan_incl(nh);
    unsigned pos = cnt + inc - nh;
    cnt += shu(inc, (lane & 48) | 15);
    unsigned rem = hm;
    while (__ballot(rem != 0u)) {
        if (rem) {
            const int grp = __builtin_ctz(rem); rem &= rem - 1u;
            const float a0 = (grp & 1) ? sc[1] : sc[0], a1 = (grp & 1) ? sc[3] : sc[2], a2 = (grp & 1) ? sc[5] : sc[4], a3 = (grp & 1) ? sc[7] : sc[6];
            const float b0 = (grp & 2) ? a1 : a0, b1 = (grp & 2) ? a3 : a2, s = (grp & 4) ? b1 : b0;
            const int key = keybase + 16 * grp + c16;
            if (pos < (unsigned)DS_CAP) { curow[pos] = (fkey(s) & 0xfffffc00u) | ((unsigned)key & 1023u); chrow[pos] = (unsigned char)(key >> 10); }
            ++pos;
        }
    }
    if (NEEDZ) {
        const unsigned lowm = (1u << c16) - 1u;
#pragma unroll
        for (int grp = 0; grp < 8; ++grp) {
            const int key = keybase + 16 * grp + c16;
            bool isz = sc[grp] == 0.0f;
            if (EDGE) isz = isz && (key <= myt);
            const unsigned zmask = (unsigned)(__ballot(isz) >> (16 * g)) & 0xffffu;
            const unsigned zpos = zc + __popc(zmask & lowm);
            if (isz && zpos < need) zlrow[zpos] = (unsigned short)key;
            zc += __popc(zmask);
        }
    }
}
__device__ __forceinline__ void dsa_select_item(const Args& a, unsigned char* lds, int b, int qb32, int wid_s) {
    const int tid = ftid(wid_s), lane = tid & 63; const int wid = __builtin_amdgcn_readfirstlane(tid >> 6);
    const int c16 = lane & 15, g = lane >> 4;
    const bf16_t* Z = (const bf16_t*)(a.ws + WS_Z); const float* SM = (const float*)(a.ws + WS_SMALL);
    unsigned short* IDX = (unsigned short*)(a.ws + WS_MG);
    unsigned short* samp = (unsigned short*)lds;
    unsigned char* ktA = lds + 131072;
    unsigned* cu = (unsigned*)lds;
    unsigned char* ch = lds + 73728;
    unsigned short* zl = (unsigned short*)(lds + 92160);
    unsigned char* ktB = lds + 108544;
    unsigned* flag = (unsigned*)(lds + 149760);
    const size_t rowbase = (size_t)b * SEQ;
    const int t0 = qb32 * 32, myt = t0 + 4 * wid + g, myrow = 4 * wid + g;
    bf16x8 af[2];
    { const int qq = c16 >> 2, h = c16 & 3; const bf16_t* qp = Z + (rowbase + t0 + 4 * wid + qq) * ZW + ZC_DQI + h * 64 + 8 * g;
      af[0] = *(const bf16x8*)qp; af[1] = *(const bf16x8*)(qp + 32); }
#ifdef PROBE_QTRUNC
    { u32x4 t0_ = __builtin_bit_cast(u32x4, af[0]), t1_ = __builtin_bit_cast(u32x4, af[1]); const unsigned mk = 0xfffcfffcu;
      t0_.x &= mk; t0_.y &= mk; t0_.z &= mk; t0_.w &= mk; t1_.x &= mk; t1_.y &= mk; t1_.z &= mk; t1_.w &= mk; af[0] = __builtin_bit_cast(bf16x8, t0_); af[1] = __builtin_bit_cast(bf16x8, t1_); }
#endif
    const f32x4 wv = *(const f32x4*)(SM + (rowbase + myt) * 8);
    const unsigned need = (unsigned)((myt + 1) < 256 ? (myt + 1) : 256);
    const int srow = tid >> 3, sch = tid & 7;
    __syncthreads();
    if (tid == 0) *flag = 0u;
    unsigned tau = 0u;
    for (int repA_ = 0; repA_ < ((SELREP & 1) ? 2 : 1); ++repA_)
    if (t0 + 32 > DS_CAP) {
        __syncthreads();
        const int ms = (t0 + 32) >> 2, ntA = (ms + 127) >> 7;
        const bf16_t* sbase = Z + (rowbase + 3) * ZW + ZC_DKI + sch * 8;
        u32x4 n0, n1;
        { const int i0 = srow < ms ? srow : ms - 1, i1 = 64 + srow < ms ? 64 + srow : ms - 1;
          n0 = *(const u32x4*)(sbase + (size_t)(4 * i0) * ZW); n1 = *(const u32x4*)(sbase + (size_t)(4 * i1) * ZW); }
        for (int T = 0; T < ntA; ++T) {
            __syncthreads();
            *(u32x4*)(ktA + srow * 144 + sch * 16) = n0; *(u32x4*)(ktA + (64 + srow) * 144 + sch * 16) = n1;
            __syncthreads();
            if (T + 1 < ntA) { const int j0 = 128 * (T + 1) + srow, j1 = j0 + 64; const int i0 = j0 < ms ? j0 : ms - 1, i1 = j1 < ms ? j1 : ms - 1;
                n0 = *(const u32x4*)(sbase + (size_t)(4 * i0) * ZW); n1 = *(const u32x4*)(sbase + (size_t)(4 * i1) * ZW); }
            float ua[8]; idx_scores8(ktA, c16, g, af, wv, ua);
#pragma unroll
            for (int grp = 0; grp < 8; ++grp) {
                const int i = 128 * T + 16 * grp + c16;
                samp[myrow * 2048 + i] = ((i < ms) && (4 * i + 3 <= myt)) ? (unsigned short)(fkey(ua[grp]) >> 16) : (unsigned short)0;
            }
        }
        LDSWAIT();
        const int nvalid = 128 * ntA;
        for (int repS_ = 0; repS_ < ((SELREP & 16) ? 2 : 1); ++repS_) {
            unsigned w[4][16];
#pragma unroll
            for (int qq = 0; qq < 4; ++qq) {
                const unsigned* sp = (const unsigned*)(samp + (4 * wid + qq) * 2048) + 16 * lane;
#pragma unroll
                for (int j = 0; j < 16; j += 4) { const u32x4 t4 = *(const u32x4*)(sp + j); w[qq][j] = t4.x; w[qq][j + 1] = t4.y; w[qq][j + 2] = t4.z; w[qq][j + 3] = t4.w; }
#pragma unroll
                for (int j = 0; j < 16; ++j) if (32 * lane + 2 * j >= nvalid) w[qq][j] = 0u;
            }
            unsigned T4[4] = {0u, 0u, 0u, 0u};
#pragma unroll 1
            for (int bit = 15; bit >= 0; --bit) {
                unsigned c[4];
#pragma unroll
                for (int qq = 0; qq < 4; ++qq) { const unsigned cand = T4[qq] | (1u << bit); unsigned cc = 0;
#pragma unroll
                    for (int j = 0; j < 16; ++j) cc += ((w[qq][j] & 0xffffu) >= cand ? 1u : 0u) + ((w[qq][j] >> 16) >= cand ? 1u : 0u);
                    c[qq] = cc; }
                const unsigned t01 = wave_total(c[0] | (c[1] << 16)), t23 = wave_total(c[2] | (c[3] << 16));
                if ((t01 & 0xffffu) >= (unsigned)DS_RANK) T4[0] |= 1u << bit;
                if ((t01 >> 16) >= (unsigned)DS_RANK) T4[1] |= 1u << bit;
                if ((t23 & 0xffffu) >= (unsigned)DS_RANK) T4[2] |= 1u << bit;
                if ((t23 >> 16) >= (unsigned)DS_RANK) T4[3] |= 1u << bit;
            }
#pragma unroll
            for (int qq = 0; qq < 4; ++qq) { const int n = t0 + 4 * wid + qq + 1; if (g == qq) tau = n > DS_CAP ? (T4[qq] << 16) : 0u; }
        }
    }
    unsigned cnt = 0u, zc = 0u;
    const float tauf = key_to_float(tau);
    const bool needz = __ballot(tauf <= 0.0f) != 0ull;
    const int ntile = (t0 + 32 + 127) >> 7;
    for (int repB_ = 0; repB_ < ((SELREP & 2) ? 2 : 1); ++repB_) { cnt = 0u; zc = 0u;
        const bf16_t* kbase = Z + (rowbase + srow) * ZW + ZC_DKI + sch * 8;
        u32x4 n0 = *(const u32x4*)kbase, n1 = *(const u32x4*)(kbase + (size_t)64 * ZW);
        __syncthreads();
        *(u32x4*)(ktB + srow * 144 + sch * 16) = n0; *(u32x4*)(ktB + (64 + srow) * 144 + sch * 16) = n1;
        __syncthreads();
        for (int T = 0; T < ntile; ++T) {
            const unsigned char* kt = ktB + (T & 1) * 18432;
            if (T + 1 < ntile) { const bf16_t* src = kbase + (size_t)(128 * (T + 1)) * ZW; n0 = *(const u32x4*)src; n1 = *(const u32x4*)(src + (size_t)64 * ZW); }
            float ub[8]; idx_scores8(kt, c16, g, af, wv, ub);
            if (128 * T + 127 <= t0) { if (needz) selB_groups<false, true>(ub, 128 * T, myt, tauf, need, lane, c16, g, cnt, zc, cu + myrow * DS_CAP, ch + myrow * DS_CAP, zl + myrow * 256);
                                       else selB_groups<false, false>(ub, 128 * T, myt, tauf, need, lane, c16, g, cnt, zc, cu + myrow * DS_CAP, ch + myrow * DS_CAP, zl + myrow * 256); }
            else { if (needz) selB_groups<true, true>(ub, 128 * T, myt, tauf, need, lane, c16, g, cnt, zc, cu + myrow * DS_CAP, ch + myrow * DS_CAP, zl + myrow * 256);
                   else selB_groups<true, false>(ub, 128 * T, myt, tauf, need, lane, c16, g, cnt, zc, cu + myrow * DS_CAP, ch + myrow * DS_CAP, zl + myrow * 256); }
            if (T + 1 < ntile) { unsigned char* kn = ktB + ((T + 1) & 1) * 18432; *(u32x4*)(kn + srow * 144 + sch * 16) = n0; *(u32x4*)(kn + (64 + srow) * 144 + sch * 16) = n1; }
            __syncthreads();
        }
    }
#if SELREP & 8
    {
        float dummy = 0.f;
        const bf16_t* kbase = Z + (rowbase + srow) * ZW + ZC_DKI + sch * 8;
        u32x4 n0 = *(const u32x4*)kbase, n1 = *(const u32x4*)(kbase + (size_t)64 * ZW);
        __syncthreads();
        *(u32x4*)(ktB + srow * 144 + sch * 16) = n0; *(u32x4*)(ktB + (64 + srow) * 144 + sch * 16) = n1;
        __syncthreads();
        for (int T = 0; T < ntile; ++T) {
            const unsigned char* kt = ktB + (T & 1) * 18432;
            if (T + 1 < ntile) { const bf16_t* src = kbase + (size_t)(128 * (T + 1)) * ZW; n0 = *(const u32x4*)src; n1 = *(const u32x4*)(src + (size_t)64 * ZW); }
            float ub[8]; idx_scores8(kt, c16, g, af, wv, ub);
#pragma unroll
            for (int grp = 0; grp < 8; ++grp) dummy += ub[grp];
            if (T + 1 < ntile) { unsigned char* kn = ktB + ((T + 1) & 1) * 18432; *(u32x4*)(kn + srow * 144 + sch * 16) = n0; *(u32x4*)(kn + (64 + srow) * 144 + sch * 16) = n1; }
            __syncthreads();
        }
        if (dummy == 123456.789f) *flag = 2u;
    }
#endif
    LDSWAIT();
    bool bad = false;
    for (int repC_ = 0; repC_ < ((SELREP & 4) ? 2 : 1); ++repC_) {
        unsigned ncq[4], ndq[4], nzq[4], uj[4][9], T4[4]; int topb[4];
#pragma unroll
        for (int qq = 0; qq < 4; ++qq) {
            ncq[qq] = (unsigned)__builtin_amdgcn_readlane((int)cnt, 16 * qq); ndq[qq] = (unsigned)__builtin_amdgcn_readlane((int)need, 16 * qq); nzq[qq] = (unsigned)__builtin_amdgcn_readlane((int)zc, 16 * qq);
            const unsigned ncl = ncq[qq] < (unsigned)DS_CAP ? ncq[qq] : (unsigned)DS_CAP;
            unsigned hi = 0u, lo = 0u;
#pragma unroll
            for (int j = 0; j < 9; ++j) { const unsigned pos = lane + 64 * j; const bool in = pos < ncl; uj[qq][j] = in ? (cu[(4 * wid + qq) * DS_CAP + pos] >> 10) : 0u;
                hi = hi > uj[qq][j] ? hi : uj[qq][j]; const unsigned x = in ? ~uj[qq][j] : 0u; lo = lo > x ? lo : x; }
            hi = wave_max_u(hi); lo = ~wave_max_u(lo);
            if (ncl == 0u) lo = hi;
            if (nzq[qq]) { hi = hi > ZCLASS ? hi : ZCLASS; lo = lo < ZCLASS ? lo : ZCLASS; }
            topb[qq] = (hi ^ lo) ? 31 - __builtin_clz(hi ^ lo) : -1;
            T4[qq] = topb[qq] >= 0 ? (hi & ~((2u << topb[qq]) - 1u)) : hi;
        }
#pragma unroll 1
        for (int bit = 21; bit >= 0; --bit) {
            unsigned c[4];
#pragma unroll
            for (int qq = 0; qq < 4; ++qq) { const unsigned cand = T4[qq] | (1u << bit); unsigned cc = 0;
#pragma unroll
                for (int j = 0; j < 9; ++j) cc += uj[qq][j] >= cand ? 1u : 0u;
                c[qq] = cc; }
            const unsigned t01 = wave_total(c[0] | (c[1] << 16)), t23 = wave_total(c[2] | (c[3] << 16));
            const unsigned tq[4] = {t01 & 0xffffu, t01 >> 16, t23 & 0xffffu, t23 >> 16};
#pragma unroll
            for (int qq = 0; qq < 4; ++qq) { const unsigned cand = T4[qq] | (1u << bit);
                if (bit <= topb[qq] && tq[qq] + (cand <= ZCLASS ? nzq[qq] : 0u) >= ndq[qq]) T4[qq] = cand; }
        }
#pragma unroll 1
        for (int qq = 0; qq < 4; ++qq) {
            const unsigned nc = ncq[qq], nd = ndq[qq], nz = nzq[qq], T = T4[qq];
            if (nc + nz < nd || nc > (unsigned)DS_CAP) { bad = true;
#ifdef NOFALLBACK
                { unsigned short* orow = IDX + (rowbase + t0 + 4 * wid + qq) * 256;
                  for (int j = 0; j < 4; ++j) if ((unsigned)(lane + 64 * j) < nd) orow[lane + 64 * j] = (unsigned short)(lane + 64 * j); }
#endif
                continue; }
            const int row = 4 * wid + qq;
            unsigned ujr[9], kj[9]; int ca = T < ZCLASS ? (int)nz : 0, nt = 0;
#pragma unroll
            for (int j = 0; j < 9; ++j) { const unsigned pos = lane + 64 * j; const unsigned cwj = pos < nc ? cu[row * DS_CAP + pos] : 0u; ujr[j] = cwj >> 10;
                kj[j] = pos < nc ? ((cwj & 1023u) | ((unsigned)ch[row * DS_CAP + pos] << 10)) : 0u;
                ca += __popcll(__ballot(ujr[j] > T)); nt += __popcll(__ballot(ujr[j] == T)); }
            const unsigned quota = nd - (unsigned)ca;
            unsigned Kstar = 0xffffu;
            if (T != ZCLASS && (unsigned)nt > quota) {
                unsigned K = 0u;
#pragma unroll 1
                for (int bit = 12; bit >= 0; --bit) { const unsigned test = K | (1u << bit); int c = 0;
#pragma unroll
                    for (int j = 0; j < 9; ++j) c += __popcll(__ballot(ujr[j] == T && kj[j] < test));
                    if ((unsigned)c < quota) K = test; }
                Kstar = K;
            }
            unsigned outbase = 0u;
            unsigned short* orow = IDX + (rowbase + t0 + row) * 256;
#pragma unroll
            for (int j = 0; j < 9; ++j) {
                const bool s = (ujr[j] > T) || (ujr[j] == T && kj[j] <= Kstar);
                const unsigned long long sb = __ballot(s);
                if (s) orow[outbase + below_me(sb)] = (unsigned short)kj[j];
                outbase += (unsigned)__popcll(sb);
            }
            const unsigned zsel = T < ZCLASS ? nz : (T == ZCLASS ? quota : 0u);
            for (unsigned i = lane; i < zsel; i += 64) orow[outbase + i] = zl[row * 256 + i];
        }
    }
    if (bad && lane == 0) atomicOr(flag, 1u);
    __syncthreads();
    const bool redo = *flag != 0u;
    __syncthreads();
#ifndef NOFALLBACK
    if (redo) dsa_select_slow(a, lds, b, qb32, wid_s);
#endif
}

constexpr int DA_WAVE_LDS = 512 + 64 * 160;
__device__ __forceinline__ void dsa_attend_wave(const Args& a, int gw, int NGW, int lane, unsigned char* wl) {
    const bf16_t* Z = (const bf16_t*)(a.ws + WS_Z); const unsigned short* IDXB = (const unsigned short*)(a.ws + WS_MG);
    bf16_t* Y1 = (bf16_t*)(a.ws + WS_H) + (size_t)MROWS * 256;
    const int c16 = lane & 15, g = lane >> 4, vr = lane >> 3, vc = lane & 7;
    unsigned short* il = (unsigned short*)wl; unsigned char* vl = wl + 512;
    const float slope2 = LOG2E * __builtin_amdgcn_exp2f(-(float)(5 + (c16 & 3)));
    const LAS unsigned char* vtr = (const LAS unsigned char*)vl + (4 * g + (c16 >> 2)) * 160 + (4 * (c16 & 3)) * 2;
    u32x2 iw = {0u, 0u};
    if (gw < MROWS) iw = *(const u32x2*)(IDXB + (size_t)gw * 256 + 4 * lane);
#pragma unroll 1
    for (int row = gw; row < MROWS; row += NGW) {
        const int t = row & (SEQ - 1); const size_t rowbase = (size_t)(row - t);
        const int nsel = (t + 1) < 256 ? (t + 1) : 256;
        { u32x2 w = iw; const int p0 = 4 * lane;
          if (p0 >= nsel) w.x &= 0xffff0000u; if (p0 + 1 >= nsel) w.x &= 0x0000ffffu; if (p0 + 2 >= nsel) w.y &= 0xffff0000u; if (p0 + 3 >= nsel) w.y &= 0x0000ffffu;
          *(u32x2*)(il + 4 * lane) = w; }
        if (row + NGW < MROWS) iw = *(const u32x2*)(IDXB + (size_t)(row + NGW) * 256 + 4 * lane);
        LDSWAIT();
        u32x4 v[8];
        const bf16_t* vb = Z + rowbase * ZW + ZC_DV + 8 * vc;
        const bf16_t* kb8 = Z + rowbase * ZW + ZC_DK + 8 * vc;
#pragma unroll
        for (int i = 0; i < 8; ++i) v[i] = *(const u32x4*)(kb8 + (size_t)il[8 * i + vr] * ZW);
        bf16x8 qf[2];
        { const bf16_t* qp = Z + (size_t)row * ZW + ZC_DQ + (c16 & 3) * 64 + 8 * g; const bf16x8 z8 = {0, 0, 0, 0, 0, 0, 0, 0};
          qf[0] = c16 < 4 ? *(const bf16x8*)qp : z8; qf[1] = c16 < 4 ? *(const bf16x8*)(qp + 32) : z8; }
        f32x4 s[16];
#pragma unroll
        for (int ch = 0; ch < 4; ++ch) {
            if (64 * ch < nsel) {
#pragma unroll
                for (int i = 0; i < 8; ++i) *(u32x4*)(vl + (8 * i + vr) * 144 + 16 * vc) = v[i];
                if (ch < 3 && 64 * (ch + 1) < nsel) {
#pragma unroll
                    for (int i = 0; i < 8; ++i) v[i] = *(const u32x4*)(kb8 + (size_t)il[64 * (ch + 1) + 8 * i + vr] * ZW);
                } else {
#pragma unroll
                    for (int i = 0; i < 8; ++i) v[i] = *(const u32x4*)(vb + (size_t)il[8 * i + vr] * ZW);
                }
                LDSWAIT();
#pragma unroll
                for (int tt = 0; tt < 4; ++tt) {
                    const bf16x8 k0 = *(const bf16x8*)(vl + (16 * tt + c16) * 144 + (8 * g) * 2), k1 = *(const bf16x8*)(vl + (16 * tt + c16) * 144 + (32 + 8 * g) * 2);
                    f32x4 acc = {0.f, 0.f, 0.f, 0.f};
                    acc = __builtin_amdgcn_mfma_f32_16x16x32_bf16(k0, qf[0], acc, 0, 0, 0);
                    acc = __builtin_amdgcn_mfma_f32_16x16x32_bf16(k1, qf[1], acc, 0, 0, 0);
                    s[4 * ch + tt] = acc; }
                asm volatile("" ::: "memory");
            } else {
#pragma unroll
                for (int tt = 0; tt < 4; ++tt) s[4 * ch + tt] = (f32x4){0.f, 0.f, 0.f, 0.f};
            }
        }
        float mx = -INFINITY;
#pragma unroll
        for (int kb = 0; kb < 16; ++kb) {
            const u32x2 kw = *(const u32x2*)(il + 16 * kb + 4 * g); const int p0 = 16 * kb + 4 * g;
            const int k0 = kw.x & 0xffff, k1 = kw.x >> 16, k2 = kw.y & 0xffff, k3 = kw.y >> 16;
            s[kb][0] = p0 < nsel ? s[kb][0] * C2 - slope2 * (float)(t - k0) : -INFINITY;
            s[kb][1] = p0 + 1 < nsel ? s[kb][1] * C2 - slope2 * (float)(t - k1) : -INFINITY;
            s[kb][2] = p0 + 2 < nsel ? s[kb][2] * C2 - slope2 * (float)(t - k2) : -INFINITY;
            s[kb][3] = p0 + 3 < nsel ? s[kb][3] * C2 - slope2 * (float)(t - k3) : -INFINITY;
            mx = fmaxf(fmaxf(mx, fmaxf(s[kb][0], s[kb][1])), fmaxf(s[kb][2], s[kb][3]));
        }
        mx = fmaxf(mx, shf(mx, lane ^ 16)); mx = fmaxf(mx, shf(mx, lane ^ 32));
        float ls = 0.f;
#pragma unroll
        for (int kb = 0; kb < 16; ++kb) {
#pragma unroll
            for (int r = 0; r < 4; ++r) { s[kb][r] = __builtin_amdgcn_exp2f(s[kb][r] - mx); ls += s[kb][r]; } }
        ls += shf(ls, lane ^ 16); ls += shf(ls, lane ^ 32);
        f32x4 o[4];
#pragma unroll
        for (int db = 0; db < 4; ++db) o[db] = (f32x4){0.f, 0.f, 0.f, 0.f};
#pragma unroll
        for (int ch = 0; ch < 4; ++ch) {
            if (64 * ch < nsel) {
#pragma unroll
                for (int i = 0; i < 8; ++i) *(u32x4*)(vl + (8 * i + vr) * 160 + 16 * vc) = v[i];
                if (ch < 3 && 64 * (ch + 1) < nsel) {
#pragma unroll
                    for (int i = 0; i < 8; ++i) v[i] = *(const u32x4*)(vb + (size_t)il[64 * (ch + 1) + 8 * i + vr] * ZW);
                }
                LDSWAIT();
#pragma unroll
                for (int s2 = 0; s2 < 2; ++s2) {
                    const f32x4 pa4 = s[4 * ch + 2 * s2], pb4 = s[4 * ch + 2 * s2 + 1];
                    u32x4 pw; pw.x = pk2(pa4[0], pa4[1]); pw.y = pk2(pa4[2], pa4[3]); pw.z = pk2(pb4[0], pb4[1]); pw.w = pk2(pb4[2], pb4[3]);
                    const bf16x8 pa = __builtin_bit_cast(bf16x8, pw);
#pragma unroll
                    for (int db = 0; db < 4; ++db) {
                        const LAS unsigned char* vp = vtr + (32 * s2) * 160 + 32 * db;
                        const s16x4 lo = __builtin_bit_cast(s16x4, __builtin_amdgcn_ds_read_tr16_b64_v4i16((LAS s16x4*)vp));
                        const s16x4 hv = __builtin_bit_cast(s16x4, __builtin_amdgcn_ds_read_tr16_b64_v4i16((LAS s16x4*)(vp + 16 * 160)));
                        const bf16x8 vf = (bf16x8){lo[0], lo[1], lo[2], lo[3], hv[0], hv[1], hv[2], hv[3]};
                        o[db] = __builtin_amdgcn_mfma_f32_16x16x32_bf16(pa, vf, o[db], 0, 0, 0);
                    }
                }
                asm volatile("" ::: "memory");
            }
        }
        const int lsi = __float_as_int(ls);
        const float i0 = 1.0f / __int_as_float(__builtin_amdgcn_readlane(lsi, 0)), i1 = 1.0f / __int_as_float(__builtin_amdgcn_readlane(lsi, 1)), i2 = 1.0f / __int_as_float(__builtin_amdgcn_readlane(lsi, 2)), i3 = 1.0f / __int_as_float(__builtin_amdgcn_readlane(lsi, 3));
        if (g == 0) { bf16_t* yp = Y1 + (size_t)row * 256 + c16;
#pragma unroll
            for (int db = 0; db < 4; ++db) { yp[0 * 64 + 16 * db] = (bf16_t)f2bf(o[db][0] * i0); yp[1 * 64 + 16 * db] = (bf16_t)f2bf(o[db][1] * i1); yp[2 * 64 + 16 * db] = (bf16_t)f2bf(o[db][2] * i2); yp[3 * 64 + 16 * db] = (bf16_t)f2bf(o[db][3] * i3); } }
        LDSWAIT();
    }
}


#ifndef PHMASK
#define PHMASK 0xffff
#endif
#ifndef DUPMASK
#define DUPMASK 0
#endif
#ifndef DUPN
#define DUPN 2
#endif
#ifndef MERGE_SP2
#define MERGE_SP2 true
#endif
#ifndef G8_SP2
#define G8_SP2 false
#endif
#ifndef EXTRASYNC
#define EXTRASYNC 0
#endif
typedef __attribute__((address_space(1))) unsigned gu32;
#define XB_TMO      128
#define XB_XCNT(j)  (256  + 64 * (j))
#define XB_XSUB(j)  (1280 + 64 * (j))
#define XB_XGEN(j)  (2304 + 64 * (j))
#define XB_TOP      3328
#define XB_TOPGEN   3392
#define XCD_BAR_WORDS 3456
#define XB_SPIN_CAP (1u << 18)

__device__ __forceinline__ unsigned xb_ld(unsigned* p)              { return __hip_atomic_load(p, __ATOMIC_RELAXED, __HIP_MEMORY_SCOPE_AGENT); }
__device__ __forceinline__ unsigned xb_add(unsigned* p, unsigned v) { return __hip_atomic_fetch_add(p, v, __ATOMIC_RELAXED, __HIP_MEMORY_SCOPE_AGENT); }
__device__ __forceinline__ unsigned xb_xcc_id() { return (unsigned)__builtin_amdgcn_s_getreg((3 << 11) | 20) & 0xFu; }
#define XB_SPIN(cond, bar) do { unsigned _sp = 0; while (cond) { __builtin_amdgcn_s_sleep(1); \
    if ((++_sp & 255u) == 0u) { if (xb_ld(&(bar)[XB_TMO])) break; if (_sp > XB_SPIN_CAP) { atomicAdd(&(bar)[XB_TMO], 1u); break; } } } } while (0)

struct XcdBarrier {
    unsigned* bar; unsigned x; int w;
    volatile LAS unsigned* st;
};

__device__ __forceinline__ bool xb_first_lane(int w) { unsigned ones = ~0u; asm volatile("" : "+s"(ones)); return w == 0 && __builtin_amdgcn_mbcnt_hi(ones, __builtin_amdgcn_mbcnt_lo(ones, 0u)) == 0u; }
__device__ __forceinline__ XcdBarrier xcd_barrier_post(unsigned* bar, volatile LAS unsigned* st, int w) {
    XcdBarrier b; b.bar = bar; b.x = xb_xcc_id(); b.st = st; b.w = w;
    if (xb_first_lane(w)) (void)xb_add(&bar[XB_XCNT(b.x)], 1u);
    return b;
}
__device__ __forceinline__ void xcd_barrier_complete(unsigned* bar, unsigned x, unsigned& nloc, unsigned& nx) {
    const unsigned G = gridDim.x * gridDim.y * gridDim.z;
    unsigned sum, cnt, mine, sp = 0u;
    for (;;) {
        sum = 0u; cnt = 0u; mine = 0u;
#pragma unroll
        for (unsigned j = 0; j < 16; ++j) { const unsigned c = xb_ld(&bar[XB_XCNT(j)]); sum += c; cnt += (c > 0u) ? 1u : 0u; mine = (j == x) ? c : mine; }
        if (sum == G) break;
        __builtin_amdgcn_s_sleep(1);
        if ((++sp & 255u) == 0u) { if (xb_ld(&bar[XB_TMO])) break; if (sp > XB_SPIN_CAP) { atomicAdd(&bar[XB_TMO], 1u); break; } }
    }
    nloc = mine > 0u ? mine : 1u; nx = cnt > 0u ? cnt : 1u;
}

__device__ __forceinline__ void xcd_barrier(const XcdBarrier& b) {
    asm volatile("s_waitcnt vmcnt(0)" ::: "memory");
    __syncthreads();
    if (xb_first_lane(b.w)) {
        unsigned* bar = b.bar;
        __builtin_amdgcn_s_waitcnt(0);
        unsigned nloc = b.st[0], nx = b.st[1];
        if (nloc == 0u) { xcd_barrier_complete(bar, b.x, nloc, nx); b.st[0] = nloc; b.st[1] = nx; }
        const unsigned old = xb_add(&bar[XB_XSUB(b.x)], 1u);
        const unsigned gen = old / nloc;
        if (old + 1u == (gen + 1u) * nloc) {
            __builtin_amdgcn_fence(__ATOMIC_RELEASE, "agent");
            asm volatile("s_waitcnt vmcnt(0)" ::: "memory");
            const unsigned og = xb_add(&bar[XB_TOP], 1u);
            const unsigned tg = og / nx;
            if (og + 1u == (tg + 1u) * nx) xb_add(&bar[XB_TOPGEN], 1u);
            else XB_SPIN(xb_ld(&bar[XB_TOPGEN]) == tg, bar);
            __builtin_amdgcn_fence(__ATOMIC_ACQUIRE, "agent");
            xb_add(&bar[XB_XGEN(b.x)], 1u);
            asm volatile("s_waitcnt vmcnt(0)" ::: "memory");
        } else {
            XB_SPIN(xb_ld(&bar[XB_XGEN(b.x)]) == gen, bar);
            __builtin_amdgcn_fence(__ATOMIC_ACQUIRE, "agent");
            asm volatile("s_waitcnt vmcnt(0)" ::: "memory");
        }
    }
    __syncthreads();
}

constexpr size_t WS_BAR = 16384;
constexpr int LDS_BARST = LDS_BYTES - 16;
#define GRID_SYNC() xcd_barrier(bar)
typedef const __attribute__((address_space(4))) Args* kargs_ptr;
__device__ __forceinline__ Args fresh_args() {
#if defined(__HIP_DEVICE_COMPILE__)
    kargs_ptr p = (kargs_ptr)__builtin_amdgcn_kernarg_segment_ptr(); asm volatile("" : "+s"(p)); return *p;
#else
    return Args{};
#endif
}
#define FRESH() const int tid = ftid(wid_s), lane = tid & 63, wid = __builtin_amdgcn_readfirstlane(tid >> 6), gw = blockIdx.x * 8 + wid, NGW = gridDim.x * 8; (void)lane; (void)gw; (void)NGW
#define WSP(T, off) ((T*)(a.ws + (off)))
__global__ void __launch_bounds__(512, 2) mega(Args a_unused) {
    extern __shared__ __attribute__((aligned(16))) unsigned char lds[];
    PG8_LAS unsigned char* lds3 = (PG8_LAS unsigned char*)lds;
    const int wid_s = __builtin_amdgcn_readfirstlane(threadIdx.x >> 6);
    if (threadIdx.x < 4) ((volatile LAS unsigned*)(lds3 + LDS_BARST))[threadIdx.x] = 0u;
    __syncthreads();
    XcdBarrier bar; { const Args a0 = fresh_args(); bar = xcd_barrier_post((unsigned*)(a0.ws + WS_BAR), (volatile LAS unsigned*)(lds3 + LDS_BARST), wid_s); }

#if PHMASK & 1
    for (int rep_ = 0; rep_ < ((DUPMASK & 1) ? DUPN : 1); ++rep_) { if (rep_) GRID_SYNC();
    { const Args a = fresh_args(); if (blockIdx.x == 0 && threadIdx.x < 16) WSP(unsigned, WS_KMAX)[threadIdx.x] = 0u; ada_gemv(a, lds, wid_s); convert_weights(a, 0, lds, wid_s); }
    }
#endif
    GRID_SYNC();
#if PHMASK & 2
    for (int rep_ = 0; rep_ < ((DUPMASK & 2) ? DUPN : 1); ++rep_) { if (rep_) GRID_SYNC();
    { const Args a = fresh_args(); FRESH();
      for (int row = gw * 8; row < MROWS; row += NGW * 8) { const int b = row >> 13; const float* md = WSP(float, WS_MOD) + (size_t)(0 * 2 + b) * NMOD;
        row_pass8<false, true, false, false, true>(a.x + (size_t)row * D, nullptr, nullptr, WSP(bf16_t, WS_H) + (size_t)row * D, WSP(unsigned char, WS_MG) + (size_t)row * D, nullptr, nullptr, a.norm_g + 0 * D, md + 1 * D, md + 0 * D, lane); } }
    }
#endif
    GRID_SYNC();

#pragma unroll 1
    for (int l = 0; l < DEPTH; ++l) {
        for (int es_ = 0; es_ < EXTRASYNC; ++es_) GRID_SYNC();
#if PHMASK & 4
    for (int rep_ = 0; rep_ < ((DUPMASK & 4) ? DUPN : 1); ++rep_) { if (rep_) GRID_SYNC();
        { const Args a = fresh_args(); const int G = gridDim.x, bid = blockIdx.x;
          { pg8::Gemm g{WSP(bf16_t, WS_MG), WSP(bf16_t, WS_WG8), MROWS, 4 * D, D}; pg8::StaticOrder S; S.init(MROWS, 4 * D, G, bid);
            pg8::EpiG E{WSP(unsigned char, WS_G)};
            pg8::gemm_phase<pg8::EpiG, pg8::StaticOrder, true, G8_SP2, true>(lds3, g, S, E, wid_s); }
          { pg8::Gemm g{WSP(bf16_t, WS_H), WSP(bf16_t, WS_W1T), MROWS, 2816, D}; pg8::StaticOrder S; S.init(MROWS, 2816, G, (bid + 64) % G);
            pg8::EpiZ E{WSP(bf16_t, WS_Z), WSP(float, WS_SMALL), WSP(unsigned char, WS_G)};
            pg8::gemm_phase<pg8::EpiZ, pg8::StaticOrder, true, true>(lds3, g, S, E, wid_s); } }
    }
#endif
        GRID_SYNC();
#if PHMASK & 8
    for (int rep_ = 0; rep_ < ((DUPMASK & 8) ? DUPN : 1); ++rep_) { if (rep_) GRID_SYNC();
        { const Args a = fresh_args(); const int G = gridDim.x, bid = blockIdx.x;
          if (bid < 8) fox_scan(a, l, bid, lds, wid_s);
          for (int it = bid - 8; it >= 0 && it < 64; it += G) fox_kmax_item(a, l, it, wid_s);
          conv_phase(a, l, wid_s);
          for (int u = bid; u < 256; u += G) { const int b = u >> 7, head = (u >> 5) & 3, qb = u & 31;
            const float slope2 = LOG2E * __builtin_amdgcn_exp2f(-(float)(1 + head)), sink2 = LOG2E * a.swa_sinks[l * 4 + head];
            const int q0 = qb * 256, tlo = q0 >= 128 ? ((q0 - 127) >> 6) : 0;
            attn_unit<1>(lds, WSP(bf16_t, WS_Z), WSP(bf16_t, WS_H) + (size_t)3 * MROWS * 256, b, head, qb, nullptr, slope2, sink2, tlo, 0.f, wid_s); } }
    }
#endif
        __syncthreads();
#if PHMASK & 16
    for (int rep_ = 0; rep_ < ((DUPMASK & 16) ? DUPN : 1); ++rep_) { if (rep_) GRID_SYNC();
        { const Args a = fresh_args(); const int G = gridDim.x, bid = blockIdx.x;
          for (int u = bid; u < 256; u += G) { const int b = u & 1, j = u >> 1;
            dsa_select_item(a, lds, b, j, wid_s); dsa_select_item(a, lds, b, 255 - j, wid_s); } }
    }
#endif
        GRID_SYNC();
#if PHMASK & 32
    for (int rep_ = 0; rep_ < ((DUPMASK & 32) ? DUPN : 1); ++rep_) { if (rep_) GRID_SYNC();
        { const Args a = fresh_args(); const int G = gridDim.x, bid = blockIdx.x;
          for (int u = bid; u < 256; u += G) { const int b = u >> 7, head = (u >> 5) & 3, qb = u & 31;
            attn_unit<0>(lds, WSP(bf16_t, WS_Z), WSP(bf16_t, WS_H) + (size_t)2 * MROWS * 256, b, head, qb, WSP(const float, WS_FCUM), 0.f, 0.f, 0, sqrtf(__uint_as_float(WSP(const unsigned, WS_KMAX)[l * 8 + b * 4 + head])), wid_s); } }
    }
#endif
#if PHMASK & 64
    for (int rep_ = 0; rep_ < ((DUPMASK & 64) ? DUPN : 1); ++rep_) { if (rep_) GRID_SYNC();
        { const Args a = fresh_args(); FRESH(); __syncthreads(); dsa_attend_wave(a, gw, NGW, lane, lds + wid * DA_WAVE_LDS); __syncthreads(); }
    }
#endif
        GRID_SYNC();
#if PHMASK & 128
    for (int rep_ = 0; rep_ < ((DUPMASK & 128) ? DUPN : 1); ++rep_) { if (rep_) GRID_SYNC();
        { const Args a = fresh_args(); const int G = gridDim.x, bid = blockIdx.x;
          int kmerge = 256; asm volatile("" : "+s"(kmerge));
          pg8::Gemm g{WSP(bf16_t, WS_H), WSP(bf16_t, WS_WBT), 4 * MROWS, 4 * D, kmerge}; pg8::MergeOrder2 S{G, bid};
          pg8::EpiMerge2 E{WSP(bf16_t, WS_MG), WSP(unsigned char, WS_G)}; E.zero();
          pg8::gemm_phase<pg8::EpiMerge2, pg8::MergeOrder2, true, MERGE_SP2, false, true>(lds3, g, S, E, wid_s); }
    }
#endif
        GRID_SYNC();
#if PHMASK & 256
    for (int rep_ = 0; rep_ < ((DUPMASK & 256) ? DUPN : 1); ++rep_) { if (rep_) GRID_SYNC();
        { const Args a = fresh_args(); const int G = gridDim.x, bid = blockIdx.x;
#if WO8
          pg8::Gemm g{WSP(bf16_t, WS_MG), WSP(bf16_t, WS_WOT), MROWS, D, D}; pg8::StaticOrder S; S.init(MROWS, D, G, bid);
          pg8::EpiPlain8 E{WSP(bf16_t, WS_H), D};
          pg8::gemm_phase<pg8::EpiPlain8, pg8::StaticOrder, true, G8_SP2, true>(lds3, g, S, E, wid_s); }
#else
          pg8::Gemm g{WSP(bf16_t, WS_MG), WSP(bf16_t, WS_WOT), MROWS, D, D}; pg8::StaticOrder S; S.init(MROWS, D, G, bid);
          pg8::EpiPlain E{WSP(bf16_t, WS_H), D};
          pg8::gemm_phase<pg8::EpiPlain, pg8::StaticOrder, true, true>(lds3, g, S, E, wid_s); }
#endif
    }
#endif
        GRID_SYNC();
#if PHMASK & 512
    for (int rep_ = 0; rep_ < ((DUPMASK & 512) ? DUPN : 1); ++rep_) { if (rep_) GRID_SYNC();
        { const Args a = fresh_args(); FRESH(); const float* ng = a.norm_g + (size_t)l * 4 * D;
          for (int row = gw * 8; row < MROWS; row += NGW * 8) { const int b = row >> 13; const float* md = WSP(float, WS_MOD) + (size_t)(l * 2 + b) * NMOD;
            bf16_t* x1g = WSP(bf16_t, WS_G) + (size_t)row * D; bf16_t* h2 = FFN8 ? nullptr : WSP(bf16_t, WS_MG) + (size_t)row * D; const bf16_t* rawp = WSP(bf16_t, WS_H) + (size_t)row * D;
            unsigned char* h28 = WSP(unsigned char, WS_G) + 32 * MiB + (size_t)row * D;
            if (l == 0) row_pass8<true, true, false, true, FFN8 != 0>(a.x + (size_t)row * D, rawp, x1g, h2, h28, md + 2 * D, ng + 1 * D, ng + 2 * D, md + 4 * D, md + 3 * D, lane);
            else row_pass8<true, true, true, true, FFN8 != 0>((const bf16_t*)a.out + (size_t)row * D, rawp, x1g, h2, h28, md + 2 * D, ng + 1 * D, ng + 2 * D, md + 4 * D, md + 3 * D, lane); } }
    }
#endif
        GRID_SYNC();
#if PHMASK & 1024
    for (int rep_ = 0; rep_ < ((DUPMASK & 1024) ? DUPN : 1); ++rep_) { if (rep_) GRID_SYNC();
        { const Args a = fresh_args(); const int G = gridDim.x, bid = blockIdx.x;
#if FFN8
          pg8::Gemm g{(const bf16_t*)(a.ws + WS_G + 32 * MiB), WSP(bf16_t, WS_WGU), MROWS, NGU, D}; pg8::StaticOrder S; S.init(MROWS, NGU, G, bid);
          pg8::EpiSwiglu8<DOWN8 != 0> E{WSP(bf16_t, WS_Z)};
          pg8::gemm_phase<pg8::EpiSwiglu8<DOWN8 != 0>, pg8::StaticOrder, true, G8_SP2, true>(lds3, g, S, E, wid_s); }
#else
          pg8::Gemm g{WSP(bf16_t, WS_MG), WSP(bf16_t, WS_WGU), MROWS, NGU, D}; pg8::StaticOrder S; S.init(MROWS, NGU, G, bid);
          pg8::EpiSwiglu E{WSP(bf16_t, WS_Z)};
          pg8::gemm_phase<pg8::EpiSwiglu, pg8::StaticOrder, true, true>(lds3, g, S, E, wid_s); }
#endif
    }
#endif
        GRID_SYNC();
#if PHMASK & 2048
    for (int rep_ = 0; rep_ < ((DUPMASK & 2048) ? DUPN : 1); ++rep_) { if (rep_) GRID_SYNC();
        { const Args a = fresh_args(); const int G = gridDim.x, bid = blockIdx.x;
#if DOWN8
          pg8::Gemm g{WSP(bf16_t, WS_Z), WSP(bf16_t, WS_WDT), MROWS, D, DFF}; pg8::StaticOrder S; S.init(MROWS, D, G, bid);
          pg8::EpiPlain8 E{WSP(bf16_t, WS_H), D};
          pg8::gemm_phase<pg8::EpiPlain8, pg8::StaticOrder, true, G8_SP2, true>(lds3, g, S, E, wid_s); }
#else
          pg8::Gemm g{WSP(bf16_t, WS_Z), WSP(bf16_t, WS_WDT), MROWS, D, DFF}; pg8::StaticOrder S; S.init(MROWS, D, G, bid);
          pg8::EpiPlain E{WSP(bf16_t, WS_H), D};
          pg8::gemm_phase<pg8::EpiPlain, pg8::StaticOrder, true, true>(lds3, g, S, E, wid_s); }
#endif
    }
#endif
        GRID_SYNC();
#if PHMASK & 4096
    for (int rep_ = 0; rep_ < ((DUPMASK & 4096) ? DUPN : 1); ++rep_) { if (rep_) GRID_SYNC();
        { const Args a = fresh_args(); FRESH(); const float* ng = a.norm_g + (size_t)l * 4 * D;
          for (int row = gw * 8; row < MROWS; row += NGW * 8) { const int b = row >> 13; const float* md = WSP(float, WS_MOD) + (size_t)(l * 2 + b) * NMOD;
            const float* mdn = WSP(float, WS_MOD) + (size_t)((l + 1) * 2 + b) * NMOD; const float* ngn = a.norm_g + (size_t)(l + 1) * 4 * D;
            const bf16_t* x1g = WSP(bf16_t, WS_G) + (size_t)row * D; bf16_t* hr = WSP(bf16_t, WS_H) + (size_t)row * D;
            if (l + 1 < DEPTH) row_pass8<true, true, true, true, true>(x1g, hr, (bf16_t*)a.out + (size_t)row * D, hr, WSP(unsigned char, WS_MG) + (size_t)row * D, md + 5 * D, ng + 3 * D, ngn, mdn + 1 * D, mdn + 0 * D, lane);
            else row_pass8<true, false, true, false>(x1g, hr, a.out + (size_t)row * D, nullptr, nullptr, md + 5 * D, ng + 3 * D, nullptr, nullptr, nullptr, lane); }
          if (l + 1 < DEPTH) convert_weights(a, l + 1, lds, wid_s); }
    }
#endif
        if (l + 1 < DEPTH) GRID_SYNC();
    }
}

extern "C" void kernel_launch(void* const* d_in, const int* in_sizes, int n_in, void* d_out, int out_size, void* d_ws, size_t ws_size, hipStream_t stream) {
    static int grid = 0;
    if (grid == 0) {
        if (n_in != 14 || out_size != MROWS * D || ws_size < WS_END) { fprintf(stderr, "kernel_launch: unexpected shapes (n_in %d out %d ws %zu)\n", n_in, out_size, ws_size); grid = -1; return; }
        int dev = 0, cus = 0, per_cu = 0;
        (void)hipGetDevice(&dev);
        (void)hipDeviceGetAttribute(&cus, hipDeviceAttributeMultiprocessorCount, dev);
        (void)hipFuncSetAttribute((const void*)mega, hipFuncAttributeMaxDynamicSharedMemorySize, LDS_BYTES);
        (void)hipOccupancyMaxActiveBlocksPerMultiprocessor(&per_cu, (const void*)mega, 512, LDS_BYTES);
        if (per_cu < 1) { fprintf(stderr, "kernel_launch: occupancy query says 0 blocks per CU\n"); per_cu = 1; }
        grid = cus;
        (void)hipGetLastError();
    }
    if (grid < 0) return;
    if (hipMemsetAsync(d_ws, 0, 65536, stream) != hipSuccess) { fprintf(stderr, "kernel_launch: memset failed\n"); return; }
    Args a{};
    const float** pp = (const float**)&a;
    for (int i = 0; i < 14; ++i) pp[i] = (const float*)d_in[i];
    a.out = (float*)d_out; a.ws = (unsigned char*)d_ws;
    void* args[] = {&a};
    hipError_t e = hipLaunchCooperativeKernel((const void*)mega, dim3(grid), dim3(512), args, LDS_BYTES, stream);
    if (e != hipSuccess) fprintf(stderr, "cooperative launch failed: %s (grid %d)\n", hipGetErrorString(e), grid);
}
```

```cpp
#include <hip/hip_runtime.h>
#include <hip/hip_cooperative_groups.h>
#include <cstdio>
#include <cstdint>
namespace cg = cooperative_groups;
namespace pg8 {
#define PG8_LAS __attribute__((address_space(3)))
typedef unsigned short bf16_t;
typedef short bf16x8 __attribute__((ext_vector_type(8)));
typedef float f32x4 __attribute__((ext_vector_type(4)));
typedef unsigned u32x4 __attribute__((ext_vector_type(4)));
typedef int v4i_t __attribute__((ext_vector_type(4)));
typedef int v8i_t __attribute__((ext_vector_type(8)));
constexpr int BM = 256, BK = 64, HALF = 128, HTB = HALF * BK * 2  , STAGE_BYTES = 8 * HTB, NXCD = 8, WGM = 8;

__host__ __device__ __forceinline__ int lds_byte(int r, int c) { const int st = (r >> 4) * 2 + (c >> 5), rr = r & 15, cc = c & 31, ob = rr * 64 + cc * 2; return st * 1024 + (ob ^ (((ob >> 9) & 1) << 5)); }
__host__ __device__ __forceinline__ void stage_rc(int b, int& R, int& C) { const int st = b / 1024, sb = b % 1024, swz = sb ^ (((sb >> 9) & 1) << 5); R = (st >> 1) * 16 + swz / 64; C = (st & 1) * 32 + (swz % 64) / 2; }
__host__ __device__ __forceinline__ int perm32(int rho) { const int n = rho >> 4, i = rho & 15; return 8 * (i >> 2) + 4 * n + (i & 3); }

struct Unit { int pm, pn; };
struct Gemm { const bf16_t* A; const bf16_t* Bt; int M, N, K; };

struct StaticOrder {
    int nM, nN, nwg, G, c;
    __host__ __device__ void init(int M, int N, int G_, int c_) { nM = M / BM; nN = N / BM; nwg = nM * nN; G = G_; c = c_; }
    __host__ __device__ bool next(int i, Unit& u) const {
        const long L = (long)i * G + c; if (L >= nwg) return false;
        int wgid = (int)L; { const int q = nwg / NXCD, r = nwg % NXCD, xcd = wgid % NXCD, off = wgid / NXCD; wgid = (xcd < r ? xcd * (q + 1) : r * (q + 1) + (xcd - r) * q) + off; }
        const int nig = WGM * nN, gid = wgid / nig, fm = gid * WGM, gsz = (nM - fm) < WGM ? (nM - fm) : WGM;
        u.pm = fm + ((wgid % nig) % gsz); u.pn = (wgid % nig) / gsz; return true;
    }
    __device__ __forceinline__ void a_ready(const Unit&) const {}
    __device__ __forceinline__ void done(const Unit&) const {}
};

__device__ __forceinline__ unsigned cvt_pk_bf16(float lo, float hi) { unsigned r; asm volatile("v_cvt_pk_bf16_f32 %0, %1, %2" : "=v"(r) : "v"(lo), "v"(hi)); return r; }
typedef float f32x2 __attribute__((ext_vector_type(2)));
#ifndef WO8
#define WO8 1
#endif
#ifndef MERGE_FENCE
#define MERGE_FENCE 1
#endif
typedef unsigned u32x2 __attribute__((ext_vector_type(2)));
__device__ __forceinline__ float bf_lo(unsigned w) { return __uint_as_float(w << 16); }
__device__ __forceinline__ float bf_hi(unsigned w) { return __uint_as_float(w & 0xffff0000u); }
#ifdef PROBE_CHEAPSIG
__device__ __forceinline__ float sigmoidf_fast(float x) { return 0.5f + 0.25f * fminf(fmaxf(x, -2.0f), 2.0f); }
#else
__device__ __forceinline__ float sigmoidf_fast(float x) { return __builtin_amdgcn_rcpf(1.0f + __builtin_amdgcn_exp2f(-1.4426950408889634f * x)); }
#endif

struct EpiPlain {
    static constexpr bool PERM = true, AFTER_DRAIN = false;
    bf16_t* O; int ldc;
    __device__ __forceinline__ void operator()(const f32x4 (&acc)[2][2][4][2], const Unit& u, int wr, int wc, int fr, int fq) const {
        const int row0 = u.pm * BM + wr * 64 + fr, col0 = u.pn * BM + wc * 32 + 8 * fq;
#pragma unroll
        for (int ai = 0; ai < 2; ++ai)
#pragma unroll
            for (int m = 0; m < 4; ++m) { bf16_t* rowp = O + (size_t)(row0 + ai * HALF + m * 16) * ldc + col0;
#pragma unroll
                for (int bj = 0; bj < 2; ++bj) { const f32x4 v0 = acc[ai][bj][m][0], v1 = acc[ai][bj][m][1];
                    u32x4 w; w.x = cvt_pk_bf16(v0[0], v0[1]); w.y = cvt_pk_bf16(v0[2], v0[3]); w.z = cvt_pk_bf16(v1[0], v1[1]); w.w = cvt_pk_bf16(v1[2], v1[3]);
                    *(u32x4*)(rowp + bj * HALF) = w; } }
    }
};
struct EpiZ {
    static constexpr bool PERM = true, AFTER_DRAIN = false;
    bf16_t* Z; float* SM; unsigned char* G;
    __device__ __forceinline__ void operator()(const f32x4 (&acc)[2][2][4][2], const Unit& u, int wr, int wc, int fr, int fq) const {
        const int row0 = u.pm * BM + wr * 64 + fr;
        if (u.pn < 11) {
            const int col0 = u.pn * BM + wc * 32 + 8 * fq;
#pragma unroll
            for (int ai = 0; ai < 2; ++ai)
#pragma unroll
                for (int m = 0; m < 4; ++m) { bf16_t* rowp = Z + (size_t)(row0 + ai * HALF + m * 16) * 2816 + col0;
#pragma unroll
                    for (int bj = 0; bj < 2; ++bj) { const f32x4 v0 = acc[ai][bj][m][0], v1 = acc[ai][bj][m][1];
                        u32x4 w; w.x = cvt_pk_bf16(v0[0], v0[1]); w.y = cvt_pk_bf16(v0[2], v0[3]); w.z = cvt_pk_bf16(v1[0], v1[1]); w.w = cvt_pk_bf16(v1[2], v1[3]);
                        *(u32x4*)(rowp + bj * HALF) = w; } }
            if (u.pn == 10 && wc == 2 && fq == 0) {
#pragma unroll
                for (int ai = 0; ai < 2; ++ai)
#pragma unroll
                    for (int m = 0; m < 4; ++m) { float* sp = SM + (size_t)(row0 + ai * HALF + m * 16) * 8;
                        *(f32x4*)sp = acc[ai][1][m][0]; *(f32x4*)(sp + 4) = acc[ai][1][m][1]; }
            }
        } else {
            const int col0 = (u.pn - 11) * BM + wc * 32 + 8 * fq;
#pragma unroll
            for (int ai = 0; ai < 2; ++ai)
#pragma unroll
                for (int m = 0; m < 4; ++m) { unsigned char* rowp = G + (size_t)(row0 + ai * HALF + m * 16) * 4096 + col0;
#pragma unroll
                    for (int bj = 0; bj < 2; ++bj) { const f32x4 v0 = acc[ai][bj][m][0], v1 = acc[ai][bj][m][1];
                        unsigned b[8];
#pragma unroll
                        for (int k = 0; k < 4; ++k) { b[k] = (unsigned)(sigmoidf_fast(v0[k]) * 255.0f + 0.5f); b[4 + k] = (unsigned)(sigmoidf_fast(v1[k]) * 255.0f + 0.5f); }
                        u32x2 w; w.x = b[0] | (b[1] << 8) | (b[2] << 16) | (b[3] << 24); w.y = b[4] | (b[5] << 8) | (b[6] << 16) | (b[7] << 24);
                        *(u32x2*)(rowp + bj * HALF) = w; } }
        }
    }
};
struct EpiG {
    static constexpr bool PERM = false, AFTER_DRAIN = false;
    unsigned char* G;
    __device__ __forceinline__ void operator()(const f32x4 (&acc)[2][2][4][2], const Unit& u, int wr, int wc, int fr, int fq) const {
        unsigned ones_ = ~0u; asm volatile("" : "+s"(ones_)); const unsigned ln_ = __builtin_amdgcn_mbcnt_hi(ones_, __builtin_amdgcn_mbcnt_lo(ones_, 0u)); (void)fr; (void)fq;
        unsigned* gb = (unsigned*)G + (size_t)(u.pm * 16 + u.pn) * (2 * 8 * 4 * 2 * 2 * 64) + (unsigned)(wr * 4 + wc) * (4 * 2 * 2 * 64) + ln_;
#pragma unroll
        for (int ai = 0; ai < 2; ++ai)
#pragma unroll
            for (int m = 0; m < 4; ++m) {
#pragma unroll
                for (int bj = 0; bj < 2; ++bj)
#pragma unroll
                    for (int n = 0; n < 2; ++n) { const f32x4 v0 = acc[ai][bj][m][n];
                        unsigned b[4];
#pragma unroll
                        for (int k = 0; k < 4; ++k) b[k] = (unsigned)(sigmoidf_fast(v0[k]) * 255.0f + 0.5f);
                        gb[(unsigned)(ai * (8 * 4 * 2 * 2 * 64) + m * (2 * 2 * 64) + bj * (2 * 64) + n * 64)] = b[0] | (b[1] << 8) | (b[2] << 16) | (b[3] << 24); }
                asm volatile("" ::: "memory"); }
    }
};
struct EpiMerge {
    static constexpr bool PERM = true, AFTER_DRAIN = false;
    bf16_t* MG; const unsigned char* G;
    __device__ __forceinline__ void operator()(const f32x4 (&acc)[2][2][4][2], const Unit& u, int wr, int wc, int fr, int fq) const {
        const int n = u.pm >> 6, pm = u.pm & 63, pn = u.pn & 3;
        const unsigned row0 = pm * BM + wr * 64 + fr, col0 = pn * BM + wc * 32 + 8 * fq;
        const unsigned char* gbase = G + n * 1024 + col0; bf16_t* mbase = MG + col0;
#pragma unroll
        for (int ai = 0; ai < 2; ++ai) {
            u32x2 gw[4][2]; u32x4 old[4][2];
#pragma unroll
            for (int m = 0; m < 4; ++m)
#pragma unroll
                for (int bj = 0; bj < 2; ++bj) { const unsigned row = row0 + ai * HALF + m * 16;
                    gw[m][bj] = *(const u32x2*)(gbase + row * 4096u + bj * HALF);
                    if (n > 0) old[m][bj] = *(const u32x4*)(mbase + row * 1024u + bj * HALF); }
#pragma unroll
            for (int m = 0; m < 4; ++m)
#pragma unroll
                for (int bj = 0; bj < 2; ++bj) { const unsigned row = row0 + ai * HALF + m * 16;
                    const f32x4 v0 = acc[ai][bj][m][0], v1 = acc[ai][bj][m][1];
                    float r[8];
#pragma unroll
                    for (int k = 0; k < 4; ++k) { r[k] = v0[k] * ((float)((gw[m][bj].x >> (8 * k)) & 255u) * (1.0f / 255.0f)); r[4 + k] = v1[k] * ((float)((gw[m][bj].y >> (8 * k)) & 255u) * (1.0f / 255.0f)); }
                    if (n > 0) { const u32x4 o = old[m][bj];
                        r[0] += bf_lo(o.x); r[1] += bf_hi(o.x); r[2] += bf_lo(o.y); r[3] += bf_hi(o.y); r[4] += bf_lo(o.z); r[5] += bf_hi(o.z); r[6] += bf_lo(o.w); r[7] += bf_hi(o.w); }
                    u32x4 w; w.x = cvt_pk_bf16(r[0], r[1]); w.y = cvt_pk_bf16(r[2], r[3]); w.z = cvt_pk_bf16(r[4], r[5]); w.w = cvt_pk_bf16(r[6], r[7]);
                    *(u32x4*)(mbase + row * 1024u + bj * HALF) = w; }
            asm volatile("" ::: "memory");
        }
    }
};
struct EpiSwiglu {
    static constexpr bool PERM = true, AFTER_DRAIN = false;
    bf16_t* Hd;
    __device__ __forceinline__ void operator()(const f32x4 (&acc)[2][2][4][2], const Unit& u, int wr, int wc, int fr, int fq) const {
        const int row0 = u.pm * BM + wr * 64 + fr, j0 = u.pn * 128 + wc * 16 + 4 * fq;
#pragma unroll
        for (int ai = 0; ai < 2; ++ai)
#pragma unroll
            for (int m = 0; m < 4; ++m) { bf16_t* rowp = Hd + (size_t)(row0 + ai * HALF + m * 16) * 2816 + j0;
#pragma unroll
                for (int bj = 0; bj < 2; ++bj) { const f32x4 v0 = acc[ai][bj][m][0], v1 = acc[ai][bj][m][1];
                    const float h0 = v0[0] * sigmoidf_fast(v0[0]) * v0[1], h1 = v0[2] * sigmoidf_fast(v0[2]) * v0[3];
                    const float h2 = v1[0] * sigmoidf_fast(v1[0]) * v1[1], h3 = v1[2] * sigmoidf_fast(v1[2]) * v1[3];
                    u32x2 w; w.x = cvt_pk_bf16(h0, h1); w.y = cvt_pk_bf16(h2, h3);
                    *(u32x2*)(rowp + bj * 64) = w; } }
    }
};
template <bool H8> struct EpiSwiglu8 {
    static constexpr bool PERM = false, AFTER_DRAIN = false;
    bf16_t* Hd;
    __device__ __forceinline__ void operator()(const f32x4 (&acc)[2][2][4][2], const Unit& u, int wr, int wc, int fr, int fq) const {
        unsigned ones_ = ~0u; asm volatile("" : "+s"(ones_)); const int ln_ = (int)__builtin_amdgcn_mbcnt_hi(ones_, __builtin_amdgcn_mbcnt_lo(ones_, 0u)); const int fr_ = ln_ & 15, fq_ = ln_ >> 4; (void)fr; (void)fq;
        const unsigned row0 = u.pm * BM + wr * 64 + fr_, j0 = u.pn * 128 + wc * 16 + 2 * fq_;
        bf16_t* hb = Hd + j0; unsigned char* h8b = (unsigned char*)Hd + j0;
#pragma unroll
        for (int ai = 0; ai < 2; ++ai)
#pragma unroll
            for (int m = 0; m < 4; ++m) { const unsigned ro = (row0 + ai * HALF + m * 16) * 2816u;
#pragma unroll
                for (int bj = 0; bj < 2; ++bj)
#pragma unroll
                    for (int n = 0; n < 2; ++n) { const f32x4 v = acc[ai][bj][m][n];
                        const float h0 = v[0] * sigmoidf_fast(v[0]) * v[1], h1 = v[2] * sigmoidf_fast(v[2]) * v[3];
                        if (H8) *(unsigned short*)(h8b + ro + bj * 64 + n * 8) = (unsigned short)__builtin_amdgcn_cvt_pk_fp8_f32(h0, h1, 0u, false);
                        else *(unsigned*)(hb + ro + bj * 64 + n * 8) = cvt_pk_bf16(h0, h1); }
                asm volatile("" ::: "memory"); }
    }
};
struct EpiPlain8 {
    static constexpr bool PERM = false, AFTER_DRAIN = false;
    bf16_t* O; int ldc;
    __device__ __forceinline__ void operator()(const f32x4 (&acc)[2][2][4][2], const Unit& u, int wr, int wc, int fr, int fq) const {
        unsigned ones_ = ~0u; asm volatile("" : "+s"(ones_)); const int ln_ = (int)__builtin_amdgcn_mbcnt_hi(ones_, __builtin_amdgcn_mbcnt_lo(ones_, 0u)); const int fr_ = ln_ & 15, fq_ = ln_ >> 4; (void)fr; (void)fq;
        const unsigned row0 = u.pm * BM + wr * 64 + fr_, col0 = u.pn * BM + wc * 32 + 4 * fq_;
        bf16_t* ob = O + col0;
#pragma unroll
        for (int ai = 0; ai < 2; ++ai)
#pragma unroll
            for (int m = 0; m < 4; ++m) { const unsigned ro = (row0 + ai * HALF + m * 16) * (unsigned)ldc;
#pragma unroll
                for (int bj = 0; bj < 2; ++bj)
#pragma unroll
                    for (int n = 0; n < 2; ++n) { const f32x4 v = acc[ai][bj][m][n]; u32x2 w; w.x = cvt_pk_bf16(v[0], v[1]); w.y = cvt_pk_bf16(v[2], v[3]);
                        *(u32x2*)(ob + ro + bj * HALF + n * 16) = w; }
                asm volatile("" ::: "memory"); }
    }
};
struct MergeOrder {
    int G, c;
    __device__ __forceinline__ bool next(int i, Unit& u) const {
        const int t = (i >> 2) * G + c; if (t >= 256) return false;
        const int n = i & 3, pm = t >> 2, pn = t & 3;
        u.pm = n * 64 + pm; u.pn = n * 4 + pn; return true;
    }
    __device__ __forceinline__ void a_ready(const Unit&) const {}
    __device__ __forceinline__ void done(const Unit&) const {}
};
struct EpiMerge2 {
    static constexpr bool PERM = true, AFTER_DRAIN = false;
    bf16_t* MG; const unsigned char* G;
    mutable f32x4 tot[2][4][2];
    __device__ __forceinline__ void zero() const {
#pragma unroll
        for (int bj = 0; bj < 2; ++bj)
#pragma unroll
            for (int m = 0; m < 4; ++m)
#pragma unroll
                for (int k = 0; k < 2; ++k) tot[bj][m][k] = (f32x4){0.f, 0.f, 0.f, 0.f};
    }
    __device__ __forceinline__ void operator()(const f32x4 (&acc)[2][2][4][2], const Unit& u, int wr, int wc, int fr, int fq) const {
        const int n = u.pn >> 2, pn = u.pn & 3, pm = u.pm - n * 128;
        const unsigned row0 = pm * HALF + wr * 64 + fr, col0 = pn * BM + wc * 32 + 8 * fq;
        const unsigned* gb = (const unsigned*)G + (size_t)((pm >> 1) * 16 + n * 4 + pn) * (2 * 8 * 4 * 2 * 2 * 64) + (unsigned)((pm & 1) * (8 * 4 * 2 * 2 * 64) + (wr * 4 + wc) * (4 * 2 * 2 * 64) + (fq >> 1) * 64 + (2 * (fq & 1)) * 16 + fr);
        u32x2 gw[4][2];
#pragma unroll
        for (int m = 0; m < 4; ++m)
#pragma unroll
            for (int bj = 0; bj < 2; ++bj) { gw[m][bj].x = gb[m * (2 * 2 * 64) + bj * (2 * 64)]; gw[m][bj].y = gb[m * (2 * 2 * 64) + bj * (2 * 64) + 16]; }
#pragma unroll
        for (int m = 0; m < 4; ++m)
#pragma unroll
            for (int bj = 0; bj < 2; ++bj) {
#pragma unroll
                for (int k = 0; k < 4; ++k) { tot[bj][m][0][k] += acc[0][bj][m][0][k] * ((float)((gw[m][bj].x >> (8 * k)) & 255u) * (1.0f / 255.0f));
                                              tot[bj][m][1][k] += acc[0][bj][m][1][k] * ((float)((gw[m][bj].y >> (8 * k)) & 255u) * (1.0f / 255.0f)); } }
        if (n == 3) {
            bf16_t* mbase = MG + col0;
#pragma unroll
            for (int m = 0; m < 4; ++m)
#pragma unroll
                for (int bj = 0; bj < 2; ++bj) { const f32x4 t0 = tot[bj][m][0], t1 = tot[bj][m][1];
#if WO8
                    u32x2 w8; w8.x = __builtin_amdgcn_cvt_pk_fp8_f32(t0[2], t0[3], __builtin_amdgcn_cvt_pk_fp8_f32(t0[0], t0[1], 0u, false), true);
                    w8.y = __builtin_amdgcn_cvt_pk_fp8_f32(t1[2], t1[3], __builtin_amdgcn_cvt_pk_fp8_f32(t1[0], t1[1], 0u, false), true);
                    *(u32x2*)((unsigned char*)MG + col0 + (row0 + m * 16) * 1024u + bj * HALF) = w8; }
#else
                    u32x4 w; w.x = cvt_pk_bf16(t0[0], t0[1]); w.y = cvt_pk_bf16(t0[2], t0[3]); w.z = cvt_pk_bf16(t1[0], t1[1]); w.w = cvt_pk_bf16(t1[2], t1[3]);
                    *(u32x4*)(mbase + (row0 + m * 16) * 1024u + bj * HALF) = w; }
#endif
            zero();
        }
    }
};
struct MergeOrder2 {
    int G, c;
    __device__ __forceinline__ bool next(int i, Unit& u) const {
        const int t = (i >> 2) * G + c; if (t >= 512) return false;
        const int n = i & 3, pm = t >> 2, pn = t & 3;
        u.pm = n * 128 + pm; u.pn = n * 4 + pn; return true;
    }
    __device__ __forceinline__ void a_ready(const Unit&) const {}
    __device__ __forceinline__ void done(const Unit&) const {}
};
struct Frag16x2 { bf16x8 k[2]; };
template <bool FP8> struct FragSel;
template <> struct FragSel<false> {
    typedef Frag16x2 type;
    static __device__ __forceinline__ type load(PG8_LAS unsigned char* p) { type f; f.k[0] = *(const PG8_LAS bf16x8*)p; f.k[1] = *(const PG8_LAS bf16x8*)(p + 1024); return f; }
    static __device__ __forceinline__ f32x4 mma(const type& w, const type& a, f32x4 c) {
        c = __builtin_amdgcn_mfma_f32_16x16x32_bf16(w.k[0], a.k[0], c, 0, 0, 0); return __builtin_amdgcn_mfma_f32_16x16x32_bf16(w.k[1], a.k[1], c, 0, 0, 0); }
};
template <> struct FragSel<true> {
    struct type { v4i_t lo, hi; };
    static __device__ __forceinline__ type load(PG8_LAS unsigned char* p) { type f; f.lo = *(const PG8_LAS v4i_t*)p; f.hi = *(const PG8_LAS v4i_t*)(p + 1024); return f; }
    static __device__ __forceinline__ f32x4 mma(const type& w, const type& a, f32x4 c) {
        return __builtin_amdgcn_mfma_scale_f32_16x16x128_f8f6f4(__builtin_shufflevector(w.lo, w.hi, 0, 1, 2, 3, 4, 5, 6, 7), __builtin_shufflevector(a.lo, a.hi, 0, 1, 2, 3, 4, 5, 6, 7), c, 0, 0, 0, 0x7a7a7a7a, 0, 0x7f7f7f7f); }
};
template <class Epi, class Sched, bool ALIGN_EPI = false, bool SP2 = false, bool FP8 = false, bool HALFM = false>
__device__ __forceinline__ void gemm_phase(PG8_LAS unsigned char* lds, const Gemm g, const Sched& S, const Epi& E, int wid_s) {
    unsigned ones_ = ~0u; asm volatile("" : "+s"(ones_));
    int tid_ = wid_s * 64 + (int)__builtin_amdgcn_mbcnt_hi(ones_, __builtin_amdgcn_mbcnt_lo(ones_, 0u)); asm volatile("" : "+v"(tid_));
    const int tid = tid_, wid = __builtin_amdgcn_readfirstlane(tid >> 6), lane = tid & 63, wr = wid >> 2, wc = wid & 3, fr = lane & 15, fq = lane >> 4;
    const int K = FP8 ? g.K / 2 : g.K, nt = K / BK;
    unsigned voffA[2], voffB[2];
#pragma unroll
    for (int i = 0; i < 2; ++i) { int R, C; stage_rc(tid * 16 + i * 8192, R, C); const int Rb = Epi::PERM ? ((R & ~31) + perm32(R & 31)) : R;
        voffA[i] = (unsigned)(R * K + C) * 2u; voffB[i] = (unsigned)(Rb * K + C) * 2u; }
    const size_t kstep = (size_t)(BK * 2);
    const size_t hstep = (size_t)HALF * K * 2;
    const size_t tstep = 2 * hstep;
    const unsigned ldsw = (unsigned)wid * 1024u;
    const unsigned ldsbase = (unsigned)(__UINTPTR_TYPE__)lds;
    const __amdgpu_buffer_rsrc_t srdA = __builtin_amdgcn_make_buffer_rsrc((void*)g.A, (short)0, 0x7fffffff, 0x00020000);
    const __amdgpu_buffer_rsrc_t srdB = __builtin_amdgcn_make_buffer_rsrc((void*)g.Bt, (short)0, 0x7fffffff, 0x00020000);
    const int aoff = lds_byte(wr * 64 + fr, fq * 8), boff = lds_byte(wc * 32 + fr, fq * 8);
#define PG8_SA(b, h) (((b) * 2 + (h)) * HTB)
#define PG8_SB(b, h) ((4 + (b) * 2 + (h)) * HTB)
#define PG8_STAGE(bufoff, gbase, voff, srd, base) do { const unsigned so_ = (unsigned)((const char*)(gbase) - (const char*)(base)); _Pragma("unroll") for (int _i = 0; _i < 2; ++_i) \
        asm volatile("s_mov_b32 m0, %0\n\ts_nop 0\n\tbuffer_load_dwordx4 %1, %2, %3 offen lds" :: "s"(ldsbase + (unsigned)(bufoff) + ldsw + (unsigned)(_i * 8192)), "v"((voff)[_i]), "s"(srd), "s"(so_) : "m0", "memory"); } while (0)
#define PG8_LDA(dst, b, h) do { _Pragma("unroll") for (int m = 0; m < 4; ++m) dst[m] = FragSel<FP8>::load(lds + PG8_SA(b, h) + aoff + m * 2048); } while (0)
#define PG8_LDB(dst, b, h) do { _Pragma("unroll") for (int n = 0; n < 2; ++n) dst[n] = FragSel<FP8>::load(lds + PG8_SB(b, h) + boff + n * 2048); } while (0)
#define PG8_MMA(ai, bj, At, Bt) do { __builtin_amdgcn_s_setprio(1); _Pragma("unroll") for (int m = 0; m < 4; ++m) _Pragma("unroll") for (int n = 0; n < 2; ++n) \
        acc[ai][bj][m][n] = FragSel<FP8>::mma(Bt[n], At[m], acc[ai][bj][m][n]); __builtin_amdgcn_s_setprio(0); } while (0)
#define PG8_WAIT_V(n) asm volatile("s_waitcnt vmcnt(" #n ")" ::: "memory")
#define PG8_WAIT_L(n) asm volatile("s_waitcnt lgkmcnt(" #n ")" ::: "memory")
#define PG8_BAR __builtin_amdgcn_s_barrier()
#define PG8_SCHED __builtin_amdgcn_sched_barrier(0)
    Unit cur, nxt; int ui = 0;
    if (!S.next(0, cur)) return;
    f32x4 acc[2][2][4][2];
#pragma unroll
    for (int a = 0; a < 2; ++a)
#pragma unroll
        for (int b = 0; b < 2; ++b)
#pragma unroll
            for (int m = 0; m < 4; ++m)
#pragma unroll
                for (int n = 0; n < 2; ++n) acc[a][b][m][n] = (f32x4){0.f, 0.f, 0.f, 0.f};
    typedef typename FragSel<FP8>::type frag_t;
    frag_t At[4], B0[2], B1[2];
    const size_t tstepA = HALFM ? hstep : tstep;
    const char* cA = (const char*)g.A + (size_t)cur.pm * tstepA; const char* cB = (const char*)g.Bt + (size_t)cur.pn * tstep;
    S.a_ready(cur);
    if constexpr (SP2) {
        PG8_STAGE(PG8_SB(0, 0), cB, voffB, srdB, g.Bt); PG8_STAGE(PG8_SB(0, 1), cB + hstep, voffB, srdB, g.Bt); PG8_STAGE(PG8_SA(0, 0), cA, voffA, srdA, g.A); PG8_STAGE(PG8_SA(0, 1), cA + hstep, voffA, srdA, g.A);
        if (wr == 1) PG8_BAR;
        PG8_WAIT_V(2); PG8_BAR;
        PG8_STAGE(PG8_SB(1, 0), cB + kstep, voffB, srdB, g.Bt); PG8_STAGE(PG8_SA(1, 0), cA + kstep, voffA, srdA, g.A); PG8_STAGE(PG8_SB(1, 1), cB + hstep + kstep, voffB, srdB, g.Bt);
        PG8_WAIT_V(6); PG8_BAR;
    } else {
        PG8_STAGE(PG8_SB(0, 0), cB, voffB, srdB, g.Bt); PG8_STAGE(PG8_SA(0, 0), cA, voffA, srdA, g.A); PG8_STAGE(PG8_SB(0, 1), cB + hstep, voffB, srdB, g.Bt); PG8_STAGE(PG8_SA(0, 1), cA + hstep, voffA, srdA, g.A);
        if (wr == 1) PG8_BAR;
        PG8_WAIT_V(4); PG8_BAR;
        PG8_STAGE(PG8_SB(1, 0), cB + kstep, voffB, srdB, g.Bt); PG8_STAGE(PG8_SA(1, 0), cA + kstep, voffA, srdA, g.A); PG8_STAGE(PG8_SB(1, 1), cB + hstep + kstep, voffB, srdB, g.Bt);
        PG8_WAIT_V(6); PG8_BAR;
    }
    for (;;) {
        const bool has_next = S.next(ui + 1, nxt);
        const char* nA = has_next ? (const char*)g.A + (size_t)nxt.pm * tstepA : cA; const char* nB = has_next ? (const char*)g.Bt + (size_t)nxt.pn * tstep : cB;
#pragma unroll 1
        for (int t = 0; t < nt; t += 2) {
            const bool last = (t == nt - 2);
            const char* a1 = cA + (size_t)(t + 1) * kstep;
            const char* a2 = last ? nA : cA + (size_t)(t + 2) * kstep; const char* b2 = last ? nB : cB + (size_t)(t + 2) * kstep;
            const char* a3 = a2 + kstep; const char* b3 = b2 + kstep;
            if (last && has_next) S.a_ready(nxt);
            if constexpr (SP2) {
            PG8_LDB(B0, 0, 0); PG8_LDB(B1, 0, 1); PG8_SCHED; PG8_LDA(At, 0, 0); PG8_STAGE(PG8_SA(1, 1), a1 + hstep, voffA, srdA, g.A);
            PG8_WAIT_V(8); PG8_WAIT_L(0); PG8_BAR; PG8_MMA(0, 0, At, B0); PG8_MMA(0, 1, At, B1); PG8_BAR; PG8_SCHED;
            if constexpr (!HALFM) PG8_LDA(At, 0, 1); PG8_STAGE(PG8_SB(0, 0), b2, voffB, srdB, g.Bt); PG8_STAGE(PG8_SB(0, 1), b2 + hstep, voffB, srdB, g.Bt); PG8_STAGE(PG8_SA(0, 0), a2, voffA, srdA, g.A);
            PG8_WAIT_V(8); PG8_WAIT_L(0); PG8_BAR; if constexpr (!HALFM) { PG8_MMA(1, 0, At, B0); PG8_MMA(1, 1, At, B1); } PG8_BAR; PG8_SCHED;
            PG8_LDB(B0, 1, 0); PG8_LDB(B1, 1, 1); PG8_SCHED; PG8_LDA(At, 1, 0); PG8_STAGE(PG8_SA(0, 1), a2 + hstep, voffA, srdA, g.A);
            PG8_WAIT_V(8); PG8_WAIT_L(0); PG8_BAR; PG8_MMA(0, 0, At, B0); PG8_MMA(0, 1, At, B1); PG8_BAR; PG8_SCHED;
            if constexpr (!HALFM) PG8_LDA(At, 1, 1); PG8_STAGE(PG8_SB(1, 0), b3, voffB, srdB, g.Bt); PG8_STAGE(PG8_SB(1, 1), b3 + hstep, voffB, srdB, g.Bt); PG8_STAGE(PG8_SA(1, 0), a3, voffA, srdA, g.A);
            PG8_WAIT_V(8); PG8_WAIT_L(0); PG8_BAR; if constexpr (!HALFM) { PG8_MMA(1, 0, At, B0); PG8_MMA(1, 1, At, B1); } PG8_BAR; PG8_SCHED;
            } else {
            PG8_LDB(B0, 0, 0); PG8_SCHED; PG8_LDA(At, 0, 0); PG8_STAGE(PG8_SA(1, 1), a1 + hstep, voffA, srdA, g.A);
            PG8_WAIT_L(8); PG8_BAR; PG8_WAIT_L(0); PG8_MMA(0, 0, At, B0); PG8_BAR; PG8_SCHED;
            PG8_LDB(B1, 0, 1); PG8_STAGE(PG8_SB(0, 0), b2, voffB, srdB, g.Bt);
            PG8_BAR; PG8_WAIT_L(0); PG8_MMA(0, 1, At, B1); PG8_BAR;
            if constexpr (!HALFM) PG8_LDA(At, 0, 1); PG8_STAGE(PG8_SA(0, 0), a2, voffA, srdA, g.A);
            PG8_BAR; PG8_WAIT_L(0); if constexpr (!HALFM) PG8_MMA(1, 0, At, B0); PG8_BAR; PG8_SCHED;
            PG8_STAGE(PG8_SB(0, 1), b2 + hstep, voffB, srdB, g.Bt);
            PG8_WAIT_V(6); PG8_BAR; if constexpr (!HALFM) PG8_MMA(1, 1, At, B1); PG8_BAR;
            PG8_LDB(B0, 1, 0); PG8_SCHED; PG8_LDA(At, 1, 0); PG8_STAGE(PG8_SA(0, 1), a2 + hstep, voffA, srdA, g.A);
            PG8_WAIT_L(8); PG8_BAR; PG8_WAIT_L(0); PG8_MMA(0, 0, At, B0); PG8_BAR; PG8_SCHED;
            PG8_LDB(B1, 1, 1); PG8_STAGE(PG8_SB(1, 0), b3, voffB, srdB, g.Bt);
            PG8_BAR; PG8_WAIT_L(0); PG8_MMA(0, 1, At, B1); PG8_BAR;
            if constexpr (!HALFM) PG8_LDA(At, 1, 1); PG8_STAGE(PG8_SA(1, 0), a3, voffA, srdA, g.A);
            PG8_BAR; PG8_WAIT_L(0); if constexpr (!HALFM) PG8_MMA(1, 0, At, B0); PG8_BAR; PG8_SCHED;
            PG8_STAGE(PG8_SB(1, 1), b3 + hstep, voffB, srdB, g.Bt);
            PG8_WAIT_V(6); PG8_BAR; if constexpr (!HALFM) PG8_MMA(1, 1, At, B1); PG8_BAR;
            }
        }
        if constexpr (ALIGN_EPI) { if (wr == 0) PG8_BAR; }
        if constexpr (!Epi::AFTER_DRAIN) { E(acc, cur, wr, wc, fr, fq); S.done(cur); }
        if (!has_next) break;
#pragma unroll
        for (int a = 0; a < 2; ++a)
#pragma unroll
            for (int b = 0; b < 2; ++b)
#pragma unroll
                for (int m = 0; m < 4; ++m)
#pragma unroll
                    for (int n = 0; n < 2; ++n) acc[a][b][m][n] = (f32x4){0.f, 0.f, 0.f, 0.f};
        cur = nxt; cA = nA; cB = nB; ++ui;
        if constexpr (ALIGN_EPI) { if (wr == 1) PG8_BAR; }
    }
    PG8_WAIT_V(0);
    if constexpr (!ALIGN_EPI) { if (wr == 0) PG8_BAR; }
    PG8_BAR;
    if constexpr (Epi::AFTER_DRAIN) { E.fused(acc, cur, wr, wc, fr, fq, lds, wid, lane); S.done(cur); }
#undef PG8_SA
#undef PG8_SB
#undef PG8_STAGE
#undef PG8_LDA
#undef PG8_LDB
#undef PG8_MMA
#undef PG8_WAIT_V
#undef PG8_WAIT_L
#undef PG8_BAR
#undef PG8_SCHED
}
}

typedef unsigned short bf16_t;
typedef short bf16x8 __attribute__((ext_vector_type(8)));
typedef short s16x4 __attribute__((ext_vector_type(4)));
typedef float f32x4 __attribute__((ext_vector_type(4)));
typedef float f32x16 __attribute__((ext_vector_type(16)));
typedef unsigned u32x4 __attribute__((ext_vector_type(4)));
typedef unsigned u32x2 __attribute__((ext_vector_type(2)));
#define LAS __attribute__((address_space(3)))

constexpr int D = 1024, BATCH = 2, SEQ = 8192, MROWS = BATCH * SEQ, DEPTH = 2;
constexpr int ZW = 2816, NW1 = 6912, INW = 6856, DFF = 2816, NGU = 5632, NMOD = 6 * D;
constexpr float RMS_EPS = 1e-6f, LOG2E = 1.4426950408889634f, C2 = 0.125f * 1.4426950408889634f;
constexpr int ZC_AU = 0, ZC_AB = 256, ZC_AC = 512, ZC_DQ = 768, ZC_DK = 1024, ZC_DV = 1088, ZC_DQI = 1152, ZC_DKI = 1408, ZC_FQ = 1472, ZC_FK = 1728, ZC_FV = 1984, ZC_SQ = 2240, ZC_SK = 2496, ZC_SV = 2624;

constexpr size_t MiB = 1u << 20;
constexpr size_t WS_KMAX = 4096;
constexpr size_t WS_MOD = 65536;
constexpr size_t WS_FCUM = WS_MOD + 98304;
constexpr size_t WS_SMALL = WS_FCUM + 262144;
constexpr size_t WS_W1T = 1 * MiB;
constexpr size_t WS_WG8 = WS_W1T + (size_t)2816 * D * 2;
constexpr size_t WS_WGU = WS_W1T + (size_t)NW1 * D * 2;
constexpr size_t WS_WBT = WS_WGU + (size_t)NGU * D * 2;
constexpr size_t WS_WOT = WS_WBT + (size_t)4 * D * 256 * 2;
constexpr size_t WS_WDT = WS_WOT + (size_t)D * D * 2;
constexpr size_t WS_H = 35 * MiB;
constexpr size_t WS_Z = 67 * MiB;
constexpr size_t WS_G = 155 * MiB;
constexpr size_t WS_MG = 219 * MiB;
constexpr size_t WS_END = 251 * MiB;
static_assert(WS_WDT + (size_t)D * DFF * 2 <= WS_H && WS_SMALL + 524288 <= WS_W1T, "ws map");

#ifndef FFN8
#define FFN8 1
#endif
#ifndef DOWN8
#define DOWN8 1
#endif
constexpr int LDS_BYTES = 151552;

struct Args {
    const float *x, *c, *w_ada, *b_ada, *norm_g, *w_in, *conv_w, *fox_bias, *swa_sinks, *w_branch, *w_o, *w_gate, *w_up, *w_down;
    float* out; unsigned char* ws;
};

__device__ __forceinline__ unsigned f2bf(float f) { unsigned u = __builtin_bit_cast(unsigned, f); return (u + 0x7fffu + ((u >> 16) & 1u)) >> 16; }
__device__ __forceinline__ unsigned pk2(float lo, float hi) { return f2bf(lo) | (f2bf(hi) << 16); }
__device__ __forceinline__ float bflo(unsigned w) { return __uint_as_float(w << 16); }
__device__ __forceinline__ float bfhi(unsigned w) { return __uint_as_float(w & 0xffff0000u); }

__device__ __forceinline__ float shf(float v, int src) { return __int_as_float(__builtin_amdgcn_ds_bpermute(src << 2, __float_as_int(v))); }
__device__ __forceinline__ unsigned shu(unsigned v, int src) { return (unsigned)__builtin_amdgcn_ds_bpermute(src << 2, (int)v); }
__device__ __forceinline__ float wave_sum(float v, int lane) {
#pragma unroll
    for (int o = 1; o < 64; o <<= 1) v += shf(v, lane ^ o);
    return v;
}
__device__ __forceinline__ int crow(int r, int hi) { return (r & 3) + 8 * (r >> 2) + 4 * hi; }
__device__ __forceinline__ float swap32_max(float m) { auto rr = __builtin_amdgcn_permlane32_swap(__float_as_uint(m), __float_as_uint(m), false, false); return fmaxf(__uint_as_float(rr[0]), __uint_as_float(rr[1])); }
__device__ __forceinline__ float swap32_sum(float m) { auto rr = __builtin_amdgcn_permlane32_swap(__float_as_uint(m), __float_as_uint(m), false, false); return __uint_as_float(rr[0]) + __uint_as_float(rr[1]); }
#define LDSWAIT() asm volatile("s_waitcnt lgkmcnt(0)" ::: "memory")
__device__ __forceinline__ int ftid(int wid_s) { unsigned ones = ~0u; asm volatile("" : "+s"(ones)); int t = wid_s * 64 + (int)__builtin_amdgcn_mbcnt_hi(ones, __builtin_amdgcn_mbcnt_lo(ones, 0u)); asm volatile("" : "+v"(t)); return t; }

__device__ __forceinline__ void ada_gemv(const Args& a, unsigned char* lds, int wid_s) {
    float* sc = (float*)lds;
    float* part = (float*)(lds + 8192);
    const int tid = ftid(wid_s), lane = tid & 63, wid = tid >> 6;
    for (int i = tid; i < 2 * D; i += 512) { const float v = a.c[i]; sc[i] = v / (1.0f + __expf(-v)); }
    __syncthreads();
    float* mod = (float*)(a.ws + WS_MOD);
    for (int item = blockIdx.x; item < DEPTH * (NMOD / 64); item += gridDim.x) {
        const int l = item / (NMOD / 64), jc = item % (NMOD / 64);
        const float* w = a.w_ada + (size_t)l * D * NMOD + (size_t)(wid * 128) * NMOD + jc * 64 + lane;
        float a0 = 0.f, a1 = 0.f;
#pragma unroll 32
        for (int k = 0; k < 128; ++k) { const float wv = w[(size_t)k * NMOD]; a0 += sc[wid * 128 + k] * wv; a1 += sc[D + wid * 128 + k] * wv; }
        part[(wid * 2 + 0) * 64 + lane] = a0; part[(wid * 2 + 1) * 64 + lane] = a1;
        __syncthreads();
        if (tid < 128) { const int b = tid >> 6, j = tid & 63; float s = 0.f;
#pragma unroll
            for (int w8 = 0; w8 < 8; ++w8) s += part[(w8 * 2 + b) * 64 + j];
            mod[((size_t)l * 2 + b) * NMOD + jc * 64 + j] = s + a.b_ada[(size_t)l * NMOD + jc * 64 + j]; }
        __syncthreads();
    }
}
__device__ __forceinline__ void transpose_item(const float* colptr, int ld, bf16_t* dst  , int dstK, float* scr, int lane) {
    float tv[32];
#pragma unroll
    for (int i = 0; i < 32; ++i) tv[i] = colptr ? colptr[(size_t)(2 * i + (lane >> 5)) * ld] : 0.f;
#pragma unroll
    for (int i = 0; i < 32; ++i) scr[(2 * i + (lane >> 5)) * 33 + (lane & 31)] = tv[i];
    LDSWAIT();
    const int c = lane & 7;
#pragma unroll
    for (int j = 0; j < 4; ++j) { const int n = (lane >> 3) + 8 * j; const float* s = scr + (8 * c) * 33 + n;
        u32x4 o; o.x = pk2(s[0 * 33], s[1 * 33]); o.y = pk2(s[2 * 33], s[3 * 33]); o.z = pk2(s[4 * 33], s[5 * 33]); o.w = pk2(s[6 * 33], s[7 * 33]);
        *(u32x4*)(dst + (size_t)n * dstK + 8 * c) = o; }
    LDSWAIT();
}
__device__ __forceinline__ void transpose_item_fp8(const float* colptr, int ld, unsigned char* dst  , int dstK, float scale, float* scr, int lane) {
    float tv[32];
#pragma unroll
    for (int i = 0; i < 32; ++i) tv[i] = colptr ? colptr[(size_t)(2 * i + (lane >> 5)) * ld] : 0.f;
#pragma unroll
    for (int i = 0; i < 32; ++i) scr[(2 * i + (lane >> 5)) * 33 + (lane & 31)] = tv[i];
    LDSWAIT();
    const int n = lane >> 1, kh = 32 * (lane & 1); const float* s = scr + kh * 33 + n;
    unsigned w[8];
#pragma unroll
    for (int q = 0; q < 8; ++q) { unsigned t = 0u;
        t = __builtin_amdgcn_cvt_pk_fp8_f32(s[(4 * q + 0) * 33] * scale, s[(4 * q + 1) * 33] * scale, t, false);
        t = __builtin_amdgcn_cvt_pk_fp8_f32(s[(4 * q + 2) * 33] * scale, s[(4 * q + 3) * 33] * scale, t, true);
        w[q] = t; }
    unsigned char* dp = dst + (size_t)n * dstK + kh;
    *(u32x4*)dp = (u32x4){w[0], w[1], w[2], w[3]}; *(u32x4*)(dp + 16) = (u32x4){w[4], w[5], w[6], w[7]};
    LDSWAIT();
}
__device__ __forceinline__ int w1_src_col(int n) {
    if (n < 1472) return n;
    if (n < 2240) return n + 4;
    if (n < 2752) return n + 8;
    if (n < 2756) return 1472 + (n - 2752);
    if (n < 2760) return 2244 + (n - 2756);
    if (n < 2816) return -1;
    return 2760 + (n - 2816);
}
__device__ __forceinline__ void convert_weights(const Args& a, int l, unsigned char* lds, int wid_s) {
    const int tid = ftid(wid_s), lane = tid & 63, wid = tid >> 6;
    float* scr = (float*)(lds + 16384) + wid * (64 * 33);
    const int gw = blockIdx.x * 8 + wid, NGW = gridDim.x * 8;
    constexpr int I_IN = 16 * 216, I_GU = 16 * 176, I_B = 512, I_O = 512, I_D = 44 * 32;
    bf16_t* W1T = (bf16_t*)(a.ws + WS_W1T); bf16_t* WGU = (bf16_t*)(a.ws + WS_WGU); bf16_t* WBT = (bf16_t*)(a.ws + WS_WBT); bf16_t* WOT = (bf16_t*)(a.ws + WS_WOT); bf16_t* WDT = (bf16_t*)(a.ws + WS_WDT);
    const int cl = lane & 31;
    for (int it = gw; it < I_IN + I_GU + I_B + I_O + I_D; it += NGW) {
        int r = it;
        if (r < I_IN) { const int kb = r / 216, nb = r % 216;
            if (nb < 88) { const int n = 32 * nb + cl, sc_ = w1_src_col(n);
                const float* cp = sc_ >= 0 ? a.w_in + (size_t)l * D * INW + (size_t)(64 * kb) * INW + sc_ : nullptr;
                transpose_item(cp, INW, W1T + (size_t)(32 * nb) * D + 64 * kb, D, scr, lane); }
            else { const int n = 32 * nb + cl;
                const float* cp = a.w_in + (size_t)l * D * INW + (size_t)(64 * kb) * INW + w1_src_col(n);
                transpose_item_fp8(cp, INW, a.ws + WS_WG8 + (size_t)(32 * (nb - 88)) * D + 64 * kb, D, 32.0f, scr, lane); }
            continue; }
        r -= I_IN;
        if (r < I_GU) { const int kb = r / 176, nb = r % 176, n = 32 * nb + cl;
            const float* cp = ((n & 1) ? a.w_up : a.w_gate) + (size_t)l * D * DFF + (size_t)(64 * kb) * DFF + (n >> 1);
#if FFN8
            transpose_item_fp8(cp, DFF, a.ws + WS_WGU + (size_t)(32 * nb) * D + 64 * kb, D, 32.0f, scr, lane); continue; }
#else
            transpose_item(cp, DFF, WGU + (size_t)(32 * nb) * D + 64 * kb, D, scr, lane); continue; }
#endif
        r -= I_GU;
        if (r < I_B) { const int nbr = r / 128, rr = r % 128, kb = rr / 32, nb = rr % 32;
            const float* cp = a.w_branch + ((size_t)(l * 4 + nbr) * 256 + 64 * kb) * D + 32 * nb + cl;
            transpose_item(cp, D, WBT + ((size_t)nbr * D + 32 * nb) * 256 + 64 * kb, 256, scr, lane); continue; }
        r -= I_B;
        if (r < I_O) { const int kb = r / 32, nb = r % 32;
            const float* cp = a.w_o + (size_t)l * D * D + (size_t)(64 * kb) * D + 32 * nb + cl;
#if WO8
            transpose_item_fp8(cp, D, a.ws + WS_WOT + (size_t)(32 * nb) * D + 64 * kb, D, 32.0f, scr, lane); continue; }
#else
            transpose_item(cp, D, WOT + (size_t)(32 * nb) * D + 64 * kb, D, scr, lane); continue; }
#endif
        r -= I_O;
        { const int kb = r / 32, nb = r % 32;
            const float* cp = a.w_down + (size_t)l * DFF * D + (size_t)(64 * kb) * D + 32 * nb + cl;
#if DOWN8
            transpose_item_fp8(cp, D, a.ws + WS_WDT + (size_t)(32 * nb) * DFF + 64 * kb, DFF, 32.0f, scr, lane); }
#else
            transpose_item(cp, D, WDT + (size_t)(32 * nb) * DFF + 64 * kb, DFF, scr, lane); }
#endif
    }
}

template <bool HAS_RAW, bool HAS_H, bool XIN16 = false, bool XOUT16 = false, bool HAS_H8 = false>
__device__ __forceinline__ void row_pass8(const void* xres_, const bf16_t* raw, void* xdst_, bf16_t* hdst, unsigned char* h8dst, const float* gate, const float* gam_out, const float* gam_in, const float* sc, const float* sh, int lane) {
    f32x4 A[4], B[4], C[4];
#pragma unroll
    for (int j = 0; j < 4; ++j) {
        if (HAS_RAW) A[j] = ((const f32x4*)gate)[lane + 64 * j] * ((const f32x4*)gam_out)[lane + 64 * j];
        if (HAS_H) { B[j] = ((const f32x4*)gam_in)[lane + 64 * j] * (((const f32x4*)sc)[lane + 64 * j] + 1.0f); C[j] = ((const f32x4*)sh)[lane + 64 * j]; }
    }
    const float* xres = (const float*)xres_; const bf16_t* xres16 = (const bf16_t*)xres_; float* xdst = (float*)xdst_; bf16_t* xdst16 = (bf16_t*)xdst_;
    f32x4 nv[4]; u32x2 nx[4], nr[4];
#pragma unroll
    for (int j = 0; j < 4; ++j) { if (XIN16) nx[j] = ((const u32x2*)xres16)[lane + 64 * j]; else nv[j] = ((const f32x4*)xres)[lane + 64 * j]; if (HAS_RAW) nr[j] = ((const u32x2*)raw)[lane + 64 * j]; }
#pragma unroll 1
    for (int r = 0; r < 8; ++r) {
        f32x4 v[4]; u32x2 w[4];
#pragma unroll
        for (int j = 0; j < 4; ++j) { if (XIN16) v[j] = (f32x4){bflo(nx[j].x), bfhi(nx[j].x), bflo(nx[j].y), bfhi(nx[j].y)}; else v[j] = nv[j]; if (HAS_RAW) w[j] = nr[j]; }
        if (r + 1 < 8) {
#pragma unroll
            for (int j = 0; j < 4; ++j) { if (XIN16) nx[j] = ((const u32x2*)(xres16 + (size_t)(r + 1) * D))[lane + 64 * j]; else nv[j] = ((const f32x4*)(xres + (size_t)(r + 1) * D))[lane + 64 * j];
                if (HAS_RAW) nr[j] = ((const u32x2*)(raw + (size_t)(r + 1) * D))[lane + 64 * j]; }
        }
        if (HAS_RAW) {
            f32x4 o[4]; float ss = 0.f;
#pragma unroll
            for (int j = 0; j < 4; ++j) { o[j] = (f32x4){bflo(w[j].x), bfhi(w[j].x), bflo(w[j].y), bfhi(w[j].y)}; ss += (o[j][0] * o[j][0] + o[j][1] * o[j][1]) + (o[j][2] * o[j][2] + o[j][3] * o[j][3]); }
            const float rstd = 1.0f / sqrtf(wave_sum(ss, lane) * (1.0f / D) + RMS_EPS);
#pragma unroll
            for (int j = 0; j < 4; ++j) { v[j] = v[j] + A[j] * (o[j] * rstd);
                if (XOUT16) { u32x2 pw; pw.x = pk2(v[j][0], v[j][1]); pw.y = pk2(v[j][2], v[j][3]); ((u32x2*)(xdst16 + (size_t)r * D))[lane + 64 * j] = pw; }
                else ((f32x4*)(xdst + (size_t)r * D))[lane + 64 * j] = v[j]; }
        }
        if (HAS_H) {
            float ss = 0.f;
#pragma unroll
            for (int j = 0; j < 4; ++j) ss += (v[j][0] * v[j][0] + v[j][1] * v[j][1]) + (v[j][2] * v[j][2] + v[j][3] * v[j][3]);
            const float rstd = 1.0f / sqrtf(wave_sum(ss, lane) * (1.0f / D) + RMS_EPS);
#pragma unroll
            for (int j = 0; j < 4; ++j) { const f32x4 h = v[j] * rstd * B[j] + C[j]; if (hdst) { u32x2 pw; pw.x = pk2(h[0], h[1]); pw.y = pk2(h[2], h[3]); ((u32x2*)(hdst + (size_t)r * D))[lane + 64 * j] = pw; }
                if (HAS_H8) { unsigned t8 = 0u; t8 = __builtin_amdgcn_cvt_pk_fp8_f32(h[0], h[1], t8, false); t8 = __builtin_amdgcn_cvt_pk_fp8_f32(h[2], h[3], t8, true); ((unsigned*)(h8dst + (size_t)r * D))[lane + 64 * j] = t8; } }
        }
    }
}

__device__ __forceinline__ void conv_phase(const Args& a, int l, int wid_s) {
    const bf16_t* Z = (const bf16_t*)(a.ws + WS_Z); bf16_t* Y0 = (bf16_t*)(a.ws + WS_H);
    const float* cw = a.conv_w + (size_t)l * 3 * 256;
    const int gt = blockIdx.x * 512 + ftid(wid_s), GT = gridDim.x * 512;
    for (int it = gt; it < MROWS * 32; it += GT) {
        const int row = it >> 5, ch = (it & 31) * 8, t = row & (SEQ - 1);
        float acc[8];
#pragma unroll
        for (int k = 0; k < 8; ++k) acc[k] = 0.f;
#pragma unroll
        for (int j = 0; j < 3; ++j) { const int dt = 2 - j; if (t - dt < 0) continue;
            const bf16_t* zr = Z + (size_t)(row - dt) * ZW;
            const u32x4 u = *(const u32x4*)(zr + ZC_AU + ch), cgt = *(const u32x4*)(zr + ZC_AC + ch);
            const f32x4 w0 = *(const f32x4*)(cw + j * 256 + ch), w1 = *(const f32x4*)(cw + j * 256 + ch + 4);
            acc[0] += w0[0] * bflo(u.x) * bflo(cgt.x); acc[1] += w0[1] * bfhi(u.x) * bfhi(cgt.x); acc[2] += w0[2] * bflo(u.y) * bflo(cgt.y); acc[3] += w0[3] * bfhi(u.y) * bfhi(cgt.y);
            acc[4] += w1[0] * bflo(u.z) * bflo(cgt.z); acc[5] += w1[1] * bfhi(u.z) * bfhi(cgt.z); acc[6] += w1[2] * bflo(u.w) * bflo(cgt.w); acc[7] += w1[3] * bfhi(u.w) * bfhi(cgt.w); }
        const u32x4 bg = *(const u32x4*)(Z + (size_t)row * ZW + ZC_AB + ch);
        u32x4 o; o.x = pk2(acc[0] * bflo(bg.x), acc[1] * bfhi(bg.x)); o.y = pk2(acc[2] * bflo(bg.y), acc[3] * bfhi(bg.y)); o.z = pk2(acc[4] * bflo(bg.z), acc[5] * bfhi(bg.z)); o.w = pk2(acc[6] * bflo(bg.w), acc[7] * bfhi(bg.w));
        *(u32x4*)(Y0 + (size_t)row * 256 + ch) = o;
    }
}

__device__ __forceinline__ void fox_scan(const Args& a, int l, int bh, unsigned char* lds, int wid_s) {
    const int tid = ftid(wid_s), lane = tid & 63, wid = tid >> 6, b = bh >> 2, h = bh & 3;
    const float* SM = (const float*)(a.ws + WS_SMALL); float* F2 = (float*)(a.ws + WS_FCUM) + (size_t)bh * SEQ;
    const float bias = a.fox_bias[l * 4 + h];
    float* wtot = (float*)lds;
    float v[16]; float run = 0.f;
#pragma unroll
    for (int i = 0; i < 16; ++i) { const float x = SM[((size_t)b * SEQ + tid * 16 + i) * 8 + 4 + h] + bias;
        const float ls = fminf(x, 0.f) - log1pf(__expf(-fabsf(x))); run += ls; v[i] = run; }
    float inc = run;
#pragma unroll
    for (int o = 1; o < 64; o <<= 1) { const float t = shf(inc, lane - o); if (lane >= o) inc += t; }
    if (lane == 63) wtot[wid] = inc;
    __syncthreads();
    float base = inc - run;
    for (int w = 0; w < wid; ++w) base += wtot[w];
#pragma unroll
    for (int i = 0; i < 16; ++i) F2[tid * 16 + i] = (base + v[i]) * LOG2E;
    __syncthreads();
}


__device__ __forceinline__ void fox_kmax_item(const Args& a, int l, int item, int wid_s) {
    const int tid = ftid(wid_s), lane = tid & 63, bh = item >> 3, chunk = item & 7, b = bh >> 2, h = bh & 3;
    const bf16_t* Z = (const bf16_t*)(a.ws + WS_Z);
    float mx = 0.f;
#pragma unroll
    for (int rr = 0; rr < 2; ++rr) { const bf16_t* kp = Z + ((size_t)b * SEQ + chunk * 1024 + rr * 512 + tid) * ZW + ZC_FK + h * 64; float q2 = 0.f;
#pragma unroll
        for (int i = 0; i < 8; ++i) { const u32x4 w = *(const u32x4*)(kp + 8 * i);
            q2 += bflo(w.x) * bflo(w.x) + bfhi(w.x) * bfhi(w.x) + bflo(w.y) * bflo(w.y) + bfhi(w.y) * bfhi(w.y) + bflo(w.z) * bflo(w.z) + bfhi(w.z) * bfhi(w.z) + bflo(w.w) * bflo(w.w) + bfhi(w.w) * bfhi(w.w); }
        mx = fmaxf(mx, q2); }
#pragma unroll
    for (int o = 1; o < 64; o <<= 1) mx = fmaxf(mx, shf(mx, lane ^ o));
    if (lane == 0) atomicMax((unsigned*)(a.ws + WS_KMAX) + l * 8 + bh, __float_as_uint(mx));
}

template <int MODE>
__device__ __forceinline__ void attn_unit(unsigned char* lds, const bf16_t* __restrict__ Z, bf16_t* __restrict__ Yn, int b, int head, int qb, const float* __restrict__ F2, float slope2, float sink2, int tile_lo, float kmax, int wid_s) {
    const int tid = ftid(wid_s), lane = tid & 63, r32 = lane & 31, hi = lane >> 5; const int wid = __builtin_amdgcn_readfirstlane(tid >> 6);
    constexpr int QOFF = MODE == 0 ? ZC_FQ : ZC_SQ, KOFF = MODE == 0 ? ZC_FK : ZC_SK, VOFF = MODE == 0 ? ZC_FV : ZC_SV;
    const int hk = MODE == 0 ? head : (head >> 1);
    const size_t rowbase = (size_t)b * SEQ;
    const int q0 = qb * 256, qa = q0 + 32 * wid, myq = qa + r32;
    unsigned char* Ks = lds; unsigned char* Vs = lds + 9216; float* Fk = (float*)(lds + 9216 + 12288); float* wsc = (float*)(lds + 49152) + wid * 64;
    bf16x8 qr[4];
    { const bf16_t* qp = Z + (rowbase + myq) * ZW + QOFF + head * 64 + hi * 8;
#pragma unroll
      for (int ks = 0; ks < 4; ++ks) qr[ks] = *(const bf16x8*)(qp + 16 * ks); }
    const float* Fh = MODE == 0 ? F2 + ((size_t)b * 4 + head) * SEQ : nullptr;
    const float fq2 = MODE == 0 ? Fh[myq] : 0.f;
    float m = -1e30f, l = 0.f; f32x16 o0, o1;
#pragma unroll
    for (int r = 0; r < 16; ++r) { o0[r] = 0.f; o1[r] = 0.f; }
    const int t_hi = (q0 + 255) >> 6;
    if (MODE == 0) {
        int* smin = (int*)(lds + 49152 + 2048);
        __syncthreads();
        if (tid == 0) *smin = 0x7fffffff;
        __syncthreads();
        if (tid < 256) {
            const int t = q0 + tid; const bf16_t* qp2 = Z + (rowbase + t) * ZW + QOFF + head * 64; float q2 = 0.f;
#pragma unroll
            for (int i = 0; i < 8; ++i) { const u32x4 w = *(const u32x4*)(qp2 + 8 * i);
                q2 += bflo(w.x) * bflo(w.x) + bfhi(w.x) * bfhi(w.x) + bflo(w.y) * bflo(w.y) + bfhi(w.y) * bfhi(w.y) + bflo(w.z) * bflo(w.z) + bfhi(w.z) * bfhi(w.z) + bflo(w.w) * bflo(w.w) + bfhi(w.w) * bfhi(w.w); }
            const float target = Fh[t] + (40.0f + 0.25f * sqrtf(q2) * kmax) * LOG2E;
            int lo = 0, hi2 = t;
            while (lo < hi2) { const int mid = (lo + hi2) >> 1; if (Fh[mid] <= target) hi2 = mid; else lo = mid + 1; }
            atomicMin(smin, lo);
        }
        __syncthreads();
#ifdef PROBE_FOXFULL
        tile_lo = 0;
#else
        tile_lo = *smin >> 6;
#endif
    }
    const int srow = tid >> 3, sch = tid & 7;
    const int i16 = lane & 15;
    const LAS unsigned char* vtr_base = (const LAS unsigned char*)(Vs) + (4 * hi + (i16 >> 2)) * 192 + (16 * ((lane >> 4) & 1) + 4 * (i16 & 3)) * 2;
    u32x4 nk, nv4; float nf = 0.f;
    { const bf16_t* src = Z + (rowbase + 64 * t_hi + srow) * ZW;
      nk = *(const u32x4*)(src + KOFF + hk * 64 + sch * 8); nv4 = *(const u32x4*)(src + VOFF + hk * 64 + sch * 8);
      if (MODE == 0 && tid < 64) nf = Fh[64 * t_hi + tid]; }
    constexpr int ABUF = 24576;
    __syncthreads();
    { unsigned char* kb_ = Ks + (t_hi & 1) * ABUF; unsigned char* vb_ = Vs + (t_hi & 1) * ABUF;
      *(u32x4*)(kb_ + srow * 144 + sch * 16) = nk; *(u32x4*)(vb_ + srow * 192 + sch * 16) = nv4;
      if (MODE == 0 && tid < 64) (Fk + (t_hi & 1) * (ABUF / 4))[tid] = nf; }
    if (t_hi > tile_lo) { const bf16_t* src = Z + (rowbase + 64 * (t_hi - 1) + srow) * ZW;
      nk = *(const u32x4*)(src + KOFF + hk * 64 + sch * 8); nv4 = *(const u32x4*)(src + VOFF + hk * 64 + sch * 8);
      if (MODE == 0 && tid < 64) nf = Fh[64 * (t_hi - 1) + tid]; }
    for (int T = t_hi; T >= tile_lo; --T) {
        __syncthreads();
        if (T > tile_lo) {
            unsigned char* kb_ = Ks + ((T - 1) & 1) * ABUF; unsigned char* vb_ = Vs + ((T - 1) & 1) * ABUF;
            *(u32x4*)(kb_ + srow * 144 + sch * 16) = nk; *(u32x4*)(vb_ + srow * 192 + sch * 16) = nv4;
            if (MODE == 0 && tid < 64) (Fk + ((T - 1) & 1) * (ABUF / 4))[tid] = nf;
            if (T - 1 > tile_lo) { const bf16_t* src = Z + (rowbase + 64 * (T - 2) + srow) * ZW;
              nk = *(const u32x4*)(src + KOFF + hk * 64 + sch * 8); nv4 = *(const u32x4*)(src + VOFF + hk * 64 + sch * 8);
              if (MODE == 0 && tid < 64) nf = Fh[64 * (T - 2) + tid]; }
        }
        const unsigned char* Kc = Ks + (T & 1) * ABUF; const float* Fc = Fk + (T & 1) * (ABUF / 4); const int vofs = (T & 1) * ABUF;
        const bool part = (64 * T <= qa + 31) && (MODE == 0 || (64 * T + 63 >= qa - 127));
        if (part) {
            f32x16 p0, p1;
#pragma unroll
            for (int r = 0; r < 16; ++r) { p0[r] = 0.f; p1[r] = 0.f; }
#pragma unroll
            for (int ks = 0; ks < 4; ++ks) {
                const bf16x8 k0 = *(const bf16x8*)(Kc + r32 * 144 + (16 * ks + 8 * hi) * 2);
                const bf16x8 k1 = *(const bf16x8*)(Kc + (32 + r32) * 144 + (16 * ks + 8 * hi) * 2);
                p0 = __builtin_amdgcn_mfma_f32_32x32x16_bf16(k0, qr[ks], p0, 0, 0, 0);
                p1 = __builtin_amdgcn_mfma_f32_32x32x16_bf16(k1, qr[ks], p1, 0, 0, 0);
            }
            const int kvb = 64 * T + 4 * hi;
            float mx = -INFINITY;
#pragma unroll
            for (int g = 0; g < 4; ++g) {
                f32x4 fk0 = {0.f, 0.f, 0.f, 0.f}, fk1 = {0.f, 0.f, 0.f, 0.f};
                if (MODE == 0) { fk0 = *(const f32x4*)(Fc + 8 * g + 4 * hi); fk1 = *(const f32x4*)(Fc + 32 + 8 * g + 4 * hi); }
#pragma unroll
                for (int i = 0; i < 4; ++i) { const int r = 4 * g + i, kv0 = kvb + 8 * g + i, kv1 = kv0 + 32;
                    float x0, x1;
                    if (MODE == 0) { x0 = p0[r] * C2 + (fq2 - fk0[i]); x1 = p1[r] * C2 + (fq2 - fk1[i]); if (kv0 > myq) x0 = -INFINITY; if (kv1 > myq) x1 = -INFINITY; }
                    else { const int d0 = myq - kv0, d1 = myq - kv1; x0 = p0[r] * C2 - slope2 * (float)d0; x1 = p1[r] * C2 - slope2 * (float)d1; if (d0 < 0 || d0 >= 128) x0 = -INFINITY; if (d1 < 0 || d1 >= 128) x1 = -INFINITY; }
                    p0[r] = x0; p1[r] = x1; mx = fmaxf(mx, fmaxf(x0, x1)); }
            }
            mx = swap32_max(mx);
            const float mn = fmaxf(m, mx), alpha = __builtin_amdgcn_exp2f(m - mn); m = mn;
            float ps = 0.f;
#pragma unroll
            for (int r = 0; r < 16; ++r) { p0[r] = __builtin_amdgcn_exp2f(p0[r] - mn); p1[r] = __builtin_amdgcn_exp2f(p1[r] - mn); ps += p0[r] + p1[r]; }
            l = l * alpha + ps;
            if (hi == 0) wsc[r32] = alpha;
            LDSWAIT();
#pragma unroll
            for (int g = 0; g < 4; ++g) { const f32x4 a4 = *(const f32x4*)(wsc + 8 * g + 4 * hi);
#pragma unroll
                for (int i = 0; i < 4; ++i) { o0[4 * g + i] *= a4[i]; o1[4 * g + i] *= a4[i]; } }
            LDSWAIT();
#pragma unroll
            for (int s = 0; s < 4; ++s) {
                u32x4 pw;
                if (s < 2) { const int e = 8 * s; pw.x = pk2(p0[e], p0[e + 1]); pw.y = pk2(p0[e + 2], p0[e + 3]); pw.z = pk2(p0[e + 4], p0[e + 5]); pw.w = pk2(p0[e + 6], p0[e + 7]); }
                else { const int e = 8 * (s - 2); pw.x = pk2(p1[e], p1[e + 1]); pw.y = pk2(p1[e + 2], p1[e + 3]); pw.z = pk2(p1[e + 4], p1[e + 5]); pw.w = pk2(p1[e + 6], p1[e + 7]); }
                const bf16x8 pa = __builtin_bit_cast(bf16x8, pw);
#pragma unroll
                for (int db = 0; db < 2; ++db) {
                    const LAS unsigned char* vp = vtr_base + vofs + (16 * s) * 192 + 64 * db;
                    const s16x4 lo = __builtin_bit_cast(s16x4, __builtin_amdgcn_ds_read_tr16_b64_v4i16((LAS s16x4*)vp));
                    const s16x4 hv = __builtin_bit_cast(s16x4, __builtin_amdgcn_ds_read_tr16_b64_v4i16((LAS s16x4*)(vp + 8 * 192)));
                    const bf16x8 vf = (bf16x8){lo[0], lo[1], lo[2], lo[3], hv[0], hv[1], hv[2], hv[3]};
                    if (db == 0) o0 = __builtin_amdgcn_mfma_f32_32x32x16_bf16(pa, vf, o0, 0, 0, 0); else o1 = __builtin_amdgcn_mfma_f32_32x32x16_bf16(pa, vf, o1, 0, 0, 0);
                }
            }
        }
    }
    float lt = swap32_sum(l);
    if (MODE == 1) lt += __builtin_amdgcn_exp2f(sink2 - m);
    const float inv = 1.0f / lt;
    LDSWAIT();
    if (hi == 0) wsc[32 + r32] = inv;
    LDSWAIT();
#pragma unroll
    for (int g = 0; g < 4; ++g) { const f32x4 iv = *(const f32x4*)(wsc + 32 + 8 * g + 4 * hi);
#pragma unroll
        for (int i = 0; i < 4; ++i) { const int r = 4 * g + i, q = qa + 8 * g + 4 * hi + i;
            bf16_t* yp = Yn + (rowbase + q) * 256 + head * 64 + r32;
            yp[0] = (bf16_t)f2bf(o0[r] * iv[i]); yp[32] = (bf16_t)f2bf(o1[r] * iv[i]); } }
    LDSWAIT();
}

__device__ __forceinline__ unsigned score_key(float s) { const unsigned u = __float_as_uint(s + 0.0f); return (u & 0x80000000u) ? ~u : (u | 0x80000000u); }
__device__ __forceinline__ void hist_find(const unsigned* hrow, int lane, unsigned need, unsigned& bin, unsigned& above) {
    unsigned w[16]; unsigned tot = 0;
#pragma unroll
    for (int i = 0; i < 16; i += 4) { const u32x4 t = *(const u32x4*)(hrow + 16 * lane + i); w[i] = t.x; w[i + 1] = t.y; w[i + 2] = t.z; w[i + 3] = t.w; }
#pragma unroll
    for (int i = 0; i < 16; ++i) tot += (w[i] & 0xffffu) + (w[i] >> 16);
    unsigned inc = tot;
#pragma unroll
    for (int o = 1; o < 64; o <<= 1) { const unsigned t = shu(inc, lane + o); if (lane + o < 64) inc += t; }
    const unsigned exc = inc - tot;
    const bool owner = (exc < need) && (inc >= need);
    unsigned run = exc, fb = 0, fa = 0; bool found = false;
#pragma unroll
    for (int i = 15; i >= 0; --i) {
        const unsigned hi = w[i] >> 16, lo = w[i] & 0xffffu;
        if (!found && run + hi >= need) { found = true; fb = 32 * lane + 2 * i + 1; fa = run; }
        run += hi;
        if (!found && run + lo >= need) { found = true; fb = 32 * lane + 2 * i; fa = run; }
        run += lo;
    }
    const unsigned long long bal = __ballot(owner);
    const int src = bal ? (int)__builtin_ctzll(bal) : 0;
    bin = shu(fb, src); above = shu(fa, src);
}
__device__ __forceinline__ void dsa_select_slow(const Args& a, unsigned char* lds, int b, int qb32, int wid_s) {
    const int tid = ftid(wid_s), lane = tid & 63; const int wid = __builtin_amdgcn_readfirstlane(tid >> 6);
    const int c16 = lane & 15, g = lane >> 4;
    const bf16_t* Z = (const bf16_t*)(a.ws + WS_Z); const float* SM = (const float*)(a.ws + WS_SMALL);
    unsigned short* IDX = (unsigned short*)(a.ws + WS_MG);
    unsigned* hist = (unsigned*)lds;
    unsigned char* kt = lds + 131072;
    const size_t rowbase = (size_t)b * SEQ;
    const int t0 = qb32 * 32, myt = t0 + 4 * wid + g;
    const int ntile = (t0 + 32 + 63) >> 6;
    bf16x8 af[2];
    { const int qq = c16 >> 2, h = c16 & 3; const bf16_t* qp = Z + (rowbase + t0 + 4 * wid + qq) * ZW + ZC_DQI + h * 64 + 8 * g;
      af[0] = *(const bf16x8*)qp; af[1] = *(const bf16x8*)(qp + 32); }
    const f32x4 wv = *(const f32x4*)(SM + (rowbase + myt) * 8);
    const unsigned need = (unsigned)((myt + 1) < 256 ? (myt + 1) : 256);
    unsigned b1 = 0, above1 = 0, thr22 = 0, quota = 0;
    unsigned tiecount = 0, outcount = 0;
    unsigned* myhist = hist + (size_t)(4 * wid + g) * 1024;
    unsigned short* myidx = IDX + (rowbase + myt) * 256;
    const int srow = tid >> 3, sch = tid & 7;
    for (int pass = 0; pass < 3; ++pass) {
        if (pass < 2) { unsigned z_ = 0u; asm volatile("" : "+v"(z_)); const u32x4 z4 = {z_, z_, z_, z_};
            for (int i = tid; i < 32 * 1024 / 4; i += 512) ((u32x4*)hist)[i] = z4; }
        for (int T = 0; T < ntile; ++T) {
            __syncthreads();
            *(u32x4*)(kt + srow * 144 + sch * 16) = *(const u32x4*)(Z + (rowbase + 64 * T + srow) * ZW + ZC_DKI + sch * 8);
            __syncthreads();
#pragma unroll
            for (int cg4 = 0; cg4 < 4; ++cg4) {
                const bf16x8 k0 = *(const bf16x8*)(kt + (16 * cg4 + c16) * 144 + (8 * g) * 2);
                const bf16x8 k1 = *(const bf16x8*)(kt + (16 * cg4 + c16) * 144 + (32 + 8 * g) * 2);
                f32x4 acc = {0.f, 0.f, 0.f, 0.f};
                acc = __builtin_amdgcn_mfma_f32_16x16x32_bf16(af[0], k0, acc, 0, 0, 0);
                acc = __builtin_amdgcn_mfma_f32_16x16x32_bf16(af[1], k1, acc, 0, 0, 0);
                const int key = 64 * T + 16 * cg4 + c16;
                const bool valid = key <= myt;
                const float sc = wv[0] * fmaxf(acc[0], 0.f) + wv[1] * fmaxf(acc[1], 0.f) + wv[2] * fmaxf(acc[2], 0.f) + wv[3] * fmaxf(acc[3], 0.f);
                const unsigned u = score_key(sc);
                if (pass == 0) { if (valid) { const unsigned bin = u >> 21; atomicAdd(myhist + (bin >> 1), (bin & 1u) ? 65536u : 1u); } }
                else if (pass == 1) { if (valid && (u >> 21) == b1) { const unsigned bin = (u >> 10) & 0x7ffu; atomicAdd(myhist + (bin >> 1), (bin & 1u) ? 65536u : 1u); } }
                else {
                    const unsigned p22 = u >> 10;
                    const bool tie = valid && (p22 == thr22);
                    const unsigned long long tb = __ballot(tie);
                    const unsigned tmask = (unsigned)(tb >> (16 * g)) & 0xffffu;
                    const bool acc_tie = tie && (tiecount + __popc(tmask & ((1u << c16) - 1u)) < quota);
                    tiecount += __popc(tmask);
                    const bool sel = (valid && p22 > thr22) || acc_tie;
                    const unsigned long long sb = __ballot(sel);
                    const unsigned smask = (unsigned)(sb >> (16 * g)) & 0xffffu;
                    if (sel) myidx[outcount + __popc(smask & ((1u << c16) - 1u))] = (unsigned short)key;
                    outcount += __popc(smask);
                }
            }
        }
        __syncthreads();
        if (pass == 0) {
#pragma unroll
            for (int qq = 0; qq < 4; ++qq) { const unsigned nd = shu(need, 16 * qq); unsigned bn, ab; hist_find(hist + (size_t)(4 * wid + qq) * 1024, lane, nd, bn, ab); if (g == qq) { b1 = bn; above1 = ab; } }
            __syncthreads();
        } else if (pass == 1) {
#pragma unroll
            for (int qq = 0; qq < 4; ++qq) { const unsigned nd = shu(need - above1, 16 * qq); unsigned bn, ab; hist_find(hist + (size_t)(4 * wid + qq) * 1024, lane, nd, bn, ab); if (g == qq) { thr22 = (b1 << 11) | bn; quota = need - above1 - ab; } }
            __syncthreads();
        }
    }
}


#ifndef SELREP
#define SELREP 0
#endif
constexpr int DS_CAP = 576, DS_RANK = 104;
constexpr unsigned ZCLASS = 0x80000000u >> 10;
__device__ __forceinline__ unsigned below_me(unsigned long long bal) { return __builtin_amdgcn_mbcnt_hi((unsigned)(bal >> 32), __builtin_amdgcn_mbcnt_lo((unsigned)bal, 0u)); }
__device__ __forceinline__ float relu1(float x) { return __builtin_amdgcn_fmed3f(x, 0.0f, 3.0e38f); }
__device__ __forceinline__ float idx_score_acc(const f32x4& acc, const f32x4& wv) {
    return fmaf(wv[3], relu1(acc[3]), fmaf(wv[2], relu1(acc[2]), fmaf(wv[1], relu1(acc[1]), wv[0] * relu1(acc[0])))) + 0.0f;
}
__device__ __forceinline__ unsigned fkey(float s) { const unsigned u = __float_as_uint(s); return (u & 0x80000000u) ? ~u : (u | 0x80000000u); }
__device__ __forceinline__ float key_to_float(unsigned k) { return k == 0u ? -INFINITY : __uint_as_float((k & 0x80000000u) ? (k & 0x7fffffffu) : ~k); }
__device__ __forceinline__ void idx_scores8(const unsigned char* kt, int c16, int g, const bf16x8 (&af)[2], const f32x4& wv, float (&u)[8]) {
    bf16x8 kf[8][2];
#pragma unroll
    for (int grp = 0; grp < 8; ++grp) { kf[grp][0] = *(const bf16x8*)(kt + (16 * grp + c16) * 144 + (8 * g) * 2); kf[grp][1] = *(const bf16x8*)(kt + (16 * grp + c16) * 144 + (32 + 8 * g) * 2); }
    __builtin_amdgcn_sched_barrier(0);
    f32x4 acc[8];
#pragma unroll
    for (int grp = 0; grp < 8; ++grp) acc[grp] = __builtin_amdgcn_mfma_f32_16x16x32_bf16(af[0], kf[grp][0], (f32x4){0.f, 0.f, 0.f, 0.f}, 0, 0, 0);
#pragma unroll
    for (int grp = 0; grp < 8; ++grp) acc[grp] = __builtin_amdgcn_mfma_f32_16x16x32_bf16(af[1], kf[grp][1], acc[grp], 0, 0, 0);
    __builtin_amdgcn_sched_barrier(0);
#pragma unroll
    for (int grp = 0; grp < 8; ++grp) u[grp] = idx_score_acc(acc[grp], wv);
}
__device__ __forceinline__ unsigned row_scan_incl(unsigned x) {
    x += (unsigned)__builtin_amdgcn_update_dpp(0, (int)x, 0x111, 0xF, 0xF, true);
    x += (unsigned)__builtin_amdgcn_update_dpp(0, (int)x, 0x112, 0xF, 0xF, true);
    x += (unsigned)__builtin_amdgcn_update_dpp(0, (int)x, 0x114, 0xF, 0xF, true);
    x += (unsigned)__builtin_amdgcn_update_dpp(0, (int)x, 0x118, 0xF, 0xF, true);
    return x;
}
__device__ __forceinline__ unsigned wave_total(unsigned x) {
    x = row_scan_incl(x);
    return (unsigned)__builtin_amdgcn_readlane((int)x, 15) + (unsigned)__builtin_amdgcn_readlane((int)x, 31) + (unsigned)__builtin_amdgcn_readlane((int)x, 47) + (unsigned)__builtin_amdgcn_readlane((int)x, 63);
}
__device__ __forceinline__ unsigned wave_max_u(unsigned x) {
    unsigned y;
    y = (unsigned)__builtin_amdgcn_update_dpp(0, (int)x, 0x111, 0xF, 0xF, true); x = x > y ? x : y;
    y = (unsigned)__builtin_amdgcn_update_dpp(0, (int)x, 0x112, 0xF, 0xF, true); x = x > y ? x : y;
    y = (unsigned)__builtin_amdgcn_update_dpp(0, (int)x, 0x114, 0xF, 0xF, true); x = x > y ? x : y;
    y = (unsigned)__builtin_amdgcn_update_dpp(0, (int)x, 0x118, 0xF, 0xF, true); x = x > y ? x : y;
    const unsigned a = (unsigned)__builtin_amdgcn_readlane((int)x, 15), b = (unsigned)__builtin_amdgcn_readlane((int)x, 31), c = (unsigned)__builtin_amdgcn_readlane((int)x, 47), d = (unsigned)__builtin_amdgcn_readlane((int)x, 63);
    const unsigned ab = a > b ? a : b, cd = c > d ? c : d; return ab > cd ? ab : cd;
}
template <bool EDGE, bool NEEDZ>
__device__ __forceinline__ void selB_groups(const float (&sc)[8], int keybase, int myt, float tauf, unsigned need, int lane, int c16, int g, unsigned& cnt, unsigned& zc, unsigned* curow, unsigned char* chrow, unsigned short* zlrow) {
    unsigned hm = 0u;
#pragma unroll
    for (int grp = 0; grp < 8; ++grp) {
        const float s = sc[grp];
        bool h = NEEDZ ? ((s >= tauf) && (s != 0.0f)) : (s >= tauf);
        if (EDGE) h = h && (keybase + 16 * grp + c16 <= myt);
        hm |= h ? (1u << grp) : 0u;
    }
    const unsigned nh = (unsigned)__popc(hm), inc = row_scan_incl(nh);
    unsigned pos = cnt + inc - nh;
    cnt += shu(inc, (lane & 48) | 15);
    unsigned rem = hm;
    while (__ballot(rem != 0u)) {
        if (rem) {
            const int grp = __builtin_ctz(rem); rem &= rem - 1u;
            const float a0 = (grp & 1) ? sc[1] : sc[0], a1 = (grp & 1) ? sc[3] : sc[2], a2 = (grp & 1) ? sc[5] : sc[4], a3 = (grp & 1) ? sc[7] : sc[6];
            const float b0 = (grp & 2) ? a1 : a0, b1 = (grp & 2) ? a3 : a2, s = (grp & 4) ? b1 : b0;
            const int key = keybase + 16 * grp + c16;
            if (pos < (unsigned)DS_CAP) { curow[pos] = (fkey(s) & 0xfffffc00u) | ((unsigned)key & 1023u); chrow[pos] = (unsigned char)(key >> 10); }
            ++pos;
        }
    }
    if (NEEDZ) {
        const unsigned lowm = (1u << c16) - 1u;
#pragma unroll
        for (int grp = 0; grp < 8; ++grp) {
            const int key = keybase + 16 * grp + c16;
            bool isz = sc[grp] == 0.0f;
            if (EDGE) isz = isz && (key <= myt);
            const unsigned zmask = (unsigned)(__ballot(isz) >> (16 * g)) & 0xffffu;
            const unsigned zpos = zc + __popc(zmask & lowm);
            if (isz && zpos < need) zlrow[zpos] = (unsigned short)key;
            zc += __popc(zmask);
        }
    }
}
__device__ __forceinline__ void dsa_select_item(const Args& a, unsigned char* lds, int b, int qb32, int wid_s) {
    const int tid = ftid(wid_s), lane = tid & 63; const int wid = __builtin_amdgcn_readfirstlane(tid >> 6);
    const int c16 = lane & 15, g = lane >> 4;
    const bf16_t* Z = (const bf16_t*)(a.ws + WS_Z); const float* SM = (const float*)(a.ws + WS_SMALL);
    unsigned short* IDX = (unsigned short*)(a.ws + WS_MG);
    unsigned short* samp = (unsigned short*)lds;
    unsigned char* ktA = lds + 131072;
    unsigned* cu = (unsigned*)lds;
    unsigned char* ch = lds + 73728;
    unsigned short* zl = (unsigned short*)(lds + 92160);
    unsigned char* ktB = lds + 108544;
    unsigned* flag = (unsigned*)(lds + 149760);
    const size_t rowbase = (size_t)b * SEQ;
    const int t0 = qb32 * 32, myt = t0 + 4 * wid + g, myrow = 4 * wid + g;
    bf16x8 af[2];
    { const int qq = c16 >> 2, h = c16 & 3; const bf16_t* qp = Z + (rowbase + t0 + 4 * wid + qq) * ZW + ZC_DQI + h * 64 + 8 * g;
      af[0] = *(const bf16x8*)qp; af[1] = *(const bf16x8*)(qp + 32); }
#ifdef PROBE_QTRUNC
    { u32x4 t0_ = __builtin_bit_cast(u32x4, af[0]), t1_ = __builtin_bit_cast(u32x4, af[1]); const unsigned mk = 0xfffcfffcu;
      t0_.x &= mk; t0_.y &= mk; t0_.z &= mk; t0_.w &= mk; t1_.x &= mk; t1_.y &= mk; t1_.z &= mk; t1_.w &= mk; af[0] = __builtin_bit_cast(bf16x8, t0_); af[1] = __builtin_bit_cast(bf16x8, t1_); }
#endif
    const f32x4 wv = *(const f32x4*)(SM + (rowbase + myt) * 8);
    const unsigned need = (unsigned)((myt + 1) < 256 ? (myt + 1) : 256);
    const int srow = tid >> 3, sch = tid & 7;
    __syncthreads();
    if (tid == 0) *flag = 0u;
    unsigned tau = 0u;
    for (int repA_ = 0; repA_ < ((SELREP & 1) ? 2 : 1); ++repA_)
    if (t0 + 32 > DS_CAP) {
        __syncthreads();
        const int ms = (t0 + 32) >> 2, ntA = (ms + 127) >> 7;
        const bf16_t* sbase = Z + (rowbase + 3) * ZW + ZC_DKI + sch * 8;
        u32x4 n0, n1;
        { const int i0 = srow < ms ? srow : ms - 1, i1 = 64 + srow < ms ? 64 + srow : ms - 1;
          n0 = *(const u32x4*)(sbase + (size_t)(4 * i0) * ZW); n1 = *(const u32x4*)(sbase + (size_t)(4 * i1) * ZW); }
        for (int T = 0; T < ntA; ++T) {
            __syncthreads();
            *(u32x4*)(ktA + srow * 144 + sch * 16) = n0; *(u32x4*)(ktA + (64 + srow) * 144 + sch * 16) = n1;
            __syncthreads();
            if (T + 1 < ntA) { const int j0 = 128 * (T + 1) + srow, j1 = j0 + 64; const int i0 = j0 < ms ? j0 : ms - 1, i1 = j1 < ms ? j1 : ms - 1;
                n0 = *(const u32x4*)(sbase + (size_t)(4 * i0) * ZW); n1 = *(const u32x4*)(sbase + (size_t)(4 * i1) * ZW); }
            float ua[8]; idx_scores8(ktA, c16, g, af, wv, ua);
#pragma unroll
            for (int grp = 0; grp < 8; ++grp) {
                const int i = 128 * T + 16 * grp + c16;
                samp[myrow * 2048 + i] = ((i < ms) && (4 * i + 3 <= myt)) ? (unsigned short)(fkey(ua[grp]) >> 16) : (unsigned short)0;
            }
        }
        LDSWAIT();
        const int nvalid = 128 * ntA;
        for (int repS_ = 0; repS_ < ((SELREP & 16) ? 2 : 1); ++repS_) {
            unsigned w[4][16];
#pragma unroll
            for (int qq = 0; qq < 4; ++qq) {
                const unsigned* sp = (const unsigned*)(samp + (4 * wid + qq) * 2048) + 16 * lane;
#pragma unroll
                for (int j = 0; j < 16; j += 4) { const u32x4 t4 = *(const u32x4*)(sp + j); w[qq][j] = t4.x; w[qq][j + 1] = t4.y; w[qq][j + 2] = t4.z; w[qq][j + 3] = t4.w; }
#pragma unroll
                for (int j = 0; j < 16; ++j) if (32 * lane + 2 * j >= nvalid) w[qq][j] = 0u;
            }
            unsigned T4[4] = {0u, 0u, 0u, 0u};
#pragma unroll 1
            for (int bit = 15; bit >= 0; --bit) {
                unsigned c[4];
#pragma unroll
                for (int qq = 0; qq < 4; ++qq) { const unsigned cand = T4[qq] | (1u << bit); unsigned cc = 0;
#pragma unroll
                    for (int j = 0; j < 16; ++j) cc += ((w[qq][j] & 0xffffu) >= cand ? 1u : 0u) + ((w[qq][j] >> 16) >= cand ? 1u : 0u);
                    c[qq] = cc; }
                const unsigned t01 = wave_total(c[0] | (c[1] << 16)), t23 = wave_total(c[2] | (c[3] << 16));
                if ((t01 & 0xffffu) >= (unsigned)DS_RANK) T4[0] |= 1u << bit;
                if ((t01 >> 16) >= (unsigned)DS_RANK) T4[1] |= 1u << bit;
                if ((t23 & 0xffffu) >= (unsigned)DS_RANK) T4[2] |= 1u << bit;
                if ((t23 >> 16) >= (unsigned)DS_RANK) T4[3] |= 1u << bit;
            }
#pragma unroll
            for (int qq = 0; qq < 4; ++qq) { const int n = t0 + 4 * wid + qq + 1; if (g == qq) tau = n > DS_CAP ? (T4[qq] << 16) : 0u; }
        }
    }
    unsigned cnt = 0u, zc = 0u;
    const float tauf = key_to_float(tau);
    const bool needz = __ballot(tauf <= 0.0f) != 0ull;
    const int ntile = (t0 + 32 + 127) >> 7;
    for (int repB_ = 0; repB_ < ((SELREP & 2) ? 2 : 1); ++repB_) { cnt = 0u; zc = 0u;
        const bf16_t* kbase = Z + (rowbase + srow) * ZW + ZC_DKI + sch * 8;
        u32x4 n0 = *(const u32x4*)kbase, n1 = *(const u32x4*)(kbase + (size_t)64 * ZW);
        __syncthreads();
        *(u32x4*)(ktB + srow * 144 + sch * 16) = n0; *(u32x4*)(ktB + (64 + srow) * 144 + sch * 16) = n1;
        __syncthreads();
        for (int T = 0; T < ntile; ++T) {
            const unsigned char* kt = ktB + (T & 1) * 18432;
            if (T + 1 < ntile) { const bf16_t* src = kbase + (size_t)(128 * (T + 1)) * ZW; n0 = *(const u32x4*)src; n1 = *(const u32x4*)(src + (size_t)64 * ZW); }
            float ub[8]; idx_scores8(kt, c16, g, af, wv, ub);
            if (128 * T + 127 <= t0) { if (needz) selB_groups<false, true>(ub, 128 * T, myt, tauf, need, lane, c16, g, cnt, zc, cu + myrow * DS_CAP, ch + myrow * DS_CAP, zl + myrow * 256);
                                       else selB_groups<false, false>(ub, 128 * T, myt, tauf, need, lane, c16, g, cnt, zc, cu + myrow * DS_CAP, ch + myrow * DS_CAP, zl + myrow * 256); }
            else { if (needz) selB_groups<true, true>(ub, 128 * T, myt, tauf, need, lane, c16, g, cnt, zc, cu + myrow * DS_CAP, ch + myrow * DS_CAP, zl + myrow * 256);
                   else selB_groups<true, false>(ub, 128 * T, myt, tauf, need, lane, c16, g, cnt, zc, cu + myrow * DS_CAP, ch + myrow * DS_CAP, zl + myrow * 256); }
            if (T + 1 < ntile) { unsigned char* kn = ktB + ((T + 1) & 1) * 18432; *(u32x4*)(kn + srow * 144 + sch * 16) = n0; *(u32x4*)(kn + (64 + srow) * 144 + sch * 16) = n1; }
            __syncthreads();
        }
    }
#if SELREP & 8
    {
        float dummy = 0.f;
        const bf16_t* kbase = Z + (rowbase + srow) * ZW + ZC_DKI + sch * 8;
        u32x4 n0 = *(const u32x4*)kbase, n1 = *(const u32x4*)(kbase + (size_t)64 * ZW);
        __syncthreads();
        *(u32x4*)(ktB + srow * 144 + sch * 16) = n0; *(u32x4*)(ktB + (64 + srow) * 144 + sch * 16) = n1;
        __syncthreads();
        for (int T = 0; T < ntile; ++T) {
            const unsigned char* kt = ktB + (T & 1) * 18432;
            if (T + 1 < ntile) { const bf16_t* src = kbase + (size_t)(128 * (T + 1)) * ZW; n0 = *(const u32x4*)src; n1 = *(const u32x4*)(src + (size_t)64 * ZW); }
            float ub[8]; idx_scores8(kt, c16, g, af, wv, ub);
#pragma unroll
            for (int grp = 0; grp < 8; ++grp) dummy += ub[grp];
            if (T + 1 < ntile) { unsigned char* kn = ktB + ((T + 1) & 1) * 18432; *(u32x4*)(kn + srow * 144 + sch * 16) = n0; *(u32x4*)(kn + (64 + srow) * 144 + sch * 16) = n1; }
            __syncthreads();
        }
        if (dummy == 123456.789f) *flag = 2u;
    }
#endif
    LDSWAIT();
    bool bad = false;
    for (int repC_ = 0; repC_ < ((SELREP & 4) ? 2 : 1); ++repC_) {
        unsigned ncq[4], ndq[4], nzq[4], uj[4][9], T4[4]; int topb[4];
#pragma unroll
        for (int qq = 0; qq < 4; ++qq) {
            ncq[qq] = (unsigned)__builtin_amdgcn_readlane((int)cnt, 16 * qq); ndq[qq] = (unsigned)__builtin_amdgcn_readlane((int)need, 16 * qq); nzq[qq] = (unsigned)__builtin_amdgcn_readlane((int)zc, 16 * qq);
            const unsigned ncl = ncq[qq] < (unsigned)DS_CAP ? ncq[qq] : (unsigned)DS_CAP;
            unsigned hi = 0u, lo = 0u;
#pragma unroll
            for (int j = 0; j < 9; ++j) { const unsigned pos = lane + 64 * j; const bool in = pos < ncl; uj[qq][j] = in ? (cu[(4 * wid + qq) * DS_CAP + pos] >> 10) : 0u;
                hi = hi > uj[qq][j] ? hi : uj[qq][j]; const unsigned x = in ? ~uj[qq][j] : 0u; lo = lo > x ? lo : x; }
            hi = wave_max_u(hi); lo = ~wave_max_u(lo);
            if (ncl == 0u) lo = hi;
            if (nzq[qq]) { hi = hi > ZCLASS ? hi : ZCLASS; lo = lo < ZCLASS ? lo : ZCLASS; }
            topb[qq] = (hi ^ lo) ? 31 - __builtin_clz(hi ^ lo) : -1;
            T4[qq] = topb[qq] >= 0 ? (hi & ~((2u << topb[qq]) - 1u)) : hi;
        }
#pragma unroll 1
        for (int bit = 21; bit >= 0; --bit) {
            unsigned c[4];
#pragma unroll
            for (int qq = 0; qq < 4; ++qq) { const unsigned cand = T4[qq] | (1u << bit); unsigned cc = 0;
#pragma unroll
                for (int j = 0; j < 9; ++j) cc += uj[qq][j] >= cand ? 1u : 0u;
                c[qq] = cc; }
            const unsigned t01 = wave_total(c[0] | (c[1] << 16)), t23 = wave_total(c[2] | (c[3] << 16));
            const unsigned tq[4] = {t01 & 0xffffu, t01 >> 16, t23 & 0xffffu, t23 >> 16};
#pragma unroll
            for (int qq = 0; qq < 4; ++qq) { const unsigned cand = T4[qq] | (1u << bit);
                if (bit <= topb[qq] && tq[qq] + (cand <= ZCLASS ? nzq[qq] : 0u) >= ndq[qq]) T4[qq] = cand; }
        }
#pragma unroll 1
        for (int qq = 0; qq < 4; ++qq) {
            const unsigned nc = ncq[qq], nd = ndq[qq], nz = nzq[qq], T = T4[qq];
            if (nc + nz < nd || nc > (unsigned)DS_CAP) { bad = true;
#ifdef NOFALLBACK
                { unsigned short* orow = IDX + (rowbase + t0 + 4 * wid + qq) * 256;
                  for (int j = 0; j < 4; ++j) if ((unsigned)(lane + 64 * j) < nd) orow[lane + 64 * j] = (unsigned short)(lane + 64 * j); }
#endif
                continue; }
            const int row = 4 * wid + qq;
            unsigned ujr[9], kj[9]; int ca = T < ZCLASS ? (int)nz : 0, nt = 0;
#pragma unroll
            for (int j = 0; j < 9; ++j) { const unsigned pos = lane + 64 * j; const unsigned cwj = pos < nc ? cu[row * DS_CAP + pos] : 0u; ujr[j] = cwj >> 10;
                kj[j] = pos < nc ? ((cwj & 1023u) | ((unsigned)ch[row * DS_CAP + pos] << 10)) : 0u;
                ca += __popcll(__ballot(ujr[j] > T)); nt += __popcll(__ballot(ujr[j] == T)); }
            const unsigned quota = nd - (unsigned)ca;
            unsigned Kstar = 0xffffu;
            if (T != ZCLASS && (unsigned)nt > quota) {
                unsigned K = 0u;
#pragma unroll 1
                for (int bit = 12; bit >= 0; --bit) { const unsigned test = K | (1u << bit); int c = 0;
#pragma unroll
                    for (int j = 0; j < 9; ++j) c += __popcll(__ballot(ujr[j] == T && kj[j] < test));
                    if ((unsigned)c < quota) K = test; }
                Kstar = K;
            }
            unsigned outbase = 0u;
            unsigned short* orow = IDX + (rowbase + t0 + row) * 256;
#pragma unroll
            for (int j = 0; j < 9; ++j) {
                const bool s = (ujr[j] > T) || (ujr[j] == T && kj[j] <= Kstar);
                const unsigned long long sb = __ballot(s);
                if (s) orow[outbase + below_me(sb)] = (unsigned short)kj[j];
                outbase += (unsigned)__popcll(sb);
            }
            const unsigned zsel = T < ZCLASS ? nz : (T == ZCLASS ? quota : 0u);
            for (unsigned i = lane; i < zsel; i += 64) orow[outbase + i] = zl[row * 256 + i];
        }
    }
    if (bad && lane == 0) atomicOr(flag, 1u);
    __syncthreads();
    const bool redo = *flag != 0u;
    __syncthreads();
#ifndef NOFALLBACK
    if (redo) dsa_select_slow(a, lds, b, qb32, wid_s);
#endif
}

constexpr int DA_WAVE_LDS = 512 + 64 * 160;
__device__ __forceinline__ void dsa_attend_wave(const Args& a, int gw, int NGW, int lane, unsigned char* wl) {
    const bf16_t* Z = (const bf16_t*)(a.ws + WS_Z); const unsigned short* IDXB = (const unsigned short*)(a.ws + WS_MG);
    bf16_t* Y1 = (bf16_t*)(a.ws + WS_H) + (size_t)MROWS * 256;
    const int c16 = lane & 15, g = lane >> 4, vr = lane >> 3, vc = lane & 7;
    unsigned short* il = (unsigned short*)wl; unsigned char* vl = wl + 512;
    const float slope2 = LOG2E * __builtin_amdgcn_exp2f(-(float)(5 + (c16 & 3)));
    const LAS unsigned char* vtr = (const LAS unsigned char*)vl + (4 * g + (c16 >> 2)) * 160 + (4 * (c16 & 3)) * 2;
    u32x2 iw = {0u, 0u};
    if (gw < MROWS) iw = *(const u32x2*)(IDXB + (size_t)gw * 256 + 4 * lane);
#pragma unroll 1
    for (int row = gw; row < MROWS; row += NGW) {
        const int t = row & (SEQ - 1); const size_t rowbase = (size_t)(row - t);
        const int nsel = (t + 1) < 256 ? (t + 1) : 256;
        { u32x2 w = iw; const int p0 = 4 * lane;
          if (p0 >= nsel) w.x &= 0xffff0000u; if (p0 + 1 >= nsel) w.x &= 0x0000ffffu; if (p0 + 2 >= nsel) w.y &= 0xffff0000u; if (p0 + 3 >= nsel) w.y &= 0x0000ffffu;
          *(u32x2*)(il + 4 * lane) = w; }
        if (row + NGW < MROWS) iw = *(const u32x2*)(IDXB + (size_t)(row + NGW) * 256 + 4 * lane);
        LDSWAIT();
        u32x4 v[8];
        const bf16_t* vb = Z + rowbase * ZW + ZC_DV + 8 * vc;
        const bf16_t* kb8 = Z + rowbase * ZW + ZC_DK + 8 * vc;
#pragma unroll
        for (int i = 0; i < 8; ++i) v[i] = *(const u32x4*)(kb8 + (size_t)il[8 * i + vr] * ZW);
        bf16x8 qf[2];
        { const bf16_t* qp = Z + (size_t)row * ZW + ZC_DQ + (c16 & 3) * 64 + 8 * g; const bf16x8 z8 = {0, 0, 0, 0, 0, 0, 0, 0};
          qf[0] = c16 < 4 ? *(const bf16x8*)qp : z8; qf[1] = c16 < 4 ? *(const bf16x8*)(qp + 32) : z8; }
        f32x4 s[16];
#pragma unroll
        for (int ch = 0; ch < 4; ++ch) {
            if (64 * ch < nsel) {
#pragma unroll
                for (int i = 0; i < 8; ++i) *(u32x4*)(vl + (8 * i + vr) * 144 + 16 * vc) = v[i];
                if (ch < 3 && 64 * (ch + 1) < nsel) {
#pragma unroll
                    for (int i = 0; i < 8; ++i) v[i] = *(const u32x4*)(kb8 + (size_t)il[64 * (ch + 1) + 8 * i + vr] * ZW);
                } else {
#pragma unroll
                    for (int i = 0; i < 8; ++i) v[i] = *(const u32x4*)(vb + (size_t)il[8 * i + vr] * ZW);
                }
                LDSWAIT();
#pragma unroll
                for (int tt = 0; tt < 4; ++tt) {
                    const bf16x8 k0 = *(const bf16x8*)(vl + (16 * tt + c16) * 144 + (8 * g) * 2), k1 = *(const bf16x8*)(vl + (16 * tt + c16) * 144 + (32 + 8 * g) * 2);
                    f32x4 acc = {0.f, 0.f, 0.f, 0.f};
                    acc = __builtin_amdgcn_mfma_f32_16x16x32_bf16(k0, qf[0], acc, 0, 0, 0);
                    acc = __builtin_amdgcn_mfma_f32_16x16x32_bf16(k1, qf[1], acc, 0, 0, 0);
                    s[4 * ch + tt] = acc; }
                asm volatile("" ::: "memory");
            } else {
#pragma unroll
                for (int tt = 0; tt < 4; ++tt) s[4 * ch + tt] = (f32x4){0.f, 0.f, 0.f, 0.f};
            }
        }
        float mx = -INFINITY;
#pragma unroll
        for (int kb = 0; kb < 16; ++kb) {
            const u32x2 kw = *(const u32x2*)(il + 16 * kb + 4 * g); const int p0 = 16 * kb + 4 * g;
            const int k0 = kw.x & 0xffff, k1 = kw.x >> 16, k2 = kw.y & 0xffff, k3 = kw.y >> 16;
            s[kb][0] = p0 < nsel ? s[kb][0] * C2 - slope2 * (float)(t - k0) : -INFINITY;
            s[kb][1] = p0 + 1 < nsel ? s[kb][1] * C2 - slope2 * (float)(t - k1) : -INFINITY;
            s[kb][2] = p0 + 2 < nsel ? s[kb][2] * C2 - slope2 * (float)(t - k2) : -INFINITY;
            s[kb][3] = p0 + 3 < nsel ? s[kb][3] * C2 - slope2 * (float)(t - k3) : -INFINITY;
            mx = fmaxf(fmaxf(mx, fmaxf(s[kb][0], s[kb][1])), fmaxf(s[kb][2], s[kb][3]));
        }
        mx = fmaxf(mx, shf(mx, lane ^ 16)); mx = fmaxf(mx, shf(mx, lane ^ 32));
        float ls = 0.f;
#pragma unroll
        for (int kb = 0; kb < 16; ++kb) {
#pragma unroll
            for (int r = 0; r < 4; ++r) { s[kb][r] = __builtin_amdgcn_exp2f(s[kb][r] - mx); ls += s[kb][r]; } }
        ls += shf(ls, lane ^ 16); ls += shf(ls, lane ^ 32);
        f32x4 o[4];
#pragma unroll
        for (int db = 0; db < 4; ++db) o[db] = (f32x4){0.f, 0.f, 0.f, 0.f};
#pragma unroll
        for (int ch = 0; ch < 4; ++ch) {
            if (64 * ch < nsel) {
#pragma unroll
                for (int i = 0; i < 8; ++i) *(u32x4*)(vl + (8 * i + vr) * 160 + 16 * vc) = v[i];
                if (ch < 3 && 64 * (ch + 1) < nsel) {
#pragma unroll
                    for (int i = 0; i < 8; ++i) v[i] = *(const u32x4*)(vb + (size_t)il[64 * (ch + 1) + 8 * i + vr] * ZW);
                }
                LDSWAIT();
#pragma unroll
                for (int s2 = 0; s2 < 2; ++s2) {
                    const f32x4 pa4 = s[4 * ch + 2 * s2], pb4 = s[4 * ch + 2 * s2 + 1];
                    u32x4 pw; pw.x = pk2(pa4[0], pa4[1]); pw.y = pk2(pa4[2], pa4[3]); pw.z = pk2(pb4[0], pb4[1]); pw.w = pk2(pb4[2], pb4[3]);
                    const bf16x8 pa = __builtin_bit_cast(bf16x8, pw);
#pragma unroll
                    for (int db = 0; db < 4; ++db) {
                        const LAS unsigned char* vp = vtr + (32 * s2) * 160 + 32 * db;
                        const s16x4 lo = __builtin_bit_cast(s16x4, __builtin_amdgcn_ds_read_tr16_b64_v4i16((LAS s16x4*)vp));
                        const s16x4 hv = __builtin_bit_cast(s16x4, __builtin_amdgcn_ds_read_tr16_b64_v4i16((LAS s16x4*)(vp + 16 * 160)));
                        const bf16x8 vf = (bf16x8){lo[0], lo[1], lo[2], lo[3], hv[0], hv[1], hv[2], hv[3]};
                        o[db] = __builtin_amdgcn_mfma_f32_16x16x32_bf16(pa, vf, o[db], 0, 0, 0);
                    }
                }
                asm volatile("" ::: "memory");
            }
        }
        const int lsi = __float_as_int(ls);
        const float i0 = 1.0f / __int_as_float(__builtin_amdgcn_readlane(lsi, 0)), i1 = 1.0f / __int_as_float(__builtin_amdgcn_readlane(lsi, 1)), i2 = 1.0f / __int_as_float(__builtin_amdgcn_readlane(lsi, 2)), i3 = 1.0f / __int_as_float(__builtin_amdgcn_readlane(lsi, 3));
        if (g == 0) { bf16_t* yp = Y1 + (size_t)row * 256 + c16;
#pragma unroll
            for (int db = 0; db < 4; ++db) { yp[0 * 64 + 16 * db] = (bf16_t)f2bf(o[db][0] * i0); yp[1 * 64 + 16 * db] = (bf16_t)f2bf(o[db][1] * i1); yp[2 * 64 + 16 * db] = (bf16_t)f2bf(o[db][2] * i2); yp[3 * 64 + 16 * db] = (bf16_t)f2bf(o[db][3] * i3); } }
        LDSWAIT();
    }
}


#ifndef PHMASK
#define PHMASK 0xffff
#endif
#ifndef DUPMASK
#define DUPMASK 0
#endif
#ifndef DUPN
#define DUPN 2
#endif
#ifndef MERGE_SP2
#define MERGE_SP2 true
#endif
#ifndef G8_SP2
#define G8_SP2 false
#endif
#ifndef EXTRASYNC
#define EXTRASYNC 0
#endif
typedef __attribute__((address_space(1))) unsigned gu32;
#define XB_TMO      128
#define XB_XCNT(j)  (256  + 64 * (j))
#define XB_XSUB(j)  (1280 + 64 * (j))
#define XB_XGEN(j)  (2304 + 64 * (j))
#define XB_TOP      3328
#define XB_TOPGEN   3392
#define XCD_BAR_WORDS 3456
#define XB_SPIN_CAP (1u << 18)

__device__ __forceinline__ unsigned xb_ld(unsigned* p)              { return __hip_atomic_load(p, __ATOMIC_RELAXED, __HIP_MEMORY_SCOPE_AGENT); }
__device__ __forceinline__ unsigned xb_add(unsigned* p, unsigned v) { return __hip_atomic_fetch_add(p, v, __ATOMIC_RELAXED, __HIP_MEMORY_SCOPE_AGENT); }
__device__ __forceinline__ unsigned xb_xcc_id() { return (unsigned)__builtin_amdgcn_s_getreg((3 << 11) | 20) & 0xFu; }
#define XB_SPIN(cond, bar) do { unsigned _sp = 0; while (cond) { __builtin_amdgcn_s_sleep(1); \
    if ((++_sp & 255u) == 0u) { if (xb_ld(&(bar)[XB_TMO])) break; if (_sp > XB_SPIN_CAP) { atomicAdd(&(bar)[XB_TMO], 1u); break; } } } } while (0)

struct XcdBarrier {
    unsigned* bar; unsigned x; int w;
    volatile LAS unsigned* st;
};

__device__ __forceinline__ bool xb_first_lane(int w) { unsigned ones = ~0u; asm volatile("" : "+s"(ones)); return w == 0 && __builtin_amdgcn_mbcnt_hi(ones, __builtin_amdgcn_mbcnt_lo(ones, 0u)) == 0u; }
__device__ __forceinline__ XcdBarrier xcd_barrier_post(unsigned* bar, volatile LAS unsigned* st, int w) {
    XcdBarrier b; b.bar = bar; b.x = xb_xcc_id(); b.st = st; b.w = w;
    if (xb_first_lane(w)) (void)xb_add(&bar[XB_XCNT(b.x)], 1u);
    return b;
}
__device__ __forceinline__ void xcd_barrier_complete(unsigned* bar, unsigned x, unsigned& nloc, unsigned& nx) {
    const unsigned G = gridDim.x * gridDim.y * gridDim.z;
    unsigned sum, cnt, mine, sp = 0u;
    for (;;) {
        sum = 0u; cnt = 0u; mine = 0u;
#pragma unroll
        for (unsigned j = 0; j < 16; ++j) { const unsigned c = xb_ld(&bar[XB_XCNT(j)]); sum += c; cnt += (c > 0u) ? 1u : 0u; mine = (j == x) ? c : mine; }
        if (sum == G) break;
        __builtin_amdgcn_s_sleep(1);
        if ((++sp & 255u) == 0u) { if (xb_ld(&bar[XB_TMO])) break; if (sp > XB_SPIN_CAP) { atomicAdd(&bar[XB_TMO], 1u); break; } }
    }
    nloc = mine > 0u ? mine : 1u; nx = cnt > 0u ? cnt : 1u;
}

__device__ __forceinline__ void xcd_barrier(const XcdBarrier& b) {
    asm volatile("s_waitcnt vmcnt(0)" ::: "memory");
    __syncthreads();
    if (xb_first_lane(b.w)) {
        unsigned* bar = b.bar;
        __builtin_amdgcn_s_waitcnt(0);
        unsigned nloc = b.st[0], nx = b.st[1];
        if (nloc == 0u) { xcd_barrier_complete(bar, b.x, nloc, nx); b.st[0] = nloc; b.st[1] = nx; }
        const unsigned old = xb_add(&bar[XB_XSUB(b.x)], 1u);
        const unsigned gen = old / nloc;
        if (old + 1u == (gen + 1u) * nloc) {
            __builtin_amdgcn_fence(__ATOMIC_RELEASE, "agent");
            asm volatile("s_waitcnt vmcnt(0)" ::: "memory");
            const unsigned og = xb_add(&bar[XB_TOP], 1u);
            const unsigned tg = og / nx;
            if (og + 1u == (tg + 1u) * nx) xb_add(&bar[XB_TOPGEN], 1u);
            else XB_SPIN(xb_ld(&bar[XB_TOPGEN]) == tg, bar);
            __builtin_amdgcn_fence(__ATOMIC_ACQUIRE, "agent");
            xb_add(&bar[XB_XGEN(b.x)], 1u);
            asm volatile("s_waitcnt vmcnt(0)" ::: "memory");
        } else {
            XB_SPIN(xb_ld(&bar[XB_XGEN(b.x)]) == gen, bar);
            __builtin_amdgcn_fence(__ATOMIC_ACQUIRE, "agent");
            asm volatile("s_waitcnt vmcnt(0)" ::: "memory");
        }
    }
    __syncthreads();
}

constexpr size_t WS_BAR = 16384;
constexpr int LDS_BARST = LDS_BYTES - 16;
#define GRID_SYNC() xcd_barrier(bar)
typedef const __attribute__((address_space(4))) Args* kargs_ptr;
__device__ __forceinline__ Args fresh_args() {
#if defined(__HIP_DEVICE_COMPILE__)
    kargs_ptr p = (kargs_ptr)__builtin_amdgcn_kernarg_segment_ptr(); asm volatile("" : "+s"(p)); return *p;
#else
    return Args{};
#endif
}
#define FRESH() const int tid = ftid(wid_s), lane = tid & 63, wid = __builtin_amdgcn_readfirstlane(tid >> 6), gw = blockIdx.x * 8 + wid, NGW = gridDim.x * 8; (void)lane; (void)gw; (void)NGW
#define WSP(T, off) ((T*)(a.ws + (off)))
__global__ void __launch_bounds__(512, 2) mega(Args a_unused) {
    extern __shared__ __attribute__((aligned(16))) unsigned char lds[];
    PG8_LAS unsigned char* lds3 = (PG8_LAS unsigned char*)lds;
    const int wid_s = __builtin_amdgcn_readfirstlane(threadIdx.x >> 6);
    if (threadIdx.x < 4) ((volatile LAS unsigned*)(lds3 + LDS_BARST))[threadIdx.x] = 0u;
    __syncthreads();
    XcdBarrier bar; { const Args a0 = fresh_args(); bar = xcd_barrier_post((unsigned*)(a0.ws + WS_BAR), (volatile LAS unsigned*)(lds3 + LDS_BARST), wid_s); }

#if PHMASK & 1
    for (int rep_ = 0; rep_ < ((DUPMASK & 1) ? DUPN : 1); ++rep_) { if (rep_) GRID_SYNC();
    { const Args a = fresh_args(); if (blockIdx.x == 0 && threadIdx.x < 16) WSP(unsigned, WS_KMAX)[threadIdx.x] = 0u; ada_gemv(a, lds, wid_s); convert_weights(a, 0, lds, wid_s); }
    }
#endif
    GRID_SYNC();
#if PHMASK & 2
    for (int rep_ = 0; rep_ < ((DUPMASK & 2) ? DUPN : 1); ++rep_) { if (rep_) GRID_SYNC();
    { const Args a = fresh_args(); FRESH();
      for (int row = gw * 8; row < MROWS; row += NGW * 8) { const int b = row >> 13; const float* md = WSP(float, WS_MOD) + (size_t)(0 * 2 + b) * NMOD;
        row_pass8<false, true, false, false, true>(a.x + (size_t)row * D, nullptr, nullptr, WSP(bf16_t, WS_H) + (size_t)row * D, WSP(unsigned char, WS_MG) + (size_t)row * D, nullptr, nullptr, a.norm_g + 0 * D, md + 1 * D, md + 0 * D, lane); } }
    }
#endif
    GRID_SYNC();

#pragma unroll 1
    for (int l = 0; l < DEPTH; ++l) {
        for (int es_ = 0; es_ < EXTRASYNC; ++es_) GRID_SYNC();
#if PHMASK & 4
    for (int rep_ = 0; rep_ < ((DUPMASK & 4) ? DUPN : 1); ++rep_) { if (rep_) GRID_SYNC();
        { const Args a = fresh_args(); const int G = gridDim.x, bid = blockIdx.x;
          { pg8::Gemm g{WSP(bf16_t, WS_MG), WSP(bf16_t, WS_WG8), MROWS, 4 * D, D}; pg8::StaticOrder S; S.init(MROWS, 4 * D, G, bid);
            pg8::EpiG E{WSP(unsigned char, WS_G)};
            pg8::gemm_phase<pg8::EpiG, pg8::StaticOrder, true, G8_SP2, true>(lds3, g, S, E, wid_s); }
          { pg8::Gemm g{WSP(bf16_t, WS_H), WSP(bf16_t, WS_W1T), MROWS, 2816, D}; pg8::StaticOrder S; S.init(MROWS, 2816, G, (bid + 64) % G);
            pg8::EpiZ E{WSP(bf16_t, WS_Z), WSP(float, WS_SMALL), WSP(unsigned char, WS_G)};
            pg8::gemm_phase<pg8::EpiZ, pg8::StaticOrder, true, true>(lds3, g, S, E, wid_s); } }
    }
#endif
        GRID_SYNC();
#if PHMASK & 8
    for (int rep_ = 0; rep_ < ((DUPMASK & 8) ? DUPN : 1); ++rep_) { if (rep_) GRID_SYNC();
        { const Args a = fresh_args(); const int G = gridDim.x, bid = blockIdx.x;
          if (bid < 8) fox_scan(a, l, bid, lds, wid_s);
          for (int it = bid - 8; it >= 0 && it < 64; it += G) fox_kmax_item(a, l, it, wid_s);
          conv_phase(a, l, wid_s);
          for (int u = bid; u < 256; u += G) { const int b = u >> 7, head = (u >> 5) & 3, qb = u & 31;
            const float slope2 = LOG2E * __builtin_amdgcn_exp2f(-(float)(1 + head)), sink2 = LOG2E * a.swa_sinks[l * 4 + head];
            const int q0 = qb * 256, tlo = q0 >= 128 ? ((q0 - 127) >> 6) : 0;
            attn_unit<1>(lds, WSP(bf16_t, WS_Z), WSP(bf16_t, WS_H) + (size_t)3 * MROWS * 256, b, head, qb, nullptr, slope2, sink2, tlo, 0.f, wid_s); } }
    }
#endif
        __syncthreads();
#if PHMASK & 16
    for (int rep_ = 0; rep_ < ((DUPMASK & 16) ? DUPN : 1); ++rep_) { if (rep_) GRID_SYNC();
        { const Args a = fresh_args(); const int G = gridDim.x, bid = blockIdx.x;
          for (int u = bid; u < 256; u += G) { const int b = u & 1, j = u >> 1;
            dsa_select_item(a, lds, b, j, wid_s); dsa_select_item(a, lds, b, 255 - j, wid_s); } }
    }
#endif
        GRID_SYNC();
#if PHMASK & 32
    for (int rep_ = 0; rep_ < ((DUPMASK & 32) ? DUPN : 1); ++rep_) { if (rep_) GRID_SYNC();
        { const Args a = fresh_args(); const int G = gridDim.x, bid = blockIdx.x;
          for (int u = bid; u < 256; u += G) { const int b = u >> 7, head = (u >> 5) & 3, qb = u & 31;
            attn_unit<0>(lds, WSP(bf16_t, WS_Z), WSP(bf16_t, WS_H) + (size_t)2 * MROWS * 256, b, head, qb, WSP(const float, WS_FCUM), 0.f, 0.f, 0, sqrtf(__uint_as_float(WSP(const unsigned, WS_KMAX)[l * 8 + b * 4 + head])), wid_s); } }
    }
#endif
#if PHMASK & 64
    for (int rep_ = 0; rep_ < ((DUPMASK & 64) ? DUPN : 1); ++rep_) { if (rep_) GRID_SYNC();
        { const Args a = fresh_args(); FRESH(); __syncthreads(); dsa_attend_wave(a, gw, NGW, lane, lds + wid * DA_WAVE_LDS); __syncthreads(); }
    }
#endif
        GRID_SYNC();
#if PHMASK & 128
    for (int rep_ = 0; rep_ < ((DUPMASK & 128) ? DUPN : 1); ++rep_) { if (rep_) GRID_SYNC();
        { const Args a = fresh_args(); const int G = gridDim.x, bid = blockIdx.x;
          int kmerge = 256; asm volatile("" : "+s"(kmerge));
          pg8::Gemm g{WSP(bf16_t, WS_H), WSP(bf16_t, WS_WBT), 4 * MROWS, 4 * D, kmerge}; pg8::MergeOrder2 S{G, bid};
          pg8::EpiMerge2 E{WSP(bf16_t, WS_MG), WSP(unsigned char, WS_G)}; E.zero();
          pg8::gemm_phase<pg8::EpiMerge2, pg8::MergeOrder2, true, MERGE_SP2, false, true>(lds3, g, S, E, wid_s); }
    }
#endif
        GRID_SYNC();
#if PHMASK & 256
    for (int rep_ = 0; rep_ < ((DUPMASK & 256) ? DUPN : 1); ++rep_) { if (rep_) GRID_SYNC();
        { const Args a = fresh_args(); const int G = gridDim.x, bid = blockIdx.x;
#if WO8
          pg8::Gemm g{WSP(bf16_t, WS_MG), WSP(bf16_t, WS_WOT), MROWS, D, D}; pg8::StaticOrder S; S.init(MROWS, D, G, bid);
          pg8::EpiPlain8 E{WSP(bf16_t, WS_H), D};
          pg8::gemm_phase<pg8::EpiPlain8, pg8::StaticOrder, true, G8_SP2, true>(lds3, g, S, E, wid_s); }
#else
          pg8::Gemm g{WSP(bf16_t, WS_MG), WSP(bf16_t, WS_WOT), MROWS, D, D}; pg8::StaticOrder S; S.init(MROWS, D, G, bid);
          pg8::EpiPlain E{WSP(bf16_t, WS_H), D};
          pg8::gemm_phase<pg8::EpiPlain, pg8::StaticOrder, true, true>(lds3, g, S, E, wid_s); }
#endif
    }
#endif
        GRID_SYNC();
#if PHMASK & 512
    for (int rep_ = 0; rep_ < ((DUPMASK & 512) ? DUPN : 1); ++rep_) { if (rep_) GRID_SYNC();
        { const Args a = fresh_args(); FRESH(); const float* ng = a.norm_g + (size_t)l * 4 * D;
          for (int row = gw * 8; row < MROWS; row += NGW * 8) { const int b = row >> 13; const float* md = WSP(float, WS_MOD) + (size_t)(l * 2 + b) * NMOD;
            bf16_t* x1g = WSP(bf16_t, WS_G) + (size_t)row * D; bf16_t* h2 = FFN8 ? nullptr : WSP(bf16_t, WS_MG) + (size_t)row * D; const bf16_t* rawp = WSP(bf16_t, WS_H) + (size_t)row * D;
            unsigned char* h28 = WSP(unsigned char, WS_G) + 32 * MiB + (size_t)row * D;
            if (l == 0) row_pass8<true, true, false, true, FFN8 != 0>(a.x + (size_t)row * D, rawp, x1g, h2, h28, md + 2 * D, ng + 1 * D, ng + 2 * D, md + 4 * D, md + 3 * D, lane);
            else row_pass8<true, true, true, true, FFN8 != 0>((const bf16_t*)a.out + (size_t)row * D, rawp, x1g, h2, h28, md + 2 * D, ng + 1 * D, ng + 2 * D, md + 4 * D, md + 3 * D, lane); } }
    }
#endif
        GRID_SYNC();
#if PHMASK & 1024
    for (int rep_ = 0; rep_ < ((DUPMASK & 1024) ? DUPN : 1); ++rep_) { if (rep_) GRID_SYNC();
        { const Args a = fresh_args(); const int G = gridDim.x, bid = blockIdx.x;
#if FFN8
          pg8::Gemm g{(const bf16_t*)(a.ws + WS_G + 32 * MiB), WSP(bf16_t, WS_WGU), MROWS, NGU, D}; pg8::StaticOrder S; S.init(MROWS, NGU, G, bid);
          pg8::EpiSwiglu8<DOWN8 != 0> E{WSP(bf16_t, WS_Z)};
          pg8::gemm_phase<pg8::EpiSwiglu8<DOWN8 != 0>, pg8::StaticOrder, true, G8_SP2, true>(lds3, g, S, E, wid_s); }
#else
          pg8::Gemm g{WSP(bf16_t, WS_MG), WSP(bf16_t, WS_WGU), MROWS, NGU, D}; pg8::StaticOrder S; S.init(MROWS, NGU, G, bid);
          pg8::EpiSwiglu E{WSP(bf16_t, WS_Z)};
          pg8::gemm_phase<pg8::EpiSwiglu, pg8::StaticOrder, true, true>(lds3, g, S, E, wid_s); }
#endif
    }
#endif
        GRID_SYNC();
#if PHMASK & 2048
    for (int rep_ = 0; rep_ < ((DUPMASK & 2048) ? DUPN : 1); ++rep_) { if (rep_) GRID_SYNC();
        { const Args a = fresh_args(); const int G = gridDim.x, bid = blockIdx.x;
#if DOWN8
          pg8::Gemm g{WSP(bf16_t, WS_Z), WSP(bf16_t, WS_WDT), MROWS, D, DFF}; pg8::StaticOrder S; S.init(MROWS, D, G, bid);
          pg8::EpiPlain8 E{WSP(bf16_t, WS_H), D};
          pg8::gemm_phase<pg8::EpiPlain8, pg8::StaticOrder, true, G8_SP2, true>(lds3, g, S, E, wid_s); }
#else
          pg8::Gemm g{WSP(bf16_t, WS_Z), WSP(bf16_t, WS_WDT), MROWS, D, DFF}; pg8::StaticOrder S; S.init(MROWS, D, G, bid);
          pg8::EpiPlain E{WSP(bf16_t, WS_H), D};
          pg8::gemm_phase<pg8::EpiPlain, pg8::StaticOrder, true, true>(lds3, g, S, E, wid_s); }
#endif
    }
#endif
        GRID_SYNC();
#if PHMASK & 4096
    for (int rep_ = 0; rep_ < ((DUPMASK & 4096) ? DUPN : 1); ++rep_) { if (rep_) GRID_SYNC();
        { const Args a = fresh_args(); FRESH(); const float* ng = a.norm_g + (size_t)l * 4 * D;
          for (int row = gw * 8; row < MROWS; row += NGW * 8) { const int b = row >> 13; const float* md = WSP(float, WS_MOD) + (size_t)(l * 2 + b) * NMOD;
            const float* mdn = WSP(float, WS_MOD) + (size_t)((l + 1) * 2 + b) * NMOD; const float* ngn = a.norm_g + (size_t)(l + 1) * 4 * D;
            const bf16_t* x1g = WSP(bf16_t, WS_G) + (size_t)row * D; bf16_t* hr = WSP(bf16_t, WS_H) + (size_t)row * D;
            if (l + 1 < DEPTH) row_pass8<true, true, true, true, true>(x1g, hr, (bf16_t*)a.out + (size_t)row * D, hr, WSP(unsigned char, WS_MG) + (size_t)row * D, md + 5 * D, ng + 3 * D, ngn, mdn + 1 * D, mdn + 0 * D, lane);
            else row_pass8<true, false, true, false>(x1g, hr, a.out + (size_t)row * D, nullptr, nullptr, md + 5 * D, ng + 3 * D, nullptr, nullptr, nullptr, lane); }
          if (l + 1 < DEPTH) convert_weights(a, l + 1, lds, wid_s); }
    }
#endif
        if (l + 1 < DEPTH) GRID_SYNC();
    }
}

extern "C" void kernel_launch(void* const* d_in, const int* in_sizes, int n_in, void* d_out, int out_size, void* d_ws, size_t ws_size, hipStream_t stream) {
    static int grid = 0;
    if (grid == 0) {
        if (n_in != 14 || out_size != MROWS * D || ws_size < WS_END) { fprintf(stderr, "kernel_launch: unexpected shapes (n_in %d out %d ws %zu)\n", n_in, out_size, ws_size); grid = -1; return; }
        int dev = 0, cus = 0, per_cu = 0;
        (void)hipGetDevice(&dev);
        (void)hipDeviceGetAttribute(&cus, hipDeviceAttributeMultiprocessorCount, dev);
        (void)hipFuncSetAttribute((const void*)mega, hipFuncAttributeMaxDynamicSharedMemorySize, LDS_BYTES);
        (void)hipOccupancyMaxActiveBlocksPerMultiprocessor(&per_cu, (const void*)mega, 512, LDS_BYTES);
        if (per_cu < 1) { fprintf(stderr, "kernel_launch: occupancy query says 0 blocks per CU\n"); per_cu = 1; }
        grid = cus;
        (void)hipGetLastError();
    }
    if (grid < 0) return;
    if (hipMemsetAsync(d_ws, 0, 65536, stream) != hipSuccess) { fprintf(stderr, "kernel_launch: memset failed\n"); return; }
    Args a{};
    const float** pp = (const float**)&a;
    for (int i = 0; i < 14; ++i) pp[i] = (const float*)d_in[i];
    a.out = (float*)d_out; a.ws = (unsigned char*)d_ws;
    void* args[] = {&a};
    hipError_t e = hipLaunchCooperativeKernel((const void*)mega, dim3(grid), dim3(512), args, LDS_BYTES, stream);
    if (e != hipSuccess) fprintf(stderr, "cooperative launch failed: %s (grid %d)\n", hipGetErrorString(e), grid);
}
```

```cpp
#include <hip/hip_runtime.h>
#include <hip/hip_cooperative_groups.h>
#include <cstdio>
#include <cstdint>
namespace cg = cooperative_groups;
namespace pg8 {
#define PG8_LAS __attribute__((address_space(3)))
typedef unsigned short bf16_t;
typedef short bf16x8 __attribute__((ext_vector_type(8)));
typedef float f32x4 __attribute__((ext_vector_type(4)));
typedef unsigned u32x4 __attribute__((ext_vector_type(4)));
typedef int v4i_t __attribute__((ext_vector_type(4)));
typedef int v8i_t __attribute__((ext_vector_type(8)));
constexpr int BM = 256, BK = 64, HALF = 128, HTB = HALF * BK * 2  , STAGE_BYTES = 8 * HTB, NXCD = 8, WGM = 8;

__host__ __device__ __forceinline__ int lds_byte(int r, int c) { const int st = (r >> 4) * 2 + (c >> 5), rr = r & 15, cc = c & 31, ob = rr * 64 + cc * 2; return st * 1024 + (ob ^ (((ob >> 9) & 1) << 5)); }
__host__ __device__ __forceinline__ void stage_rc(int b, int& R, int& C) { const int st = b / 1024, sb = b % 1024, swz = sb ^ (((sb >> 9) & 1) << 5); R = (st >> 1) * 16 + swz / 64; C = (st & 1) * 32 + (swz % 64) / 2; }
__host__ __device__ __forceinline__ int perm32(int rho) { const int n = rho >> 4, i = rho & 15; return 8 * (i >> 2) + 4 * n + (i & 3); }

struct Unit { int pm, pn; };
struct Gemm { const bf16_t* A; const bf16_t* Bt; int M, N, K; };

struct StaticOrder {
    int nM, nN, nwg, G, c;
    __host__ __device__ void init(int M, int N, int G_, int c_) { nM = M / BM; nN = N / BM; nwg = nM * nN; G = G_; c = c_; }
    __host__ __device__ bool next(int i, Unit& u) const {
        const long L = (long)i * G + c; if (L >= nwg) return false;
        int wgid = (int)L; { const int q = nwg / NXCD, r = nwg % NXCD, xcd = wgid % NXCD, off = wgid / NXCD; wgid = (xcd < r ? xcd * (q + 1) : r * (q + 1) + (xcd - r) * q) + off; }
        const int nig = WGM * nN, gid = wgid / nig, fm = gid * WGM, gsz = (nM - fm) < WGM ? (nM - fm) : WGM;
        u.pm = fm + ((wgid % nig) % gsz); u.pn = (wgid % nig) / gsz; return true;
    }
    __device__ __forceinline__ void a_ready(const Unit&) const {}
    __device__ __forceinline__ void done(const Unit&) const {}
};

__device__ __forceinline__ unsigned cvt_pk_bf16(float lo, float hi) { unsigned r; asm volatile("v_cvt_pk_bf16_f32 %0, %1, %2" : "=v"(r) : "v"(lo), "v"(hi)); return r; }
typedef float f32x2 __attribute__((ext_vector_type(2)));
#ifndef WO8
#define WO8 1
#endif
#ifndef MERGE_FENCE
#define MERGE_FENCE 1
#endif
typedef unsigned u32x2 __attribute__((ext_vector_type(2)));
__device__ __forceinline__ float bf_lo(unsigned w) { return __uint_as_float(w << 16); }
__device__ __forceinline__ float bf_hi(unsigned w) { return __uint_as_float(w & 0xffff0000u); }
#ifdef PROBE_CHEAPSIG
__device__ __forceinline__ float sigmoidf_fast(float x) { return 0.5f + 0.25f * fminf(fmaxf(x, -2.0f), 2.0f); }
#else
__device__ __forceinline__ float sigmoidf_fast(float x) { return __builtin_amdgcn_rcpf(1.0f + __builtin_amdgcn_exp2f(-1.4426950408889634f * x)); }
#endif

struct EpiPlain {
    static constexpr bool PERM = true, AFTER_DRAIN = false;
    bf16_t* O; int ldc;
    __device__ __forceinline__ void operator()(const f32x4 (&acc)[2][2][4][2], const Unit& u, int wr, int wc, int fr, int fq) const {
        const int row0 = u.pm * BM + wr * 64 + fr, col0 = u.pn * BM + wc * 32 + 8 * fq;
#pragma unroll
        for (int ai = 0; ai < 2; ++ai)
#pragma unroll
            for (int m = 0; m < 4; ++m) { bf16_t* rowp = O + (size_t)(row0 + ai * HALF + m * 16) * ldc + col0;
#pragma unroll
                for (int bj = 0; bj < 2; ++bj) { const f32x4 v0 = acc[ai][bj][m][0], v1 = acc[ai][bj][m][1];
                    u32x4 w; w.x = cvt_pk_bf16(v0[0], v0[1]); w.y = cvt_pk_bf16(v0[2], v0[3]); w.z = cvt_pk_bf16(v1[0], v1[1]); w.w = cvt_pk_bf16(v1[2], v1[3]);
                    *(u32x4*)(rowp + bj * HALF) = w; } }
    }
};
struct EpiZ {
    static constexpr bool PERM = true, AFTER_DRAIN = false;
    bf16_t* Z; float* SM; unsigned char* G;
    __device__ __forceinline__ void operator()(const f32x4 (&acc)[2][2][4][2], const Unit& u, int wr, int wc, int fr, int fq) const {
        const int row0 = u.pm * BM + wr * 64 + fr;
        if (u.pn < 11) {
            const int col0 = u.pn * BM + wc * 32 + 8 * fq;
#pragma unroll
            for (int ai = 0; ai < 2; ++ai)
#pragma unroll
                for (int m = 0; m < 4; ++m) { bf16_t* rowp = Z + (size_t)(row0 + ai * HALF + m * 16) * 2816 + col0;
#pragma unroll
                    for (int bj = 0; bj < 2; ++bj) { const f32x4 v0 = acc[ai][bj][m][0], v1 = acc[ai][bj][m][1];
                        u32x4 w; w.x = cvt_pk_bf16(v0[0], v0[1]); w.y = cvt_pk_bf16(v0[2], v0[3]); w.z = cvt_pk_bf16(v1[0], v1[1]); w.w = cvt_pk_bf16(v1[2], v1[3]);
                        *(u32x4*)(rowp + bj * HALF) = w; } }
            if (u.pn == 10 && wc == 2 && fq == 0) {
#pragma unroll
                for (int ai = 0; ai < 2; ++ai)
#pragma unroll
                    for (int m = 0; m < 4; ++m) { float* sp = SM + (size_t)(row0 + ai * HALF + m * 16) * 8;
                        *(f32x4*)sp = acc[ai][1][m][0]; *(f32x4*)(sp + 4) = acc[ai][1][m][1]; }
            }
        } else {
            const int col0 = (u.pn - 11) * BM + wc * 32 + 8 * fq;
#pragma unroll
            for (int ai = 0; ai < 2; ++ai)
#pragma unroll
                for (int m = 0; m < 4; ++m) { unsigned char* rowp = G + (size_t)(row0 + ai * HALF + m * 16) * 4096 + col0;
#pragma unroll
                    for (int bj = 0; bj < 2; ++bj) { const f32x4 v0 = acc[ai][bj][m][0], v1 = acc[ai][bj][m][1];
                        unsigned b[8];
#pragma unroll
                        for (int k = 0; k < 4; ++k) { b[k] = (unsigned)(sigmoidf_fast(v0[k]) * 255.0f + 0.5f); b[4 + k] = (unsigned)(sigmoidf_fast(v1[k]) * 255.0f + 0.5f); }
                        u32x2 w; w.x = b[0] | (b[1] << 8) | (b[2] << 16) | (b[3] << 24); w.y = b[4] | (b[5] << 8) | (b[6] << 16) | (b[7] << 24);
                        *(u32x2*)(rowp + bj * HALF) = w; } }
        }
    }
};
struct EpiG {
    static constexpr bool PERM = false, AFTER_DRAIN = false;
    unsigned char* G;
    __device__ __forceinline__ void operator()(const f32x4 (&acc)[2][2][4][2], const Unit& u, int wr, int wc, int fr, int fq) const {
        unsigned ones_ = ~0u; asm volatile("" : "+s"(ones_)); const unsigned ln_ = __builtin_amdgcn_mbcnt_hi(ones_, __builtin_amdgcn_mbcnt_lo(ones_, 0u)); (void)fr; (void)fq;
        u32x2* gb = (u32x2*)G + (size_t)(u.pm * 16 + u.pn) * (2 * 8 * 4 * 2 * 64) + (unsigned)(wr * 4 + wc) * (4 * 2 * 64) + ln_;
#pragma unroll
        for (int ai = 0; ai < 2; ++ai)
#pragma unroll
            for (int m = 0; m < 4; ++m) {
#pragma unroll
                for (int bj = 0; bj < 2; ++bj) { const f32x4 v0 = acc[ai][bj][m][0], v1 = acc[ai][bj][m][1];
                    unsigned b[8];
#pragma unroll
                    for (int k = 0; k < 4; ++k) { b[k] = (unsigned)(sigmoidf_fast(v0[k]) * 255.0f + 0.5f); b[4 + k] = (unsigned)(sigmoidf_fast(v1[k]) * 255.0f + 0.5f); }
                    u32x2 w; w.x = b[0] | (b[1] << 8) | (b[2] << 16) | (b[3] << 24); w.y = b[4] | (b[5] << 8) | (b[6] << 16) | (b[7] << 24);
                    gb[(unsigned)(ai * (8 * 4 * 2 * 64) + m * (2 * 64) + bj * 64)] = w; }
                asm volatile("" ::: "memory"); }
    }
};
struct EpiMerge {
    static constexpr bool PERM = true, AFTER_DRAIN = false;
    bf16_t* MG; const unsigned char* G;
    __device__ __forceinline__ void operator()(const f32x4 (&acc)[2][2][4][2], const Unit& u, int wr, int wc, int fr, int fq) const {
        const int n = u.pm >> 6, pm = u.pm & 63, pn = u.pn & 3;
        const unsigned row0 = pm * BM + wr * 64 + fr, col0 = pn * BM + wc * 32 + 8 * fq;
        const unsigned char* gbase = G + n * 1024 + col0; bf16_t* mbase = MG + col0;
#pragma unroll
        for (int ai = 0; ai < 2; ++ai) {
            u32x2 gw[4][2]; u32x4 old[4][2];
#pragma unroll
            for (int m = 0; m < 4; ++m)
#pragma unroll
                for (int bj = 0; bj < 2; ++bj) { const unsigned row = row0 + ai * HALF + m * 16;
                    gw[m][bj] = *(const u32x2*)(gbase + row * 4096u + bj * HALF);
                    if (n > 0) old[m][bj] = *(const u32x4*)(mbase + row * 1024u + bj * HALF); }
#pragma unroll
            for (int m = 0; m < 4; ++m)
#pragma unroll
                for (int bj = 0; bj < 2; ++bj) { const unsigned row = row0 + ai * HALF + m * 16;
                    const f32x4 v0 = acc[ai][bj][m][0], v1 = acc[ai][bj][m][1];
                    float r[8];
#pragma unroll
                    for (int k = 0; k < 4; ++k) { r[k] = v0[k] * ((float)((gw[m][bj].x >> (8 * k)) & 255u) * (1.0f / 255.0f)); r[4 + k] = v1[k] * ((float)((gw[m][bj].y >> (8 * k)) & 255u) * (1.0f / 255.0f)); }
                    if (n > 0) { const u32x4 o = old[m][bj];
                        r[0] += bf_lo(o.x); r[1] += bf_hi(o.x); r[2] += bf_lo(o.y); r[3] += bf_hi(o.y); r[4] += bf_lo(o.z); r[5] += bf_hi(o.z); r[6] += bf_lo(o.w); r[7] += bf_hi(o.w); }
                    u32x4 w; w.x = cvt_pk_bf16(r[0], r[1]); w.y = cvt_pk_bf16(r[2], r[3]); w.z = cvt_pk_bf16(r[4], r[5]); w.w = cvt_pk_bf16(r[6], r[7]);
                    *(u32x4*)(mbase + row * 1024u + bj * HALF) = w; }
            asm volatile("" ::: "memory");
        }
    }
};
struct EpiSwiglu {
    static constexpr bool PERM = true, AFTER_DRAIN = false;
    bf16_t* Hd;
    __device__ __forceinline__ void operator()(const f32x4 (&acc)[2][2][4][2], const Unit& u, int wr, int wc, int fr, int fq) const {
        const int row0 = u.pm * BM + wr * 64 + fr, j0 = u.pn * 128 + wc * 16 + 4 * fq;
#pragma unroll
        for (int ai = 0; ai < 2; ++ai)
#pragma unroll
            for (int m = 0; m < 4; ++m) { bf16_t* rowp = Hd + (size_t)(row0 + ai * HALF + m * 16) * 2816 + j0;
#pragma unroll
                for (int bj = 0; bj < 2; ++bj) { const f32x4 v0 = acc[ai][bj][m][0], v1 = acc[ai][bj][m][1];
                    const float h0 = v0[0] * sigmoidf_fast(v0[0]) * v0[1], h1 = v0[2] * sigmoidf_fast(v0[2]) * v0[3];
                    const float h2 = v1[0] * sigmoidf_fast(v1[0]) * v1[1], h3 = v1[2] * sigmoidf_fast(v1[2]) * v1[3];
                    u32x2 w; w.x = cvt_pk_bf16(h0, h1); w.y = cvt_pk_bf16(h2, h3);
                    *(u32x2*)(rowp + bj * 64) = w; } }
    }
};
template <bool H8> struct EpiSwiglu8 {
    static constexpr bool PERM = false, AFTER_DRAIN = false;
    bf16_t* Hd;
    __device__ __forceinline__ void operator()(const f32x4 (&acc)[2][2][4][2], const Unit& u, int wr, int wc, int fr, int fq) const {
        unsigned ones_ = ~0u; asm volatile("" : "+s"(ones_)); const int ln_ = (int)__builtin_amdgcn_mbcnt_hi(ones_, __builtin_amdgcn_mbcnt_lo(ones_, 0u)); const int fr_ = ln_ & 15, fq_ = ln_ >> 4; (void)fr; (void)fq;
        const unsigned row0 = u.pm * BM + wr * 64 + fr_, j0 = u.pn * 128 + wc * 32 + 8 * fq_;
        bf16_t* hb = Hd + j0; unsigned char* h8b = (unsigned char*)Hd + j0;
#pragma unroll
        for (int ai = 0; ai < 2; ++ai)
#pragma unroll
            for (int m = 0; m < 4; ++m) { const unsigned ro = (row0 + ai * HALF + m * 16) * 2816u;
                float h[8];
#pragma unroll
                for (int bj = 0; bj < 2; ++bj) { const f32x4 v0 = acc[ai][bj][m][0], v1 = acc[ai][bj][m][1];
                    h[4 * bj + 0] = v0[0] * sigmoidf_fast(v0[0]) * v0[1]; h[4 * bj + 1] = v0[2] * sigmoidf_fast(v0[2]) * v0[3];
                    h[4 * bj + 2] = v1[0] * sigmoidf_fast(v1[0]) * v1[1]; h[4 * bj + 3] = v1[2] * sigmoidf_fast(v1[2]) * v1[3]; }
                if (H8) { u32x2 w8; w8.x = __builtin_amdgcn_cvt_pk_fp8_f32(h[2], h[3], __builtin_amdgcn_cvt_pk_fp8_f32(h[0], h[1], 0u, false), true);
                    w8.y = __builtin_amdgcn_cvt_pk_fp8_f32(h[6], h[7], __builtin_amdgcn_cvt_pk_fp8_f32(h[4], h[5], 0u, false), true);
                    *(u32x2*)(h8b + ro) = w8; }
                else { u32x4 w; w.x = cvt_pk_bf16(h[0], h[1]); w.y = cvt_pk_bf16(h[2], h[3]); w.z = cvt_pk_bf16(h[4], h[5]); w.w = cvt_pk_bf16(h[6], h[7]); *(u32x4*)(hb + ro) = w; }
                asm volatile("" ::: "memory"); }
    }
};
struct EpiPlain8 {
    static constexpr bool PERM = false, AFTER_DRAIN = false;
    bf16_t* O; int ldc;
    __device__ __forceinline__ void operator()(const f32x4 (&acc)[2][2][4][2], const Unit& u, int wr, int wc, int fr, int fq) const {
        unsigned ones_ = ~0u; asm volatile("" : "+s"(ones_)); const int ln_ = (int)__builtin_amdgcn_mbcnt_hi(ones_, __builtin_amdgcn_mbcnt_lo(ones_, 0u)); const int fr_ = ln_ & 15, fq_ = ln_ >> 4; (void)fr; (void)fq;
        const unsigned row0 = u.pm * BM + wr * 64 + fr_, col0 = u.pn * BM + wc * 32 + 8 * fq_;
        bf16_t* ob = O + col0;
#pragma unroll
        for (int ai = 0; ai < 2; ++ai)
#pragma unroll
            for (int m = 0; m < 4; ++m) { const unsigned ro = (row0 + ai * HALF + m * 16) * (unsigned)ldc;
#pragma unroll
                for (int bj = 0; bj < 2; ++bj) { const f32x4 v0 = acc[ai][bj][m][0], v1 = acc[ai][bj][m][1];
                    u32x4 w; w.x = cvt_pk_bf16(v0[0], v0[1]); w.y = cvt_pk_bf16(v0[2], v0[3]); w.z = cvt_pk_bf16(v1[0], v1[1]); w.w = cvt_pk_bf16(v1[2], v1[3]);
                    *(u32x4*)(ob + ro + bj * HALF) = w; }
                asm volatile("" ::: "memory"); }
    }
};
struct MergeOrder {
    int G, c;
    __device__ __forceinline__ bool next(int i, Unit& u) const {
        const int t = (i >> 2) * G + c; if (t >= 256) return false;
        const int n = i & 3, pm = t >> 2, pn = t & 3;
        u.pm = n * 64 + pm; u.pn = n * 4 + pn; return true;
    }
    __device__ __forceinline__ void a_ready(const Unit&) const {}
    __device__ __forceinline__ void done(const Unit&) const {}
};
struct EpiMerge2 {
    static constexpr bool PERM = true, AFTER_DRAIN = false;
    bf16_t* MG; const unsigned char* G;
    mutable f32x4 tot[2][4][2];
    __device__ __forceinline__ void zero() const {
#pragma unroll
        for (int bj = 0; bj < 2; ++bj)
#pragma unroll
            for (int m = 0; m < 4; ++m)
#pragma unroll
                for (int k = 0; k < 2; ++k) tot[bj][m][k] = (f32x4){0.f, 0.f, 0.f, 0.f};
    }
    __device__ __forceinline__ void operator()(const f32x4 (&acc)[2][2][4][2], const Unit& u, int wr, int wc, int fr, int fq) const {
        const int n = u.pn >> 2, pn = u.pn & 3, pm = u.pm - n * 128;
        const unsigned row0 = pm * HALF + wr * 64 + fr, col0 = pn * BM + wc * 32 + 8 * fq;
        const u32x2* gb = (const u32x2*)G + (size_t)((pm >> 1) * 16 + n * 4 + pn) * (2 * 8 * 4 * 2 * 64) + (unsigned)((pm & 1) * (8 * 4 * 2 * 64) + (wr * 4 + wc) * (4 * 2 * 64) + (fq * 16 + fr));
        u32x2 gw[4][2];
#pragma unroll
        for (int m = 0; m < 4; ++m)
#pragma unroll
            for (int bj = 0; bj < 2; ++bj) gw[m][bj] = gb[m * (2 * 64) + bj * 64];
#pragma unroll
        for (int m = 0; m < 4; ++m)
#pragma unroll
            for (int bj = 0; bj < 2; ++bj) {
#pragma unroll
                for (int k = 0; k < 4; ++k) { tot[bj][m][0][k] += acc[0][bj][m][0][k] * ((float)((gw[m][bj].x >> (8 * k)) & 255u) * (1.0f / 255.0f));
                                              tot[bj][m][1][k] += acc[0][bj][m][1][k] * ((float)((gw[m][bj].y >> (8 * k)) & 255u) * (1.0f / 255.0f)); } }
        if (n == 3) {
            bf16_t* mbase = MG + col0;
#pragma unroll
            for (int m = 0; m < 4; ++m)
#pragma unroll
                for (int bj = 0; bj < 2; ++bj) { const f32x4 t0 = tot[bj][m][0], t1 = tot[bj][m][1];
#if WO8
                    u32x2 w8; w8.x = __builtin_amdgcn_cvt_pk_fp8_f32(t0[2], t0[3], __builtin_amdgcn_cvt_pk_fp8_f32(t0[0], t0[1], 0u, false), true);
                    w8.y = __builtin_amdgcn_cvt_pk_fp8_f32(t1[2], t1[3], __builtin_amdgcn_cvt_pk_fp8_f32(t1[0], t1[1], 0u, false), true);
                    *(u32x2*)((unsigned char*)MG + col0 + (row0 + m * 16) * 1024u + bj * HALF) = w8; }
#else
                    u32x4 w; w.x = cvt_pk_bf16(t0[0], t0[1]); w.y = cvt_pk_bf16(t0[2], t0[3]); w.z = cvt_pk_bf16(t1[0], t1[1]); w.w = cvt_pk_bf16(t1[2], t1[3]);
                    *(u32x4*)(mbase + (row0 + m * 16) * 1024u + bj * HALF) = w; }
#endif
            zero();
        }
    }
};
struct MergeOrder2 {
    int G, c;
    __device__ __forceinline__ bool next(int i, Unit& u) const {
        const int t = (i >> 2) * G + c; if (t >= 512) return false;
        const int n = i & 3, pm = t >> 2, pn = t & 3;
        u.pm = n * 128 + pm; u.pn = n * 4 + pn; return true;
    }
    __device__ __forceinline__ void a_ready(const Unit&) const {}
    __device__ __forceinline__ void done(const Unit&) const {}
};
struct Frag16x2 { bf16x8 k[2]; };
template <bool FP8> struct FragSel;
template <> struct FragSel<false> {
    typedef Frag16x2 type;
    static __device__ __forceinline__ type load(PG8_LAS unsigned char* p) { type f; f.k[0] = *(const PG8_LAS bf16x8*)p; f.k[1] = *(const PG8_LAS bf16x8*)(p + 1024); return f; }
    static __device__ __forceinline__ f32x4 mma(const type& w, const type& a, f32x4 c) {
        c = __builtin_amdgcn_mfma_f32_16x16x32_bf16(w.k[0], a.k[0], c, 0, 0, 0); return __builtin_amdgcn_mfma_f32_16x16x32_bf16(w.k[1], a.k[1], c, 0, 0, 0); }
};
template <> struct FragSel<true> {
    struct type { v4i_t lo, hi; };
    static __device__ __forceinline__ type load(PG8_LAS unsigned char* p) { type f; f.lo = *(const PG8_LAS v4i_t*)p; f.hi = *(const PG8_LAS v4i_t*)(p + 1024); return f; }
    static __device__ __forceinline__ f32x4 mma(const type& w, const type& a, f32x4 c) {
        return __builtin_amdgcn_mfma_scale_f32_16x16x128_f8f6f4(__builtin_shufflevector(w.lo, w.hi, 0, 1, 2, 3, 4, 5, 6, 7), __builtin_shufflevector(a.lo, a.hi, 0, 1, 2, 3, 4, 5, 6, 7), c, 0, 0, 0, 0x7a7a7a7a, 0, 0x7f7f7f7f); }
};
template <class Epi, class Sched, bool ALIGN_EPI = false, bool SP2 = false, bool FP8 = false, bool HALFM = false>
__device__ __forceinline__ void gemm_phase(PG8_LAS unsigned char* lds, const Gemm g, const Sched& S, const Epi& E, int wid_s) {
    unsigned ones_ = ~0u; asm volatile("" : "+s"(ones_));
    int tid_ = wid_s * 64 + (int)__builtin_amdgcn_mbcnt_hi(ones_, __builtin_amdgcn_mbcnt_lo(ones_, 0u)); asm volatile("" : "+v"(tid_));
    const int tid = tid_, wid = __builtin_amdgcn_readfirstlane(tid >> 6), lane = tid & 63, wr = wid >> 2, wc = wid & 3, fr = lane & 15, fq = lane >> 4;
    const int K = FP8 ? g.K / 2 : g.K, nt = K / BK;
    unsigned voffA[2], voffB[2];
#pragma unroll
    for (int i = 0; i < 2; ++i) { int R, C; stage_rc(tid * 16 + i * 8192, R, C); const int Rb = Epi::PERM ? ((R & ~31) + perm32(R & 31)) : R;
        voffA[i] = (unsigned)(R * K + C) * 2u; voffB[i] = (unsigned)(Rb * K + C) * 2u; }
    const size_t kstep = (size_t)(BK * 2);
    const size_t hstep = (size_t)HALF * K * 2;
    const size_t tstep = 2 * hstep;
    const unsigned ldsw = (unsigned)wid * 1024u;
    const unsigned ldsbase = (unsigned)(__UINTPTR_TYPE__)lds;
    const __amdgpu_buffer_rsrc_t srdA = __builtin_amdgcn_make_buffer_rsrc((void*)g.A, (short)0, 0x7fffffff, 0x00020000);
    const __amdgpu_buffer_rsrc_t srdB = __builtin_amdgcn_make_buffer_rsrc((void*)g.Bt, (short)0, 0x7fffffff, 0x00020000);
    const int aoff = lds_byte(wr * 64 + fr, fq * 8), boff = lds_byte(wc * 32 + fr, fq * 8);
#define PG8_SA(b, h) (((b) * 2 + (h)) * HTB)
#define PG8_SB(b, h) ((4 + (b) * 2 + (h)) * HTB)
#define PG8_STAGE(bufoff, gbase, voff, srd, base) do { const unsigned so_ = (unsigned)((const char*)(gbase) - (const char*)(base)); _Pragma("unroll") for (int _i = 0; _i < 2; ++_i) \
        asm volatile("s_mov_b32 m0, %0\n\ts_nop 0\n\tbuffer_load_dwordx4 %1, %2, %3 offen lds" :: "s"(ldsbase + (unsigned)(bufoff) + ldsw + (unsigned)(_i * 8192)), "v"((voff)[_i]), "s"(srd), "s"(so_) : "m0", "memory"); } while (0)
#define PG8_LDA(dst, b, h) do { _Pragma("unroll") for (int m = 0; m < 4; ++m) dst[m] = FragSel<FP8>::load(lds + PG8_SA(b, h) + aoff + m * 2048); } while (0)
#define PG8_LDB(dst, b, h) do { _Pragma("unroll") for (int n = 0; n < 2; ++n) dst[n] = FragSel<FP8>::load(lds + PG8_SB(b, h) + boff + n * 2048); } while (0)
#define PG8_MMA(ai, bj, At, Bt) do { __builtin_amdgcn_s_setprio(1); _Pragma("unroll") for (int m = 0; m < 4; ++m) _Pragma("unroll") for (int n = 0; n < 2; ++n) \
        acc[ai][bj][m][n] = FragSel<FP8>::mma(Bt[n], At[m], acc[ai][bj][m][n]); __builtin_amdgcn_s_setprio(0); } while (0)
#define PG8_WAIT_V(n) asm volatile("s_waitcnt vmcnt(" #n ")" ::: "memory")
#define PG8_WAIT_L(n) asm volatile("s_waitcnt lgkmcnt(" #n ")" ::: "memory")
#define PG8_BAR __builtin_amdgcn_s_barrier()
#define PG8_SCHED __builtin_amdgcn_sched_barrier(0)
    Unit cur, nxt; int ui = 0;
    if (!S.next(0, cur)) return;
    f32x4 acc[2][2][4][2];
#pragma unroll
    for (int a = 0; a < 2; ++a)
#pragma unroll
        for (int b = 0; b < 2; ++b)
#pragma unroll
            for (int m = 0; m < 4; ++m)
#pragma unroll
                for (int n = 0; n < 2; ++n) acc[a][b][m][n] = (f32x4){0.f, 0.f, 0.f, 0.f};
    typedef typename FragSel<FP8>::type frag_t;
    frag_t At[4], B0[2], B1[2];
    const size_t tstepA = HALFM ? hstep : tstep;
    const char* cA = (const char*)g.A + (size_t)cur.pm * tstepA; const char* cB = (const char*)g.Bt + (size_t)cur.pn * tstep;
    S.a_ready(cur);
    if constexpr (SP2) {
        PG8_STAGE(PG8_SB(0, 0), cB, voffB, srdB, g.Bt); PG8_STAGE(PG8_SB(0, 1), cB + hstep, voffB, srdB, g.Bt); PG8_STAGE(PG8_SA(0, 0), cA, voffA, srdA, g.A); PG8_STAGE(PG8_SA(0, 1), cA + hstep, voffA, srdA, g.A);
        if (wr == 1) PG8_BAR;
        PG8_WAIT_V(2); PG8_BAR;
        PG8_STAGE(PG8_SB(1, 0), cB + kstep, voffB, srdB, g.Bt); PG8_STAGE(PG8_SA(1, 0), cA + kstep, voffA, srdA, g.A); PG8_STAGE(PG8_SB(1, 1), cB + hstep + kstep, voffB, srdB, g.Bt);
        PG8_WAIT_V(6); PG8_BAR;
    } else {
        PG8_STAGE(PG8_SB(0, 0), cB, voffB, srdB, g.Bt); PG8_STAGE(PG8_SA(0, 0), cA, voffA, srdA, g.A); PG8_STAGE(PG8_SB(0, 1), cB + hstep, voffB, srdB, g.Bt); PG8_STAGE(PG8_SA(0, 1), cA + hstep, voffA, srdA, g.A);
        if (wr == 1) PG8_BAR;
        PG8_WAIT_V(4); PG8_BAR;
        PG8_STAGE(PG8_SB(1, 0), cB + kstep, voffB, srdB, g.Bt); PG8_STAGE(PG8_SA(1, 0), cA + kstep, voffA, srdA, g.A); PG8_STAGE(PG8_SB(1, 1), cB + hstep + kstep, voffB, srdB, g.Bt);
        PG8_WAIT_V(6); PG8_BAR;
    }
    for (;;) {
        const bool has_next = S.next(ui + 1, nxt);
        const char* nA = has_next ? (const char*)g.A + (size_t)nxt.pm * tstepA : cA; const char* nB = has_next ? (const char*)g.Bt + (size_t)nxt.pn * tstep : cB;
#pragma unroll 1
        for (int t = 0; t < nt; t += 2) {
            const bool last = (t == nt - 2);
            const char* a1 = cA + (size_t)(t + 1) * kstep;
            const char* a2 = last ? nA : cA + (size_t)(t + 2) * kstep; const char* b2 = last ? nB : cB + (size_t)(t + 2) * kstep;
            const char* a3 = a2 + kstep; const char* b3 = b2 + kstep;
            if (last && has_next) S.a_ready(nxt);
            if constexpr (SP2) {
            PG8_LDB(B0, 0, 0); PG8_LDB(B1, 0, 1); PG8_SCHED; PG8_LDA(At, 0, 0); PG8_STAGE(PG8_SA(1, 1), a1 + hstep, voffA, srdA, g.A);
            PG8_WAIT_V(8); PG8_WAIT_L(0); PG8_BAR; PG8_MMA(0, 0, At, B0); PG8_MMA(0, 1, At, B1); PG8_BAR; PG8_SCHED;
            if constexpr (!HALFM) PG8_LDA(At, 0, 1); PG8_STAGE(PG8_SB(0, 0), b2, voffB, srdB, g.Bt); PG8_STAGE(PG8_SB(0, 1), b2 + hstep, voffB, srdB, g.Bt); PG8_STAGE(PG8_SA(0, 0), a2, voffA, srdA, g.A);
            PG8_WAIT_V(8); PG8_WAIT_L(0); PG8_BAR; if constexpr (!HALFM) { PG8_MMA(1, 0, At, B0); PG8_MMA(1, 1, At, B1); } PG8_BAR; PG8_SCHED;
            PG8_LDB(B0, 1, 0); PG8_LDB(B1, 1, 1); PG8_SCHED; PG8_LDA(At, 1, 0); PG8_STAGE(PG8_SA(0, 1), a2 + hstep, voffA, srdA, g.A);
            PG8_WAIT_V(8); PG8_WAIT_L(0); PG8_BAR; PG8_MMA(0, 0, At, B0); PG8_MMA(0, 1, At, B1); PG8_BAR; PG8_SCHED;
            if constexpr (!HALFM) PG8_LDA(At, 1, 1); PG8_STAGE(PG8_SB(1, 0), b3, voffB, srdB, g.Bt); PG8_STAGE(PG8_SB(1, 1), b3 + hstep, voffB, srdB, g.Bt); PG8_STAGE(PG8_SA(1, 0), a3, voffA, srdA, g.A);
            PG8_WAIT_V(8); PG8_WAIT_L(0); PG8_BAR; if constexpr (!HALFM) { PG8_MMA(1, 0, At, B0); PG8_MMA(1, 1, At, B1); } PG8_BAR; PG8_SCHED;
            } else {
            PG8_LDB(B0, 0, 0); PG8_SCHED; PG8_LDA(At, 0, 0); PG8_STAGE(PG8_SA(1, 1), a1 + hstep, voffA, srdA, g.A);
            PG8_WAIT_L(8); PG8_BAR; PG8_WAIT_L(0); PG8_MMA(0, 0, At, B0); PG8_BAR; PG8_SCHED;
            PG8_LDB(B1, 0, 1); PG8_STAGE(PG8_SB(0, 0), b2, voffB, srdB, g.Bt);
            PG8_BAR; PG8_WAIT_L(0); PG8_MMA(0, 1, At, B1); PG8_BAR;
            if constexpr (!HALFM) PG8_LDA(At, 0, 1); PG8_STAGE(PG8_SA(0, 0), a2, voffA, srdA, g.A);
            PG8_BAR; PG8_WAIT_L(0); if constexpr (!HALFM) PG8_MMA(1, 0, At, B0); PG8_BAR; PG8_SCHED;
            PG8_STAGE(PG8_SB(0, 1), b2 + hstep, voffB, srdB, g.Bt);
            PG8_WAIT_V(6); PG8_BAR; if constexpr (!HALFM) PG8_MMA(1, 1, At, B1); PG8_BAR;
            PG8_LDB(B0, 1, 0); PG8_SCHED; PG8_LDA(At, 1, 0); PG8_STAGE(PG8_SA(0, 1), a2 + hstep, voffA, srdA, g.A);
            PG8_WAIT_L(8); PG8_BAR; PG8_WAIT_L(0); PG8_MMA(0, 0, At, B0); PG8_BAR; PG8_SCHED;
            PG8_LDB(B1, 1, 1); PG8_STAGE(PG8_SB(1, 0), b3, voffB, srdB, g.Bt);
            PG8_BAR; PG8_WAIT_L(0); PG8_MMA(0, 1, At, B1); PG8_BAR;
            if constexpr (!HALFM) PG8_LDA(At, 1, 1); PG8_STAGE(PG8_SA(1, 0), a3, voffA, srdA, g.A);
            PG8_BAR; PG8_WAIT_L(0); if constexpr (!HALFM) PG8_MMA(1, 0, At, B0); PG8_BAR; PG8_SCHED;
            PG8_STAGE(PG8_SB(1, 1), b3 + hstep, voffB, srdB, g.Bt);
            PG8_WAIT_V(6); PG8_BAR; if constexpr (!HALFM) PG8_MMA(1, 1, At, B1); PG8_BAR;
            }
        }
        if constexpr (ALIGN_EPI) { if (wr == 0) PG8_BAR; }
        if constexpr (!Epi::AFTER_DRAIN) { E(acc, cur, wr, wc, fr, fq); S.done(cur); }
        if (!has_next) break;
#pragma unroll
        for (int a = 0; a < 2; ++a)
#pragma unroll
            for (int b = 0; b < 2; ++b)
#pragma unroll
                for (int m = 0; m < 4; ++m)
#pragma unroll
                    for (int n = 0; n < 2; ++n) acc[a][b][m][n] = (f32x4){0.f, 0.f, 0.f, 0.f};
        cur = nxt; cA = nA; cB = nB; ++ui;
        if constexpr (ALIGN_EPI) { if (wr == 1) PG8_BAR; }
    }
    PG8_WAIT_V(0);
    if constexpr (!ALIGN_EPI) { if (wr == 0) PG8_BAR; }
    PG8_BAR;
    if constexpr (Epi::AFTER_DRAIN) { E.fused(acc, cur, wr, wc, fr, fq, lds, wid, lane); S.done(cur); }
#undef PG8_SA
#undef PG8_SB
#undef PG8_STAGE
#undef PG8_LDA
#undef PG8_LDB
#undef PG8_MMA
#undef PG8_WAIT_V
#undef PG8_WAIT_L
#undef PG8_BAR
#undef PG8_SCHED
}
}

typedef unsigned short bf16_t;
typedef short bf16x8 __attribute__((ext_vector_type(8)));
typedef short s16x4 __attribute__((ext_vector_type(4)));
typedef float f32x4 __attribute__((ext_vector_type(4)));
typedef float f32x16 __attribute__((ext_vector_type(16)));
typedef unsigned u32x4 __attribute__((ext_vector_type(4)));
typedef unsigned u32x2 __attribute__((ext_vector_type(2)));
#define LAS __attribute__((address_space(3)))

constexpr int D = 1024, BATCH = 2, SEQ = 8192, MROWS = BATCH * SEQ, DEPTH = 2;
constexpr int ZW = 2816, NW1 = 6912, INW = 6856, DFF = 2816, NGU = 5632, NMOD = 6 * D;
constexpr float RMS_EPS = 1e-6f, LOG2E = 1.4426950408889634f, C2 = 0.125f * 1.4426950408889634f;
constexpr int ZC_AU = 0, ZC_AB = 256, ZC_AC = 512, ZC_DQ = 768, ZC_DK = 1024, ZC_DV = 1088, ZC_DQI = 1152, ZC_DKI = 1408, ZC_FQ = 1472, ZC_FK = 1728, ZC_FV = 1984, ZC_SQ = 2240, ZC_SK = 2496, ZC_SV = 2624;

constexpr size_t MiB = 1u << 20;
constexpr size_t WS_KMAX = 4096;
constexpr size_t WS_MOD = 65536;
constexpr size_t WS_FCUM = WS_MOD + 98304;
constexpr size_t WS_SMALL = WS_FCUM + 262144;
constexpr size_t WS_W1T = 1 * MiB;
constexpr size_t WS_WG8 = WS_W1T + (size_t)2816 * D * 2;
constexpr size_t WS_WGU = WS_W1T + (size_t)NW1 * D * 2;
constexpr size_t WS_WBT = WS_WGU + (size_t)NGU * D * 2;
constexpr size_t WS_WOT = WS_WBT + (size_t)4 * D * 256 * 2;
constexpr size_t WS_WDT = WS_WOT + (size_t)D * D * 2;
constexpr size_t WS_H = 35 * MiB;
constexpr size_t WS_Z = 67 * MiB;
constexpr size_t WS_G = 155 * MiB;
constexpr size_t WS_MG = 219 * MiB;
constexpr size_t WS_END = 251 * MiB;
static_assert(WS_WDT + (size_t)D * DFF * 2 <= WS_H && WS_SMALL + 524288 <= WS_W1T, "ws map");

#ifndef FFN8
#define FFN8 1
#endif
#ifndef DOWN8
#define DOWN8 1
#endif
constexpr int LDS_BYTES = 151552;

struct Args {
    const float *x, *c, *w_ada, *b_ada, *norm_g, *w_in, *conv_w, *fox_bias, *swa_sinks, *w_branch, *w_o, *w_gate, *w_up, *w_down;
    float* out; unsigned char* ws;
};

__device__ __forceinline__ unsigned f2bf(float f) { unsigned u = __builtin_bit_cast(unsigned, f); return (u + 0x7fffu + ((u >> 16) & 1u)) >> 16; }
__device__ __forceinline__ unsigned pk2(float lo, float hi) { return f2bf(lo) | (f2bf(hi) << 16); }
__device__ __forceinline__ float bflo(unsigned w) { return __uint_as_float(w << 16); }
__device__ __forceinline__ float bfhi(unsigned w) { return __uint_as_float(w & 0xffff0000u); }

__device__ __forceinline__ float shf(float v, int src) { return __int_as_float(__builtin_amdgcn_ds_bpermute(src << 2, __float_as_int(v))); }
__device__ __forceinline__ unsigned shu(unsigned v, int src) { return (unsigned)__builtin_amdgcn_ds_bpermute(src << 2, (int)v); }
__device__ __forceinline__ float wave_sum(float v, int lane) {
#pragma unroll
    for (int o = 1; o < 64; o <<= 1) v += shf(v, lane ^ o);
    return v;
}
__device__ __forceinline__ int crow(int r, int hi) { return (r & 3) + 8 * (r >> 2) + 4 * hi; }
__device__ __forceinline__ float swap32_max(float m) { auto rr = __builtin_amdgcn_permlane32_swap(__float_as_uint(m), __float_as_uint(m), false, false); return fmaxf(__uint_as_float(rr[0]), __uint_as_float(rr[1])); }
__device__ __forceinline__ float swap32_sum(float m) { auto rr = __builtin_amdgcn_permlane32_swap(__float_as_uint(m), __float_as_uint(m), false, false); return __uint_as_float(rr[0]) + __uint_as_float(rr[1]); }
#define LDSWAIT() asm volatile("s_waitcnt lgkmcnt(0)" ::: "memory")
__device__ __forceinline__ int ftid(int wid_s) { unsigned ones = ~0u; asm volatile("" : "+s"(ones)); int t = wid_s * 64 + (int)__builtin_amdgcn_mbcnt_hi(ones, __builtin_amdgcn_mbcnt_lo(ones, 0u)); asm volatile("" : "+v"(t)); return t; }

__device__ __forceinline__ void ada_gemv(const Args& a, unsigned char* lds, int wid_s) {
    float* sc = (float*)lds;
    float* part = (float*)(lds + 8192);
    const int tid = ftid(wid_s), lane = tid & 63, wid = tid >> 6;
    for (int i = tid; i < 2 * D; i += 512) { const float v = a.c[i]; sc[i] = v / (1.0f + __expf(-v)); }
    __syncthreads();
    float* mod = (float*)(a.ws + WS_MOD);
    for (int item = blockIdx.x; item < DEPTH * (NMOD / 64); item += gridDim.x) {
        const int l = item / (NMOD / 64), jc = item % (NMOD / 64);
        const float* w = a.w_ada + (size_t)l * D * NMOD + (size_t)(wid * 128) * NMOD + jc * 64 + lane;
        float a0 = 0.f, a1 = 0.f;
#pragma unroll 32
        for (int k = 0; k < 128; ++k) { const float wv = w[(size_t)k * NMOD]; a0 += sc[wid * 128 + k] * wv; a1 += sc[D + wid * 128 + k] * wv; }
        part[(wid * 2 + 0) * 64 + lane] = a0; part[(wid * 2 + 1) * 64 + lane] = a1;
        __syncthreads();
        if (tid < 128) { const int b = tid >> 6, j = tid & 63; float s = 0.f;
#pragma unroll
            for (int w8 = 0; w8 < 8; ++w8) s += part[(w8 * 2 + b) * 64 + j];
            mod[((size_t)l * 2 + b) * NMOD + jc * 64 + j] = s + a.b_ada[(size_t)l * NMOD + jc * 64 + j]; }
        __syncthreads();
    }
}
__device__ __forceinline__ void transpose_item(const float* colptr, int ld, bf16_t* dst  , int dstK, float* scr, int lane) {
    float tv[32];
#pragma unroll
    for (int i = 0; i < 32; ++i) tv[i] = colptr ? colptr[(size_t)(2 * i + (lane >> 5)) * ld] : 0.f;
#pragma unroll
    for (int i = 0; i < 32; ++i) scr[(2 * i + (lane >> 5)) * 33 + (lane & 31)] = tv[i];
    LDSWAIT();
    const int c = lane & 7;
#pragma unroll
    for (int j = 0; j < 4; ++j) { const int n = (lane >> 3) + 8 * j; const float* s = scr + (8 * c) * 33 + n;
        u32x4 o; o.x = pk2(s[0 * 33], s[1 * 33]); o.y = pk2(s[2 * 33], s[3 * 33]); o.z = pk2(s[4 * 33], s[5 * 33]); o.w = pk2(s[6 * 33], s[7 * 33]);
        *(u32x4*)(dst + (size_t)n * dstK + 8 * c) = o; }
    LDSWAIT();
}
__device__ __forceinline__ void transpose_item_fp8(const float* colptr, int ld, unsigned char* dst  , int dstK, float scale, float* scr, int lane, bool permrows = false) {
    float tv[32];
#pragma unroll
    for (int i = 0; i < 32; ++i) tv[i] = colptr ? colptr[(size_t)(2 * i + (lane >> 5)) * ld] : 0.f;
#pragma unroll
    for (int i = 0; i < 32; ++i) scr[(2 * i + (lane >> 5)) * 33 + (lane & 31)] = tv[i];
    LDSWAIT();
    const int n = lane >> 1, kh = 32 * (lane & 1); const float* s = scr + kh * 33 + n;
    unsigned w[8];
#pragma unroll
    for (int q = 0; q < 8; ++q) { unsigned t = 0u;
        t = __builtin_amdgcn_cvt_pk_fp8_f32(s[(4 * q + 0) * 33] * scale, s[(4 * q + 1) * 33] * scale, t, false);
        t = __builtin_amdgcn_cvt_pk_fp8_f32(s[(4 * q + 2) * 33] * scale, s[(4 * q + 3) * 33] * scale, t, true);
        w[q] = t; }
    const int nrow = permrows ? (16 * ((n >> 2) & 1) + 4 * (n >> 3) + (n & 3)) : n;
    unsigned char* dp = dst + (size_t)nrow * dstK + kh;
    *(u32x4*)dp = (u32x4){w[0], w[1], w[2], w[3]}; *(u32x4*)(dp + 16) = (u32x4){w[4], w[5], w[6], w[7]};
    LDSWAIT();
}
__device__ __forceinline__ int w1_src_col(int n) {
    if (n < 1472) return n;
    if (n < 2240) return n + 4;
    if (n < 2752) return n + 8;
    if (n < 2756) return 1472 + (n - 2752);
    if (n < 2760) return 2244 + (n - 2756);
    if (n < 2816) return -1;
    return 2760 + (n - 2816);
}
__device__ __forceinline__ void convert_weights(const Args& a, int l, unsigned char* lds, int wid_s) {
    const int tid = ftid(wid_s), lane = tid & 63, wid = tid >> 6;
    float* scr = (float*)(lds + 16384) + wid * (64 * 33);
    const int gw = blockIdx.x * 8 + wid, NGW = gridDim.x * 8;
    constexpr int I_IN = 16 * 216, I_GU = 16 * 176, I_B = 512, I_O = 512, I_D = 44 * 32;
    bf16_t* W1T = (bf16_t*)(a.ws + WS_W1T); bf16_t* WGU = (bf16_t*)(a.ws + WS_WGU); bf16_t* WBT = (bf16_t*)(a.ws + WS_WBT); bf16_t* WOT = (bf16_t*)(a.ws + WS_WOT); bf16_t* WDT = (bf16_t*)(a.ws + WS_WDT);
    const int cl = lane & 31;
    for (int it = gw; it < I_IN + I_GU + I_B + I_O + I_D; it += NGW) {
        int r = it;
        if (r < I_IN) { const int kb = r / 216, nb = r % 216;
            if (nb < 88) { const int n = 32 * nb + cl, sc_ = w1_src_col(n);
                const float* cp = sc_ >= 0 ? a.w_in + (size_t)l * D * INW + (size_t)(64 * kb) * INW + sc_ : nullptr;
                transpose_item(cp, INW, W1T + (size_t)(32 * nb) * D + 64 * kb, D, scr, lane); }
            else { const int n = 32 * nb + cl;
                const float* cp = a.w_in + (size_t)l * D * INW + (size_t)(64 * kb) * INW + w1_src_col(n);
                transpose_item_fp8(cp, INW, a.ws + WS_WG8 + (size_t)(32 * (nb - 88)) * D + 64 * kb, D, 32.0f, scr, lane, true); }
            continue; }
        r -= I_IN;
        if (r < I_GU) { const int kb = r / 176, nb = r % 176, n = 32 * nb + cl;
#if FFN8
            const int rt = n & 255, hj = 128 * (n >> 8) + 32 * ((rt >> 5) & 3) + 8 * ((rt >> 3) & 3) + 4 * (rt >> 7) + 2 * ((rt >> 2) & 1) + ((rt >> 1) & 1);
            const float* cp = ((n & 1) ? a.w_up : a.w_gate) + (size_t)l * D * DFF + (size_t)(64 * kb) * DFF + hj;
#else
            const float* cp = ((n & 1) ? a.w_up : a.w_gate) + (size_t)l * D * DFF + (size_t)(64 * kb) * DFF + (n >> 1);
#endif
#if FFN8
            transpose_item_fp8(cp, DFF, a.ws + WS_WGU + (size_t)(32 * nb) * D + 64 * kb, D, 32.0f, scr, lane, true); continue; }
#else
            transpose_item(cp, DFF, WGU + (size_t)(32 * nb) * D + 64 * kb, D, scr, lane); continue; }
#endif
        r -= I_GU;
        if (r < I_B) { const int nbr = r / 128, rr = r % 128, kb = rr / 32, nb = rr % 32;
            const float* cp = a.w_branch + ((size_t)(l * 4 + nbr) * 256 + 64 * kb) * D + 32 * nb + cl;
            transpose_item(cp, D, WBT + ((size_t)nbr * D + 32 * nb) * 256 + 64 * kb, 256, scr, lane); continue; }
        r -= I_B;
        if (r < I_O) { const int kb = r / 32, nb = r % 32;
            const float* cp = a.w_o + (size_t)l * D * D + (size_t)(64 * kb) * D + 32 * nb + cl;
#if WO8
            transpose_item_fp8(cp, D, a.ws + WS_WOT + (size_t)(32 * nb) * D + 64 * kb, D, 32.0f, scr, lane, true); continue; }
#else
            transpose_item(cp, D, WOT + (size_t)(32 * nb) * D + 64 * kb, D, scr, lane); continue; }
#endif
        r -= I_O;
        { const int kb = r / 32, nb = r % 32;
            const float* cp = a.w_down + (size_t)l * DFF * D + (size_t)(64 * kb) * D + 32 * nb + cl;
#if DOWN8
            transpose_item_fp8(cp, D, a.ws + WS_WDT + (size_t)(32 * nb) * DFF + 64 * kb, DFF, 32.0f, scr, lane, true); }
#else
            transpose_item(cp, D, WDT + (size_t)(32 * nb) * DFF + 64 * kb, DFF, scr, lane); }
#endif
    }
}

template <bool HAS_RAW, bool HAS_H, bool XIN16 = false, bool XOUT16 = false, bool HAS_H8 = false>
__device__ __forceinline__ void row_pass8(const void* xres_, const bf16_t* raw, void* xdst_, bf16_t* hdst, unsigned char* h8dst, const float* gate, const float* gam_out, const float* gam_in, const float* sc, const float* sh, int lane) {
    f32x4 A[4], B[4], C[4];
#pragma unroll
    for (int j = 0; j < 4; ++j) {
        if (HAS_RAW) A[j] = ((const f32x4*)gate)[lane + 64 * j] * ((const f32x4*)gam_out)[lane + 64 * j];
        if (HAS_H) { B[j] = ((const f32x4*)gam_in)[lane + 64 * j] * (((const f32x4*)sc)[lane + 64 * j] + 1.0f); C[j] = ((const f32x4*)sh)[lane + 64 * j]; }
    }
    const float* xres = (const float*)xres_; const bf16_t* xres16 = (const bf16_t*)xres_; float* xdst = (float*)xdst_; bf16_t* xdst16 = (bf16_t*)xdst_;
    f32x4 nv[4]; u32x2 nx[4], nr[4];
#pragma unroll
    for (int j = 0; j < 4; ++j) { if (XIN16) nx[j] = ((const u32x2*)xres16)[lane + 64 * j]; else nv[j] = ((const f32x4*)xres)[lane + 64 * j]; if (HAS_RAW) nr[j] = ((const u32x2*)raw)[lane + 64 * j]; }
#pragma unroll 1
    for (int r = 0; r < 8; ++r) {
        f32x4 v[4]; u32x2 w[4];
#pragma unroll
        for (int j = 0; j < 4; ++j) { if (XIN16) v[j] = (f32x4){bflo(nx[j].x), bfhi(nx[j].x), bflo(nx[j].y), bfhi(nx[j].y)}; else v[j] = nv[j]; if (HAS_RAW) w[j] = nr[j]; }
        if (r + 1 < 8) {
#pragma unroll
            for (int j = 0; j < 4; ++j) { if (XIN16) nx[j] = ((const u32x2*)(xres16 + (size_t)(r + 1) * D))[lane + 64 * j]; else nv[j] = ((const f32x4*)(xres + (size_t)(r + 1) * D))[lane + 64 * j];
                if (HAS_RAW) nr[j] = ((const u32x2*)(raw + (size_t)(r + 1) * D))[lane + 64 * j]; }
        }
        if (HAS_RAW) {
            f32x4 o[4]; float ss = 0.f;
#pragma unroll
            for (int j = 0; j < 4; ++j) { o[j] = (f32x4){bflo(w[j].x), bfhi(w[j].x), bflo(w[j].y), bfhi(w[j].y)}; ss += (o[j][0] * o[j][0] + o[j][1] * o[j][1]) + (o[j][2] * o[j][2] + o[j][3] * o[j][3]); }
            const float rstd = 1.0f / sqrtf(wave_sum(ss, lane) * (1.0f / D) + RMS_EPS);
#pragma unroll
            for (int j = 0; j < 4; ++j) { v[j] = v[j] + A[j] * (o[j] * rstd);
                if (XOUT16) { u32x2 pw; pw.x = pk2(v[j][0], v[j][1]); pw.y = pk2(v[j][2], v[j][3]); ((u32x2*)(xdst16 + (size_t)r * D))[lane + 64 * j] = pw; }
                else ((f32x4*)(xdst + (size_t)r * D))[lane + 64 * j] = v[j]; }
        }
        if (HAS_H) {
            float ss = 0.f;
#pragma unroll
            for (int j = 0; j < 4; ++j) ss += (v[j][0] * v[j][0] + v[j][1] * v[j][1]) + (v[j][2] * v[j][2] + v[j][3] * v[j][3]);
            const float rstd = 1.0f / sqrtf(wave_sum(ss, lane) * (1.0f / D) + RMS_EPS);
#pragma unroll
            for (int j = 0; j < 4; ++j) { const f32x4 h = v[j] * rstd * B[j] + C[j]; if (hdst) { u32x2 pw; pw.x = pk2(h[0], h[1]); pw.y = pk2(h[2], h[3]); ((u32x2*)(hdst + (size_t)r * D))[lane + 64 * j] = pw; }
                if (HAS_H8) { unsigned t8 = 0u; t8 = __builtin_amdgcn_cvt_pk_fp8_f32(h[0], h[1], t8, false); t8 = __builtin_amdgcn_cvt_pk_fp8_f32(h[2], h[3], t8, true); ((unsigned*)(h8dst + (size_t)r * D))[lane + 64 * j] = t8; } }
        }
    }
}

__device__ __forceinline__ void conv_phase(const Args& a, int l, int wid_s) {
    const bf16_t* Z = (const bf16_t*)(a.ws + WS_Z); bf16_t* Y0 = (bf16_t*)(a.ws + WS_H);
    const float* cw = a.conv_w + (size_t)l * 3 * 256;
    const int gt = blockIdx.x * 512 + ftid(wid_s), GT = gridDim.x * 512;
    for (int it = gt; it < MROWS * 32; it += GT) {
        const int row = it >> 5, ch = (it & 31) * 8, t = row & (SEQ - 1);
        float acc[8];
#pragma unroll
        for (int k = 0; k < 8; ++k) acc[k] = 0.f;
#pragma unroll
        for (int j = 0; j < 3; ++j) { const int dt = 2 - j; if (t - dt < 0) continue;
            const bf16_t* zr = Z + (size_t)(row - dt) * ZW;
            const u32x4 u = *(const u32x4*)(zr + ZC_AU + ch), cgt = *(const u32x4*)(zr + ZC_AC + ch);
            const f32x4 w0 = *(const f32x4*)(cw + j * 256 + ch), w1 = *(const f32x4*)(cw + j * 256 + ch + 4);
            acc[0] += w0[0] * bflo(u.x) * bflo(cgt.x); acc[1] += w0[1] * bfhi(u.x) * bfhi(cgt.x); acc[2] += w0[2] * bflo(u.y) * bflo(cgt.y); acc[3] += w0[3] * bfhi(u.y) * bfhi(cgt.y);
            acc[4] += w1[0] * bflo(u.z) * bflo(cgt.z); acc[5] += w1[1] * bfhi(u.z) * bfhi(cgt.z); acc[6] += w1[2] * bflo(u.w) * bflo(cgt.w); acc[7] += w1[3] * bfhi(u.w) * bfhi(cgt.w); }
        const u32x4 bg = *(const u32x4*)(Z + (size_t)row * ZW + ZC_AB + ch);
        u32x4 o; o.x = pk2(acc[0] * bflo(bg.x), acc[1] * bfhi(bg.x)); o.y = pk2(acc[2] * bflo(bg.y), acc[3] * bfhi(bg.y)); o.z = pk2(acc[4] * bflo(bg.z), acc[5] * bfhi(bg.z)); o.w = pk2(acc[6] * bflo(bg.w), acc[7] * bfhi(bg.w));
        *(u32x4*)(Y0 + (size_t)row * 256 + ch) = o;
    }
}

__device__ __forceinline__ void fox_scan(const Args& a, int l, int bh, unsigned char* lds, int wid_s) {
    const int tid = ftid(wid_s), lane = tid & 63, wid = tid >> 6, b = bh >> 2, h = bh & 3;
    const float* SM = (const float*)(a.ws + WS_SMALL); float* F2 = (float*)(a.ws + WS_FCUM) + (size_t)bh * SEQ;
    const float bias = a.fox_bias[l * 4 + h];
    float* wtot = (float*)lds;
    float v[16]; float run = 0.f;
#pragma unroll
    for (int i = 0; i < 16; ++i) { const float x = SM[((size_t)b * SEQ + tid * 16 + i) * 8 + 4 + h] + bias;
        const float ls = fminf(x, 0.f) - log1pf(__expf(-fabsf(x))); run += ls; v[i] = run; }
    float inc = run;
#pragma unroll
    for (int o = 1; o < 64; o <<= 1) { const float t = shf(inc, lane - o); if (lane >= o) inc += t; }
    if (lane == 63) wtot[wid] = inc;
    __syncthreads();
    float base = inc - run;
    for (int w = 0; w < wid; ++w) base += wtot[w];
#pragma unroll
    for (int i = 0; i < 16; ++i) F2[tid * 16 + i] = (base + v[i]) * LOG2E;
    __syncthreads();
}


__device__ __forceinline__ void fox_kmax_item(const Args& a, int l, int item, int wid_s) {
    const int tid = ftid(wid_s), lane = tid & 63, bh = item >> 3, chunk = item & 7, b = bh >> 2, h = bh & 3;
    const bf16_t* Z = (const bf16_t*)(a.ws + WS_Z);
    float mx = 0.f;
#pragma unroll
    for (int rr = 0; rr < 2; ++rr) { const bf16_t* kp = Z + ((size_t)b * SEQ + chunk * 1024 + rr * 512 + tid) * ZW + ZC_FK + h * 64; float q2 = 0.f;
#pragma unroll
        for (int i = 0; i < 8; ++i) { const u32x4 w = *(const u32x4*)(kp + 8 * i);
            q2 += bflo(w.x) * bflo(w.x) + bfhi(w.x) * bfhi(w.x) + bflo(w.y) * bflo(w.y) + bfhi(w.y) * bfhi(w.y) + bflo(w.z) * bflo(w.z) + bfhi(w.z) * bfhi(w.z) + bflo(w.w) * bflo(w.w) + bfhi(w.w) * bfhi(w.w); }
        mx = fmaxf(mx, q2); }
#pragma unroll
    for (int o = 1; o < 64; o <<= 1) mx = fmaxf(mx, shf(mx, lane ^ o));
    if (lane == 0) atomicMax((unsigned*)(a.ws + WS_KMAX) + l * 8 + bh, __float_as_uint(mx));
}

template <int MODE>
__device__ __forceinline__ void attn_unit(unsigned char* lds, const bf16_t* __restrict__ Z, bf16_t* __restrict__ Yn, int b, int head, int qb, const float* __restrict__ F2, float slope2, float sink2, int tile_lo, float kmax, int wid_s) {
    const int tid = ftid(wid_s), lane = tid & 63, r32 = lane & 31, hi = lane >> 5; const int wid = __builtin_amdgcn_readfirstlane(tid >> 6);
    constexpr int QOFF = MODE == 0 ? ZC_FQ : ZC_SQ, KOFF = MODE == 0 ? ZC_FK : ZC_SK, VOFF = MODE == 0 ? ZC_FV : ZC_SV;
    const int hk = MODE == 0 ? head : (head >> 1);
    const size_t rowbase = (size_t)b * SEQ;
    const int q0 = qb * 256, qa = q0 + 32 * wid, myq = qa + r32;
    unsigned char* Ks = lds; unsigned char* Vs = lds + 9216; float* Fk = (float*)(lds + 9216 + 12288); float* wsc = (float*)(lds + 49152) + wid * 64;
    bf16x8 qr[4];
    { const bf16_t* qp = Z + (rowbase + myq) * ZW + QOFF + head * 64 + hi * 8;
#pragma unroll
      for (int ks = 0; ks < 4; ++ks) qr[ks] = *(const bf16x8*)(qp + 16 * ks); }
    const float* Fh = MODE == 0 ? F2 + ((size_t)b * 4 + head) * SEQ : nullptr;
    const float fq2 = MODE == 0 ? Fh[myq] : 0.f;
    float m = -1e30f, l = 0.f; f32x16 o0, o1;
#pragma unroll
    for (int r = 0; r < 16; ++r) { o0[r] = 0.f; o1[r] = 0.f; }
    const int t_hi = (q0 + 255) >> 6;
    if (MODE == 0) {
        int* smin = (int*)(lds + 49152 + 2048);
        __syncthreads();
        if (tid == 0) *smin = 0x7fffffff;
        __syncthreads();
        if (tid < 256) {
            const int t = q0 + tid; const bf16_t* qp2 = Z + (rowbase + t) * ZW + QOFF + head * 64; float q2 = 0.f;
#pragma unroll
            for (int i = 0; i < 8; ++i) { const u32x4 w = *(const u32x4*)(qp2 + 8 * i);
                q2 += bflo(w.x) * bflo(w.x) + bfhi(w.x) * bfhi(w.x) + bflo(w.y) * bflo(w.y) + bfhi(w.y) * bfhi(w.y) + bflo(w.z) * bflo(w.z) + bfhi(w.z) * bfhi(w.z) + bflo(w.w) * bflo(w.w) + bfhi(w.w) * bfhi(w.w); }
            const float target = Fh[t] + (40.0f + 0.25f * sqrtf(q2) * kmax) * LOG2E;
            int lo = 0, hi2 = t;
            while (lo < hi2) { const int mid = (lo + hi2) >> 1; if (Fh[mid] <= target) hi2 = mid; else lo = mid + 1; }
            atomicMin(smin, lo);
        }
        __syncthreads();
#ifdef PROBE_FOXFULL
        tile_lo = 0;
#else
        tile_lo = *smin >> 6;
#endif
    }
    const int srow = tid >> 3, sch = tid & 7;
    const int i16 = lane & 15;
    const LAS unsigned char* vtr_base = (const LAS unsigned char*)(Vs) + (4 * hi + (i16 >> 2)) * 192 + (16 * ((lane >> 4) & 1) + 4 * (i16 & 3)) * 2;
    u32x4 nk, nv4; float nf = 0.f;
    { const bf16_t* src = Z + (rowbase + 64 * t_hi + srow) * ZW;
      nk = *(const u32x4*)(src + KOFF + hk * 64 + sch * 8); nv4 = *(const u32x4*)(src + VOFF + hk * 64 + sch * 8);
      if (MODE == 0 && tid < 64) nf = Fh[64 * t_hi + tid]; }
    constexpr int ABUF = 24576;
    __syncthreads();
    { unsigned char* kb_ = Ks + (t_hi & 1) * ABUF; unsigned char* vb_ = Vs + (t_hi & 1) * ABUF;
      *(u32x4*)(kb_ + srow * 144 + sch * 16) = nk; *(u32x4*)(vb_ + srow * 192 + sch * 16) = nv4;
      if (MODE == 0 && tid < 64) (Fk + (t_hi & 1) * (ABUF / 4))[tid] = nf; }
    if (t_hi > tile_lo) { const bf16_t* src = Z + (rowbase + 64 * (t_hi - 1) + srow) * ZW;
      nk = *(const u32x4*)(src + KOFF + hk * 64 + sch * 8); nv4 = *(const u32x4*)(src + VOFF + hk * 64 + sch * 8);
      if (MODE == 0 && tid < 64) nf = Fh[64 * (t_hi - 1) + tid]; }
    for (int T = t_hi; T >= tile_lo; --T) {
        __syncthreads();
        if (T > tile_lo) {
            unsigned char* kb_ = Ks + ((T - 1) & 1) * ABUF; unsigned char* vb_ = Vs + ((T - 1) & 1) * ABUF;
            *(u32x4*)(kb_ + srow * 144 + sch * 16) = nk; *(u32x4*)(vb_ + srow * 192 + sch * 16) = nv4;
            if (MODE == 0 && tid < 64) (Fk + ((T - 1) & 1) * (ABUF / 4))[tid] = nf;
            if (T - 1 > tile_lo) { const bf16_t* src = Z + (rowbase + 64 * (T - 2) + srow) * ZW;
              nk = *(const u32x4*)(src + KOFF + hk * 64 + sch * 8); nv4 = *(const u32x4*)(src + VOFF + hk * 64 + sch * 8);
              if (MODE == 0 && tid < 64) nf = Fh[64 * (T - 2) + tid]; }
        }
        const unsigned char* Kc = Ks + (T & 1) * ABUF; const float* Fc = Fk + (T & 1) * (ABUF / 4); const int vofs = (T & 1) * ABUF;
        const bool part = (64 * T <= qa + 31) && (MODE == 0 || (64 * T + 63 >= qa - 127));
        if (part) {
            f32x16 p0, p1;
#pragma unroll
            for (int r = 0; r < 16; ++r) { p0[r] = 0.f; p1[r] = 0.f; }
#pragma unroll
            for (int ks = 0; ks < 4; ++ks) {
                const bf16x8 k0 = *(const bf16x8*)(Kc + r32 * 144 + (16 * ks + 8 * hi) * 2);
                const bf16x8 k1 = *(const bf16x8*)(Kc + (32 + r32) * 144 + (16 * ks + 8 * hi) * 2);
                p0 = __builtin_amdgcn_mfma_f32_32x32x16_bf16(k0, qr[ks], p0, 0, 0, 0);
                p1 = __builtin_amdgcn_mfma_f32_32x32x16_bf16(k1, qr[ks], p1, 0, 0, 0);
            }
            const int kvb = 64 * T + 4 * hi;
            float mx = -INFINITY;
#pragma unroll
            for (int g = 0; g < 4; ++g) {
                f32x4 fk0 = {0.f, 0.f, 0.f, 0.f}, fk1 = {0.f, 0.f, 0.f, 0.f};
                if (MODE == 0) { fk0 = *(const f32x4*)(Fc + 8 * g + 4 * hi); fk1 = *(const f32x4*)(Fc + 32 + 8 * g + 4 * hi); }
#pragma unroll
                for (int i = 0; i < 4; ++i) { const int r = 4 * g + i, kv0 = kvb + 8 * g + i, kv1 = kv0 + 32;
                    float x0, x1;
                    if (MODE == 0) { x0 = p0[r] * C2 + (fq2 - fk0[i]); x1 = p1[r] * C2 + (fq2 - fk1[i]); if (kv0 > myq) x0 = -INFINITY; if (kv1 > myq) x1 = -INFINITY; }
                    else { const int d0 = myq - kv0, d1 = myq - kv1; x0 = p0[r] * C2 - slope2 * (float)d0; x1 = p1[r] * C2 - slope2 * (float)d1; if (d0 < 0 || d0 >= 128) x0 = -INFINITY; if (d1 < 0 || d1 >= 128) x1 = -INFINITY; }
                    p0[r] = x0; p1[r] = x1; mx = fmaxf(mx, fmaxf(x0, x1)); }
            }
            mx = swap32_max(mx);
            const float mn = fmaxf(m, mx), alpha = __builtin_amdgcn_exp2f(m - mn); m = mn;
            float ps = 0.f;
#pragma unroll
            for (int r = 0; r < 16; ++r) { p0[r] = __builtin_amdgcn_exp2f(p0[r] - mn); p1[r] = __builtin_amdgcn_exp2f(p1[r] - mn); ps += p0[r] + p1[r]; }
            l = l * alpha + ps;
            if (hi == 0) wsc[r32] = alpha;
            LDSWAIT();
#pragma unroll
            for (int g = 0; g < 4; ++g) { const f32x4 a4 = *(const f32x4*)(wsc + 8 * g + 4 * hi);
#pragma unroll
                for (int i = 0; i < 4; ++i) { o0[4 * g + i] *= a4[i]; o1[4 * g + i] *= a4[i]; } }
            LDSWAIT();
#pragma unroll
            for (int s = 0; s < 4; ++s) {
                u32x4 pw;
                if (s < 2) { const int e = 8 * s; pw.x = pk2(p0[e], p0[e + 1]); pw.y = pk2(p0[e + 2], p0[e + 3]); pw.z = pk2(p0[e + 4], p0[e + 5]); pw.w = pk2(p0[e + 6], p0[e + 7]); }
                else { const int e = 8 * (s - 2); pw.x = pk2(p1[e], p1[e + 1]); pw.y = pk2(p1[e + 2], p1[e + 3]); pw.z = pk2(p1[e + 4], p1[e + 5]); pw.w = pk2(p1[e + 6], p1[e + 7]); }
                const bf16x8 pa = __builtin_bit_cast(bf16x8, pw);
#pragma unroll
                for (int db = 0; db < 2; ++db) {
                    const LAS unsigned char* vp = vtr_base + vofs + (16 * s) * 192 + 64 * db;
                    const s16x4 lo = __builtin_bit_cast(s16x4, __builtin_amdgcn_ds_read_tr16_b64_v4i16((LAS s16x4*)vp));
                    const s16x4 hv = __builtin_bit_cast(s16x4, __builtin_amdgcn_ds_read_tr16_b64_v4i16((LAS s16x4*)(vp + 8 * 192)));
                    const bf16x8 vf = (bf16x8){lo[0], lo[1], lo[2], lo[3], hv[0], hv[1], hv[2], hv[3]};
                    if (db == 0) o0 = __builtin_amdgcn_mfma_f32_32x32x16_bf16(pa, vf, o0, 0, 0, 0); else o1 = __builtin_amdgcn_mfma_f32_32x32x16_bf16(pa, vf, o1, 0, 0, 0);
                }
            }
        }
    }
    float lt = swap32_sum(l);
    if (MODE == 1) lt += __builtin_amdgcn_exp2f(sink2 - m);
    const float inv = 1.0f / lt;
    LDSWAIT();
    if (hi == 0) wsc[32 + r32] = inv;
    LDSWAIT();
#pragma unroll
    for (int g = 0; g < 4; ++g) { const f32x4 iv = *(const f32x4*)(wsc + 32 + 8 * g + 4 * hi);
#pragma unroll
        for (int i = 0; i < 4; ++i) { const int r = 4 * g + i, q = qa + 8 * g + 4 * hi + i;
            bf16_t* yp = Yn + (rowbase + q) * 256 + head * 64 + r32;
            yp[0] = (bf16_t)f2bf(o0[r] * iv[i]); yp[32] = (bf16_t)f2bf(o1[r] * iv[i]); } }
    LDSWAIT();
}

__device__ __forceinline__ unsigned score_key(float s) { const unsigned u = __float_as_uint(s + 0.0f); return (u & 0x80000000u) ? ~u : (u | 0x80000000u); }
__device__ __forceinline__ void hist_find(const unsigned* hrow, int lane, unsigned need, unsigned& bin, unsigned& above) {
    unsigned w[16]; unsigned tot = 0;
#pragma unroll
    for (int i = 0; i < 16; i += 4) { const u32x4 t = *(const u32x4*)(hrow + 16 * lane + i); w[i] = t.x; w[i + 1] = t.y; w[i + 2] = t.z; w[i + 3] = t.w; }
#pragma unroll
    for (int i = 0; i < 16; ++i) tot += (w[i] & 0xffffu) + (w[i] >> 16);
    unsigned inc = tot;
#pragma unroll
    for (int o = 1; o < 64; o <<= 1) { const unsigned t = shu(inc, lane + o); if (lane + o < 64) inc += t; }
    const unsigned exc = inc - tot;
    const bool owner = (exc < need) && (inc >= need);
    unsigned run = exc, fb = 0, fa = 0; bool found = false;
#pragma unroll
    for (int i = 15; i >= 0; --i) {
        const unsigned hi = w[i] >> 16, lo = w[i] & 0xffffu;
        if (!found && run + hi >= need) { found = true; fb = 32 * lane + 2 * i + 1; fa = run; }
        run += hi;
        if (!found && run + lo >= need) { found = true; fb = 32 * lane + 2 * i; fa = run; }
        run += lo;
    }
    const unsigned long long bal = __ballot(owner);
    const int src = bal ? (int)__builtin_ctzll(bal) : 0;
    bin = shu(fb, src); above = shu(fa, src);
}
__device__ __forceinline__ void dsa_select_slow(const Args& a, unsigned char* lds, int b, int qb32, int wid_s) {
    const int tid = ftid(wid_s), lane = tid & 63; const int wid = __builtin_amdgcn_readfirstlane(tid >> 6);
    const int c16 = lane & 15, g = lane >> 4;
    const bf16_t* Z = (const bf16_t*)(a.ws + WS_Z); const float* SM = (const float*)(a.ws + WS_SMALL);
    unsigned short* IDX = (unsigned short*)(a.ws + WS_MG);
    unsigned* hist = (unsigned*)lds;
    unsigned char* kt = lds + 131072;
    const size_t rowbase = (size_t)b * SEQ;
    const int t0 = qb32 * 32, myt = t0 + 4 * wid + g;
    const int ntile = (t0 + 32 + 63) >> 6;
    bf16x8 af[2];
    { const int qq = c16 >> 2, h = c16 & 3; const bf16_t* qp = Z + (rowbase + t0 + 4 * wid + qq) * ZW + ZC_DQI + h * 64 + 8 * g;
      af[0] = *(const bf16x8*)qp; af[1] = *(const bf16x8*)(qp + 32); }
    const f32x4 wv = *(const f32x4*)(SM + (rowbase + myt) * 8);
    const unsigned need = (unsigned)((myt + 1) < 256 ? (myt + 1) : 256);
    unsigned b1 = 0, above1 = 0, thr22 = 0, quota = 0;
    unsigned tiecount = 0, outcount = 0;
    unsigned* myhist = hist + (size_t)(4 * wid + g) * 1024;
    unsigned short* myidx = IDX + (rowbase + myt) * 256;
    const int srow = tid >> 3, sch = tid & 7;
    for (int pass = 0; pass < 3; ++pass) {
        if (pass < 2) { unsigned z_ = 0u; asm volatile("" : "+v"(z_)); const u32x4 z4 = {z_, z_, z_, z_};
            for (int i = tid; i < 32 * 1024 / 4; i += 512) ((u32x4*)hist)[i] = z4; }
        for (int T = 0; T < ntile; ++T) {
            __syncthreads();
            *(u32x4*)(kt + srow * 144 + sch * 16) = *(const u32x4*)(Z + (rowbase + 64 * T + srow) * ZW + ZC_DKI + sch * 8);
            __syncthreads();
#pragma unroll
            for (int cg4 = 0; cg4 < 4; ++cg4) {
                const bf16x8 k0 = *(const bf16x8*)(kt + (16 * cg4 + c16) * 144 + (8 * g) * 2);
                const bf16x8 k1 = *(const bf16x8*)(kt + (16 * cg4 + c16) * 144 + (32 + 8 * g) * 2);
                f32x4 acc = {0.f, 0.f, 0.f, 0.f};
                acc = __builtin_amdgcn_mfma_f32_16x16x32_bf16(af[0], k0, acc, 0, 0, 0);
                acc = __builtin_amdgcn_mfma_f32_16x16x32_bf16(af[1], k1, acc, 0, 0, 0);
                const int key = 64 * T + 16 * cg4 + c16;
                const bool valid = key <= myt;
                const float sc = wv[0] * fmaxf(acc[0], 0.f) + wv[1] * fmaxf(acc[1], 0.f) + wv[2] * fmaxf(acc[2], 0.f) + wv[3] * fmaxf(acc[3], 0.f);
                const unsigned u = score_key(sc);
                if (pass == 0) { if (valid) { const unsigned bin = u >> 21; atomicAdd(myhist + (bin >> 1), (bin & 1u) ? 65536u : 1u); } }
                else if (pass == 1) { if (valid && (u >> 21) == b1) { const unsigned bin = (u >> 10) & 0x7ffu; atomicAdd(myhist + (bin >> 1), (bin & 1u) ? 65536u : 1u); } }
                else {
                    const unsigned p22 = u >> 10;
                    const bool tie = valid && (p22 == thr22);
                    const unsigned long long tb = __ballot(tie);
                    const unsigned tmask = (unsigned)(tb >> (16 * g)) & 0xffffu;
                    const bool acc_tie = tie && (tiecount + __popc(tmask & ((1u << c16) - 1u)) < quota);
                    tiecount += __popc(tmask);
                    const bool sel = (valid && p22 > thr22) || acc_tie;
                    const unsigned long long sb = __ballot(sel);
                    const unsigned smask = (unsigned)(sb >> (16 * g)) & 0xffffu;
                    if (sel) myidx[outcount + __popc(smask & ((1u << c16) - 1u))] = (unsigned short)key;
                    outcount += __popc(smask);
                }
            }
        }
        __syncthreads();
        if (pass == 0) {
#pragma unroll
            for (int qq = 0; qq < 4; ++qq) { const unsigned nd = shu(need, 16 * qq); unsigned bn, ab; hist_find(hist + (size_t)(4 * wid + qq) * 1024, lane, nd, bn, ab); if (g == qq) { b1 = bn; above1 = ab; } }
            __syncthreads();
        } else if (pass == 1) {
#pragma unroll
            for (int qq = 0; qq < 4; ++qq) { const unsigned nd = shu(need - above1, 16 * qq); unsigned bn, ab; hist_find(hist + (size_t)(4 * wid + qq) * 1024, lane, nd, bn, ab); if (g == qq) { thr22 = (b1 << 11) | bn; quota = need - above1 - ab; } }
            __syncthreads();
        }
    }
}


#ifndef SELREP
#define SELREP 0
#endif
constexpr int DS_CAP = 576, DS_RANK = 104;
constexpr unsigned ZCLASS = 0x80000000u >> 10;
__device__ __forceinline__ unsigned below_me(unsigned long long bal) { return __builtin_amdgcn_mbcnt_hi((unsigned)(bal >> 32), __builtin_amdgcn_mbcnt_lo((unsigned)bal, 0u)); }
__device__ __forceinline__ float relu1(float x) { return __builtin_amdgcn_fmed3f(x, 0.0f, 3.0e38f); }
__device__ __forceinline__ float idx_score_acc(const f32x4& acc, const f32x4& wv) {
    return fmaf(wv[3], relu1(acc[3]), fmaf(wv[2], relu1(acc[2]), fmaf(wv[1], relu1(acc[1]), wv[0] * relu1(acc[0])))) + 0.0f;
}
__device__ __forceinline__ unsigned fkey(float s) { const unsigned u = __float_as_uint(s); return (u & 0x80000000u) ? ~u : (u | 0x80000000u); }
__device__ __forceinline__ float key_to_float(unsigned k) { return k == 0u ? -INFINITY : __uint_as_float((k & 0x80000000u) ? (k & 0x7fffffffu) : ~k); }
__device__ __forceinline__ void idx_scores8(const unsigned char* kt, int c16, int g, const bf16x8 (&af)[2], const f32x4& wv, float (&u)[8]) {
    bf16x8 kf[8][2];
#pragma unroll
    for (int grp = 0; grp < 8; ++grp) { kf[grp][0] = *(const bf16x8*)(kt + (16 * grp + c16) * 144 + (8 * g) * 2); kf[grp][1] = *(const bf16x8*)(kt + (16 * grp + c16) * 144 + (32 + 8 * g) * 2); }
    __builtin_amdgcn_sched_barrier(0);
    f32x4 acc[8];
#pragma unroll
    for (int grp = 0; grp < 8; ++grp) acc[grp] = __builtin_amdgcn_mfma_f32_16x16x32_bf16(af[0], kf[grp][0], (f32x4){0.f, 0.f, 0.f, 0.f}, 0, 0, 0);
#pragma unroll
    for (int grp = 0; grp < 8; ++grp) acc[grp] = __builtin_amdgcn_mfma_f32_16x16x32_bf16(af[1], kf[grp][1], acc[grp], 0, 0, 0);
    __builtin_amdgcn_sched_barrier(0);
#pragma unroll
    for (int grp = 0; grp < 8; ++grp) u[grp] = idx_score_acc(acc[grp], wv);
}
__device__ __forceinline__ unsigned row_scan_incl(unsigned x) {
    x += (unsigned)__builtin_amdgcn_update_dpp(0, (int)x, 0x111, 0xF, 0xF, true);
    x += (unsigned)__builtin_amdgcn_update_dpp(0, (int)x, 0x112, 0xF, 0xF, true);
    x += (unsigned)__builtin_amdgcn_update_dpp(0, (int)x, 0x114, 0xF, 0xF, true);
    x += (unsigned)__builtin_amdgcn_update_dpp(0, (int)x, 0x118, 0xF, 0xF, true);
    return x;
}
__device__ __forceinline__ unsigned wave_total(unsigned x) {
    x = row_scan_incl(x);
    return (unsigned)__builtin_amdgcn_readlane((int)x, 15) + (unsigned)__builtin_amdgcn_readlane((int)x, 31) + (unsigned)__builtin_amdgcn_readlane((int)x, 47) + (unsigned)__builtin_amdgcn_readlane((int)x, 63);
}
__device__ __forceinline__ unsigned wave_max_u(unsigned x) {
    unsigned y;
    y = (unsigned)__builtin_amdgcn_update_dpp(0, (int)x, 0x111, 0xF, 0xF, true); x = x > y ? x : y;
    y = (unsigned)__builtin_amdgcn_update_dpp(0, (int)x, 0x112, 0xF, 0xF, true); x = x > y ? x : y;
    y = (unsigned)__builtin_amdgcn_update_dpp(0, (int)x, 0x114, 0xF, 0xF, true); x = x > y ? x : y;
    y = (unsigned)__builtin_amdgcn_update_dpp(0, (int)x, 0x118, 0xF, 0xF, true); x = x > y ? x : y;
    const unsigned a = (unsigned)__builtin_amdgcn_readlane((int)x, 15), b = (unsigned)__builtin_amdgcn_readlane((int)x, 31), c = (unsigned)__builtin_amdgcn_readlane((int)x, 47), d = (unsigned)__builtin_amdgcn_readlane((int)x, 63);
    const unsigned ab = a > b ? a : b, cd = c > d ? c : d; return ab > cd ? ab : cd;
}
template <bool EDGE, bool NEEDZ>
__device__ __forceinline__ void selB_groups(const float (&sc)[8], int keybase, int myt, float tauf, unsigned need, int lane, int c16, int g, unsigned& cnt, unsigned& zc, unsigned* curow, unsigned char* chrow, unsigned short* zlrow) {
    unsigned hm = 0u;
#pragma unroll
    for (int grp = 0; grp < 8; ++grp) {
        const float s = sc[grp];
        bool h = NEEDZ ? ((s >= tauf) && (s != 0.0f)) : (s >= tauf);
        if (EDGE) h = h && (keybase + 16 * grp + c16 <= myt);
        hm |= h ? (1u << grp) : 0u;
    }
    const unsigned nh = (unsigned)__popc(hm), inc = row_scan_incl(nh);
    unsigned pos = cnt + inc - nh;
    cnt += shu(inc, (lane & 48) | 15);
    unsigned rem = hm;
    while (__ballot(rem != 0u)) {
        if (rem) {
            const int grp = __builtin_ctz(rem); rem &= rem - 1u;
            const float a0 = (grp & 1) ? sc[1] : sc[0], a1 = (grp & 1) ? sc[3] : sc[2], a2 = (grp & 1) ? sc[5] : sc[4], a3 = (grp & 1) ? sc[7] : sc[6];
            const float b0 = (grp & 2) ? a1 : a0, b1 = (grp & 2) ? a3 : a2, s = (grp & 4) ? b1 : b0;
            const int key = keybase + 16 * grp + c16;
            if (pos < (unsigned)DS_CAP) { curow[pos] = (fkey(s) & 0xfffffc00u) | ((unsigned)key & 1023u); chrow[pos] = (unsigned char)(key >> 10); }
            ++pos;
        }
    }
    if (NEEDZ) {
        const unsigned lowm = (1u << c16) - 1u;
#pragma unroll
        for (int grp = 0; grp < 8; ++grp) {
            const int key = keybase + 16 * grp + c16;
            bool isz = sc[grp] == 0.0f;
            if (EDGE) isz = isz && (key <= myt);
            const unsigned zmask = (unsigned)(__ballot(isz) >> (16 * g)) & 0xffffu;
            const unsigned zpos = zc + __popc(zmask & lowm);
            if (isz && zpos < need) zlrow[zpos] = (unsigned short)key;
            zc += __popc(zmask);
        }
    }
}
__device__ __forceinline__ void dsa_select_item(const Args& a, unsigned char* lds, int b, int qb32, int wid_s) {
    const int tid = ftid(wid_s), lane = tid & 63; const int wid = __builtin_amdgcn_readfirstlane(tid >> 6);
    const int c16 = lane & 15, g = lane >> 4;
    const bf16_t* Z = (const bf16_t*)(a.ws + WS_Z); const float* SM = (const float*)(a.ws + WS_SMALL);
    unsigned short* IDX = (unsigned short*)(a.ws + WS_MG);
    unsigned short* samp = (unsigned short*)lds;
    unsigned char* ktA = lds + 131072;
    unsigned* cu = (unsigned*)lds;
    unsigned char* ch = lds + 73728;
    unsigned short* zl = (unsigned short*)(lds + 92160);
    unsigned char* ktB = lds + 108544;
    unsigned* flag = (unsigned*)(lds + 149760);
    const size_t rowbase = (size_t)b * SEQ;
    const int t0 = qb32 * 32, myt = t0 + 4 * wid + g, myrow = 4 * wid + g;
    bf16x8 af[2];
    { const int qq = c16 >> 2, h = c16 & 3; const bf16_t* qp = Z + (rowbase + t0 + 4 * wid + qq) * ZW + ZC_DQI + h * 64 + 8 * g;
      af[0] = *(const bf16x8*)qp; af[1] = *(const bf16x8*)(qp + 32); }
#ifdef PROBE_QTRUNC
    { u32x4 t0_ = __builtin_bit_cast(u32x4, af[0]), t1_ = __builtin_bit_cast(u32x4, af[1]); const unsigned mk = 0xfffcfffcu;
      t0_.x &= mk; t0_.y &= mk; t0_.z &= mk; t0_.w &= mk; t1_.x &= mk; t1_.y &= mk; t1_.z &= mk; t1_.w &= mk; af[0] = __builtin_bit_cast(bf16x8, t0_); af[1] = __builtin_bit_cast(bf16x8, t1_); }
#endif
    const f32x4 wv = *(const f32x4*)(SM + (rowbase + myt) * 8);
    const unsigned need = (unsigned)((myt + 1) < 256 ? (myt + 1) : 256);
    const int srow = tid >> 3, sch = tid & 7;
    __syncthreads();
    if (tid == 0) *flag = 0u;
    unsigned tau = 0u;
    for (int repA_ = 0; repA_ < ((SELREP & 1) ? 2 : 1); ++repA_)
    if (t0 + 32 > DS_CAP) {
        __syncthreads();
        const int ms = (t0 + 32) >> 2, ntA = (ms + 127) >> 7;
        const bf16_t* sbase = Z + (rowbase + 3) * ZW + ZC_DKI + sch * 8;
        u32x4 n0, n1;
        { const int i0 = srow < ms ? srow : ms - 1, i1 = 64 + srow < ms ? 64 + srow : ms - 1;
          n0 = *(const u32x4*)(sbase + (size_t)(4 * i0) * ZW); n1 = *(const u32x4*)(sbase + (size_t)(4 * i1) * ZW); }
        for (int T = 0; T < ntA; ++T) {
            __syncthreads();
            *(u32x4*)(ktA + srow * 144 + sch * 16) = n0; *(u32x4*)(ktA + (64 + srow) * 144 + sch * 16) = n1;
            __syncthreads();
            if (T + 1 < ntA) { const int j0 = 128 * (T + 1) + srow, j1 = j0 + 64; const int i0 = j0 < ms ? j0 : ms - 1, i1 = j1 < ms ? j1 : ms - 1;
                n0 = *(const u32x4*)(sbase + (size_t)(4 * i0) * ZW); n1 = *(const u32x4*)(sbase + (size_t)(4 * i1) * ZW); }
            float ua[8]; idx_scores8(ktA, c16, g, af, wv, ua);
#pragma unroll
            for (int grp = 0; grp < 8; ++grp) {
                const int i = 128 * T + 16 * grp + c16;
                samp[myrow * 2048 + i] = ((i < ms) && (4 * i + 3 <= myt)) ? (unsigned short)(fkey(ua[grp]) >> 16) : (unsigned short)0;
            }
        }
        LDSWAIT();
        const int nvalid = 128 * ntA;
        for (int repS_ = 0; repS_ < ((SELREP & 16) ? 2 : 1); ++repS_) {
            unsigned w[4][16];
#pragma unroll
            for (int qq = 0; qq < 4; ++qq) {
                const unsigned* sp = (const unsigned*)(samp + (4 * wid + qq) * 2048) + 16 * lane;
#pragma unroll
                for (int j = 0; j < 16; j += 4) { const u32x4 t4 = *(const u32x4*)(sp + j); w[qq][j] = t4.x; w[qq][j + 1] = t4.y; w[qq][j + 2] = t4.z; w[qq][j + 3] = t4.w; }
#pragma unroll
                for (int j = 0; j < 16; ++j) if (32 * lane + 2 * j >= nvalid) w[qq][j] = 0u;
            }
            unsigned T4[4] = {0u, 0u, 0u, 0u};
#pragma unroll 1
            for (int bit = 15; bit >= 0; --bit) {
                unsigned c[4];
#pragma unroll
                for (int qq = 0; qq < 4; ++qq) { const unsigned cand = T4[qq] | (1u << bit); unsigned cc = 0;
#pragma unroll
                    for (int j = 0; j < 16; ++j) cc += ((w[qq][j] & 0xffffu) >= cand ? 1u : 0u) + ((w[qq][j] >> 16) >= cand ? 1u : 0u);
                    c[qq] = cc; }
                const unsigned t01 = wave_total(c[0] | (c[1] << 16)), t23 = wave_total(c[2] | (c[3] << 16));
                if ((t01 & 0xffffu) >= (unsigned)DS_RANK) T4[0] |= 1u << bit;
                if ((t01 >> 16) >= (unsigned)DS_RANK) T4[1] |= 1u << bit;
                if ((t23 & 0xffffu) >= (unsigned)DS_RANK) T4[2] |= 1u << bit;
                if ((t23 >> 16) >= (unsigned)DS_RANK) T4[3] |= 1u << bit;
            }
#pragma unroll
            for (int qq = 0; qq < 4; ++qq) { const int n = t0 + 4 * wid + qq + 1; if (g == qq) tau = n > DS_CAP ? (T4[qq] << 16) : 0u; }
        }
    }
    unsigned cnt = 0u, zc = 0u;
    const float tauf = key_to_float(tau);
    const bool needz = __ballot(tauf <= 0.0f) != 0ull;
    const int ntile = (t0 + 32 + 127) >> 7;
    for (int repB_ = 0; repB_ < ((SELREP & 2) ? 2 : 1); ++repB_) { cnt = 0u; zc = 0u;
        const bf16_t* kbase = Z + (rowbase + srow) * ZW + ZC_DKI + sch * 8;
        u32x4 n0 = *(const u32x4*)kbase, n1 = *(const u32x4*)(kbase + (size_t)64 * ZW);
        __syncthreads();
        *(u32x4*)(ktB + srow * 144 + sch * 16) = n0; *(u32x4*)(ktB + (64 + srow) * 144 + sch * 16) = n1;
        __syncthreads();
        for (int T = 0; T < ntile; ++T) {
            const unsigned char* kt = ktB + (T & 1) * 18432;
            if (T + 1 < ntile) { const bf16_t* src = kbase + (size_t)(128 * (T + 1)) * ZW; n0 = *(const u32x4*)src; n1 = *(const u32x4*)(src + (size_t)64 * ZW); }
            float ub[8]; idx_scores8(kt, c16, g, af, wv, ub);
            if (128 * T + 127 <= t0) { if (needz) selB_groups<false, true>(ub, 128 * T, myt, tauf, need, lane, c16, g, cnt, zc, cu + myrow * DS_CAP, ch + myrow * DS_CAP, zl + myrow * 256);
                                       else selB_groups<false, false>(ub, 128 * T, myt, tauf, need, lane, c16, g, cnt, zc, cu + myrow * DS_CAP, ch + myrow * DS_CAP, zl + myrow * 256); }
            else { if (needz) selB_groups<true, true>(ub, 128 * T, myt, tauf, need, lane, c16, g, cnt, zc, cu + myrow * DS_CAP, ch + myrow * DS_CAP, zl + myrow * 256);
                   else selB_groups<true, false>(ub, 128 * T, myt, tauf, need, lane, c16, g, cnt, zc, cu + myrow * DS_CAP, ch + myrow * DS_CAP, zl + myrow * 256); }
            if (T + 1 < ntile) { unsigned char* kn = ktB + ((T + 1) & 1) * 18432; *(u32x4*)(kn + srow * 144 + sch * 16) = n0; *(u32x4*)(kn + (64 + srow) * 144 + sch * 16) = n1; }
            __syncthreads();
        }
    }
#if SELREP & 8
    {
        float dummy = 0.f;
        const bf16_t* kbase = Z + (rowbase + srow) * ZW + ZC_DKI + sch * 8;
        u32x4 n0 = *(const u32x4*)kbase, n1 = *(const u32x4*)(kbase + (size_t)64 * ZW);
        __syncthreads();
        *(u32x4*)(ktB + srow * 144 + sch * 16) = n0; *(u32x4*)(ktB + (64 + srow) * 144 + sch * 16) = n1;
        __syncthreads();
        for (int T = 0; T < ntile; ++T) {
            const unsigned char* kt = ktB + (T & 1) * 18432;
            if (T + 1 < ntile) { const bf16_t* src = kbase + (size_t)(128 * (T + 1)) * ZW; n0 = *(const u32x4*)src; n1 = *(const u32x4*)(src + (size_t)64 * ZW); }
            float ub[8]; idx_scores8(kt, c16, g, af, wv, ub);
#pragma unroll
            for (int grp = 0; grp < 8; ++grp) dummy += ub[grp];
            if (T + 1 < ntile) { unsigned char* kn = ktB + ((T + 1) & 1) * 18432; *(u32x4*)(kn + srow * 144 + sch * 16) = n0; *(u32x4*)(kn + (64 + srow) * 144 + sch * 16) = n1; }
            __syncthreads();
        }
        if (dummy == 123456.789f) *flag = 2u;
    }
#endif
    LDSWAIT();
    bool bad = false;
    for (int repC_ = 0; repC_ < ((SELREP & 4) ? 2 : 1); ++repC_) {
        unsigned ncq[4], ndq[4], nzq[4], uj[4][9], T4[4]; int topb[4];
#pragma unroll
        for (int qq = 0; qq < 4; ++qq) {
            ncq[qq] = (unsigned)__builtin_amdgcn_readlane((int)cnt, 16 * qq); ndq[qq] = (unsigned)__builtin_amdgcn_readlane((int)need, 16 * qq); nzq[qq] = (unsigned)__builtin_amdgcn_readlane((int)zc, 16 * qq);
            const unsigned ncl = ncq[qq] < (unsigned)DS_CAP ? ncq[qq] : (unsigned)DS_CAP;
            unsigned hi = 0u, lo = 0u;
#pragma unroll
            for (int j = 0; j < 9; ++j) { const unsigned pos = lane + 64 * j; const bool in = pos < ncl; uj[qq][j] = in ? (cu[(4 * wid + qq) * DS_CAP + pos] >> 10) : 0u;
                hi = hi > uj[qq][j] ? hi : uj[qq][j]; const unsigned x = in ? ~uj[qq][j] : 0u; lo = lo > x ? lo : x; }
            hi = wave_max_u(hi); lo = ~wave_max_u(lo);
            if (ncl == 0u) lo = hi;
            if (nzq[qq]) { hi = hi > ZCLASS ? hi : ZCLASS; lo = lo < ZCLASS ? lo : ZCLASS; }
            topb[qq] = (hi ^ lo) ? 31 - __builtin_clz(hi ^ lo) : -1;
            T4[qq] = topb[qq] >= 0 ? (hi & ~((2u << topb[qq]) - 1u)) : hi;
        }
#pragma unroll 1
        for (int bit = 21; bit >= 0; --bit) {
            unsigned c[4];
#pragma unroll
            for (int qq = 0; qq < 4; ++qq) { const unsigned cand = T4[qq] | (1u << bit); unsigned cc = 0;
#pragma unroll
                for (int j = 0; j < 9; ++j) cc += uj[qq][j] >= cand ? 1u : 0u;
                c[qq] = cc; }
            const unsigned t01 = wave_total(c[0] | (c[1] << 16)), t23 = wave_total(c[2] | (c[3] << 16));
            const unsigned tq[4] = {t01 & 0xffffu, t01 >> 16, t23 & 0xffffu, t23 >> 16};
#pragma unroll
            for (int qq = 0; qq < 4; ++qq) { const unsigned cand = T4[qq] | (1u << bit);
                if (bit <= topb[qq] && tq[qq] + (cand <= ZCLASS ? nzq[qq] : 0u) >= ndq[qq]) T4[qq] = cand; }
        }
#pragma unroll 1
        for (int qq = 0; qq < 4; ++qq) {
            const unsigned nc = ncq[qq], nd = ndq[qq], nz = nzq[qq], T = T4[qq];
            if (nc + nz < nd || nc > (unsigned)DS_CAP) { bad = true;
#ifdef NOFALLBACK
                { unsigned short* orow = IDX + (rowbase + t0 + 4 * wid + qq) * 256;
                  for (int j = 0; j < 4; ++j) if ((unsigned)(lane + 64 * j) < nd) orow[lane + 64 * j] = (unsigned short)(lane + 64 * j); }
#endif
                continue; }
            const int row = 4 * wid + qq;
            unsigned ujr[9], kj[9]; int ca = T < ZCLASS ? (int)nz : 0, nt = 0;
#pragma unroll
            for (int j = 0; j < 9; ++j) { const unsigned pos = lane + 64 * j; const unsigned cwj = pos < nc ? cu[row * DS_CAP + pos] : 0u; ujr[j] = cwj >> 10;
                kj[j] = pos < nc ? ((cwj & 1023u) | ((unsigned)ch[row * DS_CAP + pos] << 10)) : 0u;
                ca += __popcll(__ballot(ujr[j] > T)); nt += __popcll(__ballot(ujr[j] == T)); }
            const unsigned quota = nd - (unsigned)ca;
            unsigned Kstar = 0xffffu;
            if (T != ZCLASS && (unsigned)nt > quota) {
                unsigned K = 0u;
#pragma unroll 1
                for (int bit = 12; bit >= 0; --bit) { const unsigned test = K | (1u << bit); int c = 0;
#pragma unroll
                    for (int j = 0; j < 9; ++j) c += __popcll(__ballot(ujr[j] == T && kj[j] < test));
                    if ((unsigned)c < quota) K = test; }
                Kstar = K;
            }
            unsigned outbase = 0u;
            unsigned short* orow = IDX + (rowbase + t0 + row) * 256;
#pragma unroll
            for (int j = 0; j < 9; ++j) {
                const bool s = (ujr[j] > T) || (ujr[j] == T && kj[j] <= Kstar);
                const unsigned long long sb = __ballot(s);
                if (s) orow[outbase + below_me(sb)] = (unsigned short)kj[j];
                outbase += (unsigned)__popcll(sb);
            }
            const unsigned zsel = T < ZCLASS ? nz : (T == ZCLASS ? quota : 0u);
            for (unsigned i = lane; i < zsel; i += 64) orow[outbase + i] = zl[row * 256 + i];
        }
    }
    if (bad && lane == 0) atomicOr(flag, 1u);
    __syncthreads();
    const bool redo = *flag != 0u;
    __syncthreads();
#ifndef NOFALLBACK
    if (redo) dsa_select_slow(a, lds, b, qb32, wid_s);
#endif
}

constexpr int DA_WAVE_LDS = 512 + 64 * 160;
__device__ __forceinline__ void dsa_attend_wave(const Args& a, int gw, int NGW, int lane, unsigned char* wl) {
    const bf16_t* Z = (const bf16_t*)(a.ws + WS_Z); const unsigned short* IDXB = (const unsigned short*)(a.ws + WS_MG);
    bf16_t* Y1 = (bf16_t*)(a.ws + WS_H) + (size_t)MROWS * 256;
    const int c16 = lane & 15, g = lane >> 4, vr = lane >> 3, vc = lane & 7;
    unsigned short* il = (unsigned short*)wl; unsigned char* vl = wl + 512;
    const float slope2 = LOG2E * __builtin_amdgcn_exp2f(-(float)(5 + (c16 & 3)));
    const LAS unsigned char* vtr = (const LAS unsigned char*)vl + (4 * g + (c16 >> 2)) * 160 + (4 * (c16 & 3)) * 2;
    u32x2 iw = {0u, 0u};
    if (gw < MROWS) iw = *(const u32x2*)(IDXB + (size_t)gw * 256 + 4 * lane);
#pragma unroll 1
    for (int row = gw; row < MROWS; row += NGW) {
        const int t = row & (SEQ - 1); const size_t rowbase = (size_t)(row - t);
        const int nsel = (t + 1) < 256 ? (t + 1) : 256;
        { u32x2 w = iw; const int p0 = 4 * lane;
          if (p0 >= nsel) w.x &= 0xffff0000u; if (p0 + 1 >= nsel) w.x &= 0x0000ffffu; if (p0 + 2 >= nsel) w.y &= 0xffff0000u; if (p0 + 3 >= nsel) w.y &= 0x0000ffffu;
          *(u32x2*)(il + 4 * lane) = w; }
        if (row + NGW < MROWS) iw = *(const u32x2*)(IDXB + (size_t)(row + NGW) * 256 + 4 * lane);
        LDSWAIT();
        u32x4 v[8];
        const bf16_t* vb = Z + rowbase * ZW + ZC_DV + 8 * vc;
        const bf16_t* kb8 = Z + rowbase * ZW + ZC_DK + 8 * vc;
#pragma unroll
        for (int i = 0; i < 8; ++i) v[i] = *(const u32x4*)(kb8 + (size_t)il[8 * i + vr] * ZW);
        bf16x8 qf[2];
        { const bf16_t* qp = Z + (size_t)row * ZW + ZC_DQ + (c16 & 3) * 64 + 8 * g; const bf16x8 z8 = {0, 0, 0, 0, 0, 0, 0, 0};
          qf[0] = c16 < 4 ? *(const bf16x8*)qp : z8; qf[1] = c16 < 4 ? *(const bf16x8*)(qp + 32) : z8; }
        f32x4 s[16];
#pragma unroll
        for (int ch = 0; ch < 4; ++ch) {
            if (64 * ch < nsel) {
#pragma unroll
                for (int i = 0; i < 8; ++i) *(u32x4*)(vl + (8 * i + vr) * 144 + 16 * vc) = v[i];
                if (ch < 3 && 64 * (ch + 1) < nsel) {
#pragma unroll
                    for (int i = 0; i < 8; ++i) v[i] = *(const u32x4*)(kb8 + (size_t)il[64 * (ch + 1) + 8 * i + vr] * ZW);
                } else {
#pragma unroll
                    for (int i = 0; i < 8; ++i) v[i] = *(const u32x4*)(vb + (size_t)il[8 * i + vr] * ZW);
                }
                LDSWAIT();
#pragma unroll
                for (int tt = 0; tt < 4; ++tt) {
                    const bf16x8 k0 = *(const bf16x8*)(vl + (16 * tt + c16) * 144 + (8 * g) * 2), k1 = *(const bf16x8*)(vl + (16 * tt + c16) * 144 + (32 + 8 * g) * 2);
                    f32x4 acc = {0.f, 0.f, 0.f, 0.f};
                    acc = __builtin_amdgcn_mfma_f32_16x16x32_bf16(k0, qf[0], acc, 0, 0, 0);
                    acc = __builtin_amdgcn_mfma_f32_16x16x32_bf16(k1, qf[1], acc, 0, 0, 0);
                    s[4 * ch + tt] = acc; }
                asm volatile("" ::: "memory");
            } else {
#pragma unroll
                for (int tt = 0; tt < 4; ++tt) s[4 * ch + tt] = (f32x4){0.f, 0.f, 0.f, 0.f};
            }
        }
        float mx = -INFINITY;
#pragma unroll
        for (int kb = 0; kb < 16; ++kb) {
            const u32x2 kw = *(const u32x2*)(il + 16 * kb + 4 * g); const int p0 = 16 * kb + 4 * g;
            const int k0 = kw.x & 0xffff, k1 = kw.x >> 16, k2 = kw.y & 0xffff, k3 = kw.y >> 16;
            s[kb][0] = p0 < nsel ? s[kb][0] * C2 - slope2 * (float)(t - k0) : -INFINITY;
            s[kb][1] = p0 + 1 < nsel ? s[kb][1] * C2 - slope2 * (float)(t - k1) : -INFINITY;
            s[kb][2] = p0 + 2 < nsel ? s[kb][2] * C2 - slope2 * (float)(t - k2) : -INFINITY;
            s[kb][3] = p0 + 3 < nsel ? s[kb][3] * C2 - slope2 * (float)(t - k3) : -INFINITY;
            mx = fmaxf(fmaxf(mx, fmaxf(s[kb][0], s[kb][1])), fmaxf(s[kb][2], s[kb][3]));
        }
        mx = fmaxf(mx, shf(mx, lane ^ 16)); mx = fmaxf(mx, shf(mx, lane ^ 32));
        float ls = 0.f;
#pragma unroll
        for (int kb = 0; kb < 16; ++kb) {
#pragma unroll
            for (int r = 0; r < 4; ++r) { s[kb][r] = __builtin_amdgcn_exp2f(s[kb][r] - mx); ls += s[kb][r]; } }
        ls += shf(ls, lane ^ 16); ls += shf(ls, lane ^ 32);
        f32x4 o[4];
#pragma unroll
        for (int db = 0; db < 4; ++db) o[db] = (f32x4){0.f, 0.f, 0.f, 0.f};
#pragma unroll
        for (int ch = 0; ch < 4; ++ch) {
            if (64 * ch < nsel) {
#pragma unroll
                for (int i = 0; i < 8; ++i) *(u32x4*)(vl + (8 * i + vr) * 160 + 16 * vc) = v[i];
                if (ch < 3 && 64 * (ch + 1) < nsel) {
#pragma unroll
                    for (int i = 0; i < 8; ++i) v[i] = *(const u32x4*)(vb + (size_t)il[64 * (ch + 1) + 8 * i + vr] * ZW);
                }
                LDSWAIT();
#pragma unroll
                for (int s2 = 0; s2 < 2; ++s2) {
                    const f32x4 pa4 = s[4 * ch + 2 * s2], pb4 = s[4 * ch + 2 * s2 + 1];
                    u32x4 pw; pw.x = pk2(pa4[0], pa4[1]); pw.y = pk2(pa4[2], pa4[3]); pw.z = pk2(pb4[0], pb4[1]); pw.w = pk2(pb4[2], pb4[3]);
                    const bf16x8 pa = __builtin_bit_cast(bf16x8, pw);
#pragma unroll
                    for (int db = 0; db < 4; ++db) {
                        const LAS unsigned char* vp = vtr + (32 * s2) * 160 + 32 * db;
                        const s16x4 lo = __builtin_bit_cast(s16x4, __builtin_amdgcn_ds_read_tr16_b64_v4i16((LAS s16x4*)vp));
                        const s16x4 hv = __builtin_bit_cast(s16x4, __builtin_amdgcn_ds_read_tr16_b64_v4i16((LAS s16x4*)(vp + 16 * 160)));
                        const bf16x8 vf = (bf16x8){lo[0], lo[1], lo[2], lo[3], hv[0], hv[1], hv[2], hv[3]};
                        o[db] = __builtin_amdgcn_mfma_f32_16x16x32_bf16(pa, vf, o[db], 0, 0, 0);
                    }
                }
                asm volatile("" ::: "memory");
            }
        }
        const int lsi = __float_as_int(ls);
        const float i0 = 1.0f / __int_as_float(__builtin_amdgcn_readlane(lsi, 0)), i1 = 1.0f / __int_as_float(__builtin_amdgcn_readlane(lsi, 1)), i2 = 1.0f / __int_as_float(__builtin_amdgcn_readlane(lsi, 2)), i3 = 1.0f / __int_as_float(__builtin_amdgcn_readlane(lsi, 3));
        if (g == 0) { bf16_t* yp = Y1 + (size_t)row * 256 + c16;
#pragma unroll
            for (int db = 0; db < 4; ++db) { yp[0 * 64 + 16 * db] = (bf16_t)f2bf(o[db][0] * i0); yp[1 * 64 + 16 * db] = (bf16_t)f2bf(o[db][1] * i1); yp[2 * 64 + 16 * db] = (bf16_t)f2bf(o[db][2] * i2); yp[3 * 64 + 16 * db] = (bf16_t)f2bf(o[db][3] * i3); } }
        LDSWAIT();
    }
}


#ifndef PHMASK
#define PHMASK 0xffff
#endif
#ifndef DUPMASK
#define DUPMASK 0
#endif
#ifndef DUPN
#define DUPN 2
#endif
#ifndef MERGE_SP2
#define MERGE_SP2 true
#endif
#ifndef G8_SP2
#define G8_SP2 false
#endif
#ifndef EXTRASYNC
#define EXTRASYNC 0
#endif
typedef __attribute__((address_space(1))) unsigned gu32;
#define XB_TMO      128
#define XB_XCNT(j)  (256  + 64 * (j))
#define XB_XSUB(j)  (1280 + 64 * (j))
#define XB_XGEN(j)  (2304 + 64 * (j))
#define XB_TOP      3328
#define XB_TOPGEN   3392
#define XCD_BAR_WORDS 3456
#define XB_SPIN_CAP (1u << 18)

__device__ __forceinline__ unsigned xb_ld(unsigned* p)              { return __hip_atomic_load(p, __ATOMIC_RELAXED, __HIP_MEMORY_SCOPE_AGENT); }
__device__ __forceinline__ unsigned xb_add(unsigned* p, unsigned v) { return __hip_atomic_fetch_add(p, v, __ATOMIC_RELAXED, __HIP_MEMORY_SCOPE_AGENT); }
__device__ __forceinline__ unsigned xb_xcc_id() { return (unsigned)__builtin_amdgcn_s_getreg((3 << 11) | 20) & 0xFu; }
#define XB_SPIN(cond, bar) do { unsigned _sp = 0; while (cond) { __builtin_amdgcn_s_sleep(1); \
    if ((++_sp & 255u) == 0u) { if (xb_ld(&(bar)[XB_TMO])) break; if (_sp > XB_SPIN_CAP) { atomicAdd(&(bar)[XB_TMO], 1u); break; } } } } while (0)

struct XcdBarrier {
    unsigned* bar; unsigned x; int w;
    volatile LAS unsigned* st;
};

__device__ __forceinline__ bool xb_first_lane(int w) { unsigned ones = ~0u; asm volatile("" : "+s"(ones)); return w == 0 && __builtin_amdgcn_mbcnt_hi(ones, __builtin_amdgcn_mbcnt_lo(ones, 0u)) == 0u; }
__device__ __forceinline__ XcdBarrier xcd_barrier_post(unsigned* bar, volatile LAS unsigned* st, int w) {
    XcdBarrier b; b.bar = bar; b.x = xb_xcc_id(); b.st = st; b.w = w;
    if (xb_first_lane(w)) (void)xb_add(&bar[XB_XCNT(b.x)], 1u);
    return b;
}
__device__ __forceinline__ void xcd_barrier_complete(unsigned* bar, unsigned x, unsigned& nloc, unsigned& nx) {
    const unsigned G = gridDim.x * gridDim.y * gridDim.z;
    unsigned sum, cnt, mine, sp = 0u;
    for (;;) {
        sum = 0u; cnt = 0u; mine = 0u;
#pragma unroll
        for (unsigned j = 0; j < 16; ++j) { const unsigned c = xb_ld(&bar[XB_XCNT(j)]); sum += c; cnt += (c > 0u) ? 1u : 0u; mine = (j == x) ? c : mine; }
        if (sum == G) break;
        __builtin_amdgcn_s_sleep(1);
        if ((++sp & 255u) == 0u) { if (xb_ld(&bar[XB_TMO])) break; if (sp > XB_SPIN_CAP) { atomicAdd(&bar[XB_TMO], 1u); break; } }
    }
    nloc = mine > 0u ? mine : 1u; nx = cnt > 0u ? cnt : 1u;
}

__device__ __forceinline__ void xcd_barrier(const XcdBarrier& b) {
    asm volatile("s_waitcnt vmcnt(0)" ::: "memory");
    __syncthreads();
    if (xb_first_lane(b.w)) {
        unsigned* bar = b.bar;
        __builtin_amdgcn_s_waitcnt(0);
        unsigned nloc = b.st[0], nx = b.st[1];
        if (nloc == 0u) { xcd_barrier_complete(bar, b.x, nloc, nx); b.st[0] = nloc; b.st[1] = nx; }
        const unsigned old = xb_add(&bar[XB_XSUB(b.x)], 1u);
        const unsigned gen = old / nloc;
        if (old + 1u == (gen + 1u) * nloc) {
            __builtin_amdgcn_fence(__ATOMIC_RELEASE, "agent");
            asm volatile("s_waitcnt vmcnt(0)" ::: "memory");
            const unsigned og = xb_add(&bar[XB_TOP], 1u);
            const unsigned tg = og / nx;
            if (og + 1u == (tg + 1u) * nx) xb_add(&bar[XB_TOPGEN], 1u);
            else XB_SPIN(xb_ld(&bar[XB_TOPGEN]) == tg, bar);
            __builtin_amdgcn_fence(__ATOMIC_ACQUIRE, "agent");
            xb_add(&bar[XB_XGEN(b.x)], 1u);
            asm volatile("s_waitcnt vmcnt(0)" ::: "memory");
        } else {
            XB_SPIN(xb_ld(&bar[XB_XGEN(b.x)]) == gen, bar);
            __builtin_amdgcn_fence(__ATOMIC_ACQUIRE, "agent");
            asm volatile("s_waitcnt vmcnt(0)" ::: "memory");
        }
    }
    __syncthreads();
}

constexpr size_t WS_BAR = 16384;
constexpr int LDS_BARST = LDS_BYTES - 16;
#define GRID_SYNC() xcd_barrier(bar)
typedef const __attribute__((address_space(4))) Args* kargs_ptr;
__device__ __forceinline__ Args fresh_args() {
#if defined(__HIP_DEVICE_COMPILE__)
    kargs_ptr p = (kargs_ptr)__builtin_amdgcn_kernarg_segment_ptr(); asm volatile("" : "+s"(p)); return *p;
#else
    return Args{};
#endif
}
#define FRESH() const int tid = ftid(wid_s), lane = tid & 63, wid = __builtin_amdgcn_readfirstlane(tid >> 6), gw = blockIdx.x * 8 + wid, NGW = gridDim.x * 8; (void)lane; (void)gw; (void)NGW
#define WSP(T, off) ((T*)(a.ws + (off)))
__global__ void __launch_bounds__(512, 2) mega(Args a_unused) {
    extern __shared__ __attribute__((aligned(16))) unsigned char lds[];
    PG8_LAS unsigned char* lds3 = (PG8_LAS unsigned char*)lds;
    const int wid_s = __builtin_amdgcn_readfirstlane(threadIdx.x >> 6);
    if (threadIdx.x < 4) ((volatile LAS unsigned*)(lds3 + LDS_BARST))[threadIdx.x] = 0u;
    __syncthreads();
    XcdBarrier bar; { const Args a0 = fresh_args(); bar = xcd_barrier_post((unsigned*)(a0.ws + WS_BAR), (volatile LAS unsigned*)(lds3 + LDS_BARST), wid_s); }

#if PHMASK & 1
    for (int rep_ = 0; rep_ < ((DUPMASK & 1) ? DUPN : 1); ++rep_) { if (rep_) GRID_SYNC();
    { const Args a = fresh_args(); if (blockIdx.x == 0 && threadIdx.x < 16) WSP(unsigned, WS_KMAX)[threadIdx.x] = 0u; ada_gemv(a, lds, wid_s); convert_weights(a, 0, lds, wid_s); }
    }
#endif
    GRID_SYNC();
#if PHMASK & 2
    for (int rep_ = 0; rep_ < ((DUPMASK & 2) ? DUPN : 1); ++rep_) { if (rep_) GRID_SYNC();
    { const Args a = fresh_args(); FRESH();
      for (int row = gw * 8; row < MROWS; row += NGW * 8) { const int b = row >> 13; const float* md = WSP(float, WS_MOD) + (size_t)(0 * 2 + b) * NMOD;
        row_pass8<false, true, false, false, true>(a.x + (size_t)row * D, nullptr, nullptr, WSP(bf16_t, WS_H) + (size_t)row * D, WSP(unsigned char, WS_MG) + (size_t)row * D, nullptr, nullptr, a.norm_g + 0 * D, md + 1 * D, md + 0 * D, lane); } }
    }
#endif
    GRID_SYNC();

#pragma unroll 1
    for (int l = 0; l < DEPTH; ++l) {
        for (int es_ = 0; es_ < EXTRASYNC; ++es_) GRID_SYNC();
#if PHMASK & 4
    for (int rep_ = 0; rep_ < ((DUPMASK & 4) ? DUPN : 1); ++rep_) { if (rep_) GRID_SYNC();
        { const Args a = fresh_args(); const int G = gridDim.x, bid = blockIdx.x;
          { pg8::Gemm g{WSP(bf16_t, WS_MG), WSP(bf16_t, WS_WG8), MROWS, 4 * D, D}; pg8::StaticOrder S; S.init(MROWS, 4 * D, G, bid);
            pg8::EpiG E{WSP(unsigned char, WS_G)};
            pg8::gemm_phase<pg8::EpiG, pg8::StaticOrder, true, G8_SP2, true>(lds3, g, S, E, wid_s); }
          { pg8::Gemm g{WSP(bf16_t, WS_H), WSP(bf16_t, WS_W1T), MROWS, 2816, D}; pg8::StaticOrder S; S.init(MROWS, 2816, G, (bid + 64) % G);
            pg8::EpiZ E{WSP(bf16_t, WS_Z), WSP(float, WS_SMALL), WSP(unsigned char, WS_G)};
            pg8::gemm_phase<pg8::EpiZ, pg8::StaticOrder, true, true>(lds3, g, S, E, wid_s); } }
    }
#endif
        GRID_SYNC();
#if PHMASK & 8
    for (int rep_ = 0; rep_ < ((DUPMASK & 8) ? DUPN : 1); ++rep_) { if (rep_) GRID_SYNC();
        { const Args a = fresh_args(); const int G = gridDim.x, bid = blockIdx.x;
          if (bid < 8) fox_scan(a, l, bid, lds, wid_s);
          for (int it = bid - 8; it >= 0 && it < 64; it += G) fox_kmax_item(a, l, it, wid_s);
          conv_phase(a, l, wid_s);
          for (int u = bid; u < 256; u += G) { const int b = u >> 7, head = (u >> 5) & 3, qb = u & 31;
            const float slope2 = LOG2E * __builtin_amdgcn_exp2f(-(float)(1 + head)), sink2 = LOG2E * a.swa_sinks[l * 4 + head];
            const int q0 = qb * 256, tlo = q0 >= 128 ? ((q0 - 127) >> 6) : 0;
            attn_unit<1>(lds, WSP(bf16_t, WS_Z), WSP(bf16_t, WS_H) + (size_t)3 * MROWS * 256, b, head, qb, nullptr, slope2, sink2, tlo, 0.f, wid_s); } }
    }
#endif
        __syncthreads();
#if PHMASK & 16
    for (int rep_ = 0; rep_ < ((DUPMASK & 16) ? DUPN : 1); ++rep_) { if (rep_) GRID_SYNC();
        { const Args a = fresh_args(); const int G = gridDim.x, bid = blockIdx.x;
          for (int u = bid; u < 256; u += G) { const int b = u & 1, j = u >> 1;
            dsa_select_item(a, lds, b, j, wid_s); dsa_select_item(a, lds, b, 255 - j, wid_s); } }
    }
#endif
        GRID_SYNC();
#if PHMASK & 32
    for (int rep_ = 0; rep_ < ((DUPMASK & 32) ? DUPN : 1); ++rep_) { if (rep_) GRID_SYNC();
        { const Args a = fresh_args(); const int G = gridDim.x, bid = blockIdx.x;
          for (int u = bid; u < 256; u += G) { const int b = u >> 7, head = (u >> 5) & 3, qb = u & 31;
            attn_unit<0>(lds, WSP(bf16_t, WS_Z), WSP(bf16_t, WS_H) + (size_t)2 * MROWS * 256, b, head, qb, WSP(const float, WS_FCUM), 0.f, 0.f, 0, sqrtf(__uint_as_float(WSP(const unsigned, WS_KMAX)[l * 8 + b * 4 + head])), wid_s); } }
    }
#endif
#if PHMASK & 64
    for (int rep_ = 0; rep_ < ((DUPMASK & 64) ? DUPN : 1); ++rep_) { if (rep_) GRID_SYNC();
        { const Args a = fresh_args(); FRESH(); __syncthreads(); dsa_attend_wave(a, gw, NGW, lane, lds + wid * DA_WAVE_LDS); __syncthreads(); }
    }
#endif
        GRID_SYNC();
#if PHMASK & 128
    for (int rep_ = 0; rep_ < ((DUPMASK & 128) ? DUPN : 1); ++rep_) { if (rep_) GRID_SYNC();
        { const Args a = fresh_args(); const int G = gridDim.x, bid = blockIdx.x;
          int kmerge = 256; asm volatile("" : "+s"(kmerge));
          pg8::Gemm g{WSP(bf16_t, WS_H), WSP(bf16_t, WS_WBT), 4 * MROWS, 4 * D, kmerge}; pg8::MergeOrder2 S{G, bid};
          pg8::EpiMerge2 E{WSP(bf16_t, WS_MG), WSP(unsigned char, WS_G)}; E.zero();
          pg8::gemm_phase<pg8::EpiMerge2, pg8::MergeOrder2, true, MERGE_SP2, false, true>(lds3, g, S, E, wid_s); }
    }
#endif
        GRID_SYNC();
#if PHMASK & 256
    for (int rep_ = 0; rep_ < ((DUPMASK & 256) ? DUPN : 1); ++rep_) { if (rep_) GRID_SYNC();
        { const Args a = fresh_args(); const int G = gridDim.x, bid = blockIdx.x;
#if WO8
          pg8::Gemm g{WSP(bf16_t, WS_MG), WSP(bf16_t, WS_WOT), MROWS, D, D}; pg8::StaticOrder S; S.init(MROWS, D, G, bid);
          pg8::EpiPlain8 E{WSP(bf16_t, WS_H), D};
          pg8::gemm_phase<pg8::EpiPlain8, pg8::StaticOrder, true, G8_SP2, true>(lds3, g, S, E, wid_s); }
#else
          pg8::Gemm g{WSP(bf16_t, WS_MG), WSP(bf16_t, WS_WOT), MROWS, D, D}; pg8::StaticOrder S; S.init(MROWS, D, G, bid);
          pg8::EpiPlain E{WSP(bf16_t, WS_H), D};
          pg8::gemm_phase<pg8::EpiPlain, pg8::StaticOrder, true, true>(lds3, g, S, E, wid_s); }
#endif
    }
#endif
        GRID_SYNC();
#if PHMASK & 512
    for (int rep_ = 0; rep_ < ((DUPMASK & 512) ? DUPN : 1); ++rep_) { if (rep_) GRID_SYNC();
        { const Args a = fresh_args(); FRESH(); const float* ng = a.norm_g + (size_t)l * 4 * D;
          for (int row = gw * 8; row < MROWS; row += NGW * 8) { const int b = row >> 13; const float* md = WSP(float, WS_MOD) + (size_t)(l * 2 + b) * NMOD;
            bf16_t* x1g = WSP(bf16_t, WS_G) + (size_t)row * D; bf16_t* h2 = FFN8 ? nullptr : WSP(bf16_t, WS_MG) + (size_t)row * D; const bf16_t* rawp = WSP(bf16_t, WS_H) + (size_t)row * D;
            unsigned char* h28 = WSP(unsigned char, WS_G) + 32 * MiB + (size_t)row * D;
            if (l == 0) row_pass8<true, true, false, true, FFN8 != 0>(a.x + (size_t)row * D, rawp, x1g, h2, h28, md + 2 * D, ng + 1 * D, ng + 2 * D, md + 4 * D, md + 3 * D, lane);
            else row_pass8<true, true, true, true, FFN8 != 0>((const bf16_t*)a.out + (size_t)row * D, rawp, x1g, h2, h28, md + 2 * D, ng + 1 * D, ng + 2 * D, md + 4 * D, md + 3 * D, lane); } }
    }
#endif
        GRID_SYNC();
#if PHMASK & 1024
    for (int rep_ = 0; rep_ < ((DUPMASK & 1024) ? DUPN : 1); ++rep_) { if (rep_) GRID_SYNC();
        { const Args a = fresh_args(); const int G = gridDim.x, bid = blockIdx.x;
#if FFN8
          pg8::Gemm g{(const bf16_t*)(a.ws + WS_G + 32 * MiB), WSP(bf16_t, WS_WGU), MROWS, NGU, D}; pg8::StaticOrder S; S.init(MROWS, NGU, G, bid);
          pg8::EpiSwiglu8<DOWN8 != 0> E{WSP(bf16_t, WS_Z)};
          pg8::gemm_phase<pg8::EpiSwiglu8<DOWN8 != 0>, pg8::StaticOrder, true, G8_SP2, true>(lds3, g, S, E, wid_s); }
#else
          pg8::Gemm g{WSP(bf16_t, WS_MG), WSP(bf16_t, WS_WGU), MROWS, NGU, D}; pg8::StaticOrder S; S.init(MROWS, NGU, G, bid);
          pg8::EpiSwiglu E{WSP(bf16_t, WS_Z)};
          pg8::gemm_phase<pg8::EpiSwiglu, pg8::StaticOrder, true, true>(lds3, g, S, E, wid_s); }
#endif
    }
#endif
        GRID_SYNC();
#if PHMASK & 2048
    for (int rep_ = 0; rep_ < ((DUPMASK & 2048) ? DUPN : 1); ++rep_) { if (rep_) GRID_SYNC();
        { const Args a = fresh_args(); const int G = gridDim.x, bid = blockIdx.x;
#if DOWN8
          pg8::Gemm g{WSP(bf16_t, WS_Z), WSP(bf16_t, WS_WDT), MROWS, D, DFF}; pg8::StaticOrder S; S.init(MROWS, D, G, bid);
          pg8::EpiPlain8 E{WSP(bf16_t, WS_H), D};
          pg8::gemm_phase<pg8::EpiPlain8, pg8::StaticOrder, true, G8_SP2, true>(lds3, g, S, E, wid_s); }
#else
          pg8::Gemm g{WSP(bf16_t, WS_Z), WSP(bf16_t, WS_WDT), MROWS, D, DFF}; pg8::StaticOrder S; S.init(MROWS, D, G, bid);
          pg8::EpiPlain E{WSP(bf16_t, WS_H), D};
          pg8::gemm_phase<pg8::EpiPlain, pg8::StaticOrder, true, true>(lds3, g, S, E, wid_s); }
#endif
    }
#endif
        GRID_SYNC();
#if PHMASK & 4096
    for (int rep_ = 0; rep_ < ((DUPMASK & 4096) ? DUPN : 1); ++rep_) { if (rep_) GRID_SYNC();
        { const Args a = fresh_args(); FRESH(); const float* ng = a.norm_g + (size_t)l * 4 * D;
          for (int row = gw * 8; row < MROWS; row += NGW * 8) { const int b = row >> 13; const float* md = WSP(float, WS_MOD) + (size_t)(l * 2 + b) * NMOD;
            const float* mdn = WSP(float, WS_MOD) + (size_t)((l + 1) * 2 + b) * NMOD; const float* ngn = a.norm_g + (size_t)(l + 1) * 4 * D;
            const bf16_t* x1g = WSP(bf16_t, WS_G) + (size_t)row * D; bf16_t* hr = WSP(bf16_t, WS_H) + (size_t)row * D;
            if (l + 1 < DEPTH) row_pass8<true, true, true, true, true>(x1g, hr, (bf16_t*)a.out + (size_t)row * D, hr, WSP(unsigned char, WS_MG) + (size_t)row * D, md + 5 * D, ng + 3 * D, ngn, mdn + 1 * D, mdn + 0 * D, lane);
            else row_pass8<true, false, true, false>(x1g, hr, a.out + (size_t)row * D, nullptr, nullptr, md + 5 * D, ng + 3 * D, nullptr, nullptr, nullptr, lane); }
          if (l + 1 < DEPTH) convert_weights(a, l + 1, lds, wid_s); }
    }
#endif
        if (l + 1 < DEPTH) GRID_SYNC();
    }
}

extern "C" void kernel_launch(void* const* d_in, const int* in_sizes, int n_in, void* d_out, int out_size, void* d_ws, size_t ws_size, hipStream_t stream) {
    static int grid = 0;
    if (grid == 0) {
        if (n_in != 14 || out_size != MROWS * D || ws_size < WS_END) { fprintf(stderr, "kernel_launch: unexpected shapes (n_in %d out %d ws %zu)\n", n_in, out_size, ws_size); grid = -1; return; }
        int dev = 0, cus = 0, per_cu = 0;
        (void)hipGetDevice(&dev);
        (void)hipDeviceGetAttribute(&cus, hipDeviceAttributeMultiprocessorCount, dev);
        (void)hipFuncSetAttribute((const void*)mega, hipFuncAttributeMaxDynamicSharedMemorySize, LDS_BYTES);
        (void)hipOccupancyMaxActiveBlocksPerMultiprocessor(&per_cu, (const void*)mega, 512, LDS_BYTES);
        if (per_cu < 1) { fprintf(stderr, "kernel_launch: occupancy query says 0 blocks per CU\n"); per_cu = 1; }
        grid = cus;
        (void)hipGetLastError();
    }
    if (grid < 0) return;
    if (hipMemsetAsync(d_ws, 0, 65536, stream) != hipSuccess) { fprintf(stderr, "kernel_launch: memset failed\n"); return; }
    Args a{};
    const float** pp = (const float**)&a;
    for (int i = 0; i < 14; ++i) pp[i] = (const float*)d_in[i];
    a.out = (float*)d_out; a.ws = (unsigned char*)d_ws;
    void* args[] = {&a};
    hipError_t e = hipLaunchCooperativeKernel((const void*)mega, dim3(grid), dim3(512), args, LDS_BYTES, stream);
    if (e != hipSuccess) fprintf(stderr, "cooperative launch failed: %s (grid %d)\n", hipGetErrorString(e), grid);
}
```

```cpp
#include <hip/hip_runtime.h>
#include <hip/hip_cooperative_groups.h>
#include <cstdio>
#include <cstdint>
namespace cg = cooperative_groups;
namespace pg8 {
#define PG8_LAS __attribute__((address_space(3)))
typedef unsigned short bf16_t;
typedef short bf16x8 __attribute__((ext_vector_type(8)));
typedef float f32x4 __attribute__((ext_vector_type(4)));
typedef unsigned u32x4 __attribute__((ext_vector_type(4)));
typedef int v4i_t __attribute__((ext_vector_type(4)));
typedef int v8i_t __attribute__((ext_vector_type(8)));
constexpr int BM = 256, BK = 64, HALF = 128, HTB = HALF * BK * 2  , STAGE_BYTES = 8 * HTB, NXCD = 8, WGM = 8;

__host__ __device__ __forceinline__ int lds_byte(int r, int c) { const int st = (r >> 4) * 2 + (c >> 5), rr = r & 15, cc = c & 31, ob = rr * 64 + cc * 2; return st * 1024 + (ob ^ (((ob >> 9) & 1) << 5)); }
__host__ __device__ __forceinline__ void stage_rc(int b, int& R, int& C) { const int st = b / 1024, sb = b % 1024, swz = sb ^ (((sb >> 9) & 1) << 5); R = (st >> 1) * 16 + swz / 64; C = (st & 1) * 32 + (swz % 64) / 2; }
__host__ __device__ __forceinline__ int perm32(int rho) { const int n = rho >> 4, i = rho & 15; return 8 * (i >> 2) + 4 * n + (i & 3); }

struct Unit { int pm, pn; };
struct Gemm { const bf16_t* A; const bf16_t* Bt; int M, N, K; };

struct StaticOrder {
    int nM, nN, nwg, G, c;
    __host__ __device__ void init(int M, int N, int G_, int c_) { nM = M / BM; nN = N / BM; nwg = nM * nN; G = G_; c = c_; }
    __host__ __device__ bool next(int i, Unit& u) const {
        const long L = (long)i * G + c; if (L >= nwg) return false;
        int wgid = (int)L; { const int q = nwg / NXCD, r = nwg % NXCD, xcd = wgid % NXCD, off = wgid / NXCD; wgid = (xcd < r ? xcd * (q + 1) : r * (q + 1) + (xcd - r) * q) + off; }
        const int nig = WGM * nN, gid = wgid / nig, fm = gid * WGM, gsz = (nM - fm) < WGM ? (nM - fm) : WGM;
        u.pm = fm + ((wgid % nig) % gsz); u.pn = (wgid % nig) / gsz; return true;
    }
    __device__ __forceinline__ void a_ready(const Unit&) const {}
    __device__ __forceinline__ void done(const Unit&) const {}
};

__device__ __forceinline__ unsigned cvt_pk_bf16(float lo, float hi) { unsigned r; asm volatile("v_cvt_pk_bf16_f32 %0, %1, %2" : "=v"(r) : "v"(lo), "v"(hi)); return r; }
typedef float f32x2 __attribute__((ext_vector_type(2)));
#ifndef WO8
#define WO8 1
#endif
#ifndef MERGE_FENCE
#define MERGE_FENCE 1
#endif
typedef unsigned u32x2 __attribute__((ext_vector_type(2)));
__device__ __forceinline__ float bf_lo(unsigned w) { return __uint_as_float(w << 16); }
__device__ __forceinline__ float bf_hi(unsigned w) { return __uint_as_float(w & 0xffff0000u); }
#ifdef PROBE_CHEAPSIG
__device__ __forceinline__ float sigmoidf_fast(float x) { return 0.5f + 0.25f * fminf(fmaxf(x, -2.0f), 2.0f); }
#else
__device__ __forceinline__ float sigmoidf_fast(float x) { return __builtin_amdgcn_rcpf(1.0f + __builtin_amdgcn_exp2f(-1.4426950408889634f * x)); }
#endif

struct EpiPlain {
    static constexpr bool PERM = true, AFTER_DRAIN = false;
    bf16_t* O; int ldc;
    __device__ __forceinline__ void operator()(const f32x4 (&acc)[2][2][4][2], const Unit& u, int wr, int wc, int fr, int fq) const {
        const int row0 = u.pm * BM + wr * 64 + fr, col0 = u.pn * BM + wc * 32 + 8 * fq;
#pragma unroll
        for (int ai = 0; ai < 2; ++ai)
#pragma unroll
            for (int m = 0; m < 4; ++m) { bf16_t* rowp = O + (size_t)(row0 + ai * HALF + m * 16) * ldc + col0;
#pragma unroll
                for (int bj = 0; bj < 2; ++bj) { const f32x4 v0 = acc[ai][bj][m][0], v1 = acc[ai][bj][m][1];
                    u32x4 w; w.x = cvt_pk_bf16(v0[0], v0[1]); w.y = cvt_pk_bf16(v0[2], v0[3]); w.z = cvt_pk_bf16(v1[0], v1[1]); w.w = cvt_pk_bf16(v1[2], v1[3]);
                    *(u32x4*)(rowp + bj * HALF) = w; } }
    }
};
struct EpiZ {
    static constexpr bool PERM = true, AFTER_DRAIN = false;
    bf16_t* Z; float* SM; unsigned char* G;
    __device__ __forceinline__ void operator()(const f32x4 (&acc)[2][2][4][2], const Unit& u, int wr, int wc, int fr, int fq) const {
        const int row0 = u.pm * BM + wr * 64 + fr;
        if (u.pn < 11) {
            const int col0 = u.pn * BM + wc * 32 + 8 * fq;
#pragma unroll
            for (int ai = 0; ai < 2; ++ai)
#pragma unroll
                for (int m = 0; m < 4; ++m) { bf16_t* rowp = Z + (size_t)(row0 + ai * HALF + m * 16) * 2816 + col0;
#pragma unroll
                    for (int bj = 0; bj < 2; ++bj) { const f32x4 v0 = acc[ai][bj][m][0], v1 = acc[ai][bj][m][1];
                        u32x4 w; w.x = cvt_pk_bf16(v0[0], v0[1]); w.y = cvt_pk_bf16(v0[2], v0[3]); w.z = cvt_pk_bf16(v1[0], v1[1]); w.w = cvt_pk_bf16(v1[2], v1[3]);
                        *(u32x4*)(rowp + bj * HALF) = w; } }
            if (u.pn == 10 && wc == 2 && fq == 0) {
#pragma unroll
                for (int ai = 0; ai < 2; ++ai)
#pragma unroll
                    for (int m = 0; m < 4; ++m) { float* sp = SM + (size_t)(row0 + ai * HALF + m * 16) * 8;
                        *(f32x4*)sp = acc[ai][1][m][0]; *(f32x4*)(sp + 4) = acc[ai][1][m][1]; }
            }
        } else {
            const int col0 = (u.pn - 11) * BM + wc * 32 + 8 * fq;
#pragma unroll
            for (int ai = 0; ai < 2; ++ai)
#pragma unroll
                for (int m = 0; m < 4; ++m) { unsigned char* rowp = G + (size_t)(row0 + ai * HALF + m * 16) * 4096 + col0;
#pragma unroll
                    for (int bj = 0; bj < 2; ++bj) { const f32x4 v0 = acc[ai][bj][m][0], v1 = acc[ai][bj][m][1];
                        unsigned b[8];
#pragma unroll
                        for (int k = 0; k < 4; ++k) { b[k] = (unsigned)(sigmoidf_fast(v0[k]) * 255.0f + 0.5f); b[4 + k] = (unsigned)(sigmoidf_fast(v1[k]) * 255.0f + 0.5f); }
                        u32x2 w; w.x = b[0] | (b[1] << 8) | (b[2] << 16) | (b[3] << 24); w.y = b[4] | (b[5] << 8) | (b[6] << 16) | (b[7] << 24);
                        *(u32x2*)(rowp + bj * HALF) = w; } }
        }
    }
};
struct EpiG {
    static constexpr bool PERM = false, AFTER_DRAIN = false;
    unsigned char* G;
    __device__ __forceinline__ void operator()(const f32x4 (&acc)[2][2][4][2], const Unit& u, int wr, int wc, int fr, int fq) const {
        unsigned ones_ = ~0u; asm volatile("" : "+s"(ones_)); const unsigned ln_ = __builtin_amdgcn_mbcnt_hi(ones_, __builtin_amdgcn_mbcnt_lo(ones_, 0u)); (void)fr; (void)fq;
        u32x2* gb = (u32x2*)G + (size_t)(u.pm * 16 + u.pn) * (2 * 8 * 4 * 2 * 64) + (unsigned)(wr * 4 + wc) * (4 * 2 * 64) + ln_;
#pragma unroll
        for (int ai = 0; ai < 2; ++ai)
#pragma unroll
            for (int m = 0; m < 4; ++m) {
#pragma unroll
                for (int bj = 0; bj < 2; ++bj) { const f32x4 v0 = acc[ai][bj][m][0], v1 = acc[ai][bj][m][1];
                    unsigned b[8];
#pragma unroll
                    for (int k = 0; k < 4; ++k) { b[k] = (unsigned)(sigmoidf_fast(v0[k]) * 255.0f + 0.5f); b[4 + k] = (unsigned)(sigmoidf_fast(v1[k]) * 255.0f + 0.5f); }
                    u32x2 w; w.x = b[0] | (b[1] << 8) | (b[2] << 16) | (b[3] << 24); w.y = b[4] | (b[5] << 8) | (b[6] << 16) | (b[7] << 24);
                    gb[(unsigned)(ai * (8 * 4 * 2 * 64) + m * (2 * 64) + bj * 64)] = w; }
                asm volatile("" ::: "memory"); }
    }
};
struct EpiMerge {
    static constexpr bool PERM = true, AFTER_DRAIN = false;
    bf16_t* MG; const unsigned char* G;
    __device__ __forceinline__ void operator()(const f32x4 (&acc)[2][2][4][2], const Unit& u, int wr, int wc, int fr, int fq) const {
        const int n = u.pm >> 6, pm = u.pm & 63, pn = u.pn & 3;
        const unsigned row0 = pm * BM + wr * 64 + fr, col0 = pn * BM + wc * 32 + 8 * fq;
        const unsigned char* gbase = G + n * 1024 + col0; bf16_t* mbase = MG + col0;
#pragma unroll
        for (int ai = 0; ai < 2; ++ai) {
            u32x2 gw[4][2]; u32x4 old[4][2];
#pragma unroll
            for (int m = 0; m < 4; ++m)
#pragma unroll
                for (int bj = 0; bj < 2; ++bj) { const unsigned row = row0 + ai * HALF + m * 16;
                    gw[m][bj] = *(const u32x2*)(gbase + row * 4096u + bj * HALF);
                    if (n > 0) old[m][bj] = *(const u32x4*)(mbase + row * 1024u + bj * HALF); }
#pragma unroll
            for (int m = 0; m < 4; ++m)
#pragma unroll
                for (int bj = 0; bj < 2; ++bj) { const unsigned row = row0 + ai * HALF + m * 16;
                    const f32x4 v0 = acc[ai][bj][m][0], v1 = acc[ai][bj][m][1];
                    float r[8];
#pragma unroll
                    for (int k = 0; k < 4; ++k) { r[k] = v0[k] * ((float)((gw[m][bj].x >> (8 * k)) & 255u) * (1.0f / 255.0f)); r[4 + k] = v1[k] * ((float)((gw[m][bj].y >> (8 * k)) & 255u) * (1.0f / 255.0f)); }
                    if (n > 0) { const u32x4 o = old[m][bj];
                        r[0] += bf_lo(o.x); r[1] += bf_hi(o.x); r[2] += bf_lo(o.y); r[3] += bf_hi(o.y); r[4] += bf_lo(o.z); r[5] += bf_hi(o.z); r[6] += bf_lo(o.w); r[7] += bf_hi(o.w); }
                    u32x4 w; w.x = cvt_pk_bf16(r[0], r[1]); w.y = cvt_pk_bf16(r[2], r[3]); w.z = cvt_pk_bf16(r[4], r[5]); w.w = cvt_pk_bf16(r[6], r[7]);
                    *(u32x4*)(mbase + row * 1024u + bj * HALF) = w; }
            asm volatile("" ::: "memory");
        }
    }
};
struct EpiSwiglu {
    static constexpr bool PERM = true, AFTER_DRAIN = false;
    bf16_t* Hd;
    __device__ __forceinline__ void operator()(const f32x4 (&acc)[2][2][4][2], const Unit& u, int wr, int wc, int fr, int fq) const {
        const int row0 = u.pm * BM + wr * 64 + fr, j0 = u.pn * 128 + wc * 16 + 4 * fq;
#pragma unroll
        for (int ai = 0; ai < 2; ++ai)
#pragma unroll
            for (int m = 0; m < 4; ++m) { bf16_t* rowp = Hd + (size_t)(row0 + ai * HALF + m * 16) * 2816 + j0;
#pragma unroll
                for (int bj = 0; bj < 2; ++bj) { const f32x4 v0 = acc[ai][bj][m][0], v1 = acc[ai][bj][m][1];
                    const float h0 = v0[0] * sigmoidf_fast(v0[0]) * v0[1], h1 = v0[2] * sigmoidf_fast(v0[2]) * v0[3];
                    const float h2 = v1[0] * sigmoidf_fast(v1[0]) * v1[1], h3 = v1[2] * sigmoidf_fast(v1[2]) * v1[3];
                    u32x2 w; w.x = cvt_pk_bf16(h0, h1); w.y = cvt_pk_bf16(h2, h3);
                    *(u32x2*)(rowp + bj * 64) = w; } }
    }
};
template <bool H8> struct EpiSwiglu8 {
    static constexpr bool PERM = false, AFTER_DRAIN = false;
    bf16_t* Hd;
    __device__ __forceinline__ void operator()(const f32x4 (&acc)[2][2][4][2], const Unit& u, int wr, int wc, int fr, int fq) const {
        unsigned ones_ = ~0u; asm volatile("" : "+s"(ones_)); const int ln_ = (int)__builtin_amdgcn_mbcnt_hi(ones_, __builtin_amdgcn_mbcnt_lo(ones_, 0u)); const int fr_ = ln_ & 15, fq_ = ln_ >> 4; (void)fr; (void)fq;
        const unsigned row0 = u.pm * BM + wr * 64 + fr_, j0 = u.pn * 128 + wc * 32 + 8 * fq_;
        bf16_t* hb = Hd + j0; unsigned char* h8b = (unsigned char*)Hd + j0;
#pragma unroll
        for (int ai = 0; ai < 2; ++ai)
#pragma unroll
            for (int m = 0; m < 4; ++m) { const unsigned ro = (row0 + ai * HALF + m * 16) * 2816u;
                float h[8];
#pragma unroll
                for (int bj = 0; bj < 2; ++bj) { const f32x4 v0 = acc[ai][bj][m][0], v1 = acc[ai][bj][m][1];
                    h[4 * bj + 0] = v0[0] * sigmoidf_fast(v0[0]) * v0[1]; h[4 * bj + 1] = v0[2] * sigmoidf_fast(v0[2]) * v0[3];
                    h[4 * bj + 2] = v1[0] * sigmoidf_fast(v1[0]) * v1[1]; h[4 * bj + 3] = v1[2] * sigmoidf_fast(v1[2]) * v1[3]; }
                if (H8) { u32x2 w8; w8.x = __builtin_amdgcn_cvt_pk_fp8_f32(h[2], h[3], __builtin_amdgcn_cvt_pk_fp8_f32(h[0], h[1], 0u, false), true);
                    w8.y = __builtin_amdgcn_cvt_pk_fp8_f32(h[6], h[7], __builtin_amdgcn_cvt_pk_fp8_f32(h[4], h[5], 0u, false), true);
                    *(u32x2*)(h8b + ro) = w8; }
                else { u32x4 w; w.x = cvt_pk_bf16(h[0], h[1]); w.y = cvt_pk_bf16(h[2], h[3]); w.z = cvt_pk_bf16(h[4], h[5]); w.w = cvt_pk_bf16(h[6], h[7]); *(u32x4*)(hb + ro) = w; }
                asm volatile("" ::: "memory"); }
    }
};
struct EpiPlain8 {
    static constexpr bool PERM = false, AFTER_DRAIN = false;
    bf16_t* O; int ldc;
    __device__ __forceinline__ void operator()(const f32x4 (&acc)[2][2][4][2], const Unit& u, int wr, int wc, int fr, int fq) const {
        unsigned ones_ = ~0u; asm volatile("" : "+s"(ones_)); const int ln_ = (int)__builtin_amdgcn_mbcnt_hi(ones_, __builtin_amdgcn_mbcnt_lo(ones_, 0u)); const int fr_ = ln_ & 15, fq_ = ln_ >> 4; (void)fr; (void)fq;
        const unsigned row0 = u.pm * BM + wr * 64 + fr_, col0 = u.pn * BM + wc * 32 + 8 * fq_;
        bf16_t* ob = O + col0;
#pragma unroll
        for (int ai = 0; ai < 2; ++ai)
#pragma unroll
            for (int m = 0; m < 4; ++m) { const unsigned ro = (row0 + ai * HALF + m * 16) * (unsigned)ldc;
#pragma unroll
                for (int bj = 0; bj < 2; ++bj) { const f32x4 v0 = acc[ai][bj][m][0], v1 = acc[ai][bj][m][1];
                    u32x4 w; w.x = cvt_pk_bf16(v0[0], v0[1]); w.y = cvt_pk_bf16(v0[2], v0[3]); w.z = cvt_pk_bf16(v1[0], v1[1]); w.w = cvt_pk_bf16(v1[2], v1[3]);
                    *(u32x4*)(ob + ro + bj * HALF) = w; }
                asm volatile("" ::: "memory"); }
    }
};
struct MergeOrder {
    int G, c;
    __device__ __forceinline__ bool next(int i, Unit& u) const {
        const int t = (i >> 2) * G + c; if (t >= 256) return false;
        const int n = i & 3, pm = t >> 2, pn = t & 3;
        u.pm = n * 64 + pm; u.pn = n * 4 + pn; return true;
    }
    __device__ __forceinline__ void a_ready(const Unit&) const {}
    __device__ __forceinline__ void done(const Unit&) const {}
};
struct EpiMerge2 {
    static constexpr bool PERM = true, AFTER_DRAIN = false;
    bf16_t* MG; const unsigned char* G;
    mutable f32x4 tot[2][4][2];
    __device__ __forceinline__ void zero() const {
#pragma unroll
        for (int bj = 0; bj < 2; ++bj)
#pragma unroll
            for (int m = 0; m < 4; ++m)
#pragma unroll
                for (int k = 0; k < 2; ++k) tot[bj][m][k] = (f32x4){0.f, 0.f, 0.f, 0.f};
    }
    __device__ __forceinline__ void operator()(const f32x4 (&acc)[2][2][4][2], const Unit& u, int wr, int wc, int fr, int fq) const {
        const int n = u.pn >> 2, pn = u.pn & 3, pm = u.pm - n * 128;
        const unsigned row0 = pm * HALF + wr * 64 + fr, col0 = pn * BM + wc * 32 + 8 * fq;
        const u32x2* gb = (const u32x2*)G + (size_t)((pm >> 1) * 16 + n * 4 + pn) * (2 * 8 * 4 * 2 * 64) + (unsigned)((pm & 1) * (8 * 4 * 2 * 64) + (wr * 4 + wc) * (4 * 2 * 64) + (fq * 16 + fr));
        u32x2 gw[4][2];
#pragma unroll
        for (int m = 0; m < 4; ++m)
#pragma unroll
            for (int bj = 0; bj < 2; ++bj) gw[m][bj] = gb[m * (2 * 64) + bj * 64];
#pragma unroll
        for (int m = 0; m < 4; ++m)
#pragma unroll
            for (int bj = 0; bj < 2; ++bj) {
#pragma unroll
                for (int k = 0; k < 4; ++k) { tot[bj][m][0][k] += acc[0][bj][m][0][k] * ((float)((gw[m][bj].x >> (8 * k)) & 255u) * (1.0f / 255.0f));
                                              tot[bj][m][1][k] += acc[0][bj][m][1][k] * ((float)((gw[m][bj].y >> (8 * k)) & 255u) * (1.0f / 255.0f)); } }
        if (n == 3) {
            bf16_t* mbase = MG + col0;
#pragma unroll
            for (int m = 0; m < 4; ++m)
#pragma unroll
                for (int bj = 0; bj < 2; ++bj) { const f32x4 t0 = tot[bj][m][0], t1 = tot[bj][m][1];
#if WO8
                    u32x2 w8; w8.x = __builtin_amdgcn_cvt_pk_fp8_f32(t0[2], t0[3], __builtin_amdgcn_cvt_pk_fp8_f32(t0[0], t0[1], 0u, false), true);
                    w8.y = __builtin_amdgcn_cvt_pk_fp8_f32(t1[2], t1[3], __builtin_amdgcn_cvt_pk_fp8_f32(t1[0], t1[1], 0u, false), true);
                    *(u32x2*)((unsigned char*)MG + col0 + (row0 + m * 16) * 1024u + bj * HALF) = w8; }
#else
                    u32x4 w; w.x = cvt_pk_bf16(t0[0], t0[1]); w.y = cvt_pk_bf16(t0[2], t0[3]); w.z = cvt_pk_bf16(t1[0], t1[1]); w.w = cvt_pk_bf16(t1[2], t1[3]);
                    *(u32x4*)(mbase + (row0 + m * 16) * 1024u + bj * HALF) = w; }
#endif
            zero();
        }
    }
};
struct MergeOrder2 {
    int G, c;
    __device__ __forceinline__ bool next(int i, Unit& u) const {
        const int t = (i >> 2) * G + c; if (t >= 512) return false;
        const int n = i & 3, pm = t >> 2, pn = t & 3;
        u.pm = n * 128 + pm; u.pn = n * 4 + pn; return true;
    }
    __device__ __forceinline__ void a_ready(const Unit&) const {}
    __device__ __forceinline__ void done(const Unit&) const {}
};
struct Frag16x2 { bf16x8 k[2]; };
template <bool FP8> struct FragSel;
template <> struct FragSel<false> {
    typedef Frag16x2 type;
    static __device__ __forceinline__ type load(PG8_LAS unsigned char* p) { type f; f.k[0] = *(const PG8_LAS bf16x8*)p; f.k[1] = *(const PG8_LAS bf16x8*)(p + 1024); return f; }
    static __device__ __forceinline__ f32x4 mma(const type& w, const type& a, f32x4 c) {
        c = __builtin_amdgcn_mfma_f32_16x16x32_bf16(w.k[0], a.k[0], c, 0, 0, 0); return __builtin_amdgcn_mfma_f32_16x16x32_bf16(w.k[1], a.k[1], c, 0, 0, 0); }
};
template <> struct FragSel<true> {
    struct type { v4i_t lo, hi; };
    static __device__ __forceinline__ type load(PG8_LAS unsigned char* p) { type f; f.lo = *(const PG8_LAS v4i_t*)p; f.hi = *(const PG8_LAS v4i_t*)(p + 1024); return f; }
    static __device__ __forceinline__ f32x4 mma(const type& w, const type& a, f32x4 c) {
        return __builtin_amdgcn_mfma_scale_f32_16x16x128_f8f6f4(__builtin_shufflevector(w.lo, w.hi, 0, 1, 2, 3, 4, 5, 6, 7), __builtin_shufflevector(a.lo, a.hi, 0, 1, 2, 3, 4, 5, 6, 7), c, 0, 0, 0, 0x7a7a7a7a, 0, 0x7f7f7f7f); }
};
template <class Epi, class Sched, bool ALIGN_EPI = false, bool SP2 = false, bool FP8 = false, bool HALFM = false>
__device__ __forceinline__ void gemm_phase(PG8_LAS unsigned char* lds, const Gemm g, const Sched& S, const Epi& E, int wid_s) {
    unsigned ones_ = ~0u; asm volatile("" : "+s"(ones_));
    int tid_ = wid_s * 64 + (int)__builtin_amdgcn_mbcnt_hi(ones_, __builtin_amdgcn_mbcnt_lo(ones_, 0u)); asm volatile("" : "+v"(tid_));
    const int tid = tid_, wid = __builtin_amdgcn_readfirstlane(tid >> 6), lane = tid & 63, wr = wid >> 2, wc = wid & 3, fr = lane & 15, fq = lane >> 4;
    const int K = FP8 ? g.K / 2 : g.K, nt = K / BK;
    unsigned voffA[2], voffB[2];
#pragma unroll
    for (int i = 0; i < 2; ++i) { int R, C; stage_rc(tid * 16 + i * 8192, R, C); const int Rb = Epi::PERM ? ((R & ~31) + perm32(R & 31)) : R;
        voffA[i] = (unsigned)(R * K + C) * 2u; voffB[i] = (unsigned)(Rb * K + C) * 2u; }
    const size_t kstep = (size_t)(BK * 2);
    const size_t hstep = (size_t)HALF * K * 2;
    const size_t tstep = 2 * hstep;
    const unsigned ldsw = (unsigned)wid * 1024u;
    const unsigned ldsbase = (unsigned)(__UINTPTR_TYPE__)lds;
    const __amdgpu_buffer_rsrc_t srdA = __builtin_amdgcn_make_buffer_rsrc((void*)g.A, (short)0, 0x7fffffff, 0x00020000);
    const __amdgpu_buffer_rsrc_t srdB = __builtin_amdgcn_make_buffer_rsrc((void*)g.Bt, (short)0, 0x7fffffff, 0x00020000);
    const int aoff = lds_byte(wr * 64 + fr, fq * 8), boff = lds_byte(wc * 32 + fr, fq * 8);
#define PG8_SA(b, h) (((b) * 2 + (h)) * HTB)
#define PG8_SB(b, h) ((4 + (b) * 2 + (h)) * HTB)
#define PG8_STAGE(bufoff, gbase, voff, srd, base) do { const unsigned so_ = (unsigned)((const char*)(gbase) - (const char*)(base)); _Pragma("unroll") for (int _i = 0; _i < 2; ++_i) \
        asm volatile("s_mov_b32 m0, %0\n\ts_nop 0\n\tbuffer_load_dwordx4 %1, %2, %3 offen lds" :: "s"(ldsbase + (unsigned)(bufoff) + ldsw + (unsigned)(_i * 8192)), "v"((voff)[_i]), "s"(srd), "s"(so_) : "m0", "memory"); } while (0)
#define PG8_LDA(dst, b, h) do { _Pragma("unroll") for (int m = 0; m < 4; ++m) dst[m] = FragSel<FP8>::load(lds + PG8_SA(b, h) + aoff + m * 2048); } while (0)
#define PG8_LDB(dst, b, h) do { _Pragma("unroll") for (int n = 0; n < 2; ++n) dst[n] = FragSel<FP8>::load(lds + PG8_SB(b, h) + boff + n * 2048); } while (0)
#define PG8_MMA(ai, bj, At, Bt) do { __builtin_amdgcn_s_setprio(1); _Pragma("unroll") for (int m = 0; m < 4; ++m) _Pragma("unroll") for (int n = 0; n < 2; ++n) \
        acc[ai][bj][m][n] = FragSel<FP8>::mma(Bt[n], At[m], acc[ai][bj][m][n]); __builtin_amdgcn_s_setprio(0); } while (0)
#define PG8_WAIT_V(n) asm volatile("s_waitcnt vmcnt(" #n ")" ::: "memory")
#define PG8_WAIT_L(n) asm volatile("s_waitcnt lgkmcnt(" #n ")" ::: "memory")
#define PG8_BAR __builtin_amdgcn_s_barrier()
#define PG8_SCHED __builtin_amdgcn_sched_barrier(0)
    Unit cur, nxt; int ui = 0;
    if (!S.next(0, cur)) return;
    f32x4 acc[2][2][4][2];
#pragma unroll
    for (int a = 0; a < 2; ++a)
#pragma unroll
        for (int b = 0; b < 2; ++b)
#pragma unroll
            for (int m = 0; m < 4; ++m)
#pragma unroll
                for (int n = 0; n < 2; ++n) acc[a][b][m][n] = (f32x4){0.f, 0.f, 0.f, 0.f};
    typedef typename FragSel<FP8>::type frag_t;
    frag_t At[4], B0[2], B1[2];
    const size_t tstepA = HALFM ? hstep : tstep;
    const size_t hstepA = HALFM ? 0 : hstep;
    const char* cA = (const char*)g.A + (size_t)cur.pm * tstepA; const char* cB = (const char*)g.Bt + (size_t)cur.pn * tstep;
    S.a_ready(cur);
    if constexpr (SP2) {
        PG8_STAGE(PG8_SB(0, 0), cB, voffB, srdB, g.Bt); PG8_STAGE(PG8_SB(0, 1), cB + hstep, voffB, srdB, g.Bt); PG8_STAGE(PG8_SA(0, 0), cA, voffA, srdA, g.A); PG8_STAGE(PG8_SA(0, 1), cA + hstepA, voffA, srdA, g.A);
        if (wr == 1) PG8_BAR;
        PG8_WAIT_V(2); PG8_BAR;
        PG8_STAGE(PG8_SB(1, 0), cB + kstep, voffB, srdB, g.Bt); PG8_STAGE(PG8_SA(1, 0), cA + kstep, voffA, srdA, g.A); PG8_STAGE(PG8_SB(1, 1), cB + hstep + kstep, voffB, srdB, g.Bt);
        PG8_WAIT_V(6); PG8_BAR;
    } else {
        PG8_STAGE(PG8_SB(0, 0), cB, voffB, srdB, g.Bt); PG8_STAGE(PG8_SA(0, 0), cA, voffA, srdA, g.A); PG8_STAGE(PG8_SB(0, 1), cB + hstep, voffB, srdB, g.Bt); PG8_STAGE(PG8_SA(0, 1), cA + hstepA, voffA, srdA, g.A);
        if (wr == 1) PG8_BAR;
        PG8_WAIT_V(4); PG8_BAR;
        PG8_STAGE(PG8_SB(1, 0), cB + kstep, voffB, srdB, g.Bt); PG8_STAGE(PG8_SA(1, 0), cA + kstep, voffA, srdA, g.A); PG8_STAGE(PG8_SB(1, 1), cB + hstep + kstep, voffB, srdB, g.Bt);
        PG8_WAIT_V(6); PG8_BAR;
    }
    for (;;) {
        const bool has_next = S.next(ui + 1, nxt);
        const char* nA = has_next ? (const char*)g.A + (size_t)nxt.pm * tstepA : cA; const char* nB = has_next ? (const char*)g.Bt + (size_t)nxt.pn * tstep : cB;
#pragma unroll 1
        for (int t = 0; t < nt; t += 2) {
            const bool last = (t == nt - 2);
            const char* a1 = cA + (size_t)(t + 1) * kstep;
            const char* a2 = last ? nA : cA + (size_t)(t + 2) * kstep; const char* b2 = last ? nB : cB + (size_t)(t + 2) * kstep;
            const char* a3 = a2 + kstep; const char* b3 = b2 + kstep;
            if (last && has_next) S.a_ready(nxt);
            if constexpr (SP2) {
            PG8_LDB(B0, 0, 0); PG8_LDB(B1, 0, 1); PG8_SCHED; PG8_LDA(At, 0, 0); PG8_STAGE(PG8_SA(1, 1), a1 + hstepA, voffA, srdA, g.A);
            PG8_WAIT_V(8); PG8_WAIT_L(0); PG8_BAR; PG8_MMA(0, 0, At, B0); PG8_MMA(0, 1, At, B1); PG8_BAR; PG8_SCHED;
            if constexpr (!HALFM) PG8_LDA(At, 0, 1); PG8_STAGE(PG8_SB(0, 0), b2, voffB, srdB, g.Bt); PG8_STAGE(PG8_SB(0, 1), b2 + hstep, voffB, srdB, g.Bt); PG8_STAGE(PG8_SA(0, 0), a2, voffA, srdA, g.A);
            PG8_WAIT_V(8); PG8_WAIT_L(0); PG8_BAR; if constexpr (!HALFM) { PG8_MMA(1, 0, At, B0); PG8_MMA(1, 1, At, B1); } PG8_BAR; PG8_SCHED;
            PG8_LDB(B0, 1, 0); PG8_LDB(B1, 1, 1); PG8_SCHED; PG8_LDA(At, 1, 0); PG8_STAGE(PG8_SA(0, 1), a2 + hstepA, voffA, srdA, g.A);
            PG8_WAIT_V(8); PG8_WAIT_L(0); PG8_BAR; PG8_MMA(0, 0, At, B0); PG8_MMA(0, 1, At, B1); PG8_BAR; PG8_SCHED;
            if constexpr (!HALFM) PG8_LDA(At, 1, 1); PG8_STAGE(PG8_SB(1, 0), b3, voffB, srdB, g.Bt); PG8_STAGE(PG8_SB(1, 1), b3 + hstep, voffB, srdB, g.Bt); PG8_STAGE(PG8_SA(1, 0), a3, voffA, srdA, g.A);
            PG8_WAIT_V(8); PG8_WAIT_L(0); PG8_BAR; if constexpr (!HALFM) { PG8_MMA(1, 0, At, B0); PG8_MMA(1, 1, At, B1); } PG8_BAR; PG8_SCHED;
            } else {
            PG8_LDB(B0, 0, 0); PG8_SCHED; PG8_LDA(At, 0, 0); PG8_STAGE(PG8_SA(1, 1), a1 + hstepA, voffA, srdA, g.A);
            PG8_WAIT_L(8); PG8_BAR; PG8_WAIT_L(0); PG8_MMA(0, 0, At, B0); PG8_BAR; PG8_SCHED;
            PG8_LDB(B1, 0, 1); PG8_STAGE(PG8_SB(0, 0), b2, voffB, srdB, g.Bt);
            PG8_BAR; PG8_WAIT_L(0); PG8_MMA(0, 1, At, B1); PG8_BAR;
            if constexpr (!HALFM) PG8_LDA(At, 0, 1); PG8_STAGE(PG8_SA(0, 0), a2, voffA, srdA, g.A);
            PG8_BAR; PG8_WAIT_L(0); if constexpr (!HALFM) PG8_MMA(1, 0, At, B0); PG8_BAR; PG8_SCHED;
            PG8_STAGE(PG8_SB(0, 1), b2 + hstep, voffB, srdB, g.Bt);
            PG8_WAIT_V(6); PG8_BAR; if constexpr (!HALFM) PG8_MMA(1, 1, At, B1); PG8_BAR;
            PG8_LDB(B0, 1, 0); PG8_SCHED; PG8_LDA(At, 1, 0); PG8_STAGE(PG8_SA(0, 1), a2 + hstepA, voffA, srdA, g.A);
            PG8_WAIT_L(8); PG8_BAR; PG8_WAIT_L(0); PG8_MMA(0, 0, At, B0); PG8_BAR; PG8_SCHED;
            PG8_LDB(B1, 1, 1); PG8_STAGE(PG8_SB(1, 0), b3, voffB, srdB, g.Bt);
            PG8_BAR; PG8_WAIT_L(0); PG8_MMA(0, 1, At, B1); PG8_BAR;
            if constexpr (!HALFM) PG8_LDA(At, 1, 1); PG8_STAGE(PG8_SA(1, 0), a3, voffA, srdA, g.A);
            PG8_BAR; PG8_WAIT_L(0); if constexpr (!HALFM) PG8_MMA(1, 0, At, B0); PG8_BAR; PG8_SCHED;
            PG8_STAGE(PG8_SB(1, 1), b3 + hstep, voffB, srdB, g.Bt);
            PG8_WAIT_V(6); PG8_BAR; if constexpr (!HALFM) PG8_MMA(1, 1, At, B1); PG8_BAR;
            }
        }
        if constexpr (ALIGN_EPI) { if (wr == 0) PG8_BAR; }
        if constexpr (!Epi::AFTER_DRAIN) { E(acc, cur, wr, wc, fr, fq); S.done(cur); }
        if (!has_next) break;
#pragma unroll
        for (int a = 0; a < 2; ++a)
#pragma unroll
            for (int b = 0; b < 2; ++b)
#pragma unroll
                for (int m = 0; m < 4; ++m)
#pragma unroll
                    for (int n = 0; n < 2; ++n) acc[a][b][m][n] = (f32x4){0.f, 0.f, 0.f, 0.f};
        cur = nxt; cA = nA; cB = nB; ++ui;
        if constexpr (ALIGN_EPI) { if (wr == 1) PG8_BAR; }
    }
    PG8_WAIT_V(0);
    if constexpr (!ALIGN_EPI) { if (wr == 0) PG8_BAR; }
    PG8_BAR;
    if constexpr (Epi::AFTER_DRAIN) { E.fused(acc, cur, wr, wc, fr, fq, lds, wid, lane); S.done(cur); }
#undef PG8_SA
#undef PG8_SB
#undef PG8_STAGE
#undef PG8_LDA
#undef PG8_LDB
#undef PG8_MMA
#undef PG8_WAIT_V
#undef PG8_WAIT_L
#undef PG8_BAR
#undef PG8_SCHED
}
}

typedef unsigned short bf16_t;
typedef short bf16x8 __attribute__((ext_vector_type(8)));
typedef short s16x4 __attribute__((ext_vector_type(4)));
typedef float f32x4 __attribute__((ext_vector_type(4)));
typedef float f32x16 __attribute__((ext_vector_type(16)));
typedef unsigned u32x4 __attribute__((ext_vector_type(4)));
typedef unsigned u32x2 __attribute__((ext_vector_type(2)));
#define LAS __attribute__((address_space(3)))

constexpr int D = 1024, BATCH = 2, SEQ = 8192, MROWS = BATCH * SEQ, DEPTH = 2;
constexpr int ZW = 2816, NW1 = 6912, INW = 6856, DFF = 2816, NGU = 5632, NMOD = 6 * D;
constexpr float RMS_EPS = 1e-6f, LOG2E = 1.4426950408889634f, C2 = 0.125f * 1.4426950408889634f;
constexpr int ZC_AU = 0, ZC_AB = 256, ZC_AC = 512, ZC_DQ = 768, ZC_DK = 1024, ZC_DV = 1088, ZC_DQI = 1152, ZC_DKI = 1408, ZC_FQ = 1472, ZC_FK = 1728, ZC_FV = 1984, ZC_SQ = 2240, ZC_SK = 2496, ZC_SV = 2624;

constexpr size_t MiB = 1u << 20;
constexpr size_t WS_KMAX = 4096;
constexpr size_t WS_MOD = 65536;
constexpr size_t WS_FCUM = WS_MOD + 98304;
constexpr size_t WS_SMALL = WS_FCUM + 262144;
constexpr size_t WS_W1T = 1 * MiB;
constexpr size_t WS_WG8 = WS_W1T + (size_t)2816 * D * 2;
constexpr size_t WS_WGU = WS_W1T + (size_t)NW1 * D * 2;
constexpr size_t WS_WBT = WS_WGU + (size_t)NGU * D * 2;
constexpr size_t WS_WOT = WS_WBT + (size_t)4 * D * 256 * 2;
constexpr size_t WS_WDT = WS_WOT + (size_t)D * D * 2;
constexpr size_t WS_H = 35 * MiB;
constexpr size_t WS_Z = 67 * MiB;
constexpr size_t WS_G = 155 * MiB;
constexpr size_t WS_MG = 219 * MiB;
constexpr size_t WS_END = 251 * MiB;
static_assert(WS_WDT + (size_t)D * DFF * 2 <= WS_H && WS_SMALL + 524288 <= WS_W1T, "ws map");

#ifndef FFN8
#define FFN8 1
#endif
#ifndef DOWN8
#define DOWN8 1
#endif
constexpr int LDS_BYTES = 151552;

struct Args {
    const float *x, *c, *w_ada, *b_ada, *norm_g, *w_in, *conv_w, *fox_bias, *swa_sinks, *w_branch, *w_o, *w_gate, *w_up, *w_down;
    float* out; unsigned char* ws;
};

__device__ __forceinline__ unsigned f2bf(float f) { unsigned u = __builtin_bit_cast(unsigned, f); return (u + 0x7fffu + ((u >> 16) & 1u)) >> 16; }
__device__ __forceinline__ unsigned pk2(float lo, float hi) { return f2bf(lo) | (f2bf(hi) << 16); }
__device__ __forceinline__ float bflo(unsigned w) { return __uint_as_float(w << 16); }
__device__ __forceinline__ float bfhi(unsigned w) { return __uint_as_float(w & 0xffff0000u); }

__device__ __forceinline__ float shf(float v, int src) { return __int_as_float(__builtin_amdgcn_ds_bpermute(src << 2, __float_as_int(v))); }
__device__ __forceinline__ unsigned shu(unsigned v, int src) { return (unsigned)__builtin_amdgcn_ds_bpermute(src << 2, (int)v); }
__device__ __forceinline__ float wave_sum(float v, int lane) {
#pragma unroll
    for (int o = 1; o < 64; o <<= 1) v += shf(v, lane ^ o);
    return v;
}
__device__ __forceinline__ int crow(int r, int hi) { return (r & 3) + 8 * (r >> 2) + 4 * hi; }
__device__ __forceinline__ float swap32_max(float m) { auto rr = __builtin_amdgcn_permlane32_swap(__float_as_uint(m), __float_as_uint(m), false, false); return fmaxf(__uint_as_float(rr[0]), __uint_as_float(rr[1])); }
__device__ __forceinline__ float swap32_sum(float m) { auto rr = __builtin_amdgcn_permlane32_swap(__float_as_uint(m), __float_as_uint(m), false, false); return __uint_as_float(rr[0]) + __uint_as_float(rr[1]); }
#define LDSWAIT() asm volatile("s_waitcnt lgkmcnt(0)" ::: "memory")
__device__ __forceinline__ int ftid(int wid_s) { unsigned ones = ~0u; asm volatile("" : "+s"(ones)); int t = wid_s * 64 + (int)__builtin_amdgcn_mbcnt_hi(ones, __builtin_amdgcn_mbcnt_lo(ones, 0u)); asm volatile("" : "+v"(t)); return t; }

__device__ __forceinline__ void ada_gemv(const Args& a, unsigned char* lds, int wid_s) {
    float* sc = (float*)lds;
    float* part = (float*)(lds + 8192);
    const int tid = ftid(wid_s), lane = tid & 63, wid = tid >> 6;
    for (int i = tid; i < 2 * D; i += 512) { const float v = a.c[i]; sc[i] = v / (1.0f + __expf(-v)); }
    __syncthreads();
    float* mod = (float*)(a.ws + WS_MOD);
    for (int item = blockIdx.x; item < DEPTH * (NMOD / 64); item += gridDim.x) {
        const int l = item / (NMOD / 64), jc = item % (NMOD / 64);
        const float* w = a.w_ada + (size_t)l * D * NMOD + (size_t)(wid * 128) * NMOD + jc * 64 + lane;
        float a0 = 0.f, a1 = 0.f;
#pragma unroll 32
        for (int k = 0; k < 128; ++k) { const float wv = w[(size_t)k * NMOD]; a0 += sc[wid * 128 + k] * wv; a1 += sc[D + wid * 128 + k] * wv; }
        part[(wid * 2 + 0) * 64 + lane] = a0; part[(wid * 2 + 1) * 64 + lane] = a1;
        __syncthreads();
        if (tid < 128) { const int b = tid >> 6, j = tid & 63; float s = 0.f;
#pragma unroll
            for (int w8 = 0; w8 < 8; ++w8) s += part[(w8 * 2 + b) * 64 + j];
            mod[((size_t)l * 2 + b) * NMOD + jc * 64 + j] = s + a.b_ada[(size_t)l * NMOD + jc * 64 + j]; }
        __syncthreads();
    }
}
__device__ __forceinline__ void transpose_item(const float* colptr, int ld, bf16_t* dst  , int dstK, float* scr, int lane) {
    float tv[32];
#pragma unroll
    for (int i = 0; i < 32; ++i) tv[i] = colptr ? colptr[(size_t)(2 * i + (lane >> 5)) * ld] : 0.f;
#pragma unroll
    for (int i = 0; i < 32; ++i) scr[(2 * i + (lane >> 5)) * 33 + (lane & 31)] = tv[i];
    LDSWAIT();
    const int c = lane & 7;
#pragma unroll
    for (int j = 0; j < 4; ++j) { const int n = (lane >> 3) + 8 * j; const float* s = scr + (8 * c) * 33 + n;
        u32x4 o; o.x = pk2(s[0 * 33], s[1 * 33]); o.y = pk2(s[2 * 33], s[3 * 33]); o.z = pk2(s[4 * 33], s[5 * 33]); o.w = pk2(s[6 * 33], s[7 * 33]);
        *(u32x4*)(dst + (size_t)n * dstK + 8 * c) = o; }
    LDSWAIT();
}
__device__ __forceinline__ void transpose_item_fp8(const float* colptr, int ld, unsigned char* dst  , int dstK, float scale, float* scr, int lane, bool permrows = false) {
    float tv[32];
#pragma unroll
    for (int i = 0; i < 32; ++i) tv[i] = colptr ? colptr[(size_t)(2 * i + (lane >> 5)) * ld] : 0.f;
#pragma unroll
    for (int i = 0; i < 32; ++i) scr[(2 * i + (lane >> 5)) * 33 + (lane & 31)] = tv[i];
    LDSWAIT();
    const int n = lane >> 1, kh = 32 * (lane & 1); const float* s = scr + kh * 33 + n;
    unsigned w[8];
#pragma unroll
    for (int q = 0; q < 8; ++q) { unsigned t = 0u;
        t = __builtin_amdgcn_cvt_pk_fp8_f32(s[(4 * q + 0) * 33] * scale, s[(4 * q + 1) * 33] * scale, t, false);
        t = __builtin_amdgcn_cvt_pk_fp8_f32(s[(4 * q + 2) * 33] * scale, s[(4 * q + 3) * 33] * scale, t, true);
        w[q] = t; }
    const int nrow = permrows ? (16 * ((n >> 2) & 1) + 4 * (n >> 3) + (n & 3)) : n;
    unsigned char* dp = dst + (size_t)nrow * dstK + kh;
    *(u32x4*)dp = (u32x4){w[0], w[1], w[2], w[3]}; *(u32x4*)(dp + 16) = (u32x4){w[4], w[5], w[6], w[7]};
    LDSWAIT();
}
__device__ __forceinline__ int w1_src_col(int n) {
    if (n < 1472) return n;
    if (n < 2240) return n + 4;
    if (n < 2752) return n + 8;
    if (n < 2756) return 1472 + (n - 2752);
    if (n < 2760) return 2244 + (n - 2756);
    if (n < 2816) return -1;
    return 2760 + (n - 2816);
}
__device__ __forceinline__ void convert_weights(const Args& a, int l, unsigned char* lds, int wid_s) {
    const int tid = ftid(wid_s), lane = tid & 63, wid = tid >> 6;
    float* scr = (float*)(lds + 16384) + wid * (64 * 33);
    const int gw = blockIdx.x * 8 + wid, NGW = gridDim.x * 8;
    constexpr int I_IN = 16 * 216, I_GU = 16 * 176, I_B = 512, I_O = 512, I_D = 44 * 32;
    bf16_t* W1T = (bf16_t*)(a.ws + WS_W1T); bf16_t* WGU = (bf16_t*)(a.ws + WS_WGU); bf16_t* WBT = (bf16_t*)(a.ws + WS_WBT); bf16_t* WOT = (bf16_t*)(a.ws + WS_WOT); bf16_t* WDT = (bf16_t*)(a.ws + WS_WDT);
    const int cl = lane & 31;
    for (int it = gw; it < I_IN + I_GU + I_B + I_O + I_D; it += NGW) {
        int r = it;
        if (r < I_IN) { const int kb = r / 216, nb = r % 216;
            if (nb < 88) { const int n = 32 * nb + cl, sc_ = w1_src_col(n);
                const float* cp = sc_ >= 0 ? a.w_in + (size_t)l * D * INW + (size_t)(64 * kb) * INW + sc_ : nullptr;
                transpose_item(cp, INW, W1T + (size_t)(32 * nb) * D + 64 * kb, D, scr, lane); }
            else { const int n = 32 * nb + cl;
                const float* cp = a.w_in + (size_t)l * D * INW + (size_t)(64 * kb) * INW + w1_src_col(n);
                transpose_item_fp8(cp, INW, a.ws + WS_WG8 + (size_t)(32 * (nb - 88)) * D + 64 * kb, D, 32.0f, scr, lane, true); }
            continue; }
        r -= I_IN;
        if (r < I_GU) { const int kb = r / 176, nb = r % 176, n = 32 * nb + cl;
#if FFN8
            const int rt = n & 255, hj = 128 * (n >> 8) + 32 * ((rt >> 5) & 3) + 8 * ((rt >> 3) & 3) + 4 * (rt >> 7) + 2 * ((rt >> 2) & 1) + ((rt >> 1) & 1);
            const float* cp = ((n & 1) ? a.w_up : a.w_gate) + (size_t)l * D * DFF + (size_t)(64 * kb) * DFF + hj;
#else
            const float* cp = ((n & 1) ? a.w_up : a.w_gate) + (size_t)l * D * DFF + (size_t)(64 * kb) * DFF + (n >> 1);
#endif
#if FFN8
            transpose_item_fp8(cp, DFF, a.ws + WS_WGU + (size_t)(32 * nb) * D + 64 * kb, D, 32.0f, scr, lane, true); continue; }
#else
            transpose_item(cp, DFF, WGU + (size_t)(32 * nb) * D + 64 * kb, D, scr, lane); continue; }
#endif
        r -= I_GU;
        if (r < I_B) { const int nbr = r / 128, rr = r % 128, kb = rr / 32, nb = rr % 32;
            const float* cp = a.w_branch + ((size_t)(l * 4 + nbr) * 256 + 64 * kb) * D + 32 * nb + cl;
            transpose_item(cp, D, WBT + ((size_t)nbr * D + 32 * nb) * 256 + 64 * kb, 256, scr, lane); continue; }
        r -= I_B;
        if (r < I_O) { const int kb = r / 32, nb = r % 32;
            const float* cp = a.w_o + (size_t)l * D * D + (size_t)(64 * kb) * D + 32 * nb + cl;
#if WO8
            transpose_item_fp8(cp, D, a.ws + WS_WOT + (size_t)(32 * nb) * D + 64 * kb, D, 32.0f, scr, lane, true); continue; }
#else
            transpose_item(cp, D, WOT + (size_t)(32 * nb) * D + 64 * kb, D, scr, lane); continue; }
#endif
        r -= I_O;
        { const int kb = r / 32, nb = r % 32;
            const float* cp = a.w_down + (size_t)l * DFF * D + (size_t)(64 * kb) * D + 32 * nb + cl;
#if DOWN8
            transpose_item_fp8(cp, D, a.ws + WS_WDT + (size_t)(32 * nb) * DFF + 64 * kb, DFF, 32.0f, scr, lane, true); }
#else
            transpose_item(cp, D, WDT + (size_t)(32 * nb) * DFF + 64 * kb, DFF, scr, lane); }
#endif
    }
}

template <bool HAS_RAW, bool HAS_H, bool XIN16 = false, bool XOUT16 = false, bool HAS_H8 = false>
__device__ __forceinline__ void row_pass8(const void* xres_, const bf16_t* raw, void* xdst_, bf16_t* hdst, unsigned char* h8dst, const float* gate, const float* gam_out, const float* gam_in, const float* sc, const float* sh, int lane) {
    f32x4 A[4], B[4], C[4];
#pragma unroll
    for (int j = 0; j < 4; ++j) {
        if (HAS_RAW) A[j] = ((const f32x4*)gate)[lane + 64 * j] * ((const f32x4*)gam_out)[lane + 64 * j];
        if (HAS_H) { B[j] = ((const f32x4*)gam_in)[lane + 64 * j] * (((const f32x4*)sc)[lane + 64 * j] + 1.0f); C[j] = ((const f32x4*)sh)[lane + 64 * j]; }
    }
    const float* xres = (const float*)xres_; const bf16_t* xres16 = (const bf16_t*)xres_; float* xdst = (float*)xdst_; bf16_t* xdst16 = (bf16_t*)xdst_;
    f32x4 nv[4]; u32x2 nx[4], nr[4];
#pragma unroll
    for (int j = 0; j < 4; ++j) { if (XIN16) nx[j] = ((const u32x2*)xres16)[lane + 64 * j]; else nv[j] = ((const f32x4*)xres)[lane + 64 * j]; if (HAS_RAW) nr[j] = ((const u32x2*)raw)[lane + 64 * j]; }
#pragma unroll 1
    for (int r = 0; r < 8; ++r) {
        f32x4 v[4]; u32x2 w[4];
#pragma unroll
        for (int j = 0; j < 4; ++j) { if (XIN16) v[j] = (f32x4){bflo(nx[j].x), bfhi(nx[j].x), bflo(nx[j].y), bfhi(nx[j].y)}; else v[j] = nv[j]; if (HAS_RAW) w[j] = nr[j]; }
        if (r + 1 < 8) {
#pragma unroll
            for (int j = 0; j < 4; ++j) { if (XIN16) nx[j] = ((const u32x2*)(xres16 + (size_t)(r + 1) * D))[lane + 64 * j]; else nv[j] = ((const f32x4*)(xres + (size_t)(r + 1) * D))[lane + 64 * j];
                if (HAS_RAW) nr[j] = ((const u32x2*)(raw + (size_t)(r + 1) * D))[lane + 64 * j]; }
        }
        if (HAS_RAW) {
            f32x4 o[4]; float ss = 0.f;
#pragma unroll
            for (int j = 0; j < 4; ++j) { o[j] = (f32x4){bflo(w[j].x), bfhi(w[j].x), bflo(w[j].y), bfhi(w[j].y)}; ss += (o[j][0] * o[j][0] + o[j][1] * o[j][1]) + (o[j][2] * o[j][2] + o[j][3] * o[j][3]); }
            const float rstd = 1.0f / sqrtf(wave_sum(ss, lane) * (1.0f / D) + RMS_EPS);
#pragma unroll
            for (int j = 0; j < 4; ++j) { v[j] = v[j] + A[j] * (o[j] * rstd);
                if (XOUT16) { u32x2 pw; pw.x = pk2(v[j][0], v[j][1]); pw.y = pk2(v[j][2], v[j][3]); ((u32x2*)(xdst16 + (size_t)r * D))[lane + 64 * j] = pw; }
                else ((f32x4*)(xdst + (size_t)r * D))[lane + 64 * j] = v[j]; }
        }
        if (HAS_H) {
            float ss = 0.f;
#pragma unroll
            for (int j = 0; j < 4; ++j) ss += (v[j][0] * v[j][0] + v[j][1] * v[j][1]) + (v[j][2] * v[j][2] + v[j][3] * v[j][3]);
            const float rstd = 1.0f / sqrtf(wave_sum(ss, lane) * (1.0f / D) + RMS_EPS);
#pragma unroll
            for (int j = 0; j < 4; ++j) { const f32x4 h = v[j] * rstd * B[j] + C[j]; if (hdst) { u32x2 pw; pw.x = pk2(h[0], h[1]); pw.y = pk2(h[2], h[3]); ((u32x2*)(hdst + (size_t)r * D))[lane + 64 * j] = pw; }
                if (HAS_H8) { unsigned t8 = 0u; t8 = __builtin_amdgcn_cvt_pk_fp8_f32(h[0], h[1], t8, false); t8 = __builtin_amdgcn_cvt_pk_fp8_f32(h[2], h[3], t8, true); ((unsigned*)(h8dst + (size_t)r * D))[lane + 64 * j] = t8; } }
        }
    }
}

__device__ __forceinline__ void conv_phase(const Args& a, int l, int wid_s) {
    const bf16_t* Z = (const bf16_t*)(a.ws + WS_Z); bf16_t* Y0 = (bf16_t*)(a.ws + WS_H);
    const float* cw = a.conv_w + (size_t)l * 3 * 256;
    const int gt = blockIdx.x * 512 + ftid(wid_s), GT = gridDim.x * 512;
    for (int it = gt; it < MROWS * 32; it += GT) {
        const int row = it >> 5, ch = (it & 31) * 8, t = row & (SEQ - 1);
        float acc[8];
#pragma unroll
        for (int k = 0; k < 8; ++k) acc[k] = 0.f;
#pragma unroll
        for (int j = 0; j < 3; ++j) { const int dt = 2 - j; if (t - dt < 0) continue;
            const bf16_t* zr = Z + (size_t)(row - dt) * ZW;
            const u32x4 u = *(const u32x4*)(zr + ZC_AU + ch), cgt = *(const u32x4*)(zr + ZC_AC + ch);
            const f32x4 w0 = *(const f32x4*)(cw + j * 256 + ch), w1 = *(const f32x4*)(cw + j * 256 + ch + 4);
            acc[0] += w0[0] * bflo(u.x) * bflo(cgt.x); acc[1] += w0[1] * bfhi(u.x) * bfhi(cgt.x); acc[2] += w0[2] * bflo(u.y) * bflo(cgt.y); acc[3] += w0[3] * bfhi(u.y) * bfhi(cgt.y);
            acc[4] += w1[0] * bflo(u.z) * bflo(cgt.z); acc[5] += w1[1] * bfhi(u.z) * bfhi(cgt.z); acc[6] += w1[2] * bflo(u.w) * bflo(cgt.w); acc[7] += w1[3] * bfhi(u.w) * bfhi(cgt.w); }
        const u32x4 bg = *(const u32x4*)(Z + (size_t)row * ZW + ZC_AB + ch);
        u32x4 o; o.x = pk2(acc[0] * bflo(bg.x), acc[1] * bfhi(bg.x)); o.y = pk2(acc[2] * bflo(bg.y), acc[3] * bfhi(bg.y)); o.z = pk2(acc[4] * bflo(bg.z), acc[5] * bfhi(bg.z)); o.w = pk2(acc[6] * bflo(bg.w), acc[7] * bfhi(bg.w));
        *(u32x4*)(Y0 + (size_t)row * 256 + ch) = o;
    }
}

__device__ __forceinline__ void fox_scan(const Args& a, int l, int bh, unsigned char* lds, int wid_s) {
    const int tid = ftid(wid_s), lane = tid & 63, wid = tid >> 6, b = bh >> 2, h = bh & 3;
    const float* SM = (const float*)(a.ws + WS_SMALL); float* F2 = (float*)(a.ws + WS_FCUM) + (size_t)bh * SEQ;
    const float bias = a.fox_bias[l * 4 + h];
    float* wtot = (float*)lds;
    float v[16]; float run = 0.f;
#pragma unroll
    for (int i = 0; i < 16; ++i) { const float x = SM[((size_t)b * SEQ + tid * 16 + i) * 8 + 4 + h] + bias;
        const float ls = fminf(x, 0.f) - log1pf(__expf(-fabsf(x))); run += ls; v[i] = run; }
    float inc = run;
#pragma unroll
    for (int o = 1; o < 64; o <<= 1) { const float t = shf(inc, lane - o); if (lane >= o) inc += t; }
    if (lane == 63) wtot[wid] = inc;
    __syncthreads();
    float base = inc - run;
    for (int w = 0; w < wid; ++w) base += wtot[w];
#pragma unroll
    for (int i = 0; i < 16; ++i) F2[tid * 16 + i] = (base + v[i]) * LOG2E;
    __syncthreads();
}


__device__ __forceinline__ void fox_kmax_item(const Args& a, int l, int item, int wid_s) {
    const int tid = ftid(wid_s), lane = tid & 63, bh = item >> 3, chunk = item & 7, b = bh >> 2, h = bh & 3;
    const bf16_t* Z = (const bf16_t*)(a.ws + WS_Z);
    float mx = 0.f;
#pragma unroll
    for (int rr = 0; rr < 2; ++rr) { const bf16_t* kp = Z + ((size_t)b * SEQ + chunk * 1024 + rr * 512 + tid) * ZW + ZC_FK + h * 64; float q2 = 0.f;
#pragma unroll
        for (int i = 0; i < 8; ++i) { const u32x4 w = *(const u32x4*)(kp + 8 * i);
            q2 += bflo(w.x) * bflo(w.x) + bfhi(w.x) * bfhi(w.x) + bflo(w.y) * bflo(w.y) + bfhi(w.y) * bfhi(w.y) + bflo(w.z) * bflo(w.z) + bfhi(w.z) * bfhi(w.z) + bflo(w.w) * bflo(w.w) + bfhi(w.w) * bfhi(w.w); }
        mx = fmaxf(mx, q2); }
#pragma unroll
    for (int o = 1; o < 64; o <<= 1) mx = fmaxf(mx, shf(mx, lane ^ o));
    if (lane == 0) atomicMax((unsigned*)(a.ws + WS_KMAX) + l * 8 + bh, __float_as_uint(mx));
}

template <int MODE>
__device__ __forceinline__ void attn_unit(unsigned char* lds, const bf16_t* __restrict__ Z, bf16_t* __restrict__ Yn, int b, int head, int qb, const float* __restrict__ F2, float slope2, float sink2, int tile_lo, float kmax, int wid_s) {
    const int tid = ftid(wid_s), lane = tid & 63, r32 = lane & 31, hi = lane >> 5; const int wid = __builtin_amdgcn_readfirstlane(tid >> 6);
    constexpr int QOFF = MODE == 0 ? ZC_FQ : ZC_SQ, KOFF = MODE == 0 ? ZC_FK : ZC_SK, VOFF = MODE == 0 ? ZC_FV : ZC_SV;
    const int hk = MODE == 0 ? head : (head >> 1);
    const size_t rowbase = (size_t)b * SEQ;
    const int q0 = qb * 256, qa = q0 + 32 * wid, myq = qa + r32;
    unsigned char* Ks = lds; unsigned char* Vs = lds + 9216; float* Fk = (float*)(lds + 9216 + 12288); float* wsc = (float*)(lds + 49152) + wid * 64;
    bf16x8 qr[4];
    { const bf16_t* qp = Z + (rowbase + myq) * ZW + QOFF + head * 64 + hi * 8;
#pragma unroll
      for (int ks = 0; ks < 4; ++ks) qr[ks] = *(const bf16x8*)(qp + 16 * ks); }
    const float* Fh = MODE == 0 ? F2 + ((size_t)b * 4 + head) * SEQ : nullptr;
    const float fq2 = MODE == 0 ? Fh[myq] : 0.f;
    float m = -1e30f, l = 0.f; f32x16 o0, o1;
#pragma unroll
    for (int r = 0; r < 16; ++r) { o0[r] = 0.f; o1[r] = 0.f; }
    const int t_hi = (q0 + 255) >> 6;
    if (MODE == 0) {
        int* smin = (int*)(lds + 49152 + 2048);
        __syncthreads();
        if (tid == 0) *smin = 0x7fffffff;
        __syncthreads();
        if (tid < 256) {
            const int t = q0 + tid; const bf16_t* qp2 = Z + (rowbase + t) * ZW + QOFF + head * 64; float q2 = 0.f;
#pragma unroll
            for (int i = 0; i < 8; ++i) { const u32x4 w = *(const u32x4*)(qp2 + 8 * i);
                q2 += bflo(w.x) * bflo(w.x) + bfhi(w.x) * bfhi(w.x) + bflo(w.y) * bflo(w.y) + bfhi(w.y) * bfhi(w.y) + bflo(w.z) * bflo(w.z) + bfhi(w.z) * bfhi(w.z) + bflo(w.w) * bflo(w.w) + bfhi(w.w) * bfhi(w.w); }
            const float target = Fh[t] + (40.0f + 0.25f * sqrtf(q2) * kmax) * LOG2E;
            int lo = 0, hi2 = t;
            while (lo < hi2) { const int mid = (lo + hi2) >> 1; if (Fh[mid] <= target) hi2 = mid; else lo = mid + 1; }
            atomicMin(smin, lo);
        }
        __syncthreads();
#ifdef PROBE_FOXFULL
        tile_lo = 0;
#else
        tile_lo = *smin >> 6;
#endif
    }
    const int srow = tid >> 3, sch = tid & 7;
    const int i16 = lane & 15;
    const LAS unsigned char* vtr_base = (const LAS unsigned char*)(Vs) + (4 * hi + (i16 >> 2)) * 192 + (16 * ((lane >> 4) & 1) + 4 * (i16 & 3)) * 2;
    u32x4 nk, nv4; float nf = 0.f;
    { const bf16_t* src = Z + (rowbase + 64 * t_hi + srow) * ZW;
      nk = *(const u32x4*)(src + KOFF + hk * 64 + sch * 8); nv4 = *(const u32x4*)(src + VOFF + hk * 64 + sch * 8);
      if (MODE == 0 && tid < 64) nf = Fh[64 * t_hi + tid]; }
    constexpr int ABUF = 24576;
    __syncthreads();
    { unsigned char* kb_ = Ks + (t_hi & 1) * ABUF; unsigned char* vb_ = Vs + (t_hi & 1) * ABUF;
      *(u32x4*)(kb_ + srow * 144 + sch * 16) = nk; *(u32x4*)(vb_ + srow * 192 + sch * 16) = nv4;
      if (MODE == 0 && tid < 64) (Fk + (t_hi & 1) * (ABUF / 4))[tid] = nf; }
    if (t_hi > tile_lo) { const bf16_t* src = Z + (rowbase + 64 * (t_hi - 1) + srow) * ZW;
      nk = *(const u32x4*)(src + KOFF + hk * 64 + sch * 8); nv4 = *(const u32x4*)(src + VOFF + hk * 64 + sch * 8);
      if (MODE == 0 && tid < 64) nf = Fh[64 * (t_hi - 1) + tid]; }
    for (int T = t_hi; T >= tile_lo; --T) {
        __syncthreads();
        if (T > tile_lo) {
            unsigned char* kb_ = Ks + ((T - 1) & 1) * ABUF; unsigned char* vb_ = Vs + ((T - 1) & 1) * ABUF;
            *(u32x4*)(kb_ + srow * 144 + sch * 16) = nk; *(u32x4*)(vb_ + srow * 192 + sch * 16) = nv4;
            if (MODE == 0 && tid < 64) (Fk + ((T - 1) & 1) * (ABUF / 4))[tid] = nf;
            if (T - 1 > tile_lo) { const bf16_t* src = Z + (rowbase + 64 * (T - 2) + srow) * ZW;
              nk = *(const u32x4*)(src + KOFF + hk * 64 + sch * 8); nv4 = *(const u32x4*)(src + VOFF + hk * 64 + sch * 8);
              if (MODE == 0 && tid < 64) nf = Fh[64 * (T - 2) + tid]; }
        }
        const unsigned char* Kc = Ks + (T & 1) * ABUF; const float* Fc = Fk + (T & 1) * (ABUF / 4); const int vofs = (T & 1) * ABUF;
        const bool part = (64 * T <= qa + 31) && (MODE == 0 || (64 * T + 63 >= qa - 127));
        if (part) {
            f32x16 p0, p1;
#pragma unroll
            for (int r = 0; r < 16; ++r) { p0[r] = 0.f; p1[r] = 0.f; }
#pragma unroll
            for (int ks = 0; ks < 4; ++ks) {
                const bf16x8 k0 = *(const bf16x8*)(Kc + r32 * 144 + (16 * ks + 8 * hi) * 2);
                const bf16x8 k1 = *(const bf16x8*)(Kc + (32 + r32) * 144 + (16 * ks + 8 * hi) * 2);
                p0 = __builtin_amdgcn_mfma_f32_32x32x16_bf16(k0, qr[ks], p0, 0, 0, 0);
                p1 = __builtin_amdgcn_mfma_f32_32x32x16_bf16(k1, qr[ks], p1, 0, 0, 0);
            }
            const int kvb = 64 * T + 4 * hi;
            float mx = -INFINITY;
#pragma unroll
            for (int g = 0; g < 4; ++g) {
                f32x4 fk0 = {0.f, 0.f, 0.f, 0.f}, fk1 = {0.f, 0.f, 0.f, 0.f};
                if (MODE == 0) { fk0 = *(const f32x4*)(Fc + 8 * g + 4 * hi); fk1 = *(const f32x4*)(Fc + 32 + 8 * g + 4 * hi); }
#pragma unroll
                for (int i = 0; i < 4; ++i) { const int r = 4 * g + i, kv0 = kvb + 8 * g + i, kv1 = kv0 + 32;
                    float x0, x1;
                    if (MODE == 0) { x0 = p0[r] * C2 + (fq2 - fk0[i]); x1 = p1[r] * C2 + (fq2 - fk1[i]); if (kv0 > myq) x0 = -INFINITY; if (kv1 > myq) x1 = -INFINITY; }
                    else { const int d0 = myq - kv0, d1 = myq - kv1; x0 = p0[r] * C2 - slope2 * (float)d0; x1 = p1[r] * C2 - slope2 * (float)d1; if (d0 < 0 || d0 >= 128) x0 = -INFINITY; if (d1 < 0 || d1 >= 128) x1 = -INFINITY; }
                    p0[r] = x0; p1[r] = x1; mx = fmaxf(mx, fmaxf(x0, x1)); }
            }
            mx = swap32_max(mx);
            const float mn = fmaxf(m, mx), alpha = __builtin_amdgcn_exp2f(m - mn); m = mn;
            float ps = 0.f;
#pragma unroll
            for (int r = 0; r < 16; ++r) { p0[r] = __builtin_amdgcn_exp2f(p0[r] - mn); p1[r] = __builtin_amdgcn_exp2f(p1[r] - mn); ps += p0[r] + p1[r]; }
            l = l * alpha + ps;
            if (hi == 0) wsc[r32] = alpha;
            LDSWAIT();
#pragma unroll
            for (int g = 0; g < 4; ++g) { const f32x4 a4 = *(const f32x4*)(wsc + 8 * g + 4 * hi);
#pragma unroll
                for (int i = 0; i < 4; ++i) { o0[4 * g + i] *= a4[i]; o1[4 * g + i] *= a4[i]; } }
            LDSWAIT();
#pragma unroll
            for (int s = 0; s < 4; ++s) {
                u32x4 pw;
                if (s < 2) { const int e = 8 * s; pw.x = pk2(p0[e], p0[e + 1]); pw.y = pk2(p0[e + 2], p0[e + 3]); pw.z = pk2(p0[e + 4], p0[e + 5]); pw.w = pk2(p0[e + 6], p0[e + 7]); }
                else { const int e = 8 * (s - 2); pw.x = pk2(p1[e], p1[e + 1]); pw.y = pk2(p1[e + 2], p1[e + 3]); pw.z = pk2(p1[e + 4], p1[e + 5]); pw.w = pk2(p1[e + 6], p1[e + 7]); }
                const bf16x8 pa = __builtin_bit_cast(bf16x8, pw);
#pragma unroll
                for (int db = 0; db < 2; ++db) {
                    const LAS unsigned char* vp = vtr_base + vofs + (16 * s) * 192 + 64 * db;
                    const s16x4 lo = __builtin_bit_cast(s16x4, __builtin_amdgcn_ds_read_tr16_b64_v4i16((LAS s16x4*)vp));
                    const s16x4 hv = __builtin_bit_cast(s16x4, __builtin_amdgcn_ds_read_tr16_b64_v4i16((LAS s16x4*)(vp + 8 * 192)));
                    const bf16x8 vf = (bf16x8){lo[0], lo[1], lo[2], lo[3], hv[0], hv[1], hv[2], hv[3]};
                    if (db == 0) o0 = __builtin_amdgcn_mfma_f32_32x32x16_bf16(pa, vf, o0, 0, 0, 0); else o1 = __builtin_amdgcn_mfma_f32_32x32x16_bf16(pa, vf, o1, 0, 0, 0);
                }
            }
        }
    }
    float lt = swap32_sum(l);
    if (MODE == 1) lt += __builtin_amdgcn_exp2f(sink2 - m);
    const float inv = 1.0f / lt;
    LDSWAIT();
    if (hi == 0) wsc[32 + r32] = inv;
    LDSWAIT();
#pragma unroll
    for (int g = 0; g < 4; ++g) { const f32x4 iv = *(const f32x4*)(wsc + 32 + 8 * g + 4 * hi);
#pragma unroll
        for (int i = 0; i < 4; ++i) { const int r = 4 * g + i, q = qa + 8 * g + 4 * hi + i;
            bf16_t* yp = Yn + (rowbase + q) * 256 + head * 64 + r32;
            yp[0] = (bf16_t)f2bf(o0[r] * iv[i]); yp[32] = (bf16_t)f2bf(o1[r] * iv[i]); } }
    LDSWAIT();
}

__device__ __forceinline__ unsigned score_key(float s) { const unsigned u = __float_as_uint(s + 0.0f); return (u & 0x80000000u) ? ~u : (u | 0x80000000u); }
__device__ __forceinline__ void hist_find(const unsigned* hrow, int lane, unsigned need, unsigned& bin, unsigned& above) {
    unsigned w[16]; unsigned tot = 0;
#pragma unroll
    for (int i = 0; i < 16; i += 4) { const u32x4 t = *(const u32x4*)(hrow + 16 * lane + i); w[i] = t.x; w[i + 1] = t.y; w[i + 2] = t.z; w[i + 3] = t.w; }
#pragma unroll
    for (int i = 0; i < 16; ++i) tot += (w[i] & 0xffffu) + (w[i] >> 16);
    unsigned inc = tot;
#pragma unroll
    for (int o = 1; o < 64; o <<= 1) { const unsigned t = shu(inc, lane + o); if (lane + o < 64) inc += t; }
    const unsigned exc = inc - tot;
    const bool owner = (exc < need) && (inc >= need);
    unsigned run = exc, fb = 0, fa = 0; bool found = false;
#pragma unroll
    for (int i = 15; i >= 0; --i) {
        const unsigned hi = w[i] >> 16, lo = w[i] & 0xffffu;
        if (!found && run + hi >= need) { found = true; fb = 32 * lane + 2 * i + 1; fa = run; }
        run += hi;
        if (!found && run + lo >= need) { found = true; fb = 32 * lane + 2 * i; fa = run; }
        run += lo;
    }
    const unsigned long long bal = __ballot(owner);
    const int src = bal ? (int)__builtin_ctzll(bal) : 0;
    bin = shu(fb, src); above = shu(fa, src);
}
__device__ __forceinline__ void dsa_select_slow(const Args& a, unsigned char* lds, int b, int qb32, int wid_s) {
    const int tid = ftid(wid_s), lane = tid & 63; const int wid = __builtin_amdgcn_readfirstlane(tid >> 6);
    const int c16 = lane & 15, g = lane >> 4;
    const bf16_t* Z = (const bf16_t*)(a.ws + WS_Z); const float* SM = (const float*)(a.ws + WS_SMALL);
    unsigned short* IDX = (unsigned short*)(a.ws + WS_MG);
    unsigned* hist = (unsigned*)lds;
    unsigned char* kt = lds + 131072;
    const size_t rowbase = (size_t)b * SEQ;
    const int t0 = qb32 * 32, myt = t0 + 4 * wid + g;
    const int ntile = (t0 + 32 + 63) >> 6;
    bf16x8 af[2];
    { const int qq = c16 >> 2, h = c16 & 3; const bf16_t* qp = Z + (rowbase + t0 + 4 * wid + qq) * ZW + ZC_DQI + h * 64 + 8 * g;
      af[0] = *(const bf16x8*)qp; af[1] = *(const bf16x8*)(qp + 32); }
    const f32x4 wv = *(const f32x4*)(SM + (rowbase + myt) * 8);
    const unsigned need = (unsigned)((myt + 1) < 256 ? (myt + 1) : 256);
    unsigned b1 = 0, above1 = 0, thr22 = 0, quota = 0;
    unsigned tiecount = 0, outcount = 0;
    unsigned* myhist = hist + (size_t)(4 * wid + g) * 1024;
    unsigned short* myidx = IDX + (rowbase + myt) * 256;
    const int srow = tid >> 3, sch = tid & 7;
    for (int pass = 0; pass < 3; ++pass) {
        if (pass < 2) { unsigned z_ = 0u; asm volatile("" : "+v"(z_)); const u32x4 z4 = {z_, z_, z_, z_};
            for (int i = tid; i < 32 * 1024 / 4; i += 512) ((u32x4*)hist)[i] = z4; }
        for (int T = 0; T < ntile; ++T) {
            __syncthreads();
            *(u32x4*)(kt + srow * 144 + sch * 16) = *(const u32x4*)(Z + (rowbase + 64 * T + srow) * ZW + ZC_DKI + sch * 8);
            __syncthreads();
#pragma unroll
            for (int cg4 = 0; cg4 < 4; ++cg4) {
                const bf16x8 k0 = *(const bf16x8*)(kt + (16 * cg4 + c16) * 144 + (8 * g) * 2);
                const bf16x8 k1 = *(const bf16x8*)(kt + (16 * cg4 + c16) * 144 + (32 + 8 * g) * 2);
                f32x4 acc = {0.f, 0.f, 0.f, 0.f};
                acc = __builtin_amdgcn_mfma_f32_16x16x32_bf16(af[0], k0, acc, 0, 0, 0);
                acc = __builtin_amdgcn_mfma_f32_16x16x32_bf16(af[1], k1, acc, 0, 0, 0);
                const int key = 64 * T + 16 * cg4 + c16;
                const bool valid = key <= myt;
                const float sc = wv[0] * fmaxf(acc[0], 0.f) + wv[1] * fmaxf(acc[1], 0.f) + wv[2] * fmaxf(acc[2], 0.f) + wv[3] * fmaxf(acc[3], 0.f);
                const unsigned u = score_key(sc);
                if (pass == 0) { if (valid) { const unsigned bin = u >> 21; atomicAdd(myhist + (bin >> 1), (bin & 1u) ? 65536u : 1u); } }
                else if (pass == 1) { if (valid && (u >> 21) == b1) { const unsigned bin = (u >> 10) & 0x7ffu; atomicAdd(myhist + (bin >> 1), (bin & 1u) ? 65536u : 1u); } }
                else {
                    const unsigned p22 = u >> 10;
                    const bool tie = valid && (p22 == thr22);
                    const unsigned long long tb = __ballot(tie);
                    const unsigned tmask = (unsigned)(tb >> (16 * g)) & 0xffffu;
                    const bool acc_tie = tie && (tiecount + __popc(tmask & ((1u << c16) - 1u)) < quota);
                    tiecount += __popc(tmask);
                    const bool sel = (valid && p22 > thr22) || acc_tie;
                    const unsigned long long sb = __ballot(sel);
                    const unsigned smask = (unsigned)(sb >> (16 * g)) & 0xffffu;
                    if (sel) myidx[outcount + __popc(smask & ((1u << c16) - 1u))] = (unsigned short)key;
                    outcount += __popc(smask);
                }
            }
        }
        __syncthreads();
        if (pass == 0) {
#pragma unroll
            for (int qq = 0; qq < 4; ++qq) { const unsigned nd = shu(need, 16 * qq); unsigned bn, ab; hist_find(hist + (size_t)(4 * wid + qq) * 1024, lane, nd, bn, ab); if (g == qq) { b1 = bn; above1 = ab; } }
            __syncthreads();
        } else if (pass == 1) {
#pragma unroll
            for (int qq = 0; qq < 4; ++qq) { const unsigned nd = shu(need - above1, 16 * qq); unsigned bn, ab; hist_find(hist + (size_t)(4 * wid + qq) * 1024, lane, nd, bn, ab); if (g == qq) { thr22 = (b1 << 11) | bn; quota = need - above1 - ab; } }
            __syncthreads();
        }
    }
}


#ifndef SELREP
#define SELREP 0
#endif
constexpr int DS_CAP = 576, DS_RANK = 104;
constexpr unsigned ZCLASS = 0x80000000u >> 10;
__device__ __forceinline__ unsigned below_me(unsigned long long bal) { return __builtin_amdgcn_mbcnt_hi((unsigned)(bal >> 32), __builtin_amdgcn_mbcnt_lo((unsigned)bal, 0u)); }
__device__ __forceinline__ float relu1(float x) { return __builtin_amdgcn_fmed3f(x, 0.0f, 3.0e38f); }
__device__ __forceinline__ float idx_score_acc(const f32x4& acc, const f32x4& wv) {
    return fmaf(wv[3], relu1(acc[3]), fmaf(wv[2], relu1(acc[2]), fmaf(wv[1], relu1(acc[1]), wv[0] * relu1(acc[0])))) + 0.0f;
}
__device__ __forceinline__ unsigned fkey(float s) { const unsigned u = __float_as_uint(s); return (u & 0x80000000u) ? ~u : (u | 0x80000000u); }
__device__ __forceinline__ float key_to_float(unsigned k) { return k == 0u ? -INFINITY : __uint_as_float((k & 0x80000000u) ? (k & 0x7fffffffu) : ~k); }
__device__ __forceinline__ void idx_scores8(const unsigned char* kt, int c16, int g, const bf16x8 (&af)[2], const f32x4& wv, float (&u)[8]) {
    bf16x8 kf[8][2];
#pragma unroll
    for (int grp = 0; grp < 8; ++grp) { kf[grp][0] = *(const bf16x8*)(kt + (16 * grp + c16) * 144 + (8 * g) * 2); kf[grp][1] = *(const bf16x8*)(kt + (16 * grp + c16) * 144 + (32 + 8 * g) * 2); }
    __builtin_amdgcn_sched_barrier(0);
    f32x4 acc[8];
#pragma unroll
    for (int grp = 0; grp < 8; ++grp) acc[grp] = __builtin_amdgcn_mfma_f32_16x16x32_bf16(af[0], kf[grp][0], (f32x4){0.f, 0.f, 0.f, 0.f}, 0, 0, 0);
#pragma unroll
    for (int grp = 0; grp < 8; ++grp) acc[grp] = __builtin_amdgcn_mfma_f32_16x16x32_bf16(af[1], kf[grp][1], acc[grp], 0, 0, 0);
    __builtin_amdgcn_sched_barrier(0);
#pragma unroll
    for (int grp = 0; grp < 8; ++grp) u[grp] = idx_score_acc(acc[grp], wv);
}
__device__ __forceinline__ unsigned row_scan_incl(unsigned x) {
    x += (unsigned)__builtin_amdgcn_update_dpp(0, (int)x, 0x111, 0xF, 0xF, true);
    x += (unsigned)__builtin_amdgcn_update_dpp(0, (int)x, 0x112, 0xF, 0xF, true);
    x += (unsigned)__builtin_amdgcn_update_dpp(0, (int)x, 0x114, 0xF, 0xF, true);
    x += (unsigned)__builtin_amdgcn_update_dpp(0, (int)x, 0x118, 0xF, 0xF, true);
    return x;
}
__device__ __forceinline__ unsigned wave_total(unsigned x) {
    x = row_scan_incl(x);
    return (unsigned)__builtin_amdgcn_readlane((int)x, 15) + (unsigned)__builtin_amdgcn_readlane((int)x, 31) + (unsigned)__builtin_amdgcn_readlane((int)x, 47) + (unsigned)__builtin_amdgcn_readlane((int)x, 63);
}
__device__ __forceinline__ unsigned wave_max_u(unsigned x) {
    unsigned y;
    y = (unsigned)__builtin_amdgcn_update_dpp(0, (int)x, 0x111, 0xF, 0xF, true); x = x > y ? x : y;
    y = (unsigned)__builtin_amdgcn_update_dpp(0, (int)x, 0x112, 0xF, 0xF, true); x = x > y ? x : y;
    y = (unsigned)__builtin_amdgcn_update_dpp(0, (int)x, 0x114, 0xF, 0xF, true); x = x > y ? x : y;
    y = (unsigned)__builtin_amdgcn_update_dpp(0, (int)x, 0x118, 0xF, 0xF, true); x = x > y ? x : y;
    const unsigned a = (unsigned)__builtin_amdgcn_readlane((int)x, 15), b = (unsigned)__builtin_amdgcn_readlane((int)x, 31), c = (unsigned)__builtin_amdgcn_readlane((int)x, 47), d = (unsigned)__builtin_amdgcn_readlane((int)x, 63);
    const unsigned ab = a > b ? a : b, cd = c > d ? c : d; return ab > cd ? ab : cd;
}
template <bool EDGE, bool NEEDZ>
__device__ __forceinline__ void selB_groups(const float (&sc)[8], int keybase, int myt, float tauf, unsigned need, int lane, int c16, int g, unsigned& cnt, unsigned& zc, unsigned* curow, unsigned char* chrow, unsigned short* zlrow) {
    unsigned hm = 0u;
#pragma unroll
    for (int grp = 0; grp < 8; ++grp) {
        const float s = sc[grp];
        bool h = NEEDZ ? ((s >= tauf) && (s != 0.0f)) : (s >= tauf);
        if (EDGE) h = h && (keybase + 16 * grp + c16 <= myt);
        hm |= h ? (1u << grp) : 0u;
    }
    const unsigned nh = (unsigned)__popc(hm), inc = row_scan_incl(nh);
    unsigned pos = cnt + inc - nh;
    cnt += shu(inc, (lane & 48) | 15);
    unsigned rem = hm;
    while (__ballot(rem != 0u)) {
        if (rem) {
            const int grp = __builtin_ctz(rem); rem &= rem - 1u;
            const float a0 = (grp & 1) ? sc[1] : sc[0], a1 = (grp & 1) ? sc[3] : sc[2], a2 = (grp & 1) ? sc[5] : sc[4], a3 = (grp & 1) ? sc[7] : sc[6];
            const float b0 = (grp & 2) ? a1 : a0, b1 = (grp & 2) ? a3 : a2, s = (grp & 4) ? b1 : b0;
            const int key = keybase + 16 * grp + c16;
            if (pos < (unsigned)DS_CAP) { curow[pos] = (fkey(s) & 0xfffffc00u) | ((unsigned)key & 1023u); chrow[pos] = (unsigned char)(key >> 10); }
            ++pos;
        }
    }
    if (NEEDZ) {
        const unsigned lowm = (1u << c16) - 1u;
#pragma unroll
        for (int grp = 0; grp < 8; ++grp) {
            const int key = keybase + 16 * grp + c16;
            bool isz = sc[grp] == 0.0f;
            if (EDGE) isz = isz && (key <= myt);
            const unsigned zmask = (unsigned)(__ballot(isz) >> (16 * g)) & 0xffffu;
            const unsigned zpos = zc + __popc(zmask & lowm);
            if (isz && zpos < need) zlrow[zpos] = (unsigned short)key;
            zc += __popc(zmask);
        }
    }
}
__device__ __forceinline__ void dsa_select_item(const Args& a, unsigned char* lds, int b, int qb32, int wid_s) {
    const int tid = ftid(wid_s), lane = tid & 63; const int wid = __builtin_amdgcn_readfirstlane(tid >> 6);
    const int c16 = lane & 15, g = lane >> 4;
    const bf16_t* Z = (const bf16_t*)(a.ws + WS_Z); const float* SM = (const float*)(a.ws + WS_SMALL);
    unsigned short* IDX = (unsigned short*)(a.ws + WS_MG);
    unsigned short* samp = (unsigned short*)lds;
    unsigned char* ktA = lds + 131072;
    unsigned* cu = (unsigned*)lds;
    unsigned char* ch = lds + 73728;
    unsigned short* zl = (unsigned short*)(lds + 92160);
    unsigned char* ktB = lds + 108544;
    unsigned* flag = (unsigned*)(lds + 149760);
    const size_t rowbase = (size_t)b * SEQ;
    const int t0 = qb32 * 32, myt = t0 + 4 * wid + g, myrow = 4 * wid + g;
    bf16x8 af[2];
    { const int qq = c16 >> 2, h = c16 & 3; const bf16_t* qp = Z + (rowbase + t0 + 4 * wid + qq) * ZW + ZC_DQI + h * 64 + 8 * g;
      af[0] = *(const bf16x8*)qp; af[1] = *(const bf16x8*)(qp + 32); }
#ifdef PROBE_QTRUNC
    { u32x4 t0_ = __builtin_bit_cast(u32x4, af[0]), t1_ = __builtin_bit_cast(u32x4, af[1]); const unsigned mk = 0xfffcfffcu;
      t0_.x &= mk; t0_.y &= mk; t0_.z &= mk; t0_.w &= mk; t1_.x &= mk; t1_.y &= mk; t1_.z &= mk; t1_.w &= mk; af[0] = __builtin_bit_cast(bf16x8, t0_); af[1] = __builtin_bit_cast(bf16x8, t1_); }
#endif
    const f32x4 wv = *(const f32x4*)(SM + (rowbase + myt) * 8);
    const unsigned need = (unsigned)((myt + 1) < 256 ? (myt + 1) : 256);
    const int srow = tid >> 3, sch = tid & 7;
    __syncthreads();
    if (tid == 0) *flag = 0u;
    unsigned tau = 0u;
    for (int repA_ = 0; repA_ < ((SELREP & 1) ? 2 : 1); ++repA_)
    if (t0 + 32 > DS_CAP) {
        __syncthreads();
        const int ms = (t0 + 32) >> 2, ntA = (ms + 127) >> 7;
        const bf16_t* sbase = Z + (rowbase + 3) * ZW + ZC_DKI + sch * 8;
        u32x4 n0, n1;
        { const int i0 = srow < ms ? srow : ms - 1, i1 = 64 + srow < ms ? 64 + srow : ms - 1;
          n0 = *(const u32x4*)(sbase + (size_t)(4 * i0) * ZW); n1 = *(const u32x4*)(sbase + (size_t)(4 * i1) * ZW); }
        for (int T = 0; T < ntA; ++T) {
            __syncthreads();
            *(u32x4*)(ktA + srow * 144 + sch * 16) = n0; *(u32x4*)(ktA + (64 + srow) * 144 + sch * 16) = n1;
            __syncthreads();
            if (T + 1 < ntA) { const int j0 = 128 * (T + 1) + srow, j1 = j0 + 64; const int i0 = j0 < ms ? j0 : ms - 1, i1 = j1 < ms ? j1 : ms - 1;
                n0 = *(const u32x4*)(sbase + (size_t)(4 * i0) * ZW); n1 = *(const u32x4*)(sbase + (size_t)(4 * i1) * ZW); }
            float ua[8]; idx_scores8(ktA, c16, g, af, wv, ua);
#pragma unroll
            for (int grp = 0; grp < 8; ++grp) {
                const int i = 128 * T + 16 * grp + c16;
                samp[myrow * 2048 + i] = ((i < ms) && (4 * i + 3 <= myt)) ? (unsigned short)(fkey(ua[grp]) >> 16) : (unsigned short)0;
            }
        }
        LDSWAIT();
        const int nvalid = 128 * ntA;
        for (int repS_ = 0; repS_ < ((SELREP & 16) ? 2 : 1); ++repS_) {
            unsigned w[4][16];
#pragma unroll
            for (int qq = 0; qq < 4; ++qq) {
                const unsigned* sp = (const unsigned*)(samp + (4 * wid + qq) * 2048) + 16 * lane;
#pragma unroll
                for (int j = 0; j < 16; j += 4) { const u32x4 t4 = *(const u32x4*)(sp + j); w[qq][j] = t4.x; w[qq][j + 1] = t4.y; w[qq][j + 2] = t4.z; w[qq][j + 3] = t4.w; }
#pragma unroll
                for (int j = 0; j < 16; ++j) if (32 * lane + 2 * j >= nvalid) w[qq][j] = 0u;
            }
            unsigned T4[4] = {0u, 0u, 0u, 0u};
#pragma unroll 1
            for (int bit = 15; bit >= 0; --bit) {
                unsigned c[4];
#pragma unroll
                for (int qq = 0; qq < 4; ++qq) { const unsigned cand = T4[qq] | (1u << bit); unsigned cc = 0;
#pragma unroll
                    for (int j = 0; j < 16; ++j) cc += ((w[qq][j] & 0xffffu) >= cand ? 1u : 0u) + ((w[qq][j] >> 16) >= cand ? 1u : 0u);
                    c[qq] = cc; }
                const unsigned t01 = wave_total(c[0] | (c[1] << 16)), t23 = wave_total(c[2] | (c[3] << 16));
                if ((t01 & 0xffffu) >= (unsigned)DS_RANK) T4[0] |= 1u << bit;
                if ((t01 >> 16) >= (unsigned)DS_RANK) T4[1] |= 1u << bit;
                if ((t23 & 0xffffu) >= (unsigned)DS_RANK) T4[2] |= 1u << bit;
                if ((t23 >> 16) >= (unsigned)DS_RANK) T4[3] |= 1u << bit;
            }
#pragma unroll
            for (int qq = 0; qq < 4; ++qq) { const int n = t0 + 4 * wid + qq + 1; if (g == qq) tau = n > DS_CAP ? (T4[qq] << 16) : 0u; }
        }
    }
    unsigned cnt = 0u, zc = 0u;
    const float tauf = key_to_float(tau);
    const bool needz = __ballot(tauf <= 0.0f) != 0ull;
    const int ntile = (t0 + 32 + 127) >> 7;
    for (int repB_ = 0; repB_ < ((SELREP & 2) ? 2 : 1); ++repB_) { cnt = 0u; zc = 0u;
        const bf16_t* kbase = Z + (rowbase + srow) * ZW + ZC_DKI + sch * 8;
        u32x4 n0 = *(const u32x4*)kbase, n1 = *(const u32x4*)(kbase + (size_t)64 * ZW);
        __syncthreads();
        *(u32x4*)(ktB + srow * 144 + sch * 16) = n0; *(u32x4*)(ktB + (64 + srow) * 144 + sch * 16) = n1;
        __syncthreads();
        for (int T = 0; T < ntile; ++T) {
            const unsigned char* kt = ktB + (T & 1) * 18432;
            if (T + 1 < ntile) { const bf16_t* src = kbase + (size_t)(128 * (T + 1)) * ZW; n0 = *(const u32x4*)src; n1 = *(const u32x4*)(src + (size_t)64 * ZW); }
            float ub[8]; idx_scores8(kt, c16, g, af, wv, ub);
            if (128 * T + 127 <= t0) { if (needz) selB_groups<false, true>(ub, 128 * T, myt, tauf, need, lane, c16, g, cnt, zc, cu + myrow * DS_CAP, ch + myrow * DS_CAP, zl + myrow * 256);
                                       else selB_groups<false, false>(ub, 128 * T, myt, tauf, need, lane, c16, g, cnt, zc, cu + myrow * DS_CAP, ch + myrow * DS_CAP, zl + myrow * 256); }
            else { if (needz) selB_groups<true, true>(ub, 128 * T, myt, tauf, need, lane, c16, g, cnt, zc, cu + myrow * DS_CAP, ch + myrow * DS_CAP, zl + myrow * 256);
                   else selB_groups<true, false>(ub, 128 * T, myt, tauf, need, lane, c16, g, cnt, zc, cu + myrow * DS_CAP, ch + myrow * DS_CAP, zl + myrow * 256); }
            if (T + 1 < ntile) { unsigned char* kn = ktB + ((T + 1) & 1) * 18432; *(u32x4*)(kn + srow * 144 + sch * 16) = n0; *(u32x4*)(kn + (64 + srow) * 144 + sch * 16) = n1; }
            __syncthreads();
        }
    }
#if SELREP & 8
    {
        float dummy = 0.f;
        const bf16_t* kbase = Z + (rowbase + srow) * ZW + ZC_DKI + sch * 8;
        u32x4 n0 = *(const u32x4*)kbase, n1 = *(const u32x4*)(kbase + (size_t)64 * ZW);
        __syncthreads();
        *(u32x4*)(ktB + srow * 144 + sch * 16) = n0; *(u32x4*)(ktB + (64 + srow) * 144 + sch * 16) = n1;
        __syncthreads();
        for (int T = 0; T < ntile; ++T) {
            const unsigned char* kt = ktB + (T & 1) * 18432;
            if (T + 1 < ntile) { const bf16_t* src = kbase + (size_t)(128 * (T + 1)) * ZW; n0 = *(const u32x4*)src; n1 = *(const u32x4*)(src + (size_t)64 * ZW); }
            float ub[8]; idx_scores8(kt, c16, g, af, wv, ub);
#pragma unroll
            for (int grp = 0; grp < 8; ++grp) dummy += ub[grp];
            if (T + 1 < ntile) { unsigned char* kn = ktB + ((T + 1) & 1) * 18432; *(u32x4*)(kn + srow * 144 + sch * 16) = n0; *(u32x4*)(kn + (64 + srow) * 144 + sch * 16) = n1; }
            __syncthreads();
        }
        if (dummy == 123456.789f) *flag = 2u;
    }
#endif
    LDSWAIT();
    bool bad = false;
    for (int repC_ = 0; repC_ < ((SELREP & 4) ? 2 : 1); ++repC_) {
        unsigned ncq[4], ndq[4], nzq[4], uj[4][9], T4[4]; int topb[4];
#pragma unroll
        for (int qq = 0; qq < 4; ++qq) {
            ncq[qq] = (unsigned)__builtin_amdgcn_readlane((int)cnt, 16 * qq); ndq[qq] = (unsigned)__builtin_amdgcn_readlane((int)need, 16 * qq); nzq[qq] = (unsigned)__builtin_amdgcn_readlane((int)zc, 16 * qq);
            const unsigned ncl = ncq[qq] < (unsigned)DS_CAP ? ncq[qq] : (unsigned)DS_CAP;
            unsigned hi = 0u, lo = 0u;
#pragma unroll
            for (int j = 0; j < 9; ++j) { const unsigned pos = lane + 64 * j; const bool in = pos < ncl; uj[qq][j] = in ? (cu[(4 * wid + qq) * DS_CAP + pos] >> 10) : 0u;
                hi = hi > uj[qq][j] ? hi : uj[qq][j]; const unsigned x = in ? ~uj[qq][j] : 0u; lo = lo > x ? lo : x; }
            hi = wave_max_u(hi); lo = ~wave_max_u(lo);
            if (ncl == 0u) lo = hi;
            if (nzq[qq]) { hi = hi > ZCLASS ? hi : ZCLASS; lo = lo < ZCLASS ? lo : ZCLASS; }
            topb[qq] = (hi ^ lo) ? 31 - __builtin_clz(hi ^ lo) : -1;
            T4[qq] = topb[qq] >= 0 ? (hi & ~((2u << topb[qq]) - 1u)) : hi;
        }
#pragma unroll 1
        for (int bit = 21; bit >= 0; --bit) {
            unsigned c[4];
#pragma unroll
            for (int qq = 0; qq < 4; ++qq) { const unsigned cand = T4[qq] | (1u << bit); unsigned cc = 0;
#pragma unroll
                for (int j = 0; j < 9; ++j) cc += uj[qq][j] >= cand ? 1u : 0u;
                c[qq] = cc; }
            const unsigned t01 = wave_total(c[0] | (c[1] << 16)), t23 = wave_total(c[2] | (c[3] << 16));
            const unsigned tq[4] = {t01 & 0xffffu, t01 >> 16, t23 & 0xffffu, t23 >> 16};
#pragma unroll
            for (int qq = 0; qq < 4; ++qq) { const unsigned cand = T4[qq] | (1u << bit);
                if (bit <= topb[qq] && tq[qq] + (cand <= ZCLASS ? nzq[qq] : 0u) >= ndq[qq]) T4[qq] = cand; }
        }
#pragma unroll 1
        for (int qq = 0; qq < 4; ++qq) {
            const unsigned nc = ncq[qq], nd = ndq[qq], nz = nzq[qq], T = T4[qq];
            if (nc + nz < nd || nc > (unsigned)DS_CAP) { bad = true;
#ifdef NOFALLBACK
                { unsigned short* orow = IDX + (rowbase + t0 + 4 * wid + qq) * 256;
                  for (int j = 0; j < 4; ++j) if ((unsigned)(lane + 64 * j) < nd) orow[lane + 64 * j] = (unsigned short)(lane + 64 * j); }
#endif
                continue; }
            const int row = 4 * wid + qq;
            unsigned ujr[9], kj[9]; int ca = T < ZCLASS ? (int)nz : 0, nt = 0;
#pragma unroll
            for (int j = 0; j < 9; ++j) { const unsigned pos = lane + 64 * j; const unsigned cwj = pos < nc ? cu[row * DS_CAP + pos] : 0u; ujr[j] = cwj >> 10;
                kj[j] = pos < nc ? ((cwj & 1023u) | ((unsigned)ch[row * DS_CAP + pos] << 10)) : 0u;
                ca += __popcll(__ballot(ujr[j] > T)); nt += __popcll(__ballot(ujr[j] == T)); }
            const unsigned quota = nd - (unsigned)ca;
            unsigned Kstar = 0xffffu;
            if (T != ZCLASS && (unsigned)nt > quota) {
                unsigned K = 0u;
#pragma unroll 1
                for (int bit = 12; bit >= 0; --bit) { const unsigned test = K | (1u << bit); int c = 0;
#pragma unroll
                    for (int j = 0; j < 9; ++j) c += __popcll(__ballot(ujr[j] == T && kj[j] < test));
                    if ((unsigned)c < quota) K = test; }
                Kstar = K;
            }
            unsigned outbase = 0u;
            unsigned short* orow = IDX + (rowbase + t0 + row) * 256;
#pragma unroll
            for (int j = 0; j < 9; ++j) {
                const bool s = (ujr[j] > T) || (ujr[j] == T && kj[j] <= Kstar);
                const unsigned long long sb = __ballot(s);
                if (s) orow[outbase + below_me(sb)] = (unsigned short)kj[j];
                outbase += (unsigned)__popcll(sb);
            }
            const unsigned zsel = T < ZCLASS ? nz : (T == ZCLASS ? quota : 0u);
            for (unsigned i = lane; i < zsel; i += 64) orow[outbase + i] = zl[row * 256 + i];
        }
    }
    if (bad && lane == 0) atomicOr(flag, 1u);
    __syncthreads();
    const bool redo = *flag != 0u;
    __syncthreads();
#ifndef NOFALLBACK
    if (redo) dsa_select_slow(a, lds, b, qb32, wid_s);
#endif
}

constexpr int DA_WAVE_LDS = 512 + 64 * 160;
__device__ __forceinline__ void dsa_attend_wave(const Args& a, int gw, int NGW, int lane, unsigned char* wl) {
    const bf16_t* Z = (const bf16_t*)(a.ws + WS_Z); const unsigned short* IDXB = (const unsigned short*)(a.ws + WS_MG);
    bf16_t* Y1 = (bf16_t*)(a.ws + WS_H) + (size_t)MROWS * 256;
    const int c16 = lane & 15, g = lane >> 4, vr = lane >> 3, vc = lane & 7;
    unsigned short* il = (unsigned short*)wl; unsigned char* vl = wl + 512;
    const float slope2 = LOG2E * __builtin_amdgcn_exp2f(-(float)(5 + (c16 & 3)));
    const LAS unsigned char* vtr = (const LAS unsigned char*)vl + (4 * g + (c16 >> 2)) * 160 + (4 * (c16 & 3)) * 2;
    u32x2 iw = {0u, 0u};
    if (gw < MROWS) iw = *(const u32x2*)(IDXB + (size_t)gw * 256 + 4 * lane);
#pragma unroll 1
    for (int row = gw; row < MROWS; row += NGW) {
        const int t = row & (SEQ - 1); const size_t rowbase = (size_t)(row - t);
        const int nsel = (t + 1) < 256 ? (t + 1) : 256;
        { u32x2 w = iw; const int p0 = 4 * lane;
          if (p0 >= nsel) w.x &= 0xffff0000u; if (p0 + 1 >= nsel) w.x &= 0x0000ffffu; if (p0 + 2 >= nsel) w.y &= 0xffff0000u; if (p0 + 3 >= nsel) w.y &= 0x0000ffffu;
          *(u32x2*)(il + 4 * lane) = w; }
        if (row + NGW < MROWS) iw = *(const u32x2*)(IDXB + (size_t)(row + NGW) * 256 + 4 * lane);
        LDSWAIT();
        u32x4 v[8];
        const bf16_t* vb = Z + rowbase * ZW + ZC_DV + 8 * vc;
        const bf16_t* kb8 = Z + rowbase * ZW + ZC_DK + 8 * vc;
#pragma unroll
        for (int i = 0; i < 8; ++i) v[i] = *(const u32x4*)(kb8 + (size_t)il[8 * i + vr] * ZW);
        bf16x8 qf[2];
        { const bf16_t* qp = Z + (size_t)row * ZW + ZC_DQ + (c16 & 3) * 64 + 8 * g; const bf16x8 z8 = {0, 0, 0, 0, 0, 0, 0, 0};
          qf[0] = c16 < 4 ? *(const bf16x8*)qp : z8; qf[1] = c16 < 4 ? *(const bf16x8*)(qp + 32) : z8; }
        f32x4 s[16];
#pragma unroll
        for (int ch = 0; ch < 4; ++ch) {
            if (64 * ch < nsel) {
#pragma unroll
                for (int i = 0; i < 8; ++i) *(u32x4*)(vl + (8 * i + vr) * 144 + 16 * vc) = v[i];
                if (ch < 3 && 64 * (ch + 1) < nsel) {
#pragma unroll
                    for (int i = 0; i < 8; ++i) v[i] = *(const u32x4*)(kb8 + (size_t)il[64 * (ch + 1) + 8 * i + vr] * ZW);
                } else {
#pragma unroll
                    for (int i = 0; i < 8; ++i) v[i] = *(const u32x4*)(vb + (size_t)il[8 * i + vr] * ZW);
                }
                LDSWAIT();
#pragma unroll
                for (int tt = 0; tt < 4; ++tt) {
                    const bf16x8 k0 = *(const bf16x8*)(vl + (16 * tt + c16) * 144 + (8 * g) * 2), k1 = *(const bf16x8*)(vl + (16 * tt + c16) * 144 + (32 + 8 * g) * 2);
                    f32x4 acc = {0.f, 0.f, 0.f, 0.f};
                    acc = __builtin_amdgcn_mfma_f32_16x16x32_bf16(k0, qf[0], acc, 0, 0, 0);
                    acc = __builtin_amdgcn_mfma_f32_16x16x32_bf16(k1, qf[1], acc, 0, 0, 0);
                    s[4 * ch + tt] = acc; }
                asm volatile("" ::: "memory");
            } else {
#pragma unroll
                for (int tt = 0; tt < 4; ++tt) s[4 * ch + tt] = (f32x4){0.f, 0.f, 0.f, 0.f};
            }
        }
        float mx = -INFINITY;
#pragma unroll
        for (int kb = 0; kb < 16; ++kb) {
            const u32x2 kw = *(const u32x2*)(il + 16 * kb + 4 * g); const int p0 = 16 * kb + 4 * g;
            const int k0 = kw.x & 0xffff, k1 = kw.x >> 16, k2 = kw.y & 0xffff, k3 = kw.y >> 16;
            s[kb][0] = p0 < nsel ? s[kb][0] * C2 - slope2 * (float)(t - k0) : -INFINITY;
            s[kb][1] = p0 + 1 < nsel ? s[kb][1] * C2 - slope2 * (float)(t - k1) : -INFINITY;
            s[kb][2] = p0 + 2 < nsel ? s[kb][2] * C2 - slope2 * (float)(t - k2) : -INFINITY;
            s[kb][3] = p0 + 3 < nsel ? s[kb][3] * C2 - slope2 * (float)(t - k3) : -INFINITY;
            mx = fmaxf(fmaxf(mx, fmaxf(s[kb][0], s[kb][1])), fmaxf(s[kb][2], s[kb][3]));
        }
        mx = fmaxf(mx, shf(mx, lane ^ 16)); mx = fmaxf(mx, shf(mx, lane ^ 32));
        float ls = 0.f;
#pragma unroll
        for (int kb = 0; kb < 16; ++kb) {
#pragma unroll
            for (int r = 0; r < 4; ++r) { s[kb][r] = __builtin_amdgcn_exp2f(s[kb][r] - mx); ls += s[kb][r]; } }
        ls += shf(ls, lane ^ 16); ls += shf(ls, lane ^ 32);
        f32x4 o[4];
#pragma unroll
        for (int db = 0; db < 4; ++db) o[db] = (f32x4){0.f, 0.f, 0.f, 0.f};
#pragma unroll
        for (int ch = 0; ch < 4; ++ch) {
            if (64 * ch < nsel) {
#pragma unroll
                for (int i = 0; i < 8; ++i) *(u32x4*)(vl + (8 * i + vr) * 160 + 16 * vc) = v[i];
                if (ch < 3 && 64 * (ch + 1) < nsel) {
#pragma unroll
                    for (int i = 0; i < 8; ++i) v[i] = *(const u32x4*)(vb + (size_t)il[64 * (ch + 1) + 8 * i + vr] * ZW);
                }
                LDSWAIT();
#pragma unroll
                for (int s2 = 0; s2 < 2; ++s2) {
                    const f32x4 pa4 = s[4 * ch + 2 * s2], pb4 = s[4 * ch + 2 * s2 + 1];
                    u32x4 pw; pw.x = pk2(pa4[0], pa4[1]); pw.y = pk2(pa4[2], pa4[3]); pw.z = pk2(pb4[0], pb4[1]); pw.w = pk2(pb4[2], pb4[3]);
                    const bf16x8 pa = __builtin_bit_cast(bf16x8, pw);
#pragma unroll
                    for (int db = 0; db < 4; ++db) {
                        const LAS unsigned char* vp = vtr + (32 * s2) * 160 + 32 * db;
                        const s16x4 lo = __builtin_bit_cast(s16x4, __builtin_amdgcn_ds_read_tr16_b64_v4i16((LAS s16x4*)vp));
                        const s16x4 hv = __builtin_bit_cast(s16x4, __builtin_amdgcn_ds_read_tr16_b64_v4i16((LAS s16x4*)(vp + 16 * 160)));
                        const bf16x8 vf = (bf16x8){lo[0], lo[1], lo[2], lo[3], hv[0], hv[1], hv[2], hv[3]};
                        o[db] = __builtin_amdgcn_mfma_f32_16x16x32_bf16(pa, vf, o[db], 0, 0, 0);
                    }
                }
                asm volatile("" ::: "memory");
            }
        }
        const int lsi = __float_as_int(ls);
        const float i0 = 1.0f / __int_as_float(__builtin_amdgcn_readlane(lsi, 0)), i1 = 1.0f / __int_as_float(__builtin_amdgcn_readlane(lsi, 1)), i2 = 1.0f / __int_as_float(__builtin_amdgcn_readlane(lsi, 2)), i3 = 1.0f / __int_as_float(__builtin_amdgcn_readlane(lsi, 3));
        if (g == 0) { bf16_t* yp = Y1 + (size_t)row * 256 + c16;
#pragma unroll
            for (int db = 0; db < 4; ++db) { yp[0 * 64 + 16 * db] = (bf16_t)f2bf(o[db][0] * i0); yp[1 * 64 + 16 * db] = (bf16_t)f2bf(o[db][1] * i1); yp[2 * 64 + 16 * db] = (bf16_t)f2bf(o[db][2] * i2); yp[3 * 64 + 16 * db] = (bf16_t)f2bf(o[db][3] * i3); } }
        LDSWAIT();
    }
}


#ifndef PHMASK
#define PHMASK 0xffff
#endif
#ifndef DUPMASK
#define DUPMASK 0
#endif
#ifndef DUPN
#define DUPN 2
#endif
#ifndef MERGE_SP2
#define MERGE_SP2 true
#endif
#ifndef G8_SP2
#define G8_SP2 false
#endif
#ifndef EXTRASYNC
#define EXTRASYNC 0
#endif
typedef __attribute__((address_space(1))) unsigned gu32;
#define XB_TMO      128
#define XB_XCNT(j)  (256  + 64 * (j))
#define XB_XSUB(j)  (1280 + 64 * (j))
#define XB_XGEN(j)  (2304 + 64 * (j))
#define XB_TOP      3328
#define XB_TOPGEN   3392
#define XCD_BAR_WORDS 3456
#define XB_SPIN_CAP (1u << 18)

__device__ __forceinline__ unsigned xb_ld(unsigned* p)              { return __hip_atomic_load(p, __ATOMIC_RELAXED, __HIP_MEMORY_SCOPE_AGENT); }
__device__ __forceinline__ unsigned xb_add(unsigned* p, unsigned v) { return __hip_atomic_fetch_add(p, v, __ATOMIC_RELAXED, __HIP_MEMORY_SCOPE_AGENT); }
__device__ __forceinline__ unsigned xb_xcc_id() { return (unsigned)__builtin_amdgcn_s_getreg((3 << 11) | 20) & 0xFu; }
#define XB_SPIN(cond, bar) do { unsigned _sp = 0; while (cond) { __builtin_amdgcn_s_sleep(1); \
    if ((++_sp & 255u) == 0u) { if (xb_ld(&(bar)[XB_TMO])) break; if (_sp > XB_SPIN_CAP) { atomicAdd(&(bar)[XB_TMO], 1u); break; } } } } while (0)

struct XcdBarrier {
    unsigned* bar; unsigned x; int w;
    volatile LAS unsigned* st;
};

__device__ __forceinline__ bool xb_first_lane(int w) { unsigned ones = ~0u; asm volatile("" : "+s"(ones)); return w == 0 && __builtin_amdgcn_mbcnt_hi(ones, __builtin_amdgcn_mbcnt_lo(ones, 0u)) == 0u; }
__device__ __forceinline__ XcdBarrier xcd_barrier_post(unsigned* bar, volatile LAS unsigned* st, int w) {
    XcdBarrier b; b.bar = bar; b.x = xb_xcc_id(); b.st = st; b.w = w;
    if (xb_first_lane(w)) (void)xb_add(&bar[XB_XCNT(b.x)], 1u);
    return b;
}
__device__ __forceinline__ void xcd_barrier_complete(unsigned* bar, unsigned x, unsigned& nloc, unsigned& nx) {
    const unsigned G = gridDim.x * gridDim.y * gridDim.z;
    unsigned sum, cnt, mine, sp = 0u;
    for (;;) {
        sum = 0u; cnt = 0u; mine = 0u;
#pragma unroll
        for (unsigned j = 0; j < 16; ++j) { const unsigned c = xb_ld(&bar[XB_XCNT(j)]); sum += c; cnt += (c > 0u) ? 1u : 0u; mine = (j == x) ? c : mine; }
        if (sum == G) break;
        __builtin_amdgcn_s_sleep(1);
        if ((++sp & 255u) == 0u) { if (xb_ld(&bar[XB_TMO])) break; if (sp > XB_SPIN_CAP) { atomicAdd(&bar[XB_TMO], 1u); break; } }
    }
    nloc = mine > 0u ? mine : 1u; nx = cnt > 0u ? cnt : 1u;
}

__device__ __forceinline__ void xcd_barrier(const XcdBarrier& b) {
    asm volatile("s_waitcnt vmcnt(0)" ::: "memory");
    __syncthreads();
    if (xb_first_lane(b.w)) {
        unsigned* bar = b.bar;
        __builtin_amdgcn_s_waitcnt(0);
        unsigned nloc = b.st[0], nx = b.st[1];
        if (nloc == 0u) { xcd_barrier_complete(bar, b.x, nloc, nx); b.st[0] = nloc; b.st[1] = nx; }
        const unsigned old = xb_add(&bar[XB_XSUB(b.x)], 1u);
        const unsigned gen = old / nloc;
        if (old + 1u == (gen + 1u) * nloc) {
            __builtin_amdgcn_fence(__ATOMIC_RELEASE, "agent");
            asm volatile("s_waitcnt vmcnt(0)" ::: "memory");
            const unsigned og = xb_add(&bar[XB_TOP], 1u);
            const unsigned tg = og / nx;
            if (og + 1u == (tg + 1u) * nx) xb_add(&bar[XB_TOPGEN], 1u);
            else XB_SPIN(xb_ld(&bar[XB_TOPGEN]) == tg, bar);
            __builtin_amdgcn_fence(__ATOMIC_ACQUIRE, "agent");
            xb_add(&bar[XB_XGEN(b.x)], 1u);
            asm volatile("s_waitcnt vmcnt(0)" ::: "memory");
        } else {
            XB_SPIN(xb_ld(&bar[XB_XGEN(b.x)]) == gen, bar);
            __builtin_amdgcn_fence(__ATOMIC_ACQUIRE, "agent");
            asm volatile("s_waitcnt vmcnt(0)" ::: "memory");
        }
    }
    __syncthreads();
}

constexpr size_t WS_BAR = 16384;
constexpr int LDS_BARST = LDS_BYTES - 16;
#define GRID_SYNC() xcd_barrier(bar)
typedef const __attribute__((address_space(4))) Args* kargs_ptr;
__device__ __forceinline__ Args fresh_args() {
#if defined(__HIP_DEVICE_COMPILE__)
    kargs_ptr p = (kargs_ptr)__builtin_amdgcn_kernarg_segment_ptr(); asm volatile("" : "+s"(p)); return *p;
#else
    return Args{};
#endif
}
#define FRESH() const int tid = ftid(wid_s), lane = tid & 63, wid = __builtin_amdgcn_readfirstlane(tid >> 6), gw = blockIdx.x * 8 + wid, NGW = gridDim.x * 8; (void)lane; (void)gw; (void)NGW
#define WSP(T, off) ((T*)(a.ws + (off)))
__global__ void __launch_bounds__(512, 2) mega(Args a_unused) {
    extern __shared__ __attribute__((aligned(16))) unsigned char lds[];
    PG8_LAS unsigned char* lds3 = (PG8_LAS unsigned char*)lds;
    const int wid_s = __builtin_amdgcn_readfirstlane(threadIdx.x >> 6);
    if (threadIdx.x < 4) ((volatile LAS unsigned*)(lds3 + LDS_BARST))[threadIdx.x] = 0u;
    __syncthreads();
    XcdBarrier bar; { const Args a0 = fresh_args(); bar = xcd_barrier_post((unsigned*)(a0.ws + WS_BAR), (volatile LAS unsigned*)(lds3 + LDS_BARST), wid_s); }

#if PHMASK & 1
    for (int rep_ = 0; rep_ < ((DUPMASK & 1) ? DUPN : 1); ++rep_) { if (rep_) GRID_SYNC();
    { const Args a = fresh_args(); if (blockIdx.x == 0 && threadIdx.x < 16) WSP(unsigned, WS_KMAX)[threadIdx.x] = 0u; ada_gemv(a, lds, wid_s); convert_weights(a, 0, lds, wid_s); }
    }
#endif
    GRID_SYNC();
#if PHMASK & 2
    for (int rep_ = 0; rep_ < ((DUPMASK & 2) ? DUPN : 1); ++rep_) { if (rep_) GRID_SYNC();
    { const Args a = fresh_args(); FRESH();
      for (int row = gw * 8; row < MROWS; row += NGW * 8) { const int b = row >> 13; const float* md = WSP(float, WS_MOD) + (size_t)(0 * 2 + b) * NMOD;
        row_pass8<false, true, false, false, true>(a.x + (size_t)row * D, nullptr, nullptr, WSP(bf16_t, WS_H) + (size_t)row * D, WSP(unsigned char, WS_MG) + (size_t)row * D, nullptr, nullptr, a.norm_g + 0 * D, md + 1 * D, md + 0 * D, lane); } }
    }
#endif
    GRID_SYNC();

#pragma unroll 1
    for (int l = 0; l < DEPTH; ++l) {
        for (int es_ = 0; es_ < EXTRASYNC; ++es_) GRID_SYNC();
#if PHMASK & 4
    for (int rep_ = 0; rep_ < ((DUPMASK & 4) ? DUPN : 1); ++rep_) { if (rep_) GRID_SYNC();
        { const Args a = fresh_args(); const int G = gridDim.x, bid = blockIdx.x;
          { pg8::Gemm g{WSP(bf16_t, WS_MG), WSP(bf16_t, WS_WG8), MROWS, 4 * D, D}; pg8::StaticOrder S; S.init(MROWS, 4 * D, G, bid);
            pg8::EpiG E{WSP(unsigned char, WS_G)};
            pg8::gemm_phase<pg8::EpiG, pg8::StaticOrder, true, G8_SP2, true>(lds3, g, S, E, wid_s); }
          { pg8::Gemm g{WSP(bf16_t, WS_H), WSP(bf16_t, WS_W1T), MROWS, 2816, D}; pg8::StaticOrder S; S.init(MROWS, 2816, G, (bid + 64) % G);
            pg8::EpiZ E{WSP(bf16_t, WS_Z), WSP(float, WS_SMALL), WSP(unsigned char, WS_G)};
            pg8::gemm_phase<pg8::EpiZ, pg8::StaticOrder, true, true>(lds3, g, S, E, wid_s); } }
    }
#endif
        GRID_SYNC();
#if PHMASK & 8
    for (int rep_ = 0; rep_ < ((DUPMASK & 8) ? DUPN : 1); ++rep_) { if (rep_) GRID_SYNC();
        { const Args a = fresh_args(); const int G = gridDim.x, bid = blockIdx.x;
          if (bid < 8) fox_scan(a, l, bid, lds, wid_s);
          for (int it = bid - 8; it >= 0 && it < 64; it += G) fox_kmax_item(a, l, it, wid_s);
          conv_phase(a, l, wid_s);
          for (int u = bid; u < 256; u += G) { const int b = u >> 7, head = (u >> 5) & 3, qb = u & 31;
            const float slope2 = LOG2E * __builtin_amdgcn_exp2f(-(float)(1 + head)), sink2 = LOG2E * a.swa_sinks[l * 4 + head];
            const int q0 = qb * 256, tlo = q0 >= 128 ? ((q0 - 127) >> 6) : 0;
            attn_unit<1>(lds, WSP(bf16_t, WS_Z), WSP(bf16_t, WS_H) + (size_t)3 * MROWS * 256, b, head, qb, nullptr, slope2, sink2, tlo, 0.f, wid_s); } }
    }
#endif
        __syncthreads();
#if PHMASK & 16
    for (int rep_ = 0; rep_ < ((DUPMASK & 16) ? DUPN : 1); ++rep_) { if (rep_) GRID_SYNC();
        { const Args a = fresh_args(); const int G = gridDim.x, bid = blockIdx.x;
          for (int u = bid; u < 256; u += G) { const int b = u & 1, j = u >> 1;
            dsa_select_item(a, lds, b, j, wid_s); dsa_select_item(a, lds, b, 255 - j, wid_s); } }
    }
#endif
        GRID_SYNC();
#if PHMASK & 32
    for (int rep_ = 0; rep_ < ((DUPMASK & 32) ? DUPN : 1); ++rep_) { if (rep_) GRID_SYNC();
        { const Args a = fresh_args(); const int G = gridDim.x, bid = blockIdx.x;
          for (int u = bid; u < 256; u += G) { const int b = u >> 7, head = (u >> 5) & 3, qb = u & 31;
            attn_unit<0>(lds, WSP(bf16_t, WS_Z), WSP(bf16_t, WS_H) + (size_t)2 * MROWS * 256, b, head, qb, WSP(const float, WS_FCUM), 0.f, 0.f, 0, sqrtf(__uint_as_float(WSP(const unsigned, WS_KMAX)[l * 8 + b * 4 + head])), wid_s); } }
    }
#endif
#if PHMASK & 64
    for (int rep_ = 0; rep_ < ((DUPMASK & 64) ? DUPN : 1); ++rep_) { if (rep_) GRID_SYNC();
        { const Args a = fresh_args(); FRESH(); __syncthreads(); dsa_attend_wave(a, gw, NGW, lane, lds + wid * DA_WAVE_LDS); __syncthreads(); }
    }
#endif
        GRID_SYNC();
#if PHMASK & 128
    for (int rep_ = 0; rep_ < ((DUPMASK & 128) ? DUPN : 1); ++rep_) { if (rep_) GRID_SYNC();
        { const Args a = fresh_args(); const int G = gridDim.x, bid = blockIdx.x;
          int kmerge = 256; asm volatile("" : "+s"(kmerge));
          pg8::Gemm g{WSP(bf16_t, WS_H), WSP(bf16_t, WS_WBT), 4 * MROWS, 4 * D, kmerge}; pg8::MergeOrder2 S{G, bid};
          pg8::EpiMerge2 E{WSP(bf16_t, WS_MG), WSP(unsigned char, WS_G)}; E.zero();
          pg8::gemm_phase<pg8::EpiMerge2, pg8::MergeOrder2, true, MERGE_SP2, false, true>(lds3, g, S, E, wid_s); }
    }
#endif
        GRID_SYNC();
#if PHMASK & 256
    for (int rep_ = 0; rep_ < ((DUPMASK & 256) ? DUPN : 1); ++rep_) { if (rep_) GRID_SYNC();
        { const Args a = fresh_args(); const int G = gridDim.x, bid = blockIdx.x;
#if WO8
          pg8::Gemm g{WSP(bf16_t, WS_MG), WSP(bf16_t, WS_WOT), MROWS, D, D}; pg8::StaticOrder S; S.init(MROWS, D, G, bid);
          pg8::EpiPlain8 E{WSP(bf16_t, WS_H), D};
          pg8::gemm_phase<pg8::EpiPlain8, pg8::StaticOrder, true, G8_SP2, true>(lds3, g, S, E, wid_s); }
#else
          pg8::Gemm g{WSP(bf16_t, WS_MG), WSP(bf16_t, WS_WOT), MROWS, D, D}; pg8::StaticOrder S; S.init(MROWS, D, G, bid);
          pg8::EpiPlain E{WSP(bf16_t, WS_H), D};
          pg8::gemm_phase<pg8::EpiPlain, pg8::StaticOrder, true, true>(lds3, g, S, E, wid_s); }
#endif
    }
#endif
        GRID_SYNC();
#if PHMASK & 512
    for (int rep_ = 0; rep_ < ((DUPMASK & 512) ? DUPN : 1); ++rep_) { if (rep_) GRID_SYNC();
        { const Args a = fresh_args(); FRESH(); const float* ng = a.norm_g + (size_t)l * 4 * D;
          for (int row = gw * 8; row < MROWS; row += NGW * 8) { const int b = row >> 13; const float* md = WSP(float, WS_MOD) + (size_t)(l * 2 + b) * NMOD;
            bf16_t* x1g = WSP(bf16_t, WS_G) + (size_t)row * D; bf16_t* h2 = FFN8 ? nullptr : WSP(bf16_t, WS_MG) + (size_t)row * D; const bf16_t* rawp = WSP(bf16_t, WS_H) + (size_t)row * D;
            unsigned char* h28 = WSP(unsigned char, WS_G) + 32 * MiB + (size_t)row * D;
            if (l == 0) row_pass8<true, true, false, true, FFN8 != 0>(a.x + (size_t)row * D, rawp, x1g, h2, h28, md + 2 * D, ng + 1 * D, ng + 2 * D, md + 4 * D, md + 3 * D, lane);
            else row_pass8<true, true, true, true, FFN8 != 0>((const bf16_t*)a.out + (size_t)row * D, rawp, x1g, h2, h28, md + 2 * D, ng + 1 * D, ng + 2 * D, md + 4 * D, md + 3 * D, lane); } }
    }
#endif
        GRID_SYNC();
#if PHMASK & 1024
    for (int rep_ = 0; rep_ < ((DUPMASK & 1024) ? DUPN : 1); ++rep_) { if (rep_) GRID_SYNC();
        { const Args a = fresh_args(); const int G = gridDim.x, bid = blockIdx.x;
#if FFN8
          pg8::Gemm g{(const bf16_t*)(a.ws + WS_G + 32 * MiB), WSP(bf16_t, WS_WGU), MROWS, NGU, D}; pg8::StaticOrder S; S.init(MROWS, NGU, G, bid);
          pg8::EpiSwiglu8<DOWN8 != 0> E{WSP(bf16_t, WS_Z)};
          pg8::gemm_phase<pg8::EpiSwiglu8<DOWN8 != 0>, pg8::StaticOrder, true, G8_SP2, true>(lds3, g, S, E, wid_s); }
#else
          pg8::Gemm g{WSP(bf16_t, WS_MG), WSP(bf16_t, WS_WGU), MROWS, NGU, D}; pg8::StaticOrder S; S.init(MROWS, NGU, G, bid);
          pg8::EpiSwiglu E{WSP(bf16_t, WS_Z)};
          pg8::gemm_phase<pg8::EpiSwiglu, pg8::StaticOrder, true, true>(lds3, g, S, E, wid_s); }
#endif
    }
#endif
        GRID_SYNC();
#if PHMASK & 2048
    for (int rep_ = 0; rep_ < ((DUPMASK & 2048) ? DUPN : 1); ++rep_) { if (rep_) GRID_SYNC();
        { const Args a = fresh_args(); const int G = gridDim.x, bid = blockIdx.x;
#if DOWN8
          pg8::Gemm g{WSP(bf16_t, WS_Z), WSP(bf16_t, WS_WDT), MROWS, D, DFF}; pg8::StaticOrder S; S.init(MROWS, D, G, bid);
          pg8::EpiPlain8 E{WSP(bf16_t, WS_H), D};
          pg8::gemm_phase<pg8::EpiPlain8, pg8::StaticOrder, true, G8_SP2, true>(lds3, g, S, E, wid_s); }
#else
          pg8::Gemm g{WSP(bf16_t, WS_Z), WSP(bf16_t, WS_WDT), MROWS, D, DFF}; pg8::StaticOrder S; S.init(MROWS, D, G, bid);
          pg8::EpiPlain E{WSP(bf16_t, WS_H), D};
          pg8::gemm_phase<pg8::EpiPlain, pg8::StaticOrder, true, true>(lds3, g, S, E, wid_s); }
#endif
    }
#endif
        GRID_SYNC();
#if PHMASK & 4096
    for (int rep_ = 0; rep_ < ((DUPMASK & 4096) ? DUPN : 1); ++rep_) { if (rep_) GRID_SYNC();
        { const Args a = fresh_args(); FRESH(); const float* ng = a.norm_g + (size_t)l * 4 * D;
          for (int row = gw * 8; row < MROWS; row += NGW * 8) { const int b = row >> 13; const float* md = WSP(float, WS_MOD) + (size_t)(l * 2 + b) * NMOD;
            const float* mdn = WSP(float, WS_MOD) + (size_t)((l + 1) * 2 + b) * NMOD; const float* ngn = a.norm_g + (size_t)(l + 1) * 4 * D;
            const bf16_t* x1g = WSP(bf16_t, WS_G) + (size_t)row * D; bf16_t* hr = WSP(bf16_t, WS_H) + (size_t)row * D;
            if (l + 1 < DEPTH) row_pass8<true, true, true, true, true>(x1g, hr, (bf16_t*)a.out + (size_t)row * D, hr, WSP(unsigned char, WS_MG) + (size_t)row * D, md + 5 * D, ng + 3 * D, ngn, mdn + 1 * D, mdn + 0 * D, lane);
            else row_pass8<true, false, true, false>(x1g, hr, a.out + (size_t)row * D, nullptr, nullptr, md + 5 * D, ng + 3 * D, nullptr, nullptr, nullptr, lane); }
          if (l + 1 < DEPTH) convert_weights(a, l + 1, lds, wid_s); }
    }
#endif
        if (l + 1 < DEPTH) GRID_SYNC();
    }
}

extern "C" void kernel_launch(void* const* d_in, const int* in_sizes, int n_in, void* d_out, int out_size, void* d_ws, size_t ws_size, hipStream_t stream) {
    static int grid = 0;
    if (grid == 0) {
        if (n_in != 14 || out_size != MROWS * D || ws_size < WS_END) { fprintf(stderr, "kernel_launch: unexpected shapes (n_in %d out %d ws %zu)\n", n_in, out_size, ws_size); grid = -1; return; }
        int dev = 0, cus = 0, per_cu = 0;
        (void)hipGetDevice(&dev);
        (void)hipDeviceGetAttribute(&cus, hipDeviceAttributeMultiprocessorCount, dev);
        (void)hipFuncSetAttribute((const void*)mega, hipFuncAttributeMaxDynamicSharedMemorySize, LDS_BYTES);
        (void)hipOccupancyMaxActiveBlocksPerMultiprocessor(&per_cu, (const void*)mega, 512, LDS_BYTES);
        if (per_cu < 1) { fprintf(stderr, "kernel_launch: occupancy query says 0 blocks per CU\n"); per_cu = 1; }
        grid = cus;
        (void)hipGetLastError();
    }
    if (grid < 0) return;
    if (hipMemsetAsync(d_ws, 0, 65536, stream) != hipSuccess) { fprintf(stderr, "kernel_launch: memset failed\n"); return; }
    Args a{};
    const float** pp = (const float**)&a;
    for (int i = 0; i < 14; ++i) pp[i] = (const float*)d_in[i];
    a.out = (float*)d_out; a.ws = (unsigned char*)d_ws;
    void* args[] = {&a};
    hipError_t e = hipLaunchCooperativeKernel((const void*)mega, dim3(grid), dim3(512), args, LDS_BYTES, stream);
    if (e != hipSuccess) fprintf(stderr, "cooperative launch failed: %s (grid %d)\n", hipGetErrorString(e), grid);
}
```

```cpp
#include <hip/hip_runtime.h>
#include <hip/hip_cooperative_groups.h>
#include <cstdio>
#include <cstdint>
namespace cg = cooperative_groups;
namespace pg8 {
#define PG8_LAS __attribute__((address_space(3)))
typedef unsigned short bf16_t;
typedef short bf16x8 __attribute__((ext_vector_type(8)));
typedef float f32x4 __attribute__((ext_vector_type(4)));
typedef unsigned u32x4 __attribute__((ext_vector_type(4)));
typedef int v4i_t __attribute__((ext_vector_type(4)));
typedef int v8i_t __attribute__((ext_vector_type(8)));
constexpr int BM = 256, BK = 64, HALF = 128, HTB = HALF * BK * 2  , STAGE_BYTES = 8 * HTB, NXCD = 8, WGM = 8;

__host__ __device__ __forceinline__ int lds_byte(int r, int c) { const int st = (r >> 4) * 2 + (c >> 5), rr = r & 15, cc = c & 31, ob = rr * 64 + cc * 2; return st * 1024 + (ob ^ (((ob >> 9) & 1) << 5)); }
__host__ __device__ __forceinline__ void stage_rc(int b, int& R, int& C) { const int st = b / 1024, sb = b % 1024, swz = sb ^ (((sb >> 9) & 1) << 5); R = (st >> 1) * 16 + swz / 64; C = (st & 1) * 32 + (swz % 64) / 2; }
__host__ __device__ __forceinline__ int perm32(int rho) { const int n = rho >> 4, i = rho & 15; return 8 * (i >> 2) + 4 * n + (i & 3); }

struct Unit { int pm, pn; };
struct Gemm { const bf16_t* A; const bf16_t* Bt; int M, N, K; };

struct StaticOrder {
    int nM, nN, nwg, G, c;
    __host__ __device__ void init(int M, int N, int G_, int c_) { nM = M / BM; nN = N / BM; nwg = nM * nN; G = G_; c = c_; }
    __host__ __device__ bool next(int i, Unit& u) const {
        const long L = (long)i * G + c; if (L >= nwg) return false;
        int wgid = (int)L; { const int q = nwg / NXCD, r = nwg % NXCD, xcd = wgid % NXCD, off = wgid / NXCD; wgid = (xcd < r ? xcd * (q + 1) : r * (q + 1) + (xcd - r) * q) + off; }
        const int nig = WGM * nN, gid = wgid / nig, fm = gid * WGM, gsz = (nM - fm) < WGM ? (nM - fm) : WGM;
        u.pm = fm + ((wgid % nig) % gsz); u.pn = (wgid % nig) / gsz; return true;
    }
    __device__ __forceinline__ void a_ready(const Unit&) const {}
    __device__ __forceinline__ void done(const Unit&) const {}
};

__device__ __forceinline__ unsigned cvt_pk_bf16(float lo, float hi) { unsigned r; asm volatile("v_cvt_pk_bf16_f32 %0, %1, %2" : "=v"(r) : "v"(lo), "v"(hi)); return r; }
typedef float f32x2 __attribute__((ext_vector_type(2)));
#ifndef WO8
#define WO8 1
#endif
#ifndef MERGE_FENCE
#define MERGE_FENCE 1
#endif
typedef unsigned u32x2 __attribute__((ext_vector_type(2)));
__device__ __forceinline__ float bf_lo(unsigned w) { return __uint_as_float(w << 16); }
__device__ __forceinline__ float bf_hi(unsigned w) { return __uint_as_float(w & 0xffff0000u); }
#ifdef PROBE_CHEAPSIG
__device__ __forceinline__ float sigmoidf_fast(float x) { return 0.5f + 0.25f * fminf(fmaxf(x, -2.0f), 2.0f); }
#else
__device__ __forceinline__ float sigmoidf_fast(float x) { return __builtin_amdgcn_rcpf(1.0f + __builtin_amdgcn_exp2f(-1.4426950408889634f * x)); }
__device__ __forceinline__ float sig255(float x, float r255) { return __builtin_amdgcn_rcpf(fmaf(__builtin_amdgcn_exp2f(-1.4426950408889634f * x), r255, r255)); }
#endif

struct EpiPlain {
    static constexpr bool PERM = true, AFTER_DRAIN = false;
    static constexpr int WSCALE = 0x7a7a7a7a;
    bf16_t* O; int ldc;
    __device__ __forceinline__ void operator()(const f32x4 (&acc)[2][2][4][2], const Unit& u, int wr, int wc, int fr, int fq) const {
        const int row0 = u.pm * BM + wr * 64 + fr, col0 = u.pn * BM + wc * 32 + 8 * fq;
#pragma unroll
        for (int ai = 0; ai < 2; ++ai)
#pragma unroll
            for (int m = 0; m < 4; ++m) { bf16_t* rowp = O + (size_t)(row0 + ai * HALF + m * 16) * ldc + col0;
#pragma unroll
                for (int bj = 0; bj < 2; ++bj) { const f32x4 v0 = acc[ai][bj][m][0], v1 = acc[ai][bj][m][1];
                    u32x4 w; w.x = cvt_pk_bf16(v0[0], v0[1]); w.y = cvt_pk_bf16(v0[2], v0[3]); w.z = cvt_pk_bf16(v1[0], v1[1]); w.w = cvt_pk_bf16(v1[2], v1[3]);
                    *(u32x4*)(rowp + bj * HALF) = w; } }
    }
};
struct EpiZ {
    static constexpr bool PERM = true, AFTER_DRAIN = false;
    static constexpr int WSCALE = 0x7a7a7a7a;
    bf16_t* Z; float* SM; unsigned char* G;
    __device__ __forceinline__ void operator()(const f32x4 (&acc)[2][2][4][2], const Unit& u, int wr, int wc, int fr, int fq) const {
        const int row0 = u.pm * BM + wr * 64 + fr;
        if (u.pn < 11) {
            const int col0 = u.pn * BM + wc * 32 + 8 * fq;
#pragma unroll
            for (int ai = 0; ai < 2; ++ai)
#pragma unroll
                for (int m = 0; m < 4; ++m) { bf16_t* rowp = Z + (size_t)(row0 + ai * HALF + m * 16) * 2816 + col0;
#pragma unroll
                    for (int bj = 0; bj < 2; ++bj) { const f32x4 v0 = acc[ai][bj][m][0], v1 = acc[ai][bj][m][1];
                        u32x4 w; w.x = cvt_pk_bf16(v0[0], v0[1]); w.y = cvt_pk_bf16(v0[2], v0[3]); w.z = cvt_pk_bf16(v1[0], v1[1]); w.w = cvt_pk_bf16(v1[2], v1[3]);
                        *(u32x4*)(rowp + bj * HALF) = w; } }
            if (u.pn == 10 && wc == 2 && fq == 0) {
#pragma unroll
                for (int ai = 0; ai < 2; ++ai)
#pragma unroll
                    for (int m = 0; m < 4; ++m) { float* sp = SM + (size_t)(row0 + ai * HALF + m * 16) * 8;
                        *(f32x4*)sp = acc[ai][1][m][0]; *(f32x4*)(sp + 4) = acc[ai][1][m][1]; }
            }
        } else {
            const int col0 = (u.pn - 11) * BM + wc * 32 + 8 * fq;
#pragma unroll
            for (int ai = 0; ai < 2; ++ai)
#pragma unroll
                for (int m = 0; m < 4; ++m) { unsigned char* rowp = G + (size_t)(row0 + ai * HALF + m * 16) * 4096 + col0;
#pragma unroll
                    for (int bj = 0; bj < 2; ++bj) { const f32x4 v0 = acc[ai][bj][m][0], v1 = acc[ai][bj][m][1];
                        unsigned b[8];
#pragma unroll
                        for (int k = 0; k < 4; ++k) { b[k] = (unsigned)(sigmoidf_fast(v0[k]) * 255.0f + 0.5f); b[4 + k] = (unsigned)(sigmoidf_fast(v1[k]) * 255.0f + 0.5f); }
                        u32x2 w; w.x = b[0] | (b[1] << 8) | (b[2] << 16) | (b[3] << 24); w.y = b[4] | (b[5] << 8) | (b[6] << 16) | (b[7] << 24);
                        *(u32x2*)(rowp + bj * HALF) = w; } }
        }
    }
};
struct EpiG {
    static constexpr bool PERM = false, AFTER_DRAIN = false;
    static constexpr int WSCALE = 0x7a7a7a7a;
    unsigned char* G;
    __device__ __forceinline__ void operator()(const f32x4 (&acc)[2][2][4][2], const Unit& u, int wr, int wc, int fr, int fq) const {
        unsigned ones_ = ~0u; asm volatile("" : "+s"(ones_)); const unsigned ln_ = __builtin_amdgcn_mbcnt_hi(ones_, __builtin_amdgcn_mbcnt_lo(ones_, 0u)); (void)fr; (void)fq;
        u32x2* gb = (u32x2*)G + (size_t)(u.pm * 16 + u.pn) * (2 * 8 * 4 * 2 * 64) + (unsigned)(wr * 4 + wc) * (4 * 2 * 64) + ln_;
        float r255 = 1.0f / 255.0f; asm volatile("" : "+s"(r255));
#pragma unroll
        for (int ai = 0; ai < 2; ++ai)
#pragma unroll
            for (int m = 0; m < 4; ++m) {
#pragma unroll
                for (int bj = 0; bj < 2; ++bj) { const f32x4 v0 = acc[ai][bj][m][0], v1 = acc[ai][bj][m][1];
                    u32x2 w = {0u, 0u};
#pragma unroll
                    for (int k = 0; k < 4; ++k) { w.x = __builtin_amdgcn_cvt_pk_u8_f32(sig255(v0[k], r255), k, w.x); w.y = __builtin_amdgcn_cvt_pk_u8_f32(sig255(v1[k], r255), k, w.y); }
                    gb[(unsigned)(ai * (8 * 4 * 2 * 64) + m * (2 * 64) + bj * 64)] = w; }
                asm volatile("" ::: "memory"); }
    }
};
struct EpiMerge {
    static constexpr bool PERM = true, AFTER_DRAIN = false;
    static constexpr int WSCALE = 0x7a7a7a7a;
    bf16_t* MG; const unsigned char* G;
    __device__ __forceinline__ void operator()(const f32x4 (&acc)[2][2][4][2], const Unit& u, int wr, int wc, int fr, int fq) const {
        const int n = u.pm >> 6, pm = u.pm & 63, pn = u.pn & 3;
        const unsigned row0 = pm * BM + wr * 64 + fr, col0 = pn * BM + wc * 32 + 8 * fq;
        const unsigned char* gbase = G + n * 1024 + col0; bf16_t* mbase = MG + col0;
#pragma unroll
        for (int ai = 0; ai < 2; ++ai) {
            u32x2 gw[4][2]; u32x4 old[4][2];
#pragma unroll
            for (int m = 0; m < 4; ++m)
#pragma unroll
                for (int bj = 0; bj < 2; ++bj) { const unsigned row = row0 + ai * HALF + m * 16;
                    gw[m][bj] = *(const u32x2*)(gbase + row * 4096u + bj * HALF);
                    if (n > 0) old[m][bj] = *(const u32x4*)(mbase + row * 1024u + bj * HALF); }
#pragma unroll
            for (int m = 0; m < 4; ++m)
#pragma unroll
                for (int bj = 0; bj < 2; ++bj) { const unsigned row = row0 + ai * HALF + m * 16;
                    const f32x4 v0 = acc[ai][bj][m][0], v1 = acc[ai][bj][m][1];
                    float r[8];
#pragma unroll
                    for (int k = 0; k < 4; ++k) { r[k] = v0[k] * ((float)((gw[m][bj].x >> (8 * k)) & 255u) * (1.0f / 255.0f)); r[4 + k] = v1[k] * ((float)((gw[m][bj].y >> (8 * k)) & 255u) * (1.0f / 255.0f)); }
                    if (n > 0) { const u32x4 o = old[m][bj];
                        r[0] += bf_lo(o.x); r[1] += bf_hi(o.x); r[2] += bf_lo(o.y); r[3] += bf_hi(o.y); r[4] += bf_lo(o.z); r[5] += bf_hi(o.z); r[6] += bf_lo(o.w); r[7] += bf_hi(o.w); }
                    u32x4 w; w.x = cvt_pk_bf16(r[0], r[1]); w.y = cvt_pk_bf16(r[2], r[3]); w.z = cvt_pk_bf16(r[4], r[5]); w.w = cvt_pk_bf16(r[6], r[7]);
                    *(u32x4*)(mbase + row * 1024u + bj * HALF) = w; }
            asm volatile("" ::: "memory");
        }
    }
};
struct EpiSwiglu {
    static constexpr bool PERM = true, AFTER_DRAIN = false;
    static constexpr int WSCALE = 0x7a7a7a7a;
    bf16_t* Hd;
    __device__ __forceinline__ void operator()(const f32x4 (&acc)[2][2][4][2], const Unit& u, int wr, int wc, int fr, int fq) const {
        const int row0 = u.pm * BM + wr * 64 + fr, j0 = u.pn * 128 + wc * 16 + 4 * fq;
#pragma unroll
        for (int ai = 0; ai < 2; ++ai)
#pragma unroll
            for (int m = 0; m < 4; ++m) { bf16_t* rowp = Hd + (size_t)(row0 + ai * HALF + m * 16) * 2816 + j0;
#pragma unroll
                for (int bj = 0; bj < 2; ++bj) { const f32x4 v0 = acc[ai][bj][m][0], v1 = acc[ai][bj][m][1];
                    const float h0 = v0[0] * sigmoidf_fast(v0[0]) * v0[1], h1 = v0[2] * sigmoidf_fast(v0[2]) * v0[3];
                    const float h2 = v1[0] * sigmoidf_fast(v1[0]) * v1[1], h3 = v1[2] * sigmoidf_fast(v1[2]) * v1[3];
                    u32x2 w; w.x = cvt_pk_bf16(h0, h1); w.y = cvt_pk_bf16(h2, h3);
                    *(u32x2*)(rowp + bj * 64) = w; } }
    }
};
template <bool H8> struct EpiSwiglu8 {
    static constexpr bool PERM = false, AFTER_DRAIN = false;
    static constexpr int WSCALE = 0x7a7a7a7a;
    bf16_t* Hd;
    __device__ __forceinline__ void operator()(const f32x4 (&acc)[2][2][4][2], const Unit& u, int wr, int wc, int fr, int fq) const {
        unsigned ones_ = ~0u; asm volatile("" : "+s"(ones_)); const int ln_ = (int)__builtin_amdgcn_mbcnt_hi(ones_, __builtin_amdgcn_mbcnt_lo(ones_, 0u)); const int fr_ = ln_ & 15, fq_ = ln_ >> 4; (void)fr; (void)fq;
        const unsigned row0 = u.pm * BM + wr * 64 + fr_, j0 = u.pn * 128 + wc * 32 + 8 * fq_;
        bf16_t* hb = Hd + j0; unsigned char* h8b = (unsigned char*)Hd + j0;
#pragma unroll
        for (int ai = 0; ai < 2; ++ai)
#pragma unroll
            for (int m = 0; m < 4; ++m) { const unsigned ro = (row0 + ai * HALF + m * 16) * 2816u;
                float h[8];
#pragma unroll
                for (int bj = 0; bj < 2; ++bj) { const f32x4 v0 = acc[ai][bj][m][0], v1 = acc[ai][bj][m][1];
                    h[4 * bj + 0] = v0[0] * sigmoidf_fast(v0[0]) * v0[1]; h[4 * bj + 1] = v0[2] * sigmoidf_fast(v0[2]) * v0[3];
                    h[4 * bj + 2] = v1[0] * sigmoidf_fast(v1[0]) * v1[1]; h[4 * bj + 3] = v1[2] * sigmoidf_fast(v1[2]) * v1[3]; }
                if (H8) { u32x2 w8; w8.x = __builtin_amdgcn_cvt_pk_fp8_f32(h[2], h[3], __builtin_amdgcn_cvt_pk_fp8_f32(h[0], h[1], 0u, false), true);
                    w8.y = __builtin_amdgcn_cvt_pk_fp8_f32(h[6], h[7], __builtin_amdgcn_cvt_pk_fp8_f32(h[4], h[5], 0u, false), true);
                    *(u32x2*)(h8b + ro) = w8; }
                else { u32x4 w; w.x = cvt_pk_bf16(h[0], h[1]); w.y = cvt_pk_bf16(h[2], h[3]); w.z = cvt_pk_bf16(h[4], h[5]); w.w = cvt_pk_bf16(h[6], h[7]); *(u32x4*)(hb + ro) = w; }
                asm volatile("" ::: "memory"); }
    }
};
struct EpiPlain8 {
    static constexpr bool PERM = false, AFTER_DRAIN = false;
    static constexpr int WSCALE = 0x7f7f7f7f;
    bf16_t* O; int ldc;
    __device__ __forceinline__ void operator()(const f32x4 (&acc)[2][2][4][2], const Unit& u, int wr, int wc, int fr, int fq) const {
        unsigned ones_ = ~0u; asm volatile("" : "+s"(ones_)); const int ln_ = (int)__builtin_amdgcn_mbcnt_hi(ones_, __builtin_amdgcn_mbcnt_lo(ones_, 0u)); const int fr_ = ln_ & 15, fq_ = ln_ >> 4; (void)fr; (void)fq;
        const unsigned row0 = u.pm * BM + wr * 64 + fr_, col0 = u.pn * BM + wc * 32 + 8 * fq_;
        bf16_t* ob = O + col0;
#pragma unroll
        for (int ai = 0; ai < 2; ++ai)
#pragma unroll
            for (int m = 0; m < 4; ++m) { const unsigned ro = (row0 + ai * HALF + m * 16) * (unsigned)ldc;
#pragma unroll
                for (int bj = 0; bj < 2; ++bj) { const f32x4 v0 = acc[ai][bj][m][0], v1 = acc[ai][bj][m][1];
                    u32x4 w; w.x = cvt_pk_bf16(v0[0], v0[1]); w.y = cvt_pk_bf16(v0[2], v0[3]); w.z = cvt_pk_bf16(v1[0], v1[1]); w.w = cvt_pk_bf16(v1[2], v1[3]);
                    *(u32x4*)(ob + ro + bj * HALF) = w; }
                asm volatile("" ::: "memory"); }
    }
};
struct MergeOrder {
    int G, c;
    __device__ __forceinline__ bool next(int i, Unit& u) const {
        const int t = (i >> 2) * G + c; if (t >= 256) return false;
        const int n = i & 3, pm = t >> 2, pn = t & 3;
        u.pm = n * 64 + pm; u.pn = n * 4 + pn; return true;
    }
    __device__ __forceinline__ void a_ready(const Unit&) const {}
    __device__ __forceinline__ void done(const Unit&) const {}
};
struct EpiMerge2 {
    static constexpr bool PERM = true, AFTER_DRAIN = false;
    static constexpr int WSCALE = 0x7a7a7a7a;
    bf16_t* MG; const unsigned char* G;
    mutable f32x4 tot[2][4][2];
    __device__ __forceinline__ void zero() const {
#pragma unroll
        for (int bj = 0; bj < 2; ++bj)
#pragma unroll
            for (int m = 0; m < 4; ++m)
#pragma unroll
                for (int k = 0; k < 2; ++k) tot[bj][m][k] = (f32x4){0.f, 0.f, 0.f, 0.f};
    }
    __device__ __forceinline__ void operator()(const f32x4 (&acc)[2][2][4][2], const Unit& u, int wr, int wc, int fr, int fq) const {
        const int n = u.pn >> 2, pn = u.pn & 3, pm = u.pm - n * 128;
        const unsigned row0 = pm * HALF + wr * 64 + fr, col0 = pn * BM + wc * 32 + 8 * fq;
        const u32x2* gb = (const u32x2*)G + (size_t)((pm >> 1) * 16 + n * 4 + pn) * (2 * 8 * 4 * 2 * 64) + (unsigned)((pm & 1) * (8 * 4 * 2 * 64) + (wr * 4 + wc) * (4 * 2 * 64) + (fq * 16 + fr));
        u32x2 gw[4][2];
#pragma unroll
        for (int m = 0; m < 4; ++m)
#pragma unroll
            for (int bj = 0; bj < 2; ++bj) gw[m][bj] = gb[m * (2 * 64) + bj * 64];
#pragma unroll
        for (int m = 0; m < 4; ++m)
#pragma unroll
            for (int bj = 0; bj < 2; ++bj) {
#pragma unroll
                for (int k = 0; k < 4; ++k) { tot[bj][m][0][k] += acc[0][bj][m][0][k] * ((float)((gw[m][bj].x >> (8 * k)) & 255u) * (1.0f / 255.0f));
                                              tot[bj][m][1][k] += acc[0][bj][m][1][k] * ((float)((gw[m][bj].y >> (8 * k)) & 255u) * (1.0f / 255.0f)); } }
        if (n == 3) {
            bf16_t* mbase = MG + col0;
#pragma unroll
            for (int m = 0; m < 4; ++m)
#pragma unroll
                for (int bj = 0; bj < 2; ++bj) { const f32x4 t0 = tot[bj][m][0], t1 = tot[bj][m][1];
#if WO8
                    u32x2 w8; w8.x = __builtin_amdgcn_cvt_pk_fp8_f32(t0[2], t0[3], __builtin_amdgcn_cvt_pk_fp8_f32(t0[0], t0[1], 0u, false), true);
                    w8.y = __builtin_amdgcn_cvt_pk_fp8_f32(t1[2], t1[3], __builtin_amdgcn_cvt_pk_fp8_f32(t1[0], t1[1], 0u, false), true);
                    *(u32x2*)((unsigned char*)MG + col0 + (row0 + m * 16) * 1024u + bj * HALF) = w8; }
#else
                    u32x4 w; w.x = cvt_pk_bf16(t0[0], t0[1]); w.y = cvt_pk_bf16(t0[2], t0[3]); w.z = cvt_pk_bf16(t1[0], t1[1]); w.w = cvt_pk_bf16(t1[2], t1[3]);
                    *(u32x4*)(mbase + (row0 + m * 16) * 1024u + bj * HALF) = w; }
#endif
            zero();
        }
    }
};
struct MergeOrder2 {
    int G, c;
    __device__ __forceinline__ bool next(int i, Unit& u) const {
        const int t = (i >> 2) * G + c; if (t >= 512) return false;
        const int n = i & 3, pm = t >> 2, pn = t & 3;
        u.pm = n * 128 + pm; u.pn = n * 4 + pn; return true;
    }
    __device__ __forceinline__ void a_ready(const Unit&) const {}
    __device__ __forceinline__ void done(const Unit&) const {}
};
struct Frag16x2 { bf16x8 k[2]; };
template <bool FP8> struct FragSel;
template <> struct FragSel<false> {
    typedef Frag16x2 type;
    static __device__ __forceinline__ type load(PG8_LAS unsigned char* p) { type f; f.k[0] = *(const PG8_LAS bf16x8*)p; f.k[1] = *(const PG8_LAS bf16x8*)(p + 1024); return f; }
    template <int WS> static __device__ __forceinline__ f32x4 mma(const type& w, const type& a, f32x4 c) {
        c = __builtin_amdgcn_mfma_f32_16x16x32_bf16(w.k[0], a.k[0], c, 0, 0, 0); return __builtin_amdgcn_mfma_f32_16x16x32_bf16(w.k[1], a.k[1], c, 0, 0, 0); }
};
template <> struct FragSel<true> {
    struct type { v4i_t lo, hi; };
    static __device__ __forceinline__ type load(PG8_LAS unsigned char* p) { type f; f.lo = *(const PG8_LAS v4i_t*)p; f.hi = *(const PG8_LAS v4i_t*)(p + 1024); return f; }
    template <int WS> static __device__ __forceinline__ f32x4 mma(const type& w, const type& a, f32x4 c) {
        return __builtin_amdgcn_mfma_scale_f32_16x16x128_f8f6f4(__builtin_shufflevector(w.lo, w.hi, 0, 1, 2, 3, 4, 5, 6, 7), __builtin_shufflevector(a.lo, a.hi, 0, 1, 2, 3, 4, 5, 6, 7), c, 0, 0, 0, WS, 0, 0x7f7f7f7f); }
};
template <class Epi, class Sched, bool ALIGN_EPI = false, bool SP2 = false, bool FP8 = false, bool HALFM = false>
__device__ __forceinline__ void gemm_phase(PG8_LAS unsigned char* lds, const Gemm g, const Sched& S, const Epi& E, int wid_s) {
    unsigned ones_ = ~0u; asm volatile("" : "+s"(ones_));
    int tid_ = wid_s * 64 + (int)__builtin_amdgcn_mbcnt_hi(ones_, __builtin_amdgcn_mbcnt_lo(ones_, 0u)); asm volatile("" : "+v"(tid_));
    const int tid = tid_, wid = __builtin_amdgcn_readfirstlane(tid >> 6), lane = tid & 63, wr = wid >> 2, wc = wid & 3, fr = lane & 15, fq = lane >> 4;
    const int K = FP8 ? g.K / 2 : g.K, nt = K / BK;
    unsigned voffA[2], voffB[2];
#pragma unroll
    for (int i = 0; i < 2; ++i) { int R, C; stage_rc(tid * 16 + i * 8192, R, C); const int Rb = Epi::PERM ? ((R & ~31) + perm32(R & 31)) : R;
        voffA[i] = (unsigned)(R * K + C) * 2u; voffB[i] = (unsigned)(Rb * K + C) * 2u; }
    const size_t kstep = (size_t)(BK * 2);
    const size_t hstep = (size_t)HALF * K * 2;
    const size_t tstep = 2 * hstep;
    const unsigned ldsw = (unsigned)wid * 1024u;
    const unsigned ldsbase = (unsigned)(__UINTPTR_TYPE__)lds;
    const __amdgpu_buffer_rsrc_t srdA = __builtin_amdgcn_make_buffer_rsrc((void*)g.A, (short)0, 0x7fffffff, 0x00020000);
    const __amdgpu_buffer_rsrc_t srdB = __builtin_amdgcn_make_buffer_rsrc((void*)g.Bt, (short)0, 0x7fffffff, 0x00020000);
    const int aoff = lds_byte(wr * 64 + fr, fq * 8), boff = lds_byte(wc * 32 + fr, fq * 8);
#define PG8_SA(b, h) (((b) * 2 + (h)) * HTB)
#define PG8_SB(b, h) ((4 + (b) * 2 + (h)) * HTB)
#define PG8_STAGE(bufoff, gbase, voff, srd, base) do { const unsigned so_ = (unsigned)((const char*)(gbase) - (const char*)(base)); _Pragma("unroll") for (int _i = 0; _i < 2; ++_i) \
        asm volatile("s_mov_b32 m0, %0\n\ts_nop 0\n\tbuffer_load_dwordx4 %1, %2, %3 offen lds" :: "s"(ldsbase + (unsigned)(bufoff) + ldsw + (unsigned)(_i * 8192)), "v"((voff)[_i]), "s"(srd), "s"(so_) : "m0", "memory"); } while (0)
#define PG8_LDA(dst, b, h) do { _Pragma("unroll") for (int m = 0; m < 4; ++m) dst[m] = FragSel<FP8>::load(lds + PG8_SA(b, h) + aoff + m * 2048); } while (0)
#define PG8_LDB(dst, b, h) do { _Pragma("unroll") for (int n = 0; n < 2; ++n) dst[n] = FragSel<FP8>::load(lds + PG8_SB(b, h) + boff + n * 2048); } while (0)
#define PG8_MMA(ai, bj, At, Bt) do { __builtin_amdgcn_s_setprio(1); _Pragma("unroll") for (int m = 0; m < 4; ++m) _Pragma("unroll") for (int n = 0; n < 2; ++n) \
        acc[ai][bj][m][n] = FragSel<FP8>::template mma<Epi::WSCALE>(Bt[n], At[m], acc[ai][bj][m][n]); __builtin_amdgcn_s_setprio(0); } while (0)
#define PG8_WAIT_V(n) asm volatile("s_waitcnt vmcnt(" #n ")" ::: "memory")
#define PG8_WAIT_L(n) asm volatile("s_waitcnt lgkmcnt(" #n ")" ::: "memory")
#define PG8_BAR __builtin_amdgcn_s_barrier()
#define PG8_SCHED __builtin_amdgcn_sched_barrier(0)
    Unit cur, nxt; int ui = 0;
    if (!S.next(0, cur)) return;
    f32x4 acc[2][2][4][2];
#pragma unroll
    for (int a = 0; a < 2; ++a)
#pragma unroll
        for (int b = 0; b < 2; ++b)
#pragma unroll
            for (int m = 0; m < 4; ++m)
#pragma unroll
                for (int n = 0; n < 2; ++n) acc[a][b][m][n] = (f32x4){0.f, 0.f, 0.f, 0.f};
    typedef typename FragSel<FP8>::type frag_t;
    frag_t At[4], B0[2], B1[2];
    const size_t tstepA = HALFM ? hstep : tstep;
    const size_t hstepA = HALFM ? 0 : hstep;
    const char* cA = (const char*)g.A + (size_t)cur.pm * tstepA; const char* cB = (const char*)g.Bt + (size_t)cur.pn * tstep;
    S.a_ready(cur);
    if constexpr (SP2) {
        PG8_STAGE(PG8_SB(0, 0), cB, voffB, srdB, g.Bt); PG8_STAGE(PG8_SB(0, 1), cB + hstep, voffB, srdB, g.Bt); PG8_STAGE(PG8_SA(0, 0), cA, voffA, srdA, g.A); PG8_STAGE(PG8_SA(0, 1), cA + hstepA, voffA, srdA, g.A);
        if (wr == 1) PG8_BAR;
        PG8_WAIT_V(2); PG8_BAR;
        PG8_STAGE(PG8_SB(1, 0), cB + kstep, voffB, srdB, g.Bt); PG8_STAGE(PG8_SA(1, 0), cA + kstep, voffA, srdA, g.A); PG8_STAGE(PG8_SB(1, 1), cB + hstep + kstep, voffB, srdB, g.Bt);
        PG8_WAIT_V(6); PG8_BAR;
    } else {
        PG8_STAGE(PG8_SB(0, 0), cB, voffB, srdB, g.Bt); PG8_STAGE(PG8_SA(0, 0), cA, voffA, srdA, g.A); PG8_STAGE(PG8_SB(0, 1), cB + hstep, voffB, srdB, g.Bt); PG8_STAGE(PG8_SA(0, 1), cA + hstepA, voffA, srdA, g.A);
        if (wr == 1) PG8_BAR;
        PG8_WAIT_V(4); PG8_BAR;
        PG8_STAGE(PG8_SB(1, 0), cB + kstep, voffB, srdB, g.Bt); PG8_STAGE(PG8_SA(1, 0), cA + kstep, voffA, srdA, g.A); PG8_STAGE(PG8_SB(1, 1), cB + hstep + kstep, voffB, srdB, g.Bt);
        PG8_WAIT_V(6); PG8_BAR;
    }
    for (;;) {
        const bool has_next = S.next(ui + 1, nxt);
        const char* nA = has_next ? (const char*)g.A + (size_t)nxt.pm * tstepA : cA; const char* nB = has_next ? (const char*)g.Bt + (size_t)nxt.pn * tstep : cB;
#pragma unroll 1
        for (int t = 0; t < nt; t += 2) {
            const bool last = (t == nt - 2);
            const char* a1 = cA + (size_t)(t + 1) * kstep;
            const char* a2 = last ? nA : cA + (size_t)(t + 2) * kstep; const char* b2 = last ? nB : cB + (size_t)(t + 2) * kstep;
            const char* a3 = a2 + kstep; const char* b3 = b2 + kstep;
            if (last && has_next) S.a_ready(nxt);
            if constexpr (SP2) {
            PG8_LDB(B0, 0, 0); PG8_LDB(B1, 0, 1); PG8_SCHED; PG8_LDA(At, 0, 0); PG8_STAGE(PG8_SA(1, 1), a1 + hstepA, voffA, srdA, g.A);
            PG8_WAIT_V(8); PG8_WAIT_L(0); PG8_BAR; PG8_MMA(0, 0, At, B0); PG8_MMA(0, 1, At, B1); PG8_BAR; PG8_SCHED;
            if constexpr (!HALFM) PG8_LDA(At, 0, 1); PG8_STAGE(PG8_SB(0, 0), b2, voffB, srdB, g.Bt); PG8_STAGE(PG8_SB(0, 1), b2 + hstep, voffB, srdB, g.Bt); PG8_STAGE(PG8_SA(0, 0), a2, voffA, srdA, g.A);
            PG8_WAIT_V(8); PG8_WAIT_L(0); PG8_BAR; if constexpr (!HALFM) { PG8_MMA(1, 0, At, B0); PG8_MMA(1, 1, At, B1); } PG8_BAR; PG8_SCHED;
            PG8_LDB(B0, 1, 0); PG8_LDB(B1, 1, 1); PG8_SCHED; PG8_LDA(At, 1, 0); PG8_STAGE(PG8_SA(0, 1), a2 + hstepA, voffA, srdA, g.A);
            PG8_WAIT_V(8); PG8_WAIT_L(0); PG8_BAR; PG8_MMA(0, 0, At, B0); PG8_MMA(0, 1, At, B1); PG8_BAR; PG8_SCHED;
            if constexpr (!HALFM) PG8_LDA(At, 1, 1); PG8_STAGE(PG8_SB(1, 0), b3, voffB, srdB, g.Bt); PG8_STAGE(PG8_SB(1, 1), b3 + hstep, voffB, srdB, g.Bt); PG8_STAGE(PG8_SA(1, 0), a3, voffA, srdA, g.A);
            PG8_WAIT_V(8); PG8_WAIT_L(0); PG8_BAR; if constexpr (!HALFM) { PG8_MMA(1, 0, At, B0); PG8_MMA(1, 1, At, B1); } PG8_BAR; PG8_SCHED;
            } else {
            PG8_LDB(B0, 0, 0); PG8_SCHED; PG8_LDA(At, 0, 0); PG8_STAGE(PG8_SA(1, 1), a1 + hstepA, voffA, srdA, g.A);
            PG8_WAIT_L(8); PG8_BAR; PG8_WAIT_L(0); PG8_MMA(0, 0, At, B0); PG8_BAR; PG8_SCHED;
            PG8_LDB(B1, 0, 1); PG8_STAGE(PG8_SB(0, 0), b2, voffB, srdB, g.Bt);
            PG8_BAR; PG8_WAIT_L(0); PG8_MMA(0, 1, At, B1); PG8_BAR;
            if constexpr (!HALFM) PG8_LDA(At, 0, 1); PG8_STAGE(PG8_SA(0, 0), a2, voffA, srdA, g.A);
            PG8_BAR; PG8_WAIT_L(0); if constexpr (!HALFM) PG8_MMA(1, 0, At, B0); PG8_BAR; PG8_SCHED;
            PG8_STAGE(PG8_SB(0, 1), b2 + hstep, voffB, srdB, g.Bt);
            PG8_WAIT_V(6); PG8_BAR; if constexpr (!HALFM) PG8_MMA(1, 1, At, B1); PG8_BAR;
            PG8_LDB(B0, 1, 0); PG8_SCHED; PG8_LDA(At, 1, 0); PG8_STAGE(PG8_SA(0, 1), a2 + hstepA, voffA, srdA, g.A);
            PG8_WAIT_L(8); PG8_BAR; PG8_WAIT_L(0); PG8_MMA(0, 0, At, B0); PG8_BAR; PG8_SCHED;
            PG8_LDB(B1, 1, 1); PG8_STAGE(PG8_SB(1, 0), b3, voffB, srdB, g.Bt);
            PG8_BAR; PG8_WAIT_L(0); PG8_MMA(0, 1, At, B1); PG8_BAR;
            if constexpr (!HALFM) PG8_LDA(At, 1, 1); PG8_STAGE(PG8_SA(1, 0), a3, voffA, srdA, g.A);
            PG8_BAR; PG8_WAIT_L(0); if constexpr (!HALFM) PG8_MMA(1, 0, At, B0); PG8_BAR; PG8_SCHED;
            PG8_STAGE(PG8_SB(1, 1), b3 + hstep, voffB, srdB, g.Bt);
            PG8_WAIT_V(6); PG8_BAR; if constexpr (!HALFM) PG8_MMA(1, 1, At, B1); PG8_BAR;
            }
        }
        if constexpr (ALIGN_EPI) { if (wr == 0) PG8_BAR; }
        if constexpr (!Epi::AFTER_DRAIN) { E(acc, cur, wr, wc, fr, fq); S.done(cur); }
        if (!has_next) break;
#pragma unroll
        for (int a = 0; a < 2; ++a)
#pragma unroll
            for (int b = 0; b < 2; ++b)
#pragma unroll
                for (int m = 0; m < 4; ++m)
#pragma unroll
                    for (int n = 0; n < 2; ++n) acc[a][b][m][n] = (f32x4){0.f, 0.f, 0.f, 0.f};
        cur = nxt; cA = nA; cB = nB; ++ui;
        if constexpr (ALIGN_EPI) { if (wr == 1) PG8_BAR; }
    }
    PG8_WAIT_V(0);
    if constexpr (!ALIGN_EPI) { if (wr == 0) PG8_BAR; }
    PG8_BAR;
    if constexpr (Epi::AFTER_DRAIN) { E.fused(acc, cur, wr, wc, fr, fq, lds, wid, lane); S.done(cur); }
#undef PG8_SA
#undef PG8_SB
#undef PG8_STAGE
#undef PG8_LDA
#undef PG8_LDB
#undef PG8_MMA
#undef PG8_WAIT_V
#undef PG8_WAIT_L
#undef PG8_BAR
#undef PG8_SCHED
}
}

typedef unsigned short bf16_t;
typedef short bf16x8 __attribute__((ext_vector_type(8)));
typedef short s16x4 __attribute__((ext_vector_type(4)));
typedef float f32x4 __attribute__((ext_vector_type(4)));
typedef float f32x16 __attribute__((ext_vector_type(16)));
typedef unsigned u32x4 __attribute__((ext_vector_type(4)));
typedef unsigned u32x2 __attribute__((ext_vector_type(2)));
#define LAS __attribute__((address_space(3)))

constexpr int D = 1024, BATCH = 2, SEQ = 8192, MROWS = BATCH * SEQ, DEPTH = 2;
constexpr int ZW = 2816, NW1 = 6912, INW = 6856, DFF = 2816, NGU = 5632, NMOD = 6 * D;
constexpr float RMS_EPS = 1e-6f, LOG2E = 1.4426950408889634f, C2 = 0.125f * 1.4426950408889634f;
constexpr int ZC_AU = 0, ZC_AB = 256, ZC_AC = 512, ZC_DQ = 768, ZC_DK = 1024, ZC_DV = 1088, ZC_DQI = 1152, ZC_DKI = 1408, ZC_FQ = 1472, ZC_FK = 1728, ZC_FV = 1984, ZC_SQ = 2240, ZC_SK = 2496, ZC_SV = 2624;

constexpr size_t MiB = 1u << 20;
constexpr size_t WS_KMAX = 4096;
constexpr size_t WS_MOD = 65536;
constexpr size_t WS_FCUM = WS_MOD + 98304;
constexpr size_t WS_SMALL = WS_FCUM + 262144;
constexpr size_t WS_W1T = 1 * MiB;
constexpr size_t WS_WG8 = WS_W1T + (size_t)2816 * D * 2;
constexpr size_t WS_WGU = WS_W1T + (size_t)NW1 * D * 2;
constexpr size_t WS_WBT = WS_WGU + (size_t)NGU * D * 2;
constexpr size_t WS_WOT = WS_WBT + (size_t)4 * D * 256 * 2;
constexpr size_t WS_WDT = WS_WOT + (size_t)D * D * 2;
constexpr size_t WS_H = 35 * MiB;
constexpr size_t WS_Z = 67 * MiB;
constexpr size_t WS_G = 155 * MiB;
constexpr size_t WS_MG = 219 * MiB;
constexpr size_t WS_END = 251 * MiB;
static_assert(WS_WDT + (size_t)D * DFF * 2 <= WS_H && WS_SMALL + 524288 <= WS_W1T, "ws map");

#ifndef FFN8
#define FFN8 1
#endif
#ifndef DOWN8
#define DOWN8 1
#endif
constexpr int LDS_BYTES = 151552;

struct Args {
    const float *x, *c, *w_ada, *b_ada, *norm_g, *w_in, *conv_w, *fox_bias, *swa_sinks, *w_branch, *w_o, *w_gate, *w_up, *w_down;
    float* out; unsigned char* ws;
};

typedef __bf16 hwbf16x2_t __attribute__((ext_vector_type(2)));
__device__ __forceinline__ unsigned f2bf(float f) { return (unsigned)__builtin_bit_cast(unsigned short, (__bf16)f); }
__device__ __forceinline__ unsigned pk2(float lo, float hi) { typedef float f2_ __attribute__((ext_vector_type(2))); const f2_ v_ = {lo, hi}; return __builtin_bit_cast(unsigned, __builtin_convertvector(v_, hwbf16x2_t)); }
__device__ __forceinline__ float bflo(unsigned w) { return __uint_as_float(w << 16); }
__device__ __forceinline__ float bfhi(unsigned w) { return __uint_as_float(w & 0xffff0000u); }

__device__ __forceinline__ float shf(float v, int src) { return __int_as_float(__builtin_amdgcn_ds_bpermute(src << 2, __float_as_int(v))); }
__device__ __forceinline__ unsigned shu(unsigned v, int src) { return (unsigned)__builtin_amdgcn_ds_bpermute(src << 2, (int)v); }
__device__ __forceinline__ float wave_sum(float v, int lane) {
#pragma unroll
    for (int o = 1; o < 64; o <<= 1) v += shf(v, lane ^ o);
    return v;
}
__device__ __forceinline__ int crow(int r, int hi) { return (r & 3) + 8 * (r >> 2) + 4 * hi; }
__device__ __forceinline__ float swap32_max(float m) { auto rr = __builtin_amdgcn_permlane32_swap(__float_as_uint(m), __float_as_uint(m), false, false); return fmaxf(__uint_as_float(rr[0]), __uint_as_float(rr[1])); }
__device__ __forceinline__ float swap32_sum(float m) { auto rr = __builtin_amdgcn_permlane32_swap(__float_as_uint(m), __float_as_uint(m), false, false); return __uint_as_float(rr[0]) + __uint_as_float(rr[1]); }
#define LDSWAIT() asm volatile("s_waitcnt lgkmcnt(0)" ::: "memory")
__device__ __forceinline__ bool xb_first_lane_w(int w) { unsigned ones = ~0u; asm volatile("" : "+s"(ones)); return w == 0 && __builtin_amdgcn_mbcnt_hi(ones, __builtin_amdgcn_mbcnt_lo(ones, 0u)) == 0u; }
__device__ __forceinline__ int ftid(int wid_s) { unsigned ones = ~0u; asm volatile("" : "+s"(ones)); int t = wid_s * 64 + (int)__builtin_amdgcn_mbcnt_hi(ones, __builtin_amdgcn_mbcnt_lo(ones, 0u)); asm volatile("" : "+v"(t)); return t; }

__device__ __forceinline__ void ada_gemv(const Args& a, unsigned char* lds, int wid_s) {
    float* sc = (float*)lds;
    float* part = (float*)(lds + 8192);
    const int tid = ftid(wid_s), lane = tid & 63, wid = tid >> 6;
    for (int i = tid; i < 2 * D; i += 512) { const float v = a.c[i]; sc[i] = v / (1.0f + __expf(-v)); }
    __syncthreads();
    float* mod = (float*)(a.ws + WS_MOD);
    for (int item = blockIdx.x; item < DEPTH * (NMOD / 64); item += gridDim.x) {
        const int l = item / (NMOD / 64), jc = item % (NMOD / 64);
        const float* w = a.w_ada + (size_t)l * D * NMOD + (size_t)(wid * 128) * NMOD + jc * 64 + lane;
        float a0 = 0.f, a1 = 0.f;
#pragma unroll 32
        for (int k = 0; k < 128; ++k) { const float wv = w[(size_t)k * NMOD]; a0 += sc[wid * 128 + k] * wv; a1 += sc[D + wid * 128 + k] * wv; }
        part[(wid * 2 + 0) * 64 + lane] = a0; part[(wid * 2 + 1) * 64 + lane] = a1;
        __syncthreads();
        if (tid < 128) { const int b = tid >> 6, j = tid & 63; float s = 0.f;
#pragma unroll
            for (int w8 = 0; w8 < 8; ++w8) s += part[(w8 * 2 + b) * 64 + j];
            mod[((size_t)l * 2 + b) * NMOD + jc * 64 + j] = s + a.b_ada[(size_t)l * NMOD + jc * 64 + j]; }
        __syncthreads();
    }
}
__device__ __forceinline__ void transpose_item(const float* colptr, int ld, bf16_t* dst  , int dstK, float* scr, int lane) {
    float tv[32];
#pragma unroll
    for (int i = 0; i < 32; ++i) tv[i] = colptr ? colptr[(size_t)(2 * i + (lane >> 5)) * ld] : 0.f;
#pragma unroll
    for (int i = 0; i < 32; ++i) scr[(2 * i + (lane >> 5)) * 33 + (lane & 31)] = tv[i];
    LDSWAIT();
    const int c = lane & 7;
#pragma unroll
    for (int j = 0; j < 4; ++j) { const int n = (lane >> 3) + 8 * j; const float* s = scr + (8 * c) * 33 + n;
        u32x4 o; o.x = pk2(s[0 * 33], s[1 * 33]); o.y = pk2(s[2 * 33], s[3 * 33]); o.z = pk2(s[4 * 33], s[5 * 33]); o.w = pk2(s[6 * 33], s[7 * 33]);
        *(u32x4*)(dst + (size_t)n * dstK + 8 * c) = o; }
    LDSWAIT();
}
__device__ __forceinline__ void transpose_item_fp8(const float* colptr, int ld, unsigned char* dst  , int dstK, float scale, float* scr, int lane, bool permrows = false) {
    float tv[32];
#pragma unroll
    for (int i = 0; i < 32; ++i) tv[i] = colptr ? colptr[(size_t)(2 * i + (lane >> 5)) * ld] : 0.f;
#pragma unroll
    for (int i = 0; i < 32; ++i) scr[(2 * i + (lane >> 5)) * 33 + (lane & 31)] = tv[i];
    LDSWAIT();
    const int n = lane >> 1, kh = 32 * (lane & 1); const float* s = scr + kh * 33 + n;
    unsigned w[8];
#pragma unroll
    for (int q = 0; q < 8; ++q) { unsigned t = 0u;
        t = __builtin_amdgcn_cvt_pk_fp8_f32(s[(4 * q + 0) * 33] * scale, s[(4 * q + 1) * 33] * scale, t, false);
        t = __builtin_amdgcn_cvt_pk_fp8_f32(s[(4 * q + 2) * 33] * scale, s[(4 * q + 3) * 33] * scale, t, true);
        w[q] = t; }
    const int nrow = permrows ? (16 * ((n >> 2) & 1) + 4 * (n >> 3) + (n & 3)) : n;
    unsigned char* dp = dst + (size_t)nrow * dstK + kh;
    *(u32x4*)dp = (u32x4){w[0], w[1], w[2], w[3]}; *(u32x4*)(dp + 16) = (u32x4){w[4], w[5], w[6], w[7]};
    LDSWAIT();
}
__device__ __forceinline__ int w1_src_col(int n) {
    if (n < 1472) return n;
    if (n < 2240) return n + 4;
    if (n < 2752) return n + 8;
    if (n < 2756) return 1472 + (n - 2752);
    if (n < 2760) return 2244 + (n - 2756);
    if (n < 2816) return -1;
    return 2760 + (n - 2816);
}
__device__ __forceinline__ void convert_weights(const Args& a, int l, unsigned char* lds, int wid_s) {
    const int tid = ftid(wid_s), lane = tid & 63, wid = tid >> 6;
    float* scr = (float*)(lds + 16384) + wid * (64 * 33);
    const int gw = blockIdx.x * 8 + wid, NGW = gridDim.x * 8;
    constexpr int I_IN = 16 * 216, I_GU = 16 * 176, I_B = 512, I_O = 512, I_D = 44 * 32;
    bf16_t* W1T = (bf16_t*)(a.ws + WS_W1T); bf16_t* WGU = (bf16_t*)(a.ws + WS_WGU); bf16_t* WBT = (bf16_t*)(a.ws + WS_WBT); bf16_t* WOT = (bf16_t*)(a.ws + WS_WOT); bf16_t* WDT = (bf16_t*)(a.ws + WS_WDT);
    const int cl = lane & 31;
    for (int it = gw; it < I_IN + I_GU + I_B + I_O + I_D; it += NGW) {
        int r = it;
        if (r < I_IN) { const int kb = r / 216, nb = r % 216;
            if (nb < 88) { const int n = 32 * nb + cl, sc_ = w1_src_col(n);
                const float* cp = sc_ >= 0 ? a.w_in + (size_t)l * D * INW + (size_t)(64 * kb) * INW + sc_ : nullptr;
                transpose_item(cp, INW, W1T + (size_t)(32 * nb) * D + 64 * kb, D, scr, lane); }
            else { const int n = 32 * nb + cl;
                const float* cp = a.w_in + (size_t)l * D * INW + (size_t)(64 * kb) * INW + w1_src_col(n);
                transpose_item_fp8(cp, INW, a.ws + WS_WG8 + (size_t)(32 * (nb - 88)) * D + 64 * kb, D, 32.0f, scr, lane, true); }
            continue; }
        r -= I_IN;
        if (r < I_GU) { const int kb = r / 176, nb = r % 176, n = 32 * nb + cl;
#if FFN8
            const int rt = n & 255, hj = 128 * (n >> 8) + 32 * ((rt >> 5) & 3) + 8 * ((rt >> 3) & 3) + 4 * (rt >> 7) + 2 * ((rt >> 2) & 1) + ((rt >> 1) & 1);
            const float* cp = ((n & 1) ? a.w_up : a.w_gate) + (size_t)l * D * DFF + (size_t)(64 * kb) * DFF + hj;
#else
            const float* cp = ((n & 1) ? a.w_up : a.w_gate) + (size_t)l * D * DFF + (size_t)(64 * kb) * DFF + (n >> 1);
#endif
#if FFN8
            transpose_item_fp8(cp, DFF, a.ws + WS_WGU + (size_t)(32 * nb) * D + 64 * kb, D, 32.0f, scr, lane, true); continue; }
#else
            transpose_item(cp, DFF, WGU + (size_t)(32 * nb) * D + 64 * kb, D, scr, lane); continue; }
#endif
        r -= I_GU;
        if (r < I_B) { const int nbr = r / 128, rr = r % 128, kb = rr / 32, nb = rr % 32;
            const float* cp = a.w_branch + ((size_t)(l * 4 + nbr) * 256 + 64 * kb) * D + 32 * nb + cl;
            transpose_item(cp, D, WBT + ((size_t)nbr * D + 32 * nb) * 256 + 64 * kb, 256, scr, lane); continue; }
        r -= I_B;
        if (r < I_O) { const int kb = r / 32, nb = r % 32;
            const float* cp = a.w_o + (size_t)l * D * D + (size_t)(64 * kb) * D + 32 * nb + cl;
#if WO8
            transpose_item_fp8(cp, D, a.ws + WS_WOT + (size_t)(32 * nb) * D + 64 * kb, D, 32.0f, scr, lane, true); continue; }
#else
            transpose_item(cp, D, WOT + (size_t)(32 * nb) * D + 64 * kb, D, scr, lane); continue; }
#endif
        r -= I_O;
        { const int kb = r / 32, nb = r % 32;
            const float* cp = a.w_down + (size_t)l * DFF * D + (size_t)(64 * kb) * D + 32 * nb + cl;
#if DOWN8
            transpose_item_fp8(cp, D, a.ws + WS_WDT + (size_t)(32 * nb) * DFF + 64 * kb, DFF, 32.0f, scr, lane, true); }
#else
            transpose_item(cp, D, WDT + (size_t)(32 * nb) * DFF + 64 * kb, DFF, scr, lane); }
#endif
    }
}

template <bool HAS_RAW, bool HAS_H, bool XIN16 = false, bool XOUT16 = false, bool HAS_H8 = false>
__device__ __forceinline__ void row_pass8(const void* xres_, const bf16_t* raw, void* xdst_, bf16_t* hdst, unsigned char* h8dst, const float* gate, const float* gam_out, const float* gam_in, const float* sc, const float* sh, int lane) {
    f32x4 A[4], B[4], C[4];
#pragma unroll
    for (int j = 0; j < 4; ++j) {
        if (HAS_RAW) A[j] = ((const f32x4*)gate)[lane + 64 * j] * ((const f32x4*)gam_out)[lane + 64 * j];
        if (HAS_H) { B[j] = ((const f32x4*)gam_in)[lane + 64 * j] * (((const f32x4*)sc)[lane + 64 * j] + 1.0f); C[j] = ((const f32x4*)sh)[lane + 64 * j]; }
    }
    const float* xres = (const float*)xres_; const bf16_t* xres16 = (const bf16_t*)xres_; float* xdst = (float*)xdst_; bf16_t* xdst16 = (bf16_t*)xdst_;
    f32x4 nv[4], mv[4]; u32x2 nx[4], nr[4], mx[4], mr[4];
#pragma unroll
    for (int j = 0; j < 4; ++j) { if (XIN16) nx[j] = ((const u32x2*)xres16)[lane + 64 * j]; else nv[j] = ((const f32x4*)xres)[lane + 64 * j]; if (HAS_RAW) nr[j] = ((const u32x2*)raw)[lane + 64 * j]; }
#pragma unroll
    for (int j = 0; j < 4; ++j) { if (XIN16) mx[j] = ((const u32x2*)(xres16 + (size_t)D))[lane + 64 * j]; else mv[j] = ((const f32x4*)(xres + (size_t)D))[lane + 64 * j]; if (HAS_RAW) mr[j] = ((const u32x2*)(raw + (size_t)D))[lane + 64 * j]; }
#pragma unroll 1
    for (int r = 0; r < 8; ++r) {
        f32x4 v[4]; u32x2 w[4];
#pragma unroll
        for (int j = 0; j < 4; ++j) { if (XIN16) v[j] = (f32x4){bflo(nx[j].x), bfhi(nx[j].x), bflo(nx[j].y), bfhi(nx[j].y)}; else v[j] = nv[j]; if (HAS_RAW) w[j] = nr[j]; }
#pragma unroll
        for (int j = 0; j < 4; ++j) { if (XIN16) nx[j] = mx[j]; else nv[j] = mv[j]; if (HAS_RAW) nr[j] = mr[j]; }
        if (r + 2 < 8) {
#pragma unroll
            for (int j = 0; j < 4; ++j) { if (XIN16) mx[j] = ((const u32x2*)(xres16 + (size_t)(r + 2) * D))[lane + 64 * j]; else mv[j] = ((const f32x4*)(xres + (size_t)(r + 2) * D))[lane + 64 * j];
                if (HAS_RAW) mr[j] = ((const u32x2*)(raw + (size_t)(r + 2) * D))[lane + 64 * j]; }
        }
        if (HAS_RAW) {
            f32x4 o[4]; float ss = 0.f;
#pragma unroll
            for (int j = 0; j < 4; ++j) { o[j] = (f32x4){bflo(w[j].x), bfhi(w[j].x), bflo(w[j].y), bfhi(w[j].y)}; ss += (o[j][0] * o[j][0] + o[j][1] * o[j][1]) + (o[j][2] * o[j][2] + o[j][3] * o[j][3]); }
            const float rstd = 1.0f / sqrtf(wave_sum(ss, lane) * (1.0f / D) + RMS_EPS * 1024.0f);
#pragma unroll
            for (int j = 0; j < 4; ++j) { v[j] = v[j] + A[j] * (o[j] * rstd);
                if (XOUT16) { u32x2 pw; pw.x = pk2(v[j][0], v[j][1]); pw.y = pk2(v[j][2], v[j][3]); ((u32x2*)(xdst16 + (size_t)r * D))[lane + 64 * j] = pw; }
                else ((f32x4*)(xdst + (size_t)r * D))[lane + 64 * j] = v[j]; }
        }
        if (HAS_H) {
            float ss = 0.f;
#pragma unroll
            for (int j = 0; j < 4; ++j) ss += (v[j][0] * v[j][0] + v[j][1] * v[j][1]) + (v[j][2] * v[j][2] + v[j][3] * v[j][3]);
            const float rstd = 1.0f / sqrtf(wave_sum(ss, lane) * (1.0f / D) + RMS_EPS);
#pragma unroll
            for (int j = 0; j < 4; ++j) { const f32x4 h = v[j] * rstd * B[j] + C[j]; if (hdst) { u32x2 pw; pw.x = pk2(h[0], h[1]); pw.y = pk2(h[2], h[3]); ((u32x2*)(hdst + (size_t)r * D))[lane + 64 * j] = pw; }
                if (HAS_H8) { unsigned t8 = 0u; t8 = __builtin_amdgcn_cvt_pk_fp8_f32(h[0], h[1], t8, false); t8 = __builtin_amdgcn_cvt_pk_fp8_f32(h[2], h[3], t8, true); ((unsigned*)(h8dst + (size_t)r * D))[lane + 64 * j] = t8; } }
        }
    }
}

__device__ __forceinline__ void conv_phase(const Args& a, int l, int wid_s) {
    const bf16_t* Z = (const bf16_t*)(a.ws + WS_Z); bf16_t* Y0 = (bf16_t*)(a.ws + WS_H);
    const float* cw = a.conv_w + (size_t)l * 3 * 256;
    const int gt = blockIdx.x * 512 + ftid(wid_s), GT = gridDim.x * 512;
    for (int it = gt; it < MROWS * 32; it += GT) {
        const int row = it >> 5, ch = (it & 31) * 8, t = row & (SEQ - 1);
        float acc[8];
#pragma unroll
        for (int k = 0; k < 8; ++k) acc[k] = 0.f;
#pragma unroll
        for (int j = 0; j < 3; ++j) { const int dt = 2 - j; if (t - dt < 0) continue;
            const bf16_t* zr = Z + (size_t)(row - dt) * ZW;
            const u32x4 u = *(const u32x4*)(zr + ZC_AU + ch), cgt = *(const u32x4*)(zr + ZC_AC + ch);
            const f32x4 w0 = *(const f32x4*)(cw + j * 256 + ch), w1 = *(const f32x4*)(cw + j * 256 + ch + 4);
            acc[0] += w0[0] * bflo(u.x) * bflo(cgt.x); acc[1] += w0[1] * bfhi(u.x) * bfhi(cgt.x); acc[2] += w0[2] * bflo(u.y) * bflo(cgt.y); acc[3] += w0[3] * bfhi(u.y) * bfhi(cgt.y);
            acc[4] += w1[0] * bflo(u.z) * bflo(cgt.z); acc[5] += w1[1] * bfhi(u.z) * bfhi(cgt.z); acc[6] += w1[2] * bflo(u.w) * bflo(cgt.w); acc[7] += w1[3] * bfhi(u.w) * bfhi(cgt.w); }
        const u32x4 bg = *(const u32x4*)(Z + (size_t)row * ZW + ZC_AB + ch);
        u32x4 o; o.x = pk2(acc[0] * bflo(bg.x), acc[1] * bfhi(bg.x)); o.y = pk2(acc[2] * bflo(bg.y), acc[3] * bfhi(bg.y)); o.z = pk2(acc[4] * bflo(bg.z), acc[5] * bfhi(bg.z)); o.w = pk2(acc[6] * bflo(bg.w), acc[7] * bfhi(bg.w));
        *(u32x4*)(Y0 + (size_t)row * 256 + ch) = o;
    }
}

__device__ __forceinline__ void fox_scan(const Args& a, int l, int bh, unsigned char* lds, int wid_s) {
    const int tid = ftid(wid_s), lane = tid & 63, wid = tid >> 6, b = bh >> 2, h = bh & 3;
    const float* SM = (const float*)(a.ws + WS_SMALL); float* F2 = (float*)(a.ws + WS_FCUM) + (size_t)bh * SEQ;
    const float bias = a.fox_bias[l * 4 + h];
    float* wtot = (float*)lds;
    float v[16]; float run = 0.f;
#pragma unroll
    for (int i = 0; i < 16; ++i) { const float x = SM[((size_t)b * SEQ + tid * 16 + i) * 8 + 4 + h] + bias;
        const float ls = fminf(x, 0.f) - log1pf(__expf(-fabsf(x))); run += ls; v[i] = run; }
    float inc = run;
#pragma unroll
    for (int o = 1; o < 64; o <<= 1) { const float t = shf(inc, lane - o); if (lane >= o) inc += t; }
    if (lane == 63) wtot[wid] = inc;
    __syncthreads();
    float base = inc - run;
    for (int w = 0; w < wid; ++w) base += wtot[w];
#pragma unroll
    for (int i = 0; i < 16; ++i) F2[tid * 16 + i] = (base + v[i]) * LOG2E;
    __syncthreads();
}


__device__ __forceinline__ void fox_kmax_item(const Args& a, int l, int item, int wid_s) {
    const int tid = ftid(wid_s), lane = tid & 63, bh = item >> 3, chunk = item & 7, b = bh >> 2, h = bh & 3;
    const bf16_t* Z = (const bf16_t*)(a.ws + WS_Z);
    float mx = 0.f;
#pragma unroll
    for (int rr = 0; rr < 2; ++rr) { const bf16_t* kp = Z + ((size_t)b * SEQ + chunk * 1024 + rr * 512 + tid) * ZW + ZC_FK + h * 64; float q2 = 0.f;
#pragma unroll
        for (int i = 0; i < 8; ++i) { const u32x4 w = *(const u32x4*)(kp + 8 * i);
            q2 += bflo(w.x) * bflo(w.x) + bfhi(w.x) * bfhi(w.x) + bflo(w.y) * bflo(w.y) + bfhi(w.y) * bfhi(w.y) + bflo(w.z) * bflo(w.z) + bfhi(w.z) * bfhi(w.z) + bflo(w.w) * bflo(w.w) + bfhi(w.w) * bfhi(w.w); }
        mx = fmaxf(mx, q2); }
#pragma unroll
    for (int o = 1; o < 64; o <<= 1) mx = fmaxf(mx, shf(mx, lane ^ o));
    if (lane == 0) atomicMax((unsigned*)(a.ws + WS_KMAX) + l * 8 + bh, __float_as_uint(mx));
}

__device__ __forceinline__ void fox_publish(unsigned* flag, int wid_s) {
    asm volatile("s_waitcnt vmcnt(0)" ::: "memory");
    __syncthreads();
    if (xb_first_lane_w(wid_s)) { __builtin_amdgcn_fence(__ATOMIC_RELEASE, "agent"); asm volatile("s_waitcnt vmcnt(0)" ::: "memory");
        (void)__hip_atomic_fetch_add(flag, 1u, __ATOMIC_RELAXED, __HIP_MEMORY_SCOPE_AGENT); }
}
__device__ __forceinline__ void fox_await(unsigned* flag, unsigned want, int wid_s) {
    if (xb_first_lane_w(wid_s)) { unsigned sp_ = 0u;
        while (__hip_atomic_load(flag, __ATOMIC_RELAXED, __HIP_MEMORY_SCOPE_AGENT) < want) { __builtin_amdgcn_s_sleep(2); if (++sp_ > (1u << 22)) break; }
        __builtin_amdgcn_fence(__ATOMIC_ACQUIRE, "agent"); asm volatile("s_waitcnt vmcnt(0)" ::: "memory"); }
    __syncthreads();
}
#ifndef DEFER_THR
#define DEFER_THR 8.0f
#endif
#ifndef SKIP_THR
#define SKIP_THR 46.0f
#endif
template <int MODE>
__device__ __forceinline__ void attn_unit(unsigned char* lds, const bf16_t* __restrict__ Z, bf16_t* __restrict__ Yn, int b, int head, int qb, const float* __restrict__ F2, float slope2, float sink2, int tile_lo, float kmax, int wid_s) {
    const int tid = ftid(wid_s), lane = tid & 63, r32 = lane & 31, hi = lane >> 5; const int wid = __builtin_amdgcn_readfirstlane(tid >> 6);
    constexpr int QOFF = MODE == 0 ? ZC_FQ : ZC_SQ, KOFF = MODE == 0 ? ZC_FK : ZC_SK, VOFF = MODE == 0 ? ZC_FV : ZC_SV;
    const int hk = MODE == 0 ? head : (head >> 1);
    float c2l = C2; asm volatile("" : "+v"(c2l));
    const size_t rowbase = (size_t)b * SEQ;
    const int q0 = qb * 256, qa = q0 + 32 * wid, myq = qa + r32;
    unsigned char* Ks = lds; unsigned char* Vs = lds + 9216; float* Fk = (float*)(lds + 9216 + 12288); float* wsc = (float*)(lds + 49152) + wid * 64;
    bf16x8 qr[4];
    { const bf16_t* qp = Z + (rowbase + myq) * ZW + QOFF + head * 64 + hi * 8;
#pragma unroll
      for (int ks = 0; ks < 4; ++ks) qr[ks] = *(const bf16x8*)(qp + 16 * ks); }
    const float* Fh = MODE == 0 ? F2 + ((size_t)b * 4 + head) * SEQ : nullptr;
    const float fq2 = MODE == 0 ? Fh[myq] : 0.f;
    float m = -1e30f, l = 0.f; f32x16 o0, o1;
#pragma unroll
    for (int r = 0; r < 16; ++r) { o0[r] = 0.f; o1[r] = 0.f; }
    const int t_hi = (q0 + 255) >> 6;
    if (MODE == 0) {
        int* smin = (int*)(lds + 49152 + 2048);
        __syncthreads();
        if (tid == 0) *smin = 0x7fffffff;
        __syncthreads();
        if (tid < 256) {
            const int t = q0 + tid; const bf16_t* qp2 = Z + (rowbase + t) * ZW + QOFF + head * 64; const bf16_t* kp2 = Z + (rowbase + t) * ZW + KOFF + hk * 64; float q2 = 0.f, dqk = 0.f;
#pragma unroll
            for (int i = 0; i < 8; ++i) { const u32x4 w = *(const u32x4*)(qp2 + 8 * i); const u32x4 kw = *(const u32x4*)(kp2 + 8 * i);
                q2 += bflo(w.x) * bflo(w.x) + bfhi(w.x) * bfhi(w.x) + bflo(w.y) * bflo(w.y) + bfhi(w.y) * bfhi(w.y) + bflo(w.z) * bflo(w.z) + bfhi(w.z) * bfhi(w.z) + bflo(w.w) * bflo(w.w) + bfhi(w.w) * bfhi(w.w);
                dqk += bflo(w.x) * bflo(kw.x) + bfhi(w.x) * bfhi(kw.x) + bflo(w.y) * bflo(kw.y) + bfhi(w.y) * bfhi(kw.y) + bflo(w.z) * bflo(kw.z) + bfhi(w.z) * bfhi(kw.z) + bflo(w.w) * bflo(kw.w) + bfhi(w.w) * bfhi(kw.w); }
            const float target = Fh[t] + (40.0f + 0.125f * (sqrtf(q2) * kmax - dqk)) * LOG2E;
            int lo = 0, hi2 = t;
            while (lo < hi2) { const int mid = (lo + hi2) >> 1; if (Fh[mid] <= target) hi2 = mid; else lo = mid + 1; }
            atomicMin(smin, lo);
        }
        __syncthreads();
#ifdef PROBE_FOXFULL
        tile_lo = 0;
#else
        tile_lo = *smin >> 6;
#endif
    }
    const int srow = tid >> 3, sch = tid & 7;
    const int i16 = lane & 15;
    const LAS unsigned char* vtr_base = (const LAS unsigned char*)(Vs) + (4 * hi + (i16 >> 2)) * 192 + (16 * ((lane >> 4) & 1) + 4 * (i16 & 3)) * 2;
    u32x4 nk, nv4; float nf = 0.f;
    { const bf16_t* src = Z + (rowbase + 64 * t_hi + srow) * ZW;
      nk = *(const u32x4*)(src + KOFF + hk * 64 + sch * 8); nv4 = *(const u32x4*)(src + VOFF + hk * 64 + sch * 8);
      if (MODE == 0 && tid < 64) nf = Fh[64 * t_hi + tid]; }
    constexpr int ABUF = 24576;
    __syncthreads();
    { unsigned char* kb_ = Ks + (t_hi & 1) * ABUF; unsigned char* vb_ = Vs + (t_hi & 1) * ABUF;
      *(u32x4*)(kb_ + srow * 144 + sch * 16) = nk; *(u32x4*)(vb_ + srow * 192 + sch * 16) = nv4;
      if (MODE == 0 && tid < 64) (Fk + (t_hi & 1) * (ABUF / 4))[tid] = nf; }
    if (t_hi > tile_lo) { const bf16_t* src = Z + (rowbase + 64 * (t_hi - 1) + srow) * ZW;
      nk = *(const u32x4*)(src + KOFF + hk * 64 + sch * 8); nv4 = *(const u32x4*)(src + VOFF + hk * 64 + sch * 8);
      if (MODE == 0 && tid < 64) nf = Fh[64 * (t_hi - 1) + tid]; }
    for (int T = t_hi; T >= tile_lo; --T) {
        __syncthreads();
        if (T > tile_lo) {
            unsigned char* kb_ = Ks + ((T - 1) & 1) * ABUF; unsigned char* vb_ = Vs + ((T - 1) & 1) * ABUF;
            *(u32x4*)(kb_ + srow * 144 + sch * 16) = nk; *(u32x4*)(vb_ + srow * 192 + sch * 16) = nv4;
            if (MODE == 0 && tid < 64) (Fk + ((T - 1) & 1) * (ABUF / 4))[tid] = nf;
            if (T - 1 > tile_lo) { const bf16_t* src = Z + (rowbase + 64 * (T - 2) + srow) * ZW;
              nk = *(const u32x4*)(src + KOFF + hk * 64 + sch * 8); nv4 = *(const u32x4*)(src + VOFF + hk * 64 + sch * 8);
              if (MODE == 0 && tid < 64) nf = Fh[64 * (T - 2) + tid]; }
        }
        const unsigned char* Kc = Ks + (T & 1) * ABUF; const float* Fc = Fk + (T & 1) * (ABUF / 4); const int vofs = (T & 1) * ABUF;
        const bool part = (64 * T <= qa + 31) && (MODE == 0 || (64 * T + 63 >= qa - 127));
        if (part) {
            f32x16 p0, p1;
#pragma unroll
            for (int r = 0; r < 16; ++r) { p0[r] = 0.f; p1[r] = 0.f; }
#pragma unroll
            for (int ks = 0; ks < 4; ++ks) {
                const bf16x8 k0 = *(const bf16x8*)(Kc + r32 * 144 + (16 * ks + 8 * hi) * 2);
                const bf16x8 k1 = *(const bf16x8*)(Kc + (32 + r32) * 144 + (16 * ks + 8 * hi) * 2);
                p0 = __builtin_amdgcn_mfma_f32_32x32x16_bf16(k0, qr[ks], p0, 0, 0, 0);
                p1 = __builtin_amdgcn_mfma_f32_32x32x16_bf16(k1, qr[ks], p1, 0, 0, 0);
            }
            const int kvb = 64 * T + 4 * hi;
            float mx = -INFINITY;
#pragma unroll
            for (int g = 0; g < 4; ++g) {
                f32x4 fk0 = {0.f, 0.f, 0.f, 0.f}, fk1 = {0.f, 0.f, 0.f, 0.f};
                if (MODE == 0) { fk0 = *(const f32x4*)(Fc + 8 * g + 4 * hi); fk1 = *(const f32x4*)(Fc + 32 + 8 * g + 4 * hi); }
#pragma unroll
                for (int i = 0; i < 4; ++i) { const int r = 4 * g + i, kv0 = kvb + 8 * g + i, kv1 = kv0 + 32;
                    float x0, x1;
                    if (MODE == 0) { x0 = p0[r] * c2l + (fq2 - fk0[i]); x1 = p1[r] * c2l + (fq2 - fk1[i]); if (kv0 > myq) x0 = -INFINITY; if (kv1 > myq) x1 = -INFINITY; }
                    else { const int d0 = myq - kv0, d1 = myq - kv1; x0 = p0[r] * c2l - slope2 * (float)d0; x1 = p1[r] * c2l - slope2 * (float)d1; if (d0 < 0 || d0 >= 128) x0 = -INFINITY; if (d1 < 0 || d1 >= 128) x1 = -INFINITY; }
                    p0[r] = x0; p1[r] = x1; mx = fmaxf(mx, fmaxf(x0, x1)); }
            }
            mx = swap32_max(mx);
            if (__ballot(mx > m - SKIP_THR)) {
            if (__ballot(mx > m + DEFER_THR)) {
                const float mn = fmaxf(m, mx), alpha = __builtin_amdgcn_exp2f(m - mn); m = mn;
                l *= alpha;
                if (hi == 0) wsc[r32] = alpha;
                LDSWAIT();
#pragma unroll
                for (int g = 0; g < 4; ++g) { const f32x4 a4 = *(const f32x4*)(wsc + 8 * g + 4 * hi);
#pragma unroll
                    for (int i = 0; i < 4; ++i) { o0[4 * g + i] *= a4[i]; o1[4 * g + i] *= a4[i]; } }
                LDSWAIT();
            }
            float ps = 0.f;
#pragma unroll
            for (int r = 0; r < 16; ++r) { p0[r] = __builtin_amdgcn_exp2f(p0[r] - m); p1[r] = __builtin_amdgcn_exp2f(p1[r] - m); ps += p0[r] + p1[r]; }
            l += ps;
#pragma unroll
            for (int s = 0; s < 4; ++s) {
                u32x4 pw;
                if (s < 2) { const int e = 8 * s; pw.x = pk2(p0[e], p0[e + 1]); pw.y = pk2(p0[e + 2], p0[e + 3]); pw.z = pk2(p0[e + 4], p0[e + 5]); pw.w = pk2(p0[e + 6], p0[e + 7]); }
                else { const int e = 8 * (s - 2); pw.x = pk2(p1[e], p1[e + 1]); pw.y = pk2(p1[e + 2], p1[e + 3]); pw.z = pk2(p1[e + 4], p1[e + 5]); pw.w = pk2(p1[e + 6], p1[e + 7]); }
                const bf16x8 pa = __builtin_bit_cast(bf16x8, pw);
#pragma unroll
                for (int db = 0; db < 2; ++db) {
                    const LAS unsigned char* vp = vtr_base + vofs + (16 * s) * 192 + 64 * db;
                    const s16x4 lo = __builtin_bit_cast(s16x4, __builtin_amdgcn_ds_read_tr16_b64_v4i16((LAS s16x4*)vp));
                    const s16x4 hv = __builtin_bit_cast(s16x4, __builtin_amdgcn_ds_read_tr16_b64_v4i16((LAS s16x4*)(vp + 8 * 192)));
                    const bf16x8 vf = (bf16x8){lo[0], lo[1], lo[2], lo[3], hv[0], hv[1], hv[2], hv[3]};
                    if (db == 0) o0 = __builtin_amdgcn_mfma_f32_32x32x16_bf16(pa, vf, o0, 0, 0, 0); else o1 = __builtin_amdgcn_mfma_f32_32x32x16_bf16(pa, vf, o1, 0, 0, 0);
                }
            }
            }
        }
    }
    float lt = swap32_sum(l);
    if (MODE == 1) lt += __builtin_amdgcn_exp2f(sink2 - m);
    const float inv = 1.0f / lt;
    LDSWAIT();
    if (hi == 0) wsc[32 + r32] = inv;
    LDSWAIT();
#pragma unroll
    for (int g = 0; g < 4; ++g) { const f32x4 iv = *(const f32x4*)(wsc + 32 + 8 * g + 4 * hi);
#pragma unroll
        for (int i = 0; i < 4; ++i) { const int r = 4 * g + i, q = qa + 8 * g + 4 * hi + i;
            bf16_t* yp = Yn + (rowbase + q) * 256 + head * 64 + r32;
            yp[0] = (bf16_t)f2bf(o0[r] * iv[i]); yp[32] = (bf16_t)f2bf(o1[r] * iv[i]); } }
    LDSWAIT();
}

__device__ __forceinline__ unsigned score_key(float s) { const unsigned u = __float_as_uint(s + 0.0f); return (u & 0x80000000u) ? ~u : (u | 0x80000000u); }
__device__ __forceinline__ void hist_find(const unsigned* hrow, int lane, unsigned need, unsigned& bin, unsigned& above) {
    unsigned w[16]; unsigned tot = 0;
#pragma unroll
    for (int i = 0; i < 16; i += 4) { const u32x4 t = *(const u32x4*)(hrow + 16 * lane + i); w[i] = t.x; w[i + 1] = t.y; w[i + 2] = t.z; w[i + 3] = t.w; }
#pragma unroll
    for (int i = 0; i < 16; ++i) tot += (w[i] & 0xffffu) + (w[i] >> 16);
    unsigned inc = tot;
#pragma unroll
    for (int o = 1; o < 64; o <<= 1) { const unsigned t = shu(inc, lane + o); if (lane + o < 64) inc += t; }
    const unsigned exc = inc - tot;
    const bool owner = (exc < need) && (inc >= need);
    unsigned run = exc, fb = 0, fa = 0; bool found = false;
#pragma unroll
    for (int i = 15; i >= 0; --i) {
        const unsigned hi = w[i] >> 16, lo = w[i] & 0xffffu;
        if (!found && run + hi >= need) { found = true; fb = 32 * lane + 2 * i + 1; fa = run; }
        run += hi;
        if (!found && run + lo >= need) { found = true; fb = 32 * lane + 2 * i; fa = run; }
        run += lo;
    }
    const unsigned long long bal = __ballot(owner);
    const int src = bal ? (int)__builtin_ctzll(bal) : 0;
    bin = shu(fb, src); above = shu(fa, src);
}
__device__ __forceinline__ void dsa_select_slow(const Args& a, unsigned char* lds, int b, int qb32, int wid_s) {
    const int tid = ftid(wid_s), lane = tid & 63; const int wid = __builtin_amdgcn_readfirstlane(tid >> 6);
    const int c16 = lane & 15, g = lane >> 4;
    const bf16_t* Z = (const bf16_t*)(a.ws + WS_Z); const float* SM = (const float*)(a.ws + WS_SMALL);
    unsigned short* IDX = (unsigned short*)(a.ws + WS_MG);
    unsigned* hist = (unsigned*)lds;
    unsigned char* kt = lds + 131072;
    const size_t rowbase = (size_t)b * SEQ;
    const int t0 = qb32 * 32, myt = t0 + 4 * wid + g;
    const int ntile = (t0 + 32 + 63) >> 6;
    bf16x8 af[2];
    { const int qq = c16 >> 2, h = c16 & 3; const bf16_t* qp = Z + (rowbase + t0 + 4 * wid + qq) * ZW + ZC_DQI + h * 64 + 8 * g;
      af[0] = *(const bf16x8*)qp; af[1] = *(const bf16x8*)(qp + 32); }
    const f32x4 wv = *(const f32x4*)(SM + (rowbase + myt) * 8);
    const unsigned need = (unsigned)((myt + 1) < 256 ? (myt + 1) : 256);
    unsigned b1 = 0, above1 = 0, thr22 = 0, quota = 0;
    unsigned tiecount = 0, outcount = 0;
    unsigned* myhist = hist + (size_t)(4 * wid + g) * 1024;
    unsigned short* myidx = IDX + (rowbase + myt) * 256;
    const int srow = tid >> 3, sch = tid & 7;
    for (int pass = 0; pass < 3; ++pass) {
        if (pass < 2) { unsigned z_ = 0u; asm volatile("" : "+v"(z_)); const u32x4 z4 = {z_, z_, z_, z_};
            for (int i = tid; i < 32 * 1024 / 4; i += 512) ((u32x4*)hist)[i] = z4; }
        for (int T = 0; T < ntile; ++T) {
            __syncthreads();
            *(u32x4*)(kt + srow * 144 + sch * 16) = *(const u32x4*)(Z + (rowbase + 64 * T + srow) * ZW + ZC_DKI + sch * 8);
            __syncthreads();
#pragma unroll
            for (int cg4 = 0; cg4 < 4; ++cg4) {
                const bf16x8 k0 = *(const bf16x8*)(kt + (16 * cg4 + c16) * 144 + (8 * g) * 2);
                const bf16x8 k1 = *(const bf16x8*)(kt + (16 * cg4 + c16) * 144 + (32 + 8 * g) * 2);
                f32x4 acc = {0.f, 0.f, 0.f, 0.f};
                acc = __builtin_amdgcn_mfma_f32_16x16x32_bf16(af[0], k0, acc, 0, 0, 0);
                acc = __builtin_amdgcn_mfma_f32_16x16x32_bf16(af[1], k1, acc, 0, 0, 0);
                const int key = 64 * T + 16 * cg4 + c16;
                const bool valid = key <= myt;
                const float sc = wv[0] * fmaxf(acc[0], 0.f) + wv[1] * fmaxf(acc[1], 0.f) + wv[2] * fmaxf(acc[2], 0.f) + wv[3] * fmaxf(acc[3], 0.f);
                const unsigned u = score_key(sc);
                if (pass == 0) { if (valid) { const unsigned bin = u >> 21; atomicAdd(myhist + (bin >> 1), (bin & 1u) ? 65536u : 1u); } }
                else if (pass == 1) { if (valid && (u >> 21) == b1) { const unsigned bin = (u >> 10) & 0x7ffu; atomicAdd(myhist + (bin >> 1), (bin & 1u) ? 65536u : 1u); } }
                else {
                    const unsigned p22 = u >> 10;
                    const bool tie = valid && (p22 == thr22);
                    const unsigned long long tb = __ballot(tie);
                    const unsigned tmask = (unsigned)(tb >> (16 * g)) & 0xffffu;
                    const bool acc_tie = tie && (tiecount + __popc(tmask & ((1u << c16) - 1u)) < quota);
                    tiecount += __popc(tmask);
                    const bool sel = (valid && p22 > thr22) || acc_tie;
                    const unsigned long long sb = __ballot(sel);
                    const unsigned smask = (unsigned)(sb >> (16 * g)) & 0xffffu;
                    if (sel) myidx[outcount + __popc(smask & ((1u << c16) - 1u))] = (unsigned short)key;
                    outcount += __popc(smask);
                }
            }
        }
        __syncthreads();
        if (pass == 0) {
#pragma unroll
            for (int qq = 0; qq < 4; ++qq) { const unsigned nd = shu(need, 16 * qq); unsigned bn, ab; hist_find(hist + (size_t)(4 * wid + qq) * 1024, lane, nd, bn, ab); if (g == qq) { b1 = bn; above1 = ab; } }
            __syncthreads();
        } else if (pass == 1) {
#pragma unroll
            for (int qq = 0; qq < 4; ++qq) { const unsigned nd = shu(need - above1, 16 * qq); unsigned bn, ab; hist_find(hist + (size_t)(4 * wid + qq) * 1024, lane, nd, bn, ab); if (g == qq) { thr22 = (b1 << 11) | bn; quota = need - above1 - ab; } }
            __syncthreads();
        }
    }
}


#ifndef SELREP
#define SELREP 0
#endif
constexpr int DS_CAP = 576, DS_RANK = 104;
constexpr unsigned ZCLASS = 0x80000000u >> 10;
__device__ __forceinline__ unsigned below_me(unsigned long long bal) { return __builtin_amdgcn_mbcnt_hi((unsigned)(bal >> 32), __builtin_amdgcn_mbcnt_lo((unsigned)bal, 0u)); }
__device__ __forceinline__ float relu1(float x) { return __builtin_amdgcn_fmed3f(x, 0.0f, 3.0e38f); }
template <bool CANON = true>
__device__ __forceinline__ float idx_score_acc(const f32x4& acc, const f32x4& wv) {
    const float s = fmaf(wv[3], relu1(acc[3]), fmaf(wv[2], relu1(acc[2]), fmaf(wv[1], relu1(acc[1]), wv[0] * relu1(acc[0]))));
    return CANON ? s + 0.0f : s;
}
__device__ __forceinline__ unsigned fkey(float s) { const unsigned u = __float_as_uint(s); return (u & 0x80000000u) ? ~u : (u | 0x80000000u); }
__device__ __forceinline__ float key_to_float(unsigned k) { return k == 0u ? -INFINITY : __uint_as_float((k & 0x80000000u) ? (k & 0x7fffffffu) : ~k); }
template <bool CANON = true>
__device__ __forceinline__ void idx_scores8(const unsigned char* kt, int c16, int g, const bf16x8 (&af)[2], const f32x4& wv, float (&u)[8]) {
    bf16x8 kf[8][2];
#pragma unroll
    for (int grp = 0; grp < 8; ++grp) { kf[grp][0] = *(const bf16x8*)(kt + (16 * grp + c16) * 144 + (8 * g) * 2); kf[grp][1] = *(const bf16x8*)(kt + (16 * grp + c16) * 144 + (32 + 8 * g) * 2); }
    __builtin_amdgcn_sched_barrier(0);
    f32x4 acc[8];
#pragma unroll
    for (int grp = 0; grp < 8; ++grp) acc[grp] = __builtin_amdgcn_mfma_f32_16x16x32_bf16(af[0], kf[grp][0], (f32x4){0.f, 0.f, 0.f, 0.f}, 0, 0, 0);
#pragma unroll
    for (int grp = 0; grp < 8; ++grp) acc[grp] = __builtin_amdgcn_mfma_f32_16x16x32_bf16(af[1], kf[grp][1], acc[grp], 0, 0, 0);
    __builtin_amdgcn_sched_barrier(0);
#pragma unroll
    for (int grp = 0; grp < 8; ++grp) u[grp] = idx_score_acc<CANON>(acc[grp], wv);
}
__device__ __forceinline__ unsigned row_scan_incl(unsigned x) {
    x += (unsigned)__builtin_amdgcn_update_dpp(0, (int)x, 0x111, 0xF, 0xF, true);
    x += (unsigned)__builtin_amdgcn_update_dpp(0, (int)x, 0x112, 0xF, 0xF, true);
    x += (unsigned)__builtin_amdgcn_update_dpp(0, (int)x, 0x114, 0xF, 0xF, true);
    x += (unsigned)__builtin_amdgcn_update_dpp(0, (int)x, 0x118, 0xF, 0xF, true);
    return x;
}
__device__ __forceinline__ unsigned wave_total(unsigned x) {
    x = row_scan_incl(x);
    return (unsigned)__builtin_amdgcn_readlane((int)x, 15) + (unsigned)__builtin_amdgcn_readlane((int)x, 31) + (unsigned)__builtin_amdgcn_readlane((int)x, 47) + (unsigned)__builtin_amdgcn_readlane((int)x, 63);
}
__device__ __forceinline__ unsigned wave_max_u(unsigned x) {
    unsigned y;
    y = (unsigned)__builtin_amdgcn_update_dpp(0, (int)x, 0x111, 0xF, 0xF, true); x = x > y ? x : y;
    y = (unsigned)__builtin_amdgcn_update_dpp(0, (int)x, 0x112, 0xF, 0xF, true); x = x > y ? x : y;
    y = (unsigned)__builtin_amdgcn_update_dpp(0, (int)x, 0x114, 0xF, 0xF, true); x = x > y ? x : y;
    y = (unsigned)__builtin_amdgcn_update_dpp(0, (int)x, 0x118, 0xF, 0xF, true); x = x > y ? x : y;
    const unsigned a = (unsigned)__builtin_amdgcn_readlane((int)x, 15), b = (unsigned)__builtin_amdgcn_readlane((int)x, 31), c = (unsigned)__builtin_amdgcn_readlane((int)x, 47), d = (unsigned)__builtin_amdgcn_readlane((int)x, 63);
    const unsigned ab = a > b ? a : b, cd = c > d ? c : d; return ab > cd ? ab : cd;
}
template <bool EDGE, bool NEEDZ>
__device__ __forceinline__ void selB_groups(const float (&sc)[8], int keybase, int myt, float tauf, unsigned need, int lane, int c16, int g, unsigned& cnt, unsigned& zc, unsigned* curow, unsigned char* chrow, unsigned short* zlrow) {
    unsigned hm = 0u;
#pragma unroll
    for (int grp = 0; grp < 8; ++grp) {
        const float s = sc[grp];
        bool h = NEEDZ ? ((s >= tauf) && (s != 0.0f)) : (s >= tauf);
        if (EDGE) h = h && (keybase + 16 * grp + c16 <= myt);
        hm |= h ? (1u << grp) : 0u;
    }
    const unsigned nh = (unsigned)__popc(hm), inc = row_scan_incl(nh);
    unsigned pos = cnt + inc - nh;
    cnt += shu(inc, (lane & 48) | 15);
    unsigned rem = hm;
    while (__ballot(rem != 0u)) {
        if (rem) {
            const int grp = __builtin_ctz(rem); rem &= rem - 1u;
            const float a0 = (grp & 1) ? sc[1] : sc[0], a1 = (grp & 1) ? sc[3] : sc[2], a2 = (grp & 1) ? sc[5] : sc[4], a3 = (grp & 1) ? sc[7] : sc[6];
            const float b0 = (grp & 2) ? a1 : a0, b1 = (grp & 2) ? a3 : a2, s = (grp & 4) ? b1 : b0;
            const int key = keybase + 16 * grp + c16;
            if (pos < (unsigned)DS_CAP) { curow[pos] = (fkey(s) & 0xfffffc00u) | ((unsigned)key & 1023u); chrow[pos] = (unsigned char)(key >> 10); }
            ++pos;
        }
    }
    if (NEEDZ) {
        const unsigned lowm = (1u << c16) - 1u;
#pragma unroll
        for (int grp = 0; grp < 8; ++grp) {
            const int key = keybase + 16 * grp + c16;
            bool isz = sc[grp] == 0.0f;
            if (EDGE) isz = isz && (key <= myt);
            const unsigned zmask = (unsigned)(__ballot(isz) >> (16 * g)) & 0xffffu;
            const unsigned zpos = zc + __popc(zmask & lowm);
            if (isz && zpos < need) zlrow[zpos] = (unsigned short)key;
            zc += __popc(zmask);
        }
    }
}
typedef short s16x2_t __attribute__((ext_vector_type(2)));
template <int NW>
__device__ __forceinline__ void samp_bisect(const unsigned short* samp, int wid, int lane, int ntA, unsigned (&T4)[4]) {
    s16x2_t wb[4][NW];
    unsigned bias = 0x80008000u; asm volatile("" : "+s"(bias));
#pragma unroll
    for (int qq = 0; qq < 4; ++qq) {
        const unsigned* sp = (const unsigned*)(samp + (4 * wid + qq) * 2048) + lane;
#pragma unroll
        for (int j = 0; j < NW; ++j) { unsigned x = sp[64 * j]; if (j >= ntA) x = 0u; wb[qq][j] = __builtin_bit_cast(s16x2_t, x ^ bias); }
    }
    T4[0] = T4[1] = T4[2] = T4[3] = 0u;
    constexpr unsigned LTMAX = 128u * NW - (unsigned)DS_RANK;
#pragma unroll 1
    for (int bit = 15; bit >= 0; --bit) {
        unsigned c[4];
#pragma unroll
        for (int qq = 0; qq < 4; ++qq) { const short cb = (short)((T4[qq] | (1u << bit)) ^ (bias >> 16)); const s16x2_t c2 = {cb, cb}; s16x2_t ac[4] = {{0, 0}, {0, 0}, {0, 0}, {0, 0}};
#pragma unroll
            for (int j = 0; j < NW; ++j) ac[j & 3] -= (__builtin_elementwise_sub_sat(wb[qq][j], c2) >> 15);
            const s16x2_t acc = (ac[0] + ac[1]) + (ac[2] + ac[3]);
            c[qq] = (unsigned)(int)acc.x + (unsigned)(int)acc.y; }
        const unsigned t01 = wave_total(c[0] | (c[1] << 16)), t23 = wave_total(c[2] | (c[3] << 16));
        if ((t01 & 0xffffu) <= LTMAX) T4[0] |= 1u << bit;
        if ((t01 >> 16) <= LTMAX) T4[1] |= 1u << bit;
        if ((t23 & 0xffffu) <= LTMAX) T4[2] |= 1u << bit;
        if ((t23 >> 16) <= LTMAX) T4[3] |= 1u << bit;
    }
}
__device__ __forceinline__ void dsa_select_item(const Args& a, unsigned char* lds, int b, int qb32, int wid_s) {
    const int tid = ftid(wid_s), lane = tid & 63; const int wid = __builtin_amdgcn_readfirstlane(tid >> 6);
    const int c16 = lane & 15, g = lane >> 4;
    const bf16_t* Z = (const bf16_t*)(a.ws + WS_Z); const float* SM = (const float*)(a.ws + WS_SMALL);
    unsigned short* IDX = (unsigned short*)(a.ws + WS_MG);
    unsigned short* samp = (unsigned short*)lds;
    unsigned char* ktA = lds + 131072;
    unsigned* cu = (unsigned*)lds;
    unsigned char* ch = lds + 73728;
    unsigned short* zl = (unsigned short*)(lds + 92160);
    unsigned char* ktB = lds + 108544;
    unsigned* flag = (unsigned*)(lds + 149760);
    const size_t rowbase = (size_t)b * SEQ;
    const int t0 = qb32 * 32, myt = t0 + 4 * wid + g, myrow = 4 * wid + g;
    bf16x8 af[2];
    { const int qq = c16 >> 2, h = c16 & 3; const bf16_t* qp = Z + (rowbase + t0 + 4 * wid + qq) * ZW + ZC_DQI + h * 64 + 8 * g;
      af[0] = *(const bf16x8*)qp; af[1] = *(const bf16x8*)(qp + 32); }
#ifdef PROBE_QTRUNC
    { u32x4 t0_ = __builtin_bit_cast(u32x4, af[0]), t1_ = __builtin_bit_cast(u32x4, af[1]); const unsigned mk = 0xfffcfffcu;
      t0_.x &= mk; t0_.y &= mk; t0_.z &= mk; t0_.w &= mk; t1_.x &= mk; t1_.y &= mk; t1_.z &= mk; t1_.w &= mk; af[0] = __builtin_bit_cast(bf16x8, t0_); af[1] = __builtin_bit_cast(bf16x8, t1_); }
#endif
    const f32x4 wv = *(const f32x4*)(SM + (rowbase + myt) * 8);
    const unsigned need = (unsigned)((myt + 1) < 256 ? (myt + 1) : 256);
    const int srow = tid >> 3, sch = tid & 7;
    __syncthreads();
    if (tid == 0) *flag = 0u;
    unsigned tau = 0u;
    for (int repA_ = 0; repA_ < ((SELREP & 1) ? 2 : 1); ++repA_)
    if (t0 + 32 > DS_CAP) {
        __syncthreads();
        const int ms = (t0 + 32) >> 2, ntA = (ms + 127) >> 7;
        const bf16_t* sbase = Z + (rowbase + 3) * ZW + ZC_DKI + sch * 8;
        u32x4 n0, n1;
        { const int i0 = srow < ms ? srow : ms - 1, i1 = 64 + srow < ms ? 64 + srow : ms - 1;
          n0 = *(const u32x4*)(sbase + (size_t)(4 * i0) * ZW); n1 = *(const u32x4*)(sbase + (size_t)(4 * i1) * ZW); }
        for (int T = 0; T < ntA; ++T) {
            __syncthreads();
            *(u32x4*)(ktA + srow * 144 + sch * 16) = n0; *(u32x4*)(ktA + (64 + srow) * 144 + sch * 16) = n1;
            __syncthreads();
            if (T + 1 < ntA) { const int j0 = 128 * (T + 1) + srow, j1 = j0 + 64; const int i0 = j0 < ms ? j0 : ms - 1, i1 = j1 < ms ? j1 : ms - 1;
                n0 = *(const u32x4*)(sbase + (size_t)(4 * i0) * ZW); n1 = *(const u32x4*)(sbase + (size_t)(4 * i1) * ZW); }
            float ua[8]; idx_scores8(ktA, c16, g, af, wv, ua);
#pragma unroll
            for (int grp = 0; grp < 8; ++grp) {
                const int i = 128 * T + 16 * grp + c16;
                samp[myrow * 2048 + i] = ((i < ms) && (4 * i + 3 <= myt)) ? (unsigned short)(fkey(ua[grp]) >> 16) : (unsigned short)0;
            }
        }
        LDSWAIT();
        const int nvalid = 128 * ntA;
        for (int repS_ = 0; repS_ < ((SELREP & 16) ? 2 : 1); ++repS_) {
            unsigned T4[4];
            if (ntA <= 4) samp_bisect<4>(samp, wid, lane, ntA, T4); else if (ntA <= 8) samp_bisect<8>(samp, wid, lane, ntA, T4);
            else if (ntA <= 12) samp_bisect<12>(samp, wid, lane, ntA, T4); else samp_bisect<16>(samp, wid, lane, ntA, T4);
#pragma unroll
            for (int qq = 0; qq < 4; ++qq) { const int n = t0 + 4 * wid + qq + 1; if (g == qq) tau = n > DS_CAP ? (T4[qq] << 16) : 0u; }
        }
    }
    unsigned cnt = 0u, zc = 0u;
    const float tauf = key_to_float(tau);
    const bool needz = __ballot(tauf <= 0.0f) != 0ull;
    const int ntile = (t0 + 32 + 127) >> 7;
    for (int repB_ = 0; repB_ < ((SELREP & 2) ? 2 : 1); ++repB_) { cnt = 0u; zc = 0u;
        const bf16_t* kbase = Z + (rowbase + srow) * ZW + ZC_DKI + sch * 8;
        u32x4 n0 = *(const u32x4*)kbase, n1 = *(const u32x4*)(kbase + (size_t)64 * ZW);
        __syncthreads();
        *(u32x4*)(ktB + srow * 144 + sch * 16) = n0; *(u32x4*)(ktB + (64 + srow) * 144 + sch * 16) = n1;
        __syncthreads();
#define SELB_BOOK(u_, Ts) do { \
            if (128 * (Ts) + 127 <= t0) { if (needz) selB_groups<false, true>(u_, 128 * (Ts), myt, tauf, need, lane, c16, g, cnt, zc, cu + myrow * DS_CAP, ch + myrow * DS_CAP, zl + myrow * 256); \
                                        else selB_groups<false, false>(u_, 128 * (Ts), myt, tauf, need, lane, c16, g, cnt, zc, cu + myrow * DS_CAP, ch + myrow * DS_CAP, zl + myrow * 256); } \
            else { if (needz) selB_groups<true, true>(u_, 128 * (Ts), myt, tauf, need, lane, c16, g, cnt, zc, cu + myrow * DS_CAP, ch + myrow * DS_CAP, zl + myrow * 256); \
                   else selB_groups<true, false>(u_, 128 * (Ts), myt, tauf, need, lane, c16, g, cnt, zc, cu + myrow * DS_CAP, ch + myrow * DS_CAP, zl + myrow * 256); } } while (0)
#define SELB_STAGE(T) do { if ((T) + 1 < ntile) { unsigned char* kn = ktB + (((T) + 1) & 1) * 18432; *(u32x4*)(kn + srow * 144 + sch * 16) = n0; *(u32x4*)(kn + (64 + srow) * 144 + sch * 16) = n1; } } while (0)
#define SELB_FETCH(T) do { if ((T) + 1 < ntile) { const bf16_t* src = kbase + (size_t)(128 * ((T) + 1)) * ZW; n0 = *(const u32x4*)src; n1 = *(const u32x4*)(src + (size_t)64 * ZW); } } while (0)
        if (wid < 4) {
#pragma unroll 1
            for (int T = 0; T < ntile; ++T) {
                SELB_FETCH(T);
                float ub[8]; idx_scores8<false>(ktB + (T & 1) * 18432, c16, g, af, wv, ub);
                SELB_BOOK(ub, T);
                SELB_STAGE(T);
                __syncthreads();
            }
        } else {
#pragma unroll 1
            for (int T = 0; T < ntile; ++T) {
                SELB_FETCH(T);
                float ub[8]; idx_scores8<false>(ktB + (T & 1) * 18432, c16, g, af, wv, ub);
                SELB_STAGE(T);
                __syncthreads();
                SELB_BOOK(ub, T);
            }
        }
    }
#if SELREP & 8
    {
        float dummy = 0.f;
        const bf16_t* kbase = Z + (rowbase + srow) * ZW + ZC_DKI + sch * 8;
        u32x4 n0 = *(const u32x4*)kbase, n1 = *(const u32x4*)(kbase + (size_t)64 * ZW);
        __syncthreads();
        *(u32x4*)(ktB + srow * 144 + sch * 16) = n0; *(u32x4*)(ktB + (64 + srow) * 144 + sch * 16) = n1;
        __syncthreads();
        for (int T = 0; T < ntile; ++T) {
            const unsigned char* kt = ktB + (T & 1) * 18432;
            if (T + 1 < ntile) { const bf16_t* src = kbase + (size_t)(128 * (T + 1)) * ZW; n0 = *(const u32x4*)src; n1 = *(const u32x4*)(src + (size_t)64 * ZW); }
            float ub[8]; idx_scores8(kt, c16, g, af, wv, ub);
#pragma unroll
            for (int grp = 0; grp < 8; ++grp) dummy += ub[grp];
            if (T + 1 < ntile) { unsigned char* kn = ktB + ((T + 1) & 1) * 18432; *(u32x4*)(kn + srow * 144 + sch * 16) = n0; *(u32x4*)(kn + (64 + srow) * 144 + sch * 16) = n1; }
            __syncthreads();
        }
        if (dummy == 123456.789f) *flag = 2u;
    }
#endif
    LDSWAIT();
    bool bad = false;
    for (int repC_ = 0; repC_ < ((SELREP & 4) ? 2 : 1); ++repC_) {
        unsigned ncq[4], ndq[4], nzq[4], uj[4][9], T4[4]; int topb[4];
#pragma unroll
        for (int qq = 0; qq < 4; ++qq) {
            ncq[qq] = (unsigned)__builtin_amdgcn_readlane((int)cnt, 16 * qq); ndq[qq] = (unsigned)__builtin_amdgcn_readlane((int)need, 16 * qq); nzq[qq] = (unsigned)__builtin_amdgcn_readlane((int)zc, 16 * qq);
            const unsigned ncl = ncq[qq] < (unsigned)DS_CAP ? ncq[qq] : (unsigned)DS_CAP;
            unsigned hi = 0u, lo = 0u;
#pragma unroll
            for (int j = 0; j < 9; ++j) { const unsigned pos = lane + 64 * j; const bool in = pos < ncl; uj[qq][j] = in ? (cu[(4 * wid + qq) * DS_CAP + pos] >> 10) : 0u;
                hi = hi > uj[qq][j] ? hi : uj[qq][j]; const unsigned x = in ? ~uj[qq][j] : 0u; lo = lo > x ? lo : x; }
            hi = wave_max_u(hi); lo = ~wave_max_u(lo);
            if (ncl == 0u) lo = hi;
            if (nzq[qq]) { hi = hi > ZCLASS ? hi : ZCLASS; lo = lo < ZCLASS ? lo : ZCLASS; }
            topb[qq] = (hi ^ lo) ? 31 - __builtin_clz(hi ^ lo) : -1;
            T4[qq] = topb[qq] >= 0 ? (hi & ~((2u << topb[qq]) - 1u)) : hi;
        }
#pragma unroll 1
        for (int bit = ((SELREP & 32) && repC_ == 0) ? -1 : 21; bit >= 0; --bit) {
            unsigned c[4];
#pragma unroll
            for (int qq = 0; qq < 4; ++qq) { const unsigned cand = T4[qq] | (1u << bit); unsigned cc = 0;
#pragma unroll
                for (int j = 0; j < 9; ++j) cc += uj[qq][j] >= cand ? 1u : 0u;
                c[qq] = cc; }
            const unsigned t01 = wave_total(c[0] | (c[1] << 16)), t23 = wave_total(c[2] | (c[3] << 16));
            const unsigned tq[4] = {t01 & 0xffffu, t01 >> 16, t23 & 0xffffu, t23 >> 16};
#pragma unroll
            for (int qq = 0; qq < 4; ++qq) { const unsigned cand = T4[qq] | (1u << bit);
                if (bit <= topb[qq] && tq[qq] + (cand <= ZCLASS ? nzq[qq] : 0u) >= ndq[qq]) T4[qq] = cand; }
        }
#pragma unroll 1
        for (int qq = ((SELREP & 64) && repC_ == 0) ? 4 : 0; qq < 4; ++qq) {
            const unsigned nc = ncq[qq], nd = ndq[qq], nz = nzq[qq], T = T4[qq];
            if (nc + nz < nd || nc > (unsigned)DS_CAP) { bad = true;
#ifdef NOFALLBACK
                { unsigned short* orow = IDX + (rowbase + t0 + 4 * wid + qq) * 256;
                  for (int j = 0; j < 4; ++j) if ((unsigned)(lane + 64 * j) < nd) orow[lane + 64 * j] = (unsigned short)(lane + 64 * j); }
#endif
                continue; }
            const int row = 4 * wid + qq;
            unsigned ujr[9], kj[9]; int ca = T < ZCLASS ? (int)nz : 0, nt = 0;
#pragma unroll
            for (int j = 0; j < 9; ++j) { const unsigned pos = lane + 64 * j; const unsigned cwj = pos < nc ? cu[row * DS_CAP + pos] : 0u; ujr[j] = cwj >> 10;
                kj[j] = pos < nc ? ((cwj & 1023u) | ((unsigned)ch[row * DS_CAP + pos] << 10)) : 0u;
                ca += __popcll(__ballot(ujr[j] > T)); nt += __popcll(__ballot(ujr[j] == T)); }
            const unsigned quota = nd - (unsigned)ca;
            unsigned Kstar = 0xffffu;
            if (T != ZCLASS && (unsigned)nt > quota) {
                unsigned K = 0u;
#pragma unroll 1
                for (int bit = 12; bit >= 0; --bit) { const unsigned test = K | (1u << bit); int c = 0;
#pragma unroll
                    for (int j = 0; j < 9; ++j) c += __popcll(__ballot(ujr[j] == T && kj[j] < test));
                    if ((unsigned)c < quota) K = test; }
                Kstar = K;
            }
            unsigned outbase = 0u;
            unsigned short* orow = IDX + (rowbase + t0 + row) * 256;
#pragma unroll
            for (int j = 0; j < 9; ++j) {
                const bool s = (ujr[j] > T) || (ujr[j] == T && kj[j] <= Kstar);
                const unsigned long long sb = __ballot(s);
                if (s) orow[outbase + below_me(sb)] = (unsigned short)kj[j];
                outbase += (unsigned)__popcll(sb);
            }
            const unsigned zsel = T < ZCLASS ? nz : (T == ZCLASS ? quota : 0u);
            for (unsigned i = lane; i < zsel; i += 64) orow[outbase + i] = zl[row * 256 + i];
        }
    }
    if (bad && lane == 0) atomicOr(flag, 1u);
    __syncthreads();
    const bool redo = *flag != 0u;
    __syncthreads();
#ifndef NOFALLBACK
    if (redo) dsa_select_slow(a, lds, b, qb32, wid_s);
#endif
}

constexpr int DA_WAVE_LDS = 512 + 64 * 160;
__device__ __forceinline__ void dsa_attend_wave(const Args& a, int ra, int rb, int lane, unsigned char* wl) {
    const bf16_t* Z = (const bf16_t*)(a.ws + WS_Z); const unsigned short* IDXB = (const unsigned short*)(a.ws + WS_MG);
    bf16_t* Y1 = (bf16_t*)(a.ws + WS_H) + (size_t)MROWS * 256;
    const int c16 = lane & 15, g = lane >> 4, vr = lane >> 3, vc = lane & 7;
    unsigned short* il = (unsigned short*)wl; unsigned char* vl = wl + 512;
    const float slope2 = LOG2E * __builtin_amdgcn_exp2f(-(float)(5 + (c16 & 3)));
    const LAS unsigned char* vtr = (const LAS unsigned char*)vl + (4 * g + (c16 >> 2)) * 160 + (4 * (c16 & 3)) * 2;
    float c2l = C2; asm volatile("" : "+v"(c2l));
    u32x2 iw = {0u, 0u};
    iw = *(const u32x2*)(IDXB + (size_t)ra * 256 + 4 * lane);
#pragma unroll 1
    for (int qi = 0; qi < 8; ++qi) { const int row = qi < 4 ? ra + qi : rb + qi - 4, nrow = qi + 1 < 4 ? ra + qi + 1 : rb + qi - 3;
        const int t = row & (SEQ - 1); const size_t rowbase = (size_t)(row - t);
        const int nsel = (t + 1) < 256 ? (t + 1) : 256;
        { u32x2 w = iw; const int p0 = 4 * lane;
          if (p0 >= nsel) w.x &= 0xffff0000u; if (p0 + 1 >= nsel) w.x &= 0x0000ffffu; if (p0 + 2 >= nsel) w.y &= 0xffff0000u; if (p0 + 3 >= nsel) w.y &= 0x0000ffffu;
          *(u32x2*)(il + 4 * lane) = w; }
        if (qi + 1 < 8) iw = *(const u32x2*)(IDXB + (size_t)nrow * 256 + 4 * lane);
        LDSWAIT();
        u32x4 v[8];
        const bf16_t* vb = Z + rowbase * ZW + ZC_DV + 8 * vc;
        const bf16_t* kb8 = Z + rowbase * ZW + ZC_DK + 8 * vc;
#pragma unroll
        for (int i = 0; i < 8; ++i) v[i] = *(const u32x4*)(kb8 + (size_t)il[8 * i + vr] * ZW);
        bf16x8 qf[2];
        { const bf16_t* qp = Z + (size_t)row * ZW + ZC_DQ + (c16 & 3) * 64 + 8 * g; const bf16x8 z8 = {0, 0, 0, 0, 0, 0, 0, 0};
          qf[0] = c16 < 4 ? *(const bf16x8*)qp : z8; qf[1] = c16 < 4 ? *(const bf16x8*)(qp + 32) : z8; }
        f32x4 s[16];
#pragma unroll
        for (int ch = 0; ch < 4; ++ch) {
            if (64 * ch < nsel) {
#pragma unroll
                for (int i = 0; i < 8; ++i) *(u32x4*)(vl + (8 * i + vr) * 144 + 16 * vc) = v[i];
                if (ch < 3 && 64 * (ch + 1) < nsel) {
#pragma unroll
                    for (int i = 0; i < 8; ++i) v[i] = *(const u32x4*)(kb8 + (size_t)il[64 * (ch + 1) + 8 * i + vr] * ZW);
                } else {
#pragma unroll
                    for (int i = 0; i < 8; ++i) v[i] = *(const u32x4*)(vb + (size_t)il[8 * i + vr] * ZW);
                }
                LDSWAIT();
#pragma unroll
                for (int tt = 0; tt < 4; ++tt) {
                    const bf16x8 k0 = *(const bf16x8*)(vl + (16 * tt + c16) * 144 + (8 * g) * 2), k1 = *(const bf16x8*)(vl + (16 * tt + c16) * 144 + (32 + 8 * g) * 2);
                    f32x4 acc = {0.f, 0.f, 0.f, 0.f};
                    acc = __builtin_amdgcn_mfma_f32_16x16x32_bf16(k0, qf[0], acc, 0, 0, 0);
                    acc = __builtin_amdgcn_mfma_f32_16x16x32_bf16(k1, qf[1], acc, 0, 0, 0);
                    s[4 * ch + tt] = acc; }
                asm volatile("" ::: "memory");
            } else {
#pragma unroll
                for (int tt = 0; tt < 4; ++tt) s[4 * ch + tt] = (f32x4){0.f, 0.f, 0.f, 0.f};
            }
        }
        float mx = -INFINITY;
#pragma unroll
        for (int kb = 0; kb < 16; ++kb) {
            const u32x2 kw = *(const u32x2*)(il + 16 * kb + 4 * g); const int p0 = 16 * kb + 4 * g;
            const int k0 = kw.x & 0xffff, k1 = kw.x >> 16, k2 = kw.y & 0xffff, k3 = kw.y >> 16;
            s[kb][0] = p0 < nsel ? s[kb][0] * c2l - slope2 * (float)(t - k0) : -INFINITY;
            s[kb][1] = p0 + 1 < nsel ? s[kb][1] * c2l - slope2 * (float)(t - k1) : -INFINITY;
            s[kb][2] = p0 + 2 < nsel ? s[kb][2] * c2l - slope2 * (float)(t - k2) : -INFINITY;
            s[kb][3] = p0 + 3 < nsel ? s[kb][3] * c2l - slope2 * (float)(t - k3) : -INFINITY;
            mx = fmaxf(fmaxf(mx, fmaxf(s[kb][0], s[kb][1])), fmaxf(s[kb][2], s[kb][3]));
        }
        mx = fmaxf(mx, shf(mx, lane ^ 16)); mx = fmaxf(mx, shf(mx, lane ^ 32));
        float ls = 0.f;
#pragma unroll
        for (int kb = 0; kb < 16; ++kb) {
#pragma unroll
            for (int r = 0; r < 4; ++r) { s[kb][r] = __builtin_amdgcn_exp2f(s[kb][r] - mx); ls += s[kb][r]; } }
        ls += shf(ls, lane ^ 16); ls += shf(ls, lane ^ 32);
        f32x4 o[4];
#pragma unroll
        for (int db = 0; db < 4; ++db) o[db] = (f32x4){0.f, 0.f, 0.f, 0.f};
#pragma unroll
        for (int ch = 0; ch < 4; ++ch) {
            if (64 * ch < nsel) {
#pragma unroll
                for (int i = 0; i < 8; ++i) *(u32x4*)(vl + (8 * i + vr) * 160 + 16 * vc) = v[i];
                if (ch < 3 && 64 * (ch + 1) < nsel) {
#pragma unroll
                    for (int i = 0; i < 8; ++i) v[i] = *(const u32x4*)(vb + (size_t)il[64 * (ch + 1) + 8 * i + vr] * ZW);
                }
                LDSWAIT();
#pragma unroll
                for (int s2 = 0; s2 < 2; ++s2) {
                    const f32x4 pa4 = s[4 * ch + 2 * s2], pb4 = s[4 * ch + 2 * s2 + 1];
                    u32x4 pw; pw.x = pk2(pa4[0], pa4[1]); pw.y = pk2(pa4[2], pa4[3]); pw.z = pk2(pb4[0], pb4[1]); pw.w = pk2(pb4[2], pb4[3]);
                    const bf16x8 pa = __builtin_bit_cast(bf16x8, pw);
#pragma unroll
                    for (int db = 0; db < 4; ++db) {
                        const LAS unsigned char* vp = vtr + (32 * s2) * 160 + 32 * db;
                        const s16x4 lo = __builtin_bit_cast(s16x4, __builtin_amdgcn_ds_read_tr16_b64_v4i16((LAS s16x4*)vp));
                        const s16x4 hv = __builtin_bit_cast(s16x4, __builtin_amdgcn_ds_read_tr16_b64_v4i16((LAS s16x4*)(vp + 16 * 160)));
                        const bf16x8 vf = (bf16x8){lo[0], lo[1], lo[2], lo[3], hv[0], hv[1], hv[2], hv[3]};
                        o[db] = __builtin_amdgcn_mfma_f32_16x16x32_bf16(pa, vf, o[db], 0, 0, 0);
                    }
                }
                asm volatile("" ::: "memory");
            }
        }
        const int lsi = __float_as_int(ls);
        const float i0 = 1.0f / __int_as_float(__builtin_amdgcn_readlane(lsi, 0)), i1 = 1.0f / __int_as_float(__builtin_amdgcn_readlane(lsi, 1)), i2 = 1.0f / __int_as_float(__builtin_amdgcn_readlane(lsi, 2)), i3 = 1.0f / __int_as_float(__builtin_amdgcn_readlane(lsi, 3));
        if (g == 0) { bf16_t* yp = Y1 + (size_t)row * 256 + c16;
#pragma unroll
            for (int db = 0; db < 4; ++db) { yp[0 * 64 + 16 * db] = (bf16_t)f2bf(o[db][0] * i0); yp[1 * 64 + 16 * db] = (bf16_t)f2bf(o[db][1] * i1); yp[2 * 64 + 16 * db] = (bf16_t)f2bf(o[db][2] * i2); yp[3 * 64 + 16 * db] = (bf16_t)f2bf(o[db][3] * i3); } }
        LDSWAIT();
    }
}


#ifndef PHMASK
#define PHMASK 0xffff
#endif
#ifndef DUPMASK
#define DUPMASK 0
#endif
#ifndef DUPN
#define DUPN 2
#endif
#ifndef MERGE_SP2
#define MERGE_SP2 true
#endif
#ifndef G8_SP2
#define G8_SP2 false
#endif
#ifndef EXTRASYNC
#define EXTRASYNC 0
#endif
typedef __attribute__((address_space(1))) unsigned gu32;
#define XB_TMO      128
#define XB_XCNT(j)  (256  + 64 * (j))
#define XB_XSUB(j)  (1280 + 64 * (j))
#define XB_XGEN(j)  (2304 + 64 * (j))
#define XB_TOP      3328
#define XB_TOPGEN   3392
#define XCD_BAR_WORDS 3456
#define XB_GMASK(j) (3520 + 64 * (j))
#define XB_GSUB(j)  (4096 + 64 * (j))
#define XB_GGEN(j)  (4672 + 64 * (j))
#define XB_SPIN_CAP (1u << 18)

__device__ __forceinline__ unsigned xb_ld(unsigned* p)              { return __hip_atomic_load(p, __ATOMIC_RELAXED, __HIP_MEMORY_SCOPE_AGENT); }
__device__ __forceinline__ unsigned xb_add(unsigned* p, unsigned v) { return __hip_atomic_fetch_add(p, v, __ATOMIC_RELAXED, __HIP_MEMORY_SCOPE_AGENT); }
__device__ __forceinline__ unsigned xb_xcc_id() { return (unsigned)__builtin_amdgcn_s_getreg((3 << 11) | 20) & 0xFu; }
#define XB_SPIN(cond, bar) do { unsigned _sp = 0; while (cond) { __builtin_amdgcn_s_sleep(1); \
    if ((++_sp & 255u) == 0u) { if (xb_ld(&(bar)[XB_TMO])) break; if (_sp > XB_SPIN_CAP) { atomicAdd(&(bar)[XB_TMO], 1u); break; } } } } while (0)

struct XcdBarrier {
    unsigned* bar; unsigned x; int w;
    volatile LAS unsigned* st;
};

__device__ __forceinline__ bool xb_first_lane(int w) { unsigned ones = ~0u; asm volatile("" : "+s"(ones)); return w == 0 && __builtin_amdgcn_mbcnt_hi(ones, __builtin_amdgcn_mbcnt_lo(ones, 0u)) == 0u; }
__device__ __forceinline__ XcdBarrier xcd_barrier_post(unsigned* bar, volatile LAS unsigned* st, int w) {
    XcdBarrier b; b.bar = bar; b.x = xb_xcc_id(); b.st = st; b.w = w;
    if (xb_first_lane(w)) { (void)xb_add(&bar[XB_XCNT(b.x)], 1u); (void)__hip_atomic_fetch_or(&bar[XB_GMASK(blockIdx.x & 7u)], 1u << b.x, __ATOMIC_RELAXED, __HIP_MEMORY_SCOPE_AGENT); }
    return b;
}
__device__ __forceinline__ void xcd_barrier_complete(unsigned* bar, unsigned x, unsigned& nloc, unsigned& nx) {
    const unsigned G = gridDim.x * gridDim.y * gridDim.z;
    unsigned sum, cnt, mine, sp = 0u;
    for (;;) {
        sum = 0u; cnt = 0u; mine = 0u;
#pragma unroll
        for (unsigned j = 0; j < 16; ++j) { const unsigned c = xb_ld(&bar[XB_XCNT(j)]); sum += c; cnt += (c > 0u) ? 1u : 0u; mine = (j == x) ? c : mine; }
        if (sum == G) break;
        __builtin_amdgcn_s_sleep(1);
        if ((++sp & 255u) == 0u) { if (xb_ld(&bar[XB_TMO])) break; if (sp > XB_SPIN_CAP) { atomicAdd(&bar[XB_TMO], 1u); break; } }
    }
    nloc = mine > 0u ? mine : 1u; nx = cnt > 0u ? cnt : 1u;
}

__device__ __forceinline__ void xcd_barrier(const XcdBarrier& b) {
    asm volatile("s_waitcnt vmcnt(0)" ::: "memory");
    __syncthreads();
    if (xb_first_lane(b.w)) {
        unsigned* bar = b.bar;
        __builtin_amdgcn_s_waitcnt(0);
        unsigned nloc = b.st[0], nx = b.st[1];
        if (nloc == 0u) { xcd_barrier_complete(bar, b.x, nloc, nx); b.st[0] = nloc; b.st[1] = nx; }
        const unsigned old = xb_add(&bar[XB_XSUB(b.x)], 1u);
        const unsigned gen = old / nloc;
        if (old + 1u == (gen + 1u) * nloc) {
            __builtin_amdgcn_fence(__ATOMIC_RELEASE, "agent");
            asm volatile("s_waitcnt vmcnt(0)" ::: "memory");
            const unsigned og = xb_add(&bar[XB_TOP], 1u);
            const unsigned tg = og / nx;
            if (og + 1u == (tg + 1u) * nx) xb_add(&bar[XB_TOPGEN], 1u);
            else XB_SPIN(xb_ld(&bar[XB_TOPGEN]) == tg, bar);
            __builtin_amdgcn_fence(__ATOMIC_ACQUIRE, "agent");
            xb_add(&bar[XB_XGEN(b.x)], 1u);
            asm volatile("s_waitcnt vmcnt(0)" ::: "memory");
        } else {
            asm volatile("buffer_inv sc1" ::: "memory");
            XB_SPIN(xb_ld(&bar[XB_XGEN(b.x)]) == gen, bar);
            asm volatile("s_waitcnt vmcnt(0)" ::: "memory");
        }
    }
    __syncthreads();
}

__device__ __forceinline__ void xcd_group_sync(const XcdBarrier& b) {
    asm volatile("s_waitcnt vmcnt(0)" ::: "memory");
    __syncthreads();
    if (xb_first_lane(b.w)) {
        unsigned* bar = b.bar; const unsigned j = blockIdx.x & 7u;
        const unsigned old = xb_add(&bar[XB_GSUB(j)], 1u), gen = old >> 5;
        asm volatile("buffer_inv sc1" ::: "memory");
        if (old + 1u == (gen + 1u) << 5) xb_add(&bar[XB_GGEN(j)], 1u);
        else XB_SPIN(xb_ld(&bar[XB_GGEN(j)]) == gen, bar);
        asm volatile("s_waitcnt vmcnt(0)" ::: "memory");
    }
    __syncthreads();
}
__device__ __forceinline__ void xcd_group_check(const XcdBarrier& b) {
    if (xb_first_lane(b.w)) { bool ok = gridDim.x == 256u;
#pragma unroll
        for (unsigned j = 0; j < 8; ++j) { const unsigned m = xb_ld(&b.bar[XB_GMASK(j)]); ok = ok && m != 0u && (m & (m - 1u)) == 0u; }
        b.st[2] = ok ? 1u : 0u; }
    __syncthreads();
}
#define XSYNC() do { if (bar.st[2]) xcd_group_sync(bar); else xcd_barrier(bar); } while (0)
constexpr size_t WS_BAR = 16384;
constexpr int LDS_BARST = LDS_BYTES - 16;
#define GRID_SYNC() xcd_barrier(bar)
typedef const __attribute__((address_space(4))) Args* kargs_ptr;
__device__ __forceinline__ Args fresh_args() {
#if defined(__HIP_DEVICE_COMPILE__)
    kargs_ptr p = (kargs_ptr)__builtin_amdgcn_kernarg_segment_ptr(); asm volatile("" : "+s"(p)); return *p;
#else
    return Args{};
#endif
}
#define FRESH() const int tid = ftid(wid_s), lane = tid & 63, wid = __builtin_amdgcn_readfirstlane(tid >> 6), gw = blockIdx.x * 8 + wid, NGW = gridDim.x * 8; (void)lane; (void)gw; (void)NGW
#define WSP(T, off) ((T*)(a.ws + (off)))
__global__ void __launch_bounds__(512, 2) mega(Args a_unused) {
    extern __shared__ __attribute__((aligned(16))) unsigned char lds[];
    PG8_LAS unsigned char* lds3 = (PG8_LAS unsigned char*)lds;
    const int wid_s = __builtin_amdgcn_readfirstlane(threadIdx.x >> 6);
    if (threadIdx.x < 4) ((volatile LAS unsigned*)(lds3 + LDS_BARST))[threadIdx.x] = 0u;
    __syncthreads();
    XcdBarrier bar; { const Args a0 = fresh_args(); bar = xcd_barrier_post((unsigned*)(a0.ws + WS_BAR), (volatile LAS unsigned*)(lds3 + LDS_BARST), wid_s); }

#pragma unroll 1
    for (int l = 0; l <= DEPTH; ++l) {
        { const Args a = fresh_args();
          if (l == 0) { const int t_ = ftid(wid_s); if (blockIdx.x == 0 && t_ < 16) WSP(unsigned, WS_KMAX)[t_] = 0u; ada_gemv(a, lds, wid_s); }
          else { const int lp = l - 1;
        { const Args a = fresh_args(); FRESH(); const float* ng = a.norm_g + (size_t)lp * 4 * D;
          for (int row = gw * 8; row < MROWS; row += NGW * 8) { const int b = row >> 13; const float* md = WSP(float, WS_MOD) + (size_t)(lp * 2 + b) * NMOD;
            const float* mdn = WSP(float, WS_MOD) + (size_t)((lp + 1) * 2 + b) * NMOD; const float* ngn = a.norm_g + (size_t)(lp + 1) * 4 * D;
            const bf16_t* x1g = WSP(bf16_t, WS_G) + (size_t)row * D; bf16_t* hr = WSP(bf16_t, WS_H) + (size_t)row * D;
            if (lp + 1 < DEPTH) row_pass8<true, true, true, true, true>(x1g, hr, (bf16_t*)a.out + (size_t)row * D, hr, WSP(unsigned char, WS_MG) + (size_t)row * D, md + 5 * D, ng + 3 * D, ngn, mdn + 1 * D, mdn + 0 * D, lane);
            else row_pass8<true, false, true, false>(x1g, hr, a.out + (size_t)row * D, nullptr, nullptr, md + 5 * D, ng + 3 * D, nullptr, nullptr, nullptr, lane); }
        }
          }
          if (l < DEPTH) convert_weights(a, l, lds, wid_s); }
        if (l == DEPTH) break;
        GRID_SYNC();
        if (l == 0) { xcd_group_check(bar);
    { const Args a = fresh_args(); FRESH();
      const int rw0 = gridDim.x == 256u ? (int)(2048u * (blockIdx.x & 7u) + 64u * (blockIdx.x >> 3)) + 8 * wid : gw * 8, rwstep = gridDim.x == 256u ? MROWS : NGW * 8;
      for (int row = rw0; row < MROWS; row += rwstep) { const int b = row >> 13; const float* md = WSP(float, WS_MOD) + (size_t)(0 * 2 + b) * NMOD;
        row_pass8<false, true, false, false, true>(a.x + (size_t)row * D, nullptr, nullptr, WSP(bf16_t, WS_H) + (size_t)row * D, WSP(unsigned char, WS_MG) + (size_t)row * D, nullptr, nullptr, a.norm_g + 0 * D, md + 1 * D, md + 0 * D, lane); } }
        XSYNC();
        }
        for (int es_ = 0; es_ < EXTRASYNC; ++es_) GRID_SYNC();
#if PHMASK & 4
    for (int rep_ = 0; rep_ < ((DUPMASK & 4) ? DUPN : 1); ++rep_) { if (rep_) GRID_SYNC();
        { const Args a = fresh_args(); const int G = gridDim.x, bid = blockIdx.x;
          { pg8::Gemm g{WSP(bf16_t, WS_MG), WSP(bf16_t, WS_WG8), MROWS, 4 * D, D}; pg8::StaticOrder S; S.init(MROWS, 4 * D, G, bid);
            pg8::EpiG E{WSP(unsigned char, WS_G)};
            pg8::gemm_phase<pg8::EpiG, pg8::StaticOrder, true, G8_SP2, true>(lds3, g, S, E, wid_s); }
          { pg8::Gemm g{WSP(bf16_t, WS_H), WSP(bf16_t, WS_W1T), MROWS, 2816, D}; pg8::StaticOrder S; S.init(MROWS, 2816, G, (bid + 64) % G);
            pg8::EpiZ E{WSP(bf16_t, WS_Z), WSP(float, WS_SMALL), WSP(unsigned char, WS_G)};
            pg8::gemm_phase<pg8::EpiZ, pg8::StaticOrder, true, true>(lds3, g, S, E, wid_s); } }
    }
#endif
        GRID_SYNC();
#if PHMASK & 8
    for (int rep_ = 0; rep_ < ((DUPMASK & 8) ? DUPN : 1); ++rep_) { if (rep_) GRID_SYNC();
        { const Args a = fresh_args(); const int G = gridDim.x, bid = blockIdx.x;
          unsigned* fflag = WSP(unsigned, 8192) + l * 16;
          if (bid < 8) { fox_scan(a, l, bid, lds, wid_s); fox_publish(fflag, wid_s); }
          for (int it = bid - 8; it >= 0 && it < 64; it += G) { fox_kmax_item(a, l, it, wid_s); fox_publish(fflag, wid_s); }
          conv_phase(a, l, wid_s);
          for (int u = bid; u < 256; u += G) { const int b = u >> 7, head = (u >> 5) & 3, qb = u & 31;
            const float slope2 = LOG2E * __builtin_amdgcn_exp2f(-(float)(1 + head)), sink2 = LOG2E * a.swa_sinks[l * 4 + head];
            const int q0 = qb * 256, tlo = q0 >= 128 ? ((q0 - 127) >> 6) : 0;
            attn_unit<1>(lds, WSP(bf16_t, WS_Z), WSP(bf16_t, WS_H) + (size_t)3 * MROWS * 256, b, head, qb, nullptr, slope2, sink2, tlo, 0.f, wid_s); } }
    }
#endif
        __syncthreads();
#if PHMASK & 16
    for (int rep_ = 0; rep_ < ((DUPMASK & 16) ? DUPN : 1); ++rep_) { if (rep_) GRID_SYNC();
        { const Args a = fresh_args(); const int G = gridDim.x, bid = blockIdx.x;
#pragma unroll 1
          for (int u2 = 2 * bid; u2 < 512; u2 += 2 * G) { const int b = (u2 >> 1) & 1, j = u2 >> 2;
#pragma unroll 1
            for (int k = 0; k < 2; ++k) dsa_select_item(a, lds, b, k ? 255 - j : j, wid_s); } }
    }
#endif
        { const Args a = fresh_args(); const int G = gridDim.x, bid = blockIdx.x;
          fox_await(WSP(unsigned, 8192) + l * 16, 72u, wid_s);
          for (int u = bid; u < 256; u += G) { const int b = u >> 7, head = (u >> 5) & 3, qb = u & 31;
            attn_unit<0>(lds, WSP(bf16_t, WS_Z), WSP(bf16_t, WS_H) + (size_t)2 * MROWS * 256, b, head, qb, WSP(const float, WS_FCUM), 0.f, 0.f, 0, sqrtf(__uint_as_float(WSP(const unsigned, WS_KMAX)[l * 8 + b * 4 + head])), wid_s); } }
        { const Args a = fresh_args(); FRESH(); __syncthreads();
          for (int u2 = 2 * (int)blockIdx.x; u2 < 512; u2 += 2 * (int)gridDim.x) { const int b = (u2 >> 1) & 1, j = u2 >> 2;
            dsa_attend_wave(a, b * SEQ + 32 * j + 4 * wid, b * SEQ + 32 * (255 - j) + 4 * wid, lane, lds + wid * DA_WAVE_LDS); }
          __syncthreads(); }
        GRID_SYNC();
#if PHMASK & 128
    for (int rep_ = 0; rep_ < ((DUPMASK & 128) ? DUPN : 1); ++rep_) { if (rep_) GRID_SYNC();
        { const Args a = fresh_args(); const int G = gridDim.x, bid = blockIdx.x;
          int kmerge = 256; asm volatile("" : "+s"(kmerge));
          pg8::Gemm g{WSP(bf16_t, WS_H), WSP(bf16_t, WS_WBT), 4 * MROWS, 4 * D, kmerge}; pg8::MergeOrder2 S{G, bid};
          pg8::EpiMerge2 E{WSP(bf16_t, WS_MG), WSP(unsigned char, WS_G)}; E.zero();
          pg8::gemm_phase<pg8::EpiMerge2, pg8::MergeOrder2, true, MERGE_SP2, false, true>(lds3, g, S, E, wid_s); }
    }
#endif
        GRID_SYNC();
#pragma unroll 1
        for (int hf = 0; hf < 2; ++hf) {
        { const Args a = fresh_args(); const int G = gridDim.x, bid = blockIdx.x;
          int kk = hf ? DFF : D; asm volatile("" : "+s"(kk));
          pg8::Gemm g{hf ? WSP(bf16_t, WS_Z) : WSP(bf16_t, WS_MG), hf ? WSP(bf16_t, WS_WDT) : WSP(bf16_t, WS_WOT), MROWS, D, kk}; pg8::StaticOrder S; S.init(MROWS, D, G, bid);
          pg8::EpiPlain8 E{WSP(bf16_t, WS_H), D};
          pg8::gemm_phase<pg8::EpiPlain8, pg8::StaticOrder, true, G8_SP2, true>(lds3, g, S, E, wid_s); }
        if (hf == 0) XSYNC(); else GRID_SYNC();
        if (hf == 0) {
        { const Args a = fresh_args(); FRESH(); const float* ng = a.norm_g + (size_t)l * 4 * D;
          const int rw0 = gridDim.x == 256u ? (int)(2048u * (blockIdx.x & 7u) + 64u * (blockIdx.x >> 3)) + 8 * wid : gw * 8, rwstep = gridDim.x == 256u ? MROWS : NGW * 8;
          for (int row = rw0; row < MROWS; row += rwstep) { const int b = row >> 13; const float* md = WSP(float, WS_MOD) + (size_t)(l * 2 + b) * NMOD;
            bf16_t* x1g = WSP(bf16_t, WS_G) + (size_t)row * D; bf16_t* h2 = FFN8 ? nullptr : WSP(bf16_t, WS_MG) + (size_t)row * D; const bf16_t* rawp = WSP(bf16_t, WS_H) + (size_t)row * D;
            unsigned char* h28 = WSP(unsigned char, WS_G) + 32 * MiB + (size_t)row * D;
            if (l == 0) row_pass8<true, true, false, true, FFN8 != 0>(a.x + (size_t)row * D, rawp, x1g, h2, h28, md + 2 * D, ng + 1 * D, ng + 2 * D, md + 4 * D, md + 3 * D, lane);
            else row_pass8<true, true, true, true, FFN8 != 0>((const bf16_t*)a.out + (size_t)row * D, rawp, x1g, h2, h28, md + 2 * D, ng + 1 * D, ng + 2 * D, md + 4 * D, md + 3 * D, lane); } }
        XSYNC();
        { const Args a = fresh_args(); const int G = gridDim.x, bid = blockIdx.x;
          pg8::Gemm g{(const bf16_t*)(a.ws + WS_G + 32 * MiB), WSP(bf16_t, WS_WGU), MROWS, NGU, D}; pg8::StaticOrder S; S.init(MROWS, NGU, G, bid);
          pg8::EpiSwiglu8<DOWN8 != 0> E{WSP(bf16_t, WS_Z)};
          pg8::gemm_phase<pg8::EpiSwiglu8<DOWN8 != 0>, pg8::StaticOrder, true, G8_SP2, true>(lds3, g, S, E, wid_s); }
        XSYNC();
        }
        }
    }
}

extern "C" void kernel_launch(void* const* d_in, const int* in_sizes, int n_in, void* d_out, int out_size, void* d_ws, size_t ws_size, hipStream_t stream) {
    static int grid = 0;
    if (grid == 0) {
        if (n_in != 14 || out_size != MROWS * D || ws_size < WS_END) { fprintf(stderr, "kernel_launch: unexpected shapes (n_in %d out %d ws %zu)\n", n_in, out_size, ws_size); grid = -1; return; }
        int dev = 0, cus = 0, per_cu = 0;
        (void)hipGetDevice(&dev);
        (void)hipDeviceGetAttribute(&cus, hipDeviceAttributeMultiprocessorCount, dev);
        (void)hipFuncSetAttribute((const void*)mega, hipFuncAttributeMaxDynamicSharedMemorySize, LDS_BYTES);
        (void)hipOccupancyMaxActiveBlocksPerMultiprocessor(&per_cu, (const void*)mega, 512, LDS_BYTES);
        if (per_cu < 1) { fprintf(stderr, "kernel_launch: occupancy query says 0 blocks per CU\n"); per_cu = 1; }
        grid = cus;
        (void)hipGetLastError();
    }
    if (grid < 0) return;
    if (hipMemsetAsync(d_ws, 0, 65536, stream) != hipSuccess) { fprintf(stderr, "kernel_launch: memset failed\n"); return; }
    Args a{};
    const float** pp = (const float**)&a;
    for (int i = 0; i < 14; ++i) pp[i] = (const float*)d_in[i];
    a.out = (float*)d_out; a.ws = (unsigned char*)d_ws;
    void* args[] = {&a};
    hipError_t e = hipLaunchCooperativeKernel((const void*)mega, dim3(grid), dim3(512), args, LDS_BYTES, stream);
    if (e != hipSuccess) fprintf(stderr, "cooperative launch failed: %s (grid %d)\n", hipGetErrorString(e), grid);
}
```
